# Optimizing an MI355X kernel written in HIP

```python
import jax, jax.numpy as jnp
from jax import lax
import numpy as np

D_MODEL = 1024
BATCH = 2
SEQ = 16384
DEPTH = 2

CHUNK = 64

SB_HEAD_DIM = 64
SB_HEADS = 4
SB_WIDTH = SB_HEADS * SB_HEAD_DIM
Q_BLOCK = 128
SUB = 32

POOL_WINDOWS = (2, 4, 8, 16)
POOL_GROUPS = len(POOL_WINDOWS)
POOL_WIDTH = D_MODEL - SB_WIDTH
POOL_GROUP_DIM = POOL_WIDTH // POOL_GROUPS

N_BRANCHES = 2
IN_WIDTH = 3 * SB_WIDTH + POOL_WIDTH + N_BRANCHES * D_MODEL

N_EXPERTS = 32
TOP_K = 4
D_EXPERT = D_MODEL
SWIGLU_LIMIT = 7.0
SWIGLU_ALPHA = 1.702
EXPERT_BLOCK = 256

NORM_EPS = 1e-6

kernel_name = "hybrid_stickbreak_pool_moe_encoder"


def rmsnorm(x, g):
    xf = x.astype(jnp.float32)
    r = lax.rsqrt(jnp.mean(xf * xf, axis=-1, keepdims=True) + NORM_EPS)
    return (xf * r * g.astype(jnp.float32)).astype(x.dtype)


def stick_breaking_attention(q, k, v):
    B, S, H, hd = q.shape
    qf = q.astype(jnp.float32) * (1.0 / np.sqrt(hd).astype(np.float32))
    kf = k.astype(jnp.float32)
    vf = v.astype(jnp.float32)
    tri_incl = jnp.tri(SUB, dtype=jnp.float32)
    outs = []
    for i in range(S // Q_BLOCK):
        n_k = (i + 1) * Q_BLOCK
        n_sub = n_k // SUB
        qb = qf[:, i * Q_BLOCK:(i + 1) * Q_BLOCK]
        kb = kf[:, :n_k]
        vb = vf[:, :n_k]
        z = jnp.einsum('bqhd,bkhd->bhqk', qb, kb)
        qpos = i * Q_BLOCK + jnp.arange(Q_BLOCK)
        mask = jnp.arange(n_k)[None, :] < qpos[:, None]
        log_keep = jnp.where(mask, jax.nn.log_sigmoid(-z), 0.0)
        lr = log_keep.reshape(B, H, Q_BLOCK, n_sub, SUB)
        r_in = jnp.einsum('bhqnj,jk->bhqnk', lr, tri_incl)
        after = jnp.einsum('bhqn,nm->bhqm', lr.sum(-1), jnp.tri(n_sub, k=-1, dtype=jnp.float32))
        log_a = z + (r_in + after[..., None]).reshape(B, H, Q_BLOCK, n_k)
        a = jnp.exp(jnp.where(mask, log_a, -jnp.inf))
        outs.append(jnp.einsum('bhqk,bkhd->bqhd', a, vb))
    o = jnp.concatenate(outs, axis=1)
    return o.reshape(B, S, H * hd)


def multi_scale_pool(u, pool_w, pool_b, pool_scale):
    B, S, G, Cg = u.shape
    uf = u.astype(jnp.float32)
    cs0 = jnp.concatenate([jnp.zeros((B, 1, G, Cg), jnp.float32), jnp.cumsum(uf, axis=1)], axis=1)
    t1 = jnp.arange(1, S + 1).astype(jnp.float32)
    outs = []
    for g, w in enumerate(POOL_WINDOWS):
        cg = cs0[:, :, g]
        lo = jnp.pad(cg[:, :S - w + 1], ((0, 0), (w - 1, 0), (0, 0)))
        mean = (cg[:, 1:] - lo) / jnp.minimum(t1, float(w))[None, :, None]
        outs.append(mean - uf[:, :, g])
    mixed = jnp.stack(outs, axis=2)
    y = jnp.einsum('bsgc,gcd->bsgd', mixed, pool_w.astype(jnp.float32)) + pool_b.astype(jnp.float32)
    y = y * pool_scale.astype(jnp.float32)
    return y.reshape(B, S, G * Cg)


def hybrid_mixer(h, w_in, pool_w, pool_b, pool_scale, w_br_attn, w_br_pool, w_out):
    B, S, _ = h.shape
    p = h @ w_in
    q, k, v, u, g = jnp.split(p, [SB_WIDTH, 2 * SB_WIDTH, 3 * SB_WIDTH, 3 * SB_WIDTH + POOL_WIDTH], axis=-1)
    shp = (B, S, SB_HEADS, SB_HEAD_DIM)
    attn = stick_breaking_attention(q.reshape(shp), k.reshape(shp), v.reshape(shp)).astype(h.dtype)
    pool = multi_scale_pool(u.reshape(B, S, POOL_GROUPS, POOL_GROUP_DIM), pool_w, pool_b, pool_scale).astype(h.dtype)
    g_attn, g_pool = jnp.split(jax.nn.sigmoid(g), N_BRANCHES, axis=-1)
    merged = g_attn * (attn @ w_br_attn) + g_pool * (pool @ w_br_pool)
    return merged @ w_out


def moe(h, router_w, router_b, w_gu, b_gu, w_dn, b_dn):
    B, S, D = h.shape
    T = B * S
    xt = h.reshape(T, D)
    logits = (xt @ router_w + router_b).astype(jnp.float32)
    top_v, top_i = lax.top_k(logits, TOP_K)
    gates = jax.nn.softmax(top_v, axis=-1)
    e_flat = top_i.reshape(-1)
    g_flat = gates.reshape(-1)
    tok_flat = jnp.repeat(jnp.arange(T, dtype=jnp.int32), TOP_K)
    order = jnp.argsort(e_flat)
    e_sorted = e_flat[order]
    counts = jnp.bincount(e_flat, length=N_EXPERTS)
    padded = ((counts + EXPERT_BLOCK - 1) // EXPERT_BLOCK) * EXPERT_BLOCK
    start = jnp.cumsum(counts) - counts
    pend = jnp.cumsum(padded)
    pstart = pend - padded
    rank = jnp.arange(T * TOP_K) - start[e_sorted]
    dest = pstart[e_sorted] + rank
    n_rows = T * TOP_K + N_EXPERTS * EXPERT_BLOCK
    n_blocks = n_rows // EXPERT_BLOCK
    row_tok = jnp.zeros((n_rows,), jnp.int32).at[dest].set(tok_flat[order])
    row_gate = jnp.zeros((n_rows,), jnp.float32).at[dest].set(g_flat[order])
    block_e = jnp.minimum(jnp.searchsorted(pend, jnp.arange(n_blocks) * EXPERT_BLOCK, side='right'), N_EXPERTS - 1)
    xr = xt[row_tok].reshape(n_blocks, EXPERT_BLOCK, D)

    def expert_block(args):
        xb, e = args
        gu = xb @ w_gu[e] + b_gu[e]
        gate, up = jnp.split(gu, 2, axis=-1)
        gate = jnp.minimum(gate, SWIGLU_LIMIT)
        up = jnp.clip(up, -SWIGLU_LIMIT, SWIGLU_LIMIT)
        act = (up + 1.0) * gate * jax.nn.sigmoid(SWIGLU_ALPHA * gate)
        return act @ w_dn[e] + b_dn[e]

    yr = lax.map(expert_block, (xr, block_e)).reshape(n_rows, D)
    y = jax.ops.segment_sum(yr.astype(jnp.float32) * row_gate[:, None], row_tok, num_segments=T)
    return y.reshape(B, S, D).astype(h.dtype)


def setup_inputs(seed: int = 0) -> dict:
    key = jax.random.key(seed)
    ks = jax.random.split(key, 24)
    L, D = DEPTH, D_MODEL

    def nrm(k, shape, scale):
        return jax.random.normal(k, shape, jnp.float32) * scale

    return {
        "x": nrm(ks[0], (BATCH, SEQ, D), 1.0),
        "c": nrm(ks[1], (BATCH, D), 1.0),
        "ada_w": nrm(ks[2], (L, D, 6 * D), 0.5 * D ** -0.5),
        "ada_b": nrm(ks[3], (L, 6 * D), 0.01),
        "pre1_g": 1.0 + nrm(ks[4], (L, D), 0.05),
        "post1_g": 1.0 + nrm(ks[5], (L, D), 0.05),
        "pre2_g": 1.0 + nrm(ks[6], (L, D), 0.05),
        "post2_g": 1.0 + nrm(ks[7], (L, D), 0.05),
        "w_in": nrm(ks[8], (L, D, IN_WIDTH), D ** -0.5),
        "pool_w": nrm(ks[9], (L, POOL_GROUPS, POOL_GROUP_DIM, POOL_GROUP_DIM), POOL_GROUP_DIM ** -0.5),
        "pool_b": nrm(ks[10], (L, POOL_GROUPS, POOL_GROUP_DIM), 0.01),
        "pool_scale": 1.0 + nrm(ks[11], (L, POOL_GROUPS, POOL_GROUP_DIM), 0.1),
        "w_br_attn": nrm(ks[12], (L, SB_WIDTH, D), SB_WIDTH ** -0.5),
        "w_br_pool": nrm(ks[13], (L, POOL_WIDTH, D), POOL_WIDTH ** -0.5),
        "w_out": nrm(ks[14], (L, D, D), D ** -0.5),
        "router_w": nrm(ks[15], (L, D, N_EXPERTS), D ** -0.5),
        "router_b": nrm(ks[16], (L, N_EXPERTS), 0.01),
        "w_gu": nrm(ks[17], (L, N_EXPERTS, D, 2 * D_EXPERT), D ** -0.5),
        "b_gu": nrm(ks[18], (L, N_EXPERTS, 2 * D_EXPERT), 0.01),
        "w_dn": nrm(ks[19], (L, N_EXPERTS, D_EXPERT, D), D_EXPERT ** -0.5),
        "b_dn": nrm(ks[20], (L, N_EXPERTS, D), 0.01),
    }


def reference(x, c, ada_w, ada_b, pre1_g, post1_g, pre2_g, post2_g, w_in, pool_w, pool_b, pool_scale,
              w_br_attn, w_br_pool, w_out, router_w, router_b, w_gu, b_gu, w_dn, b_dn):
    c_act = jax.nn.silu(c)
    for l in range(DEPTH):
        mod = (c_act @ ada_w[l] + ada_b[l])[:, None, :]
        shift1, scale1, gate1, shift2, scale2, gate2 = jnp.split(mod, 6, axis=-1)
        h = rmsnorm(x, pre1_g[l]) * (1.0 + scale1) + shift1
        y = hybrid_mixer(h, w_in[l], pool_w[l], pool_b[l], pool_scale[l], w_br_attn[l], w_br_pool[l], w_out[l])
        x = x + gate1 * rmsnorm(y, post1_g[l])
        h = rmsnorm(x, pre2_g[l]) * (1.0 + scale2) + shift2
        y = moe(h, router_w[l], router_b[l], w_gu[l], b_gu[l], w_dn[l], b_dn[l])
        x = x + gate2 * rmsnorm(y, post2_g[l])
    return x
```

```cpp
#include <hip/hip_runtime.h>
#include <cstdio>
#include <cstdint>

#ifndef N_LAUNCHES
#define N_LAUNCHES 0
#endif
#ifndef FAST_GEMM
#define FAST_GEMM 0
#endif

#define LAS __attribute__((address_space(3)))
#define GAS __attribute__((address_space(1)))
typedef unsigned short bf16_t;
typedef short bf16x8 __attribute__((ext_vector_type(8)));
typedef short s16x4 __attribute__((ext_vector_type(4)));
typedef float f32x4 __attribute__((ext_vector_type(4)));
typedef float f32x2 __attribute__((ext_vector_type(2)));
typedef float f32x16 __attribute__((ext_vector_type(16)));
typedef unsigned u32x4 __attribute__((ext_vector_type(4)));
typedef unsigned u32x2 __attribute__((ext_vector_type(2)));

constexpr int D = 1024, BATCH = 2, SEQ = 16384, T = BATCH * SEQ, DEPTH = 2;
constexpr int SBW = 256, NH = 4, HD = 64, PW = 768, PGD = 192, INW = 3584;
constexpr int NE = 32, TOPK = 4;
constexpr float NORM_EPS = 1e-6f, SW_LIMIT = 7.0f, SW_ALPHA = 1.702f;
constexpr float STICK_EXIT = -40.0f;
constexpr int NWAVES = 8, NTHREADS = 512;
constexpr int MAXTILES = (T * TOPK) / 256 + NE;

constexpr size_t MiB = 1u << 20;
constexpr size_t WS_CTL = 0, CTL_ZERO_BYTES = 1 * MiB;
constexpr size_t WS_MOD = 1 * MiB;
constexpr size_t WS_W = 2 * MiB, WL_STRIDE = 205 * MiB;
constexpr size_t WO_WIN = 0, WO_BRA = 7 * MiB, WO_BRP = 7 * MiB + MiB / 2, WO_OUT = 9 * MiB, WO_POOL = 11 * MiB, WO_ROUTER = 12 * MiB + MiB / 2, WO_GU = 13 * MiB, WO_DN = 141 * MiB;
constexpr size_t WS_H = 416 * MiB, WS_Q = 480 * MiB, WS_K = 496 * MiB, WS_VT = 512 * MiB, WS_U = 528 * MiB, WS_G = 576 * MiB;
constexpr size_t WS_AP = 704 * MiB, WS_MIX = 768 * MiB, WS_MRG = 816 * MiB, WS_Y = 880 * MiB;
constexpr size_t WS_TOPE = 944 * MiB, WS_TOPS = 944 * MiB + MiB / 2, WS_ROWTOK = 946 * MiB, WS_ROWGATE = 950 * MiB;
constexpr size_t WS_ACT = 960 * MiB, WS_YR = 1232 * MiB, WS_END = 1504 * MiB;
static_assert(WO_DN + (size_t)NE * D * D * 2 <= WL_STRIDE && WS_W + DEPTH * WL_STRIDE <= WS_H, "weights map");
static_assert(WS_ACT + (size_t)MAXTILES * 256 * D * 2 <= WS_YR && WS_YR + (size_t)MAXTILES * 256 * D * 2 <= WS_END, "act map");
constexpr int CW_BAR = 4096, CW_CNT = 8192;

constexpr int RING_BYTES = 131072, LDSCTL_OFF = RING_BYTES, LDS_BYTES = 147456;
constexpr int MISC_BAR = 8;
constexpr int MISC_TB = 64, MISC_CNT = 128;

__device__ __forceinline__ unsigned f2bf(float f) { unsigned u = __builtin_bit_cast(unsigned, f); return (u + 0x7fffu + ((u >> 16) & 1u)) >> 16; }
__device__ __forceinline__ unsigned pk2(float lo, float hi) { return f2bf(lo) | (f2bf(hi) << 16); }
__device__ __forceinline__ float bf_lo(unsigned w) { return __builtin_bit_cast(float, w << 16); }
__device__ __forceinline__ float bf_hi(unsigned w) { return __builtin_bit_cast(float, w & 0xffff0000u); }
__device__ __forceinline__ float fast_exp(float x) { return __builtin_amdgcn_exp2f(x * 1.4426950408889634f); }
__device__ __forceinline__ float fast_sigmoid(float x) { return __builtin_amdgcn_rcpf(1.0f + fast_exp(-x)); }
__device__ __forceinline__ float softplus_f(float z) { return fmaxf(z, 0.f) + 0.6931471805599453f * __builtin_amdgcn_logf(1.0f + fast_exp(-fabsf(z))); }
__device__ __forceinline__ float wave_sum(float v) {
#pragma unroll
    for (int o = 1; o < 64; o <<= 1) v += __shfl_xor(v, o);
    return v;
}
__device__ __forceinline__ int launder_v(int x) { asm volatile("" : "+v"(x)); return x; }
#define LDS_WAIT() asm volatile("s_waitcnt lgkmcnt(0)" ::: "memory")
#define VM_WAIT() asm volatile("s_waitcnt vmcnt(0)" ::: "memory")

#define XB_TMO      128
#define XB_XCNT(j)  (256  + 64 * (j))
#define XB_XSUB(j)  (1280 + 64 * (j))
#define XB_XGEN(j)  (2304 + 64 * (j))
#define XB_TOP      3328
#define XB_TOPGEN   3392
#define XCD_BAR_WORDS 3456
#define XB_SPIN_CAP (1u << 18)
__device__ __forceinline__ unsigned xb_ld(unsigned* p)              { return __hip_atomic_load(p, __ATOMIC_RELAXED, __HIP_MEMORY_SCOPE_AGENT); }
__device__ __forceinline__ unsigned xb_add(unsigned* p, unsigned v) { return __hip_atomic_fetch_add(p, v, __ATOMIC_RELAXED, __HIP_MEMORY_SCOPE_AGENT); }
__device__ __forceinline__ unsigned xb_xcc_id() { return (unsigned)__builtin_amdgcn_s_getreg((3 << 11) | 20) & 0xFu; }
#define XB_SPIN(cond, bar) do { unsigned _sp = 0; while (cond) { __builtin_amdgcn_s_sleep(1); \
    if ((++_sp & 255u) == 0u) { if (xb_ld(&(bar)[XB_TMO])) break; if (_sp > XB_SPIN_CAP) { atomicAdd(&(bar)[XB_TMO], 1u); break; } } } } while (0)
struct XcdBarrier { unsigned* bar; unsigned x; volatile LAS unsigned* st; };
__device__ __forceinline__ XcdBarrier xcd_barrier_post(unsigned* bar, volatile LAS unsigned* st) {
    XcdBarrier b; b.bar = bar; b.x = xb_xcc_id(); b.st = st;
    if (threadIdx.x == 0) (void)xb_add(&bar[XB_XCNT(b.x)], 1u);
    return b;
}
__device__ __forceinline__ void xcd_barrier_complete(unsigned* bar, unsigned x, unsigned& nloc, unsigned& nx) {
    const unsigned G = gridDim.x * gridDim.y * gridDim.z;
    unsigned sum, cnt, mine, sp = 0u;
    for (;;) {
        sum = 0u; cnt = 0u; mine = 0u;
#pragma unroll
        for (unsigned j = 0; j < 16; ++j) { const unsigned c = xb_ld(&bar[XB_XCNT(j)]); sum += c; cnt += (c > 0u) ? 1u : 0u; mine = (j == x) ? c : mine; }
        if (sum == G) break;
        __builtin_amdgcn_s_sleep(1);
        if ((++sp & 255u) == 0u) { if (xb_ld(&bar[XB_TMO])) break; if (sp > XB_SPIN_CAP) { atomicAdd(&bar[XB_TMO], 1u); break; } }
    }
    nloc = mine > 0u ? mine : 1u; nx = cnt > 0u ? cnt : 1u;
}
__device__ __forceinline__ void xcd_barrier(const XcdBarrier& b) {
    asm volatile("s_waitcnt vmcnt(0)" ::: "memory");
    __syncthreads();
    if (threadIdx.x == 0) {
        unsigned* bar = b.bar;
        __builtin_amdgcn_s_waitcnt(0);
        unsigned nloc = b.st[0], nx = b.st[1];
        if (nloc == 0u) { xcd_barrier_complete(bar, b.x, nloc, nx); b.st[0] = nloc; b.st[1] = nx; }
        const unsigned old = xb_add(&bar[XB_XSUB(b.x)], 1u);
        const unsigned gen = old / nloc;
        if (old + 1u == (gen + 1u) * nloc) {
            __builtin_amdgcn_fence(__ATOMIC_RELEASE, "agent");
            asm volatile("s_waitcnt vmcnt(0)" ::: "memory");
            const unsigned og = xb_add(&bar[XB_TOP], 1u);
            const unsigned tg = og / nx;
            if (og + 1u == (tg + 1u) * nx) xb_add(&bar[XB_TOPGEN], 1u);
            else XB_SPIN(xb_ld(&bar[XB_TOPGEN]) == tg, bar);
            __builtin_amdgcn_fence(__ATOMIC_ACQUIRE, "agent");
            xb_add(&bar[XB_XGEN(b.x)], 1u);
            asm volatile("s_waitcnt vmcnt(0)" ::: "memory");
        } else {
            XB_SPIN(xb_ld(&bar[XB_XGEN(b.x)]) == gen, bar);
            __builtin_amdgcn_fence(__ATOMIC_ACQUIRE, "agent");
            asm volatile("s_waitcnt vmcnt(0)" ::: "memory");
        }
    }
    __syncthreads();
}

namespace pg8 {
constexpr int BM = 256, BK = 64, HALF = 128, HTB = HALF * BK * 2, STAGE_BYTES = 8 * HTB, NXCD = 8, WGM = 8;
__host__ __device__ __forceinline__ int lds_byte(int r, int c) { const int st = (r >> 4) * 2 + (c >> 5), rr = r & 15, cc = c & 31, ob = rr * 64 + cc * 2; return st * 1024 + (ob ^ (((ob >> 9) & 1) << 5)); }
__host__ __device__ __forceinline__ void stage_rc(int b, int& R, int& C) { const int st = b / 1024, sb = b % 1024, swz = sb ^ (((sb >> 9) & 1) << 5); R = (st >> 1) * 16 + swz / 64; C = (st & 1) * 32 + (swz % 64) / 2; }
__host__ __device__ __forceinline__ int perm32(int rho) { const int n = rho >> 4, i = rho & 15; return 8 * (i >> 2) + 4 * n + (i & 3); }

struct Unit { int pm, pn, e, nvalid, slot0; unsigned aoff, boff; };
struct Gemm { const bf16_t* A; const bf16_t* Bt; int lda, ldb, K; const int* gather; };

__device__ __forceinline__ bool order_unit(int i, int G, int c, int nM, int nN, int& pm, int& pn) {
    const int nwg = nM * nN; const long L = (long)i * G + c; if (L >= nwg) return false;
    int wgid = (int)L; { const int q = nwg / NXCD, r = nwg % NXCD, xcd = wgid % NXCD, off = wgid / NXCD; wgid = (xcd < r ? xcd * (q + 1) : r * (q + 1) + (xcd - r) * q) + off; }
    const int nig = WGM * nN, gid = wgid / nig, fm = gid * WGM, gsz = (nM - fm) < WGM ? (nM - fm) : WGM;
    pm = fm + ((wgid % nig) % gsz); pn = (wgid % nig) / gsz; return true;
}
struct StaticOrder {
    int nM, nN, G, c, lda, ldb, kstride;
    __device__ __forceinline__ bool next(int i, Unit& u) const {
        if (!order_unit(i, G, c, nM, nN, u.pm, u.pn)) return false;
        u.e = 0; u.nvalid = 256; u.slot0 = 0;
        u.aoff = (unsigned)(u.pm * BM) * (unsigned)lda + (unsigned)(kstride * u.pn); u.boff = (unsigned)(u.pn * BM) * (unsigned)ldb + (unsigned)(kstride * u.pn); return true;
    }
};
struct MoeOrder {
    const volatile LAS int* tb; const volatile LAS int* cnt; int nN, G, c, nw;
    __device__ __forceinline__ bool next(int i, Unit& u) const {
        const int nM = tb[NE];
        if (!order_unit(i, G, c, nM, nN, u.pm, u.pn)) return false;
        int e = 0;
#pragma unroll 1
        for (int j = 1; j < NE; ++j) e += (tb[j] <= u.pm) ? 1 : 0;
        u.e = e; u.slot0 = (u.pm - tb[e]) * BM; const int left = cnt[e] - u.slot0; u.nvalid = left < BM ? left : BM;
        u.aoff = (unsigned)(u.pm * BM) * (unsigned)D; u.boff = ((unsigned)e * (unsigned)nw + (unsigned)(u.pn * BM)) * (unsigned)D; return true;
    }
};

__device__ __forceinline__ unsigned cvt_pk_bf16(float lo, float hi) { unsigned r; asm volatile("v_cvt_pk_bf16_f32 %0, %1, %2" : "=v"(r) : "v"(lo), "v"(hi)); return r; }
__device__ __forceinline__ u32x4 pack8(const f32x4 a, const f32x4 b) { u32x4 w; w.x = cvt_pk_bf16(a[0], a[1]); w.y = cvt_pk_bf16(a[2], a[3]); w.z = cvt_pk_bf16(b[0], b[1]); w.w = cvt_pk_bf16(b[2], b[3]); return w; }
__device__ __forceinline__ void unpack8(const u32x4 w, f32x4& a, f32x4& b) { a = (f32x4){bf_lo(w.x), bf_hi(w.x), bf_lo(w.y), bf_hi(w.y)}; b = (f32x4){bf_lo(w.z), bf_hi(w.z), bf_lo(w.w), bf_hi(w.w)}; }

#define EPI_LOOP_ROWS for (int ai = 0; ai < 2; ++ai) _Pragma("unroll") for (int m = 0; m < 4; ++m)
struct EpiIn {
    static constexpr bool PERM = true;
    bf16_t *Q, *KB, *U, *G;
    __device__ __forceinline__ void operator()(const f32x4 (&acc)[2][2][4][2], const Unit& u, int wr, int wc, int fr, int fq) const {
        const int pn = u.pn; bf16_t* base; int ld, c0, mode;
        if (pn == 0) { base = Q; ld = SBW; c0 = 0; mode = 1; } else if (pn == 1) { base = KB; ld = SBW; c0 = 0; mode = 0; }
        else if (pn < 5) { base = U; ld = PW; c0 = (pn - 2) * BM; mode = 0; } else { base = G; ld = 2 * D; c0 = (pn - 5) * BM; mode = 2; }
        const int row0 = u.pm * BM + wr * 64 + fr, col0 = c0 + wc * 32 + 8 * fq;
#pragma unroll
        EPI_LOOP_ROWS { bf16_t* rowp = base + (size_t)(row0 + ai * HALF + m * 16) * ld + col0;
#pragma unroll
            for (int bj = 0; bj < 2; ++bj) { f32x4 v0 = acc[ai][bj][m][0], v1 = acc[ai][bj][m][1];
                if (mode == 1) { v0 = v0 * 0.125f; v1 = v1 * 0.125f; }
                if (mode == 2) {
#pragma unroll
                    for (int j = 0; j < 4; ++j) { v0[j] = fast_sigmoid(v0[j]); v1[j] = fast_sigmoid(v1[j]); } }
                *(u32x4*)(rowp + bj * HALF) = pack8(v0, v1); } }
    }
};
struct EpiPlain {
    static constexpr bool PERM = true;
    bf16_t* O; int ldc, coff; const float* bias; const float* scale;
    __device__ __forceinline__ void operator()(const f32x4 (&acc)[2][2][4][2], const Unit& u, int wr, int wc, int fr, int fq) const {
        const int row0 = u.pm * BM + wr * 64 + fr, col0 = u.pn * BM + wc * 32 + 8 * fq;
        f32x4 bv[2][2], sv[2][2];
#pragma unroll
        for (int bj = 0; bj < 2; ++bj)
#pragma unroll
            for (int n = 0; n < 2; ++n) { bv[bj][n] = bias ? *(const f32x4*)(bias + col0 + bj * HALF + 4 * n) : (f32x4){0.f, 0.f, 0.f, 0.f};
                                          sv[bj][n] = scale ? *(const f32x4*)(scale + col0 + bj * HALF + 4 * n) : (f32x4){1.f, 1.f, 1.f, 1.f}; }
#pragma unroll
        EPI_LOOP_ROWS { bf16_t* rowp = O + (size_t)(row0 + ai * HALF + m * 16) * ldc + coff + col0;
#pragma unroll
            for (int bj = 0; bj < 2; ++bj) *(u32x4*)(rowp + bj * HALF) = pack8((acc[ai][bj][m][0] + bv[bj][0]) * sv[bj][0], (acc[ai][bj][m][1] + bv[bj][1]) * sv[bj][1]); }
    }
};
template <bool ADD> struct EpiBranch {
    static constexpr bool PERM = true;
    bf16_t* MRG; const bf16_t* G; int goff;
    __device__ __forceinline__ void operator()(const f32x4 (&acc)[2][2][4][2], const Unit& u, int wr, int wc, int fr, int fq) const {
        const int row0 = u.pm * BM + wr * 64 + fr, col0 = u.pn * BM + wc * 32 + 8 * fq;
#pragma unroll
        EPI_LOOP_ROWS { const size_t r = (size_t)(row0 + ai * HALF + m * 16);
#pragma unroll
            for (int bj = 0; bj < 2; ++bj) { const int c = col0 + bj * HALF;
                f32x4 g0, g1; unpack8(*(const u32x4*)(G + r * (2 * D) + goff + c), g0, g1);
                f32x4 v0 = g0 * acc[ai][bj][m][0], v1 = g1 * acc[ai][bj][m][1];
                if (ADD) { f32x4 p0, p1; unpack8(*(const u32x4*)(MRG + r * D + c), p0, p1); v0 = v0 + p0; v1 = v1 + p1; }
                *(u32x4*)(MRG + r * D + c) = pack8(v0, v1); } }
    }
};
struct EpiGU {
    static constexpr bool PERM = true;
    bf16_t* ACT; const float* bgu;
    __device__ __forceinline__ void operator()(const f32x4 (&acc)[2][2][4][2], const Unit& u, int wr, int wc, int fr, int fq) const {
        const int row0 = u.pm * BM + wr * 64 + fr, col0 = u.pn * HALF + wc * 32 + 8 * fq;
        const float* bg = bgu + (size_t)u.e * (2 * D) + col0;
        f32x4 bgv[2], buv[2];
#pragma unroll
        for (int n = 0; n < 2; ++n) { bgv[n] = *(const f32x4*)(bg + 4 * n); buv[n] = *(const f32x4*)(bg + D + 4 * n); }
#pragma unroll
        EPI_LOOP_ROWS { f32x4 o[2];
#pragma unroll
            for (int n = 0; n < 2; ++n) { f32x4 gt = acc[ai][0][m][n] + bgv[n], up = acc[ai][1][m][n] + buv[n];
#pragma unroll
                for (int j = 0; j < 4; ++j) { const float g = fminf(gt[j], SW_LIMIT), uu = fminf(fmaxf(up[j], -SW_LIMIT), SW_LIMIT); o[n][j] = (uu + 1.0f) * g * fast_sigmoid(SW_ALPHA * g); } }
            *(u32x4*)(ACT + (size_t)(row0 + ai * HALF + m * 16) * D + col0) = pack8(o[0], o[1]); }
    }
};
struct EpiDN {
    static constexpr bool PERM = true;
    bf16_t* YR; const float* bdn; const float* rowgate;
    __device__ __forceinline__ void operator()(const f32x4 (&acc)[2][2][4][2], const Unit& u, int wr, int wc, int fr, int fq) const {
        const int rl0 = wr * 64 + fr, col0 = u.pn * BM + wc * 32 + 8 * fq;
        const float* bp = bdn + (size_t)u.e * D + col0; const float* gp = rowgate + (size_t)u.e * T + u.slot0;
        f32x4 bv[2][2];
#pragma unroll
        for (int bj = 0; bj < 2; ++bj)
#pragma unroll
            for (int n = 0; n < 2; ++n) bv[bj][n] = *(const f32x4*)(bp + bj * HALF + 4 * n);
#pragma unroll
        EPI_LOOP_ROWS { const int rl = rl0 + ai * HALF + m * 16; const float gt = rl < u.nvalid ? gp[rl] : 0.f;
            bf16_t* rowp = YR + (size_t)(u.pm * BM + rl) * D + col0;
#pragma unroll
            for (int bj = 0; bj < 2; ++bj) *(u32x4*)(rowp + bj * HALF) = pack8((acc[ai][bj][m][0] + bv[bj][0]) * gt, (acc[ai][bj][m][1] + bv[bj][1]) * gt); }
    }
};

template <class Epi, class Sched>
__device__ __forceinline__ void gemm_simple(const Gemm g, const Sched& S, const Epi& E) {
    const int tid = launder_v((int)threadIdx.x), wid = __builtin_amdgcn_readfirstlane(tid >> 6), lane = tid & 63, wr = wid >> 2, wc = wid & 3, fr = lane & 15, fq = lane >> 4;
    Unit u;
    for (int ui = 0; S.next(ui, u); ++ui) {
        f32x4 acc[2][2][4][2];
#pragma unroll
        for (int a = 0; a < 2; ++a)
#pragma unroll
            for (int b = 0; b < 2; ++b)
#pragma unroll
                for (int m = 0; m < 4; ++m)
#pragma unroll
                    for (int n = 0; n < 2; ++n) acc[a][b][m][n] = (f32x4){0.f, 0.f, 0.f, 0.f};
        unsigned ao[2][4], bo[2][2];
#pragma unroll
        for (int ai = 0; ai < 2; ++ai)
#pragma unroll
            for (int m = 0; m < 4; ++m) { const int rl = ai * HALF + wr * 64 + m * 16 + fr;
                if (g.gather) { const int tok = rl < u.nvalid ? g.gather[(size_t)u.e * T + u.slot0 + rl] : 0; ao[ai][m] = (unsigned)tok * (unsigned)g.lda + fq * 8; }
                else ao[ai][m] = u.aoff + (unsigned)rl * (unsigned)g.lda + fq * 8; }
#pragma unroll
        for (int bj = 0; bj < 2; ++bj)
#pragma unroll
            for (int n = 0; n < 2; ++n) { const int slot = 16 * n + fr, brow = bj * HALF + wc * 32 + (Epi::PERM ? perm32(slot) : slot); bo[bj][n] = u.boff + (unsigned)brow * (unsigned)g.ldb + fq * 8; }
#pragma unroll 1
        for (int k = 0; k < g.K; k += 32) {
            bf16x8 b[2][2];
#pragma unroll
            for (int bj = 0; bj < 2; ++bj)
#pragma unroll
                for (int n = 0; n < 2; ++n) b[bj][n] = *(const bf16x8*)(g.Bt + (size_t)bo[bj][n] + k);
#pragma unroll
            for (int ai = 0; ai < 2; ++ai) {
                bf16x8 a[4];
#pragma unroll
                for (int m = 0; m < 4; ++m) a[m] = *(const bf16x8*)(g.A + (size_t)ao[ai][m] + k);
#pragma unroll
                for (int bj = 0; bj < 2; ++bj)
#pragma unroll
                    for (int m = 0; m < 4; ++m)
#pragma unroll
                        for (int n = 0; n < 2; ++n) acc[ai][bj][m][n] = __builtin_amdgcn_mfma_f32_16x16x32_bf16(b[bj][n], a[m], acc[ai][bj][m][n], 0, 0, 0);
            }
        }
        E(acc, u, wr, wc, fr, fq);
    }
}

template <class Epi, class Sched>
__device__ __forceinline__ void gemm_phase(LAS unsigned char* lds, const Gemm g, const Sched& S, const Epi& E) {
    gemm_simple<Epi, Sched>(g, S, E);
}
}

struct Frame {
    LAS unsigned char* lds;
    volatile LAS unsigned* MISC;
    unsigned* ctl;
    int tid, lane, wave, vcu, G;
};
struct Args { const float* in[21]; float* out; unsigned char* ws; int ph_lo, ph_hi; };
static_assert(sizeof(Args) == 21 * 8 + 8 + 8 + 8, "Args has no padding");

__device__ __forceinline__ void mods_phase(Frame& F, const float* c, const float* ada_w, const float* ada_b, float* MOD) {
    LAS float* cact = (LAS float*)F.lds;
    LAS float* part = (LAS float*)(F.lds + 8192);
    for (int i = F.tid; i < BATCH * D; i += NTHREADS) { const float v = c[i]; cact[i] = v * fast_sigmoid(v); }
    __syncthreads();
    constexpr int NTASK = DEPTH * (6 * D / 64);
    for (int task = F.vcu; task < NTASK; task += F.G) {
        const int l = task / (6 * D / 64), j0 = (task % (6 * D / 64)) * 64;
        const float* w = ada_w + (size_t)l * D * (6 * D) + j0 + F.lane;
        const int k0 = F.wave * 128;
        float a0 = 0.f, a1 = 0.f;
#pragma unroll 16
        for (int k = 0; k < 128; ++k) { const float wv = w[(size_t)(k0 + k) * (6 * D)]; a0 += cact[k0 + k] * wv; a1 += cact[D + k0 + k] * wv; }
        part[(F.wave * 2 + 0) * 64 + F.lane] = a0; part[(F.wave * 2 + 1) * 64 + F.lane] = a1;
        __syncthreads();
        if (F.tid < 128) { const int b = F.tid >> 6, j = F.tid & 63; float s = 0.f;
#pragma unroll
            for (int w8 = 0; w8 < 8; ++w8) s += part[(w8 * 2 + b) * 64 + j];
            MOD[((size_t)l * BATCH + b) * (6 * D) + j0 + j] = s + ada_b[(size_t)l * (6 * D) + j0 + j]; }
        __syncthreads();
    }
}
__device__ __forceinline__ void tr_item(const float* W, int ldw, bf16_t* WT, int ldt, int k0, int n0, int drow0, int dcol0, LAS float* scr, int lane) {
#pragma unroll 8
    for (int i = 0; i < 32; ++i) { const int kk = 2 * i + (lane >> 5); scr[kk * 33 + (lane & 31)] = W[(size_t)(k0 + kk) * ldw + n0 + (lane & 31)]; }
    LDS_WAIT(); asm volatile("" ::: "memory");
    const int c = lane & 7;
#pragma unroll
    for (int j = 0; j < 4; ++j) { const int n = (lane >> 3) + 8 * j; const LAS float* s = scr + (8 * c) * 33 + n;
        u32x4 o; o.x = pk2(s[0 * 33], s[1 * 33]); o.y = pk2(s[2 * 33], s[3 * 33]); o.z = pk2(s[4 * 33], s[5 * 33]); o.w = pk2(s[6 * 33], s[7 * 33]);
        *(u32x4*)(WT + (size_t)(drow0 + n) * ldt + dcol0 + k0 + 8 * c) = o; }
    LDS_WAIT(); asm volatile("" ::: "memory");
}
__device__ __forceinline__ int win_drow(int n0) {
    if (n0 < 512) return n0; if (n0 < 768) return 3328 + (n0 - 512); if (n0 < 1536) return 512 + (n0 - 768); return 1280 + (n0 - 1536);
}
__device__ __forceinline__ void convert_phase(Frame& F, const Args& args) {
    LAS float* scr = (LAS float*)(F.lds + F.wave * 16384);
    const int gw = F.vcu * NWAVES + F.wave, NGW = F.G * NWAVES;
    constexpr int I_IN = 16 * 112, I_BRA = 4 * 32, I_BRP = 12 * 32, I_OUT = 16 * 32, I_RT = 16, I_PL = 4 * 3 * 6, I_GU = NE * 16 * 64, I_DN = NE * 16 * 32;
    constexpr int I_LAYER = I_IN + I_BRA + I_BRP + I_OUT + I_RT + I_PL + I_GU + I_DN;
    for (int it = gw; it < DEPTH * I_LAYER; it += NGW) {
        const int l = it / I_LAYER; int r = it % I_LAYER;
        unsigned char* wl = args.ws + WS_W + (size_t)l * WL_STRIDE;
        if (r < I_GU) { const int e = r / (16 * 64), q = r % (16 * 64), kb = q / 64, nb = q % 64, n0 = nb * 32, half = n0 / D, cc = n0 % D;
            tr_item(args.in[17] + ((size_t)l * NE + e) * D * (2 * D), 2 * D, (bf16_t*)(wl + WO_GU) + (size_t)e * (2 * D) * D, D, kb * 64, n0, (cc / 128) * 256 + half * 128 + (cc % 128), 0, scr, F.lane); continue; } r -= I_GU;
        if (r < I_DN) { const int e = r / (16 * 32), q = r % (16 * 32), kb = q / 32, nb = q % 32;
            tr_item(args.in[19] + ((size_t)l * NE + e) * D * D, D, (bf16_t*)(wl + WO_DN) + (size_t)e * D * D, D, kb * 64, nb * 32, nb * 32, 0, scr, F.lane); continue; } r -= I_DN;
        if (r < I_IN) { const int kb = r / 112, nb = r % 112;
            tr_item(args.in[8] + (size_t)l * D * INW, INW, (bf16_t*)(wl + WO_WIN), D, kb * 64, nb * 32, win_drow(nb * 32), 0, scr, F.lane); continue; } r -= I_IN;
        if (r < I_BRA) { const int kb = r / 32, nb = r % 32;
            tr_item(args.in[12] + (size_t)l * SBW * D, D, (bf16_t*)(wl + WO_BRA), SBW, kb * 64, nb * 32, nb * 32, 0, scr, F.lane); continue; } r -= I_BRA;
        if (r < I_BRP) { const int kb = r / 32, nb = r % 32;
            tr_item(args.in[13] + (size_t)l * PW * D, D, (bf16_t*)(wl + WO_BRP), PW, kb * 64, nb * 32, nb * 32, 0, scr, F.lane); continue; } r -= I_BRP;
        if (r < I_OUT) { const int kb = r / 32, nb = r % 32;
            tr_item(args.in[14] + (size_t)l * D * D, D, (bf16_t*)(wl + WO_OUT), D, kb * 64, nb * 32, nb * 32, 0, scr, F.lane); continue; } r -= I_OUT;
        if (r < I_RT) { tr_item(args.in[15] + (size_t)l * D * NE, NE, (bf16_t*)(wl + WO_ROUTER), D, r * 64, 0, 0, 0, scr, F.lane); continue; } r -= I_RT;
        { const int gidx = r / 18, q = r % 18, kb = q / 6, nb = q % 6;
            tr_item(args.in[9] + ((size_t)l * 4 + gidx) * PGD * PGD, PGD, (bf16_t*)(wl + WO_POOL), PW, kb * 64, nb * 32, gidx * PGD + nb * 32, gidx * PGD, scr, F.lane); }
    }
    for (int it = gw; it < DEPTH * PW; it += NGW) { const int l = it / PW, n = it % PW, gidx = n / PGD;
        bf16_t* rowp = (bf16_t*)(args.ws + WS_W + (size_t)l * WL_STRIDE + WO_POOL) + (size_t)n * PW;
        for (int ch = F.lane; ch < PW / 8; ch += 64) if (ch / (PGD / 8) != gidx) *(u32x4*)(rowp + ch * 8) = (u32x4){0u, 0u, 0u, 0u}; }
}

__device__ __forceinline__ void norm_mod_store(const f32x4 (&v)[4], const float* g, const float* sc, const float* sh, bf16_t* hrow, int lane) {
    float ss = 0.f;
#pragma unroll
    for (int j = 0; j < 4; ++j) ss += (v[j].x * v[j].x + v[j].y * v[j].y) + (v[j].z * v[j].z + v[j].w * v[j].w);
    const float r = 1.0f / sqrtf(wave_sum(ss) * (1.0f / D) + NORM_EPS);
#pragma unroll
    for (int j = 0; j < 4; ++j) { const int c = 4 * lane + 256 * j; const f32x4 gg = *(const f32x4*)(g + c), s1 = *(const f32x4*)(sc + c), s0 = *(const f32x4*)(sh + c);
        const f32x4 o = v[j] * r * gg * (s1 + 1.0f) + s0; u32x2 w; w.x = pk2(o.x, o.y); w.y = pk2(o.z, o.w); *(u32x2*)(hrow + c) = w; }
}
__device__ __forceinline__ void rowpass_pre(Frame& F, const float* x, const float* g, const float* MODl, bf16_t* H) {
    const int gw = F.vcu * NWAVES + F.wave, NGW = F.G * NWAVES;
    for (int row = gw; row < T; row += NGW) { const int b = row / SEQ; const float* mod = MODl + (size_t)b * 6 * D;
        f32x4 v[4];
#pragma unroll
        for (int j = 0; j < 4; ++j) v[j] = *(const f32x4*)(x + (size_t)row * D + 4 * F.lane + 256 * j);
        norm_mod_store(v, g, mod + 1 * D, mod + 0 * D, H + (size_t)row * D, F.lane); }
}
__device__ __forceinline__ void rowpass_mid(Frame& F, const float* xin, float* xout, const bf16_t* Y, const float* post_g, const float* pre2_g, const float* MODl, bf16_t* H) {
    const int gw = F.vcu * NWAVES + F.wave, NGW = F.G * NWAVES;
    for (int row = gw; row < T; row += NGW) { const int b = row / SEQ; const float* mod = MODl + (size_t)b * 6 * D;
        f32x4 v[4], y[4]; float ss = 0.f;
#pragma unroll
        for (int j = 0; j < 4; ++j) { const int c = 4 * F.lane + 256 * j; v[j] = *(const f32x4*)(xin + (size_t)row * D + c);
            const u32x2 w = *(const u32x2*)(Y + (size_t)row * D + c); y[j] = (f32x4){bf_lo(w.x), bf_hi(w.x), bf_lo(w.y), bf_hi(w.y)};
            ss += (y[j].x * y[j].x + y[j].y * y[j].y) + (y[j].z * y[j].z + y[j].w * y[j].w); }
        const float r = 1.0f / sqrtf(wave_sum(ss) * (1.0f / D) + NORM_EPS);
#pragma unroll
        for (int j = 0; j < 4; ++j) { const int c = 4 * F.lane + 256 * j; const f32x4 pg = *(const f32x4*)(post_g + c), g1 = *(const f32x4*)(mod + 2 * D + c);
            v[j] = v[j] + g1 * (y[j] * r * pg); *(f32x4*)(xout + (size_t)row * D + c) = v[j]; }
        norm_mod_store(v, pre2_g, mod + 4 * D, mod + 3 * D, H + (size_t)row * D, F.lane); }
}
__device__ __forceinline__ void rowpass_comb(Frame& F, float* x, const bf16_t* YR, const int* TOPE, const int* TOPS, const float* post_g, const float* MODl,
                                             bool has_next, const float* pre1_g_next, const float* MODn, bf16_t* H) {
    const int gw = F.vcu * NWAVES + F.wave, NGW = F.G * NWAVES;
    const volatile LAS int* tb = (const volatile LAS int*)(F.MISC + MISC_TB);
    for (int row = gw; row < T; row += NGW) { const int b = row / SEQ; const float* mod = MODl + (size_t)b * 6 * D;
        f32x4 v[4], y[4];
#pragma unroll
        for (int j = 0; j < 4; ++j) { v[j] = *(const f32x4*)(x + (size_t)row * D + 4 * F.lane + 256 * j); y[j] = (f32x4){0.f, 0.f, 0.f, 0.f}; }
#pragma unroll
        for (int k = 0; k < TOPK; ++k) { const int e = TOPE[row * TOPK + k], s = TOPS[row * TOPK + k]; const size_t pr = (size_t)tb[e] * 256 + s;
#pragma unroll
            for (int j = 0; j < 4; ++j) { const u32x2 w = *(const u32x2*)(YR + pr * D + 4 * F.lane + 256 * j); y[j] = y[j] + (f32x4){bf_lo(w.x), bf_hi(w.x), bf_lo(w.y), bf_hi(w.y)}; } }
        float ss = 0.f;
#pragma unroll
        for (int j = 0; j < 4; ++j) ss += (y[j].x * y[j].x + y[j].y * y[j].y) + (y[j].z * y[j].z + y[j].w * y[j].w);
        const float r = 1.0f / sqrtf(wave_sum(ss) * (1.0f / D) + NORM_EPS);
#pragma unroll
        for (int j = 0; j < 4; ++j) { const int c = 4 * F.lane + 256 * j; const f32x4 pg = *(const f32x4*)(post_g + c), g2 = *(const f32x4*)(mod + 5 * D + c);
            v[j] = v[j] + g2 * (y[j] * r * pg); *(f32x4*)(x + (size_t)row * D + c) = v[j]; }
        if (has_next) { const float* modn = MODn + (size_t)b * 6 * D; norm_mod_store(v, pre1_g_next, modn + 1 * D, modn + 0 * D, H + (size_t)row * D, F.lane); } }
}

__device__ __forceinline__ void attn_phase(Frame& F, const bf16_t* Q, const bf16_t* KB, const bf16_t* VT, bf16_t* AP) {
    const int gw = F.vcu * NWAVES + F.wave, NGW = F.G * NWAVES;
    const int r = F.lane & 31, hh = F.lane >> 5;
    constexpr int NQT = SEQ / 32, NTASK = BATCH * NH * NQT;
    for (int task = gw; task < NTASK; task += NGW) {
        const int qt = task % NQT, h = (task / NQT) % NH, b = task / (NQT * NH), q0 = qt * 32;
        const size_t trow0 = (size_t)b * SEQ;
        bf16x8 qf[4];
#pragma unroll
        for (int ks = 0; ks < 4; ++ks) qf[ks] = *(const bf16x8*)(Q + (trow0 + q0 + r) * SBW + h * HD + ks * 16 + hh * 8);
        f32x16 o0, o1;
#pragma unroll
        for (int i = 0; i < 16; ++i) { o0[i] = 0.f; o1[i] = 0.f; }
        float C = 0.f;
        for (int kb = q0; kb >= 0; kb -= 32) {
            const bool diag = (kb == q0);
            f32x16 s;
#pragma unroll
            for (int i = 0; i < 16; ++i) s[i] = 0.f;
            const bf16_t* kp = KB + (trow0 + kb + r) * SBW + h * HD + hh * 8;
#pragma unroll
            for (int ks = 0; ks < 4; ++ks) { const bf16x8 kf = *(const bf16x8*)(kp + ks * 16); s = __builtin_amdgcn_mfma_f32_32x32x16_bf16(kf, qf[ks], s, 0, 0, 0); }
            s16x4 vlo[2][2], vhi[2][2];
#pragma unroll
            for (int st = 0; st < 2; ++st)
#pragma unroll
                for (int dt = 0; dt < 2; ++dt) { const bf16_t* vp = VT + (size_t)(h * HD + dt * 32 + r) * T + trow0 + kb + 16 * st + 4 * hh; vlo[st][dt] = *(const s16x4*)vp; vhi[st][dt] = *(const s16x4*)(vp + 8); }
            float lk[16];
#pragma unroll
            for (int i = 0; i < 16; ++i) { const int kc = 8 * (i >> 2) + 4 * hh + (i & 3); const bool valid = !diag || (kc < r); lk[i] = valid ? -softplus_f(s[i]) : 0.f; }
            float rt[4], pt[4], both[4];
#pragma unroll
            for (int gq = 0; gq < 4; ++gq) { lk[4 * gq + 2] += lk[4 * gq + 3]; lk[4 * gq + 1] += lk[4 * gq + 2]; lk[4 * gq + 0] += lk[4 * gq + 1]; rt[gq] = lk[4 * gq]; }
#pragma unroll
            for (int gq = 0; gq < 4; ++gq) { pt[gq] = __shfl_xor(rt[gq], 32); both[gq] = rt[gq] + pt[gq]; }
            float after[4]; after[3] = 0.f; after[2] = both[3]; after[1] = both[3] + both[2]; after[0] = after[1] + both[1];
            f32x16 a;
#pragma unroll
            for (int gq = 0; gq < 4; ++gq) { const float off = after[gq] + (hh == 0 ? pt[gq] : 0.f) + C;
#pragma unroll
                for (int j = 0; j < 4; ++j) { const int i = 4 * gq + j, kc = 8 * gq + 4 * hh + j; const bool valid = !diag || (kc < r);
                    a[i] = valid ? fast_exp(s[i] + lk[i] + off) : 0.f; } }
            C += both[0] + after[0];
#pragma unroll
            for (int st = 0; st < 2; ++st) {
                u32x4 pw; pw.x = pk2(a[8 * st + 0], a[8 * st + 1]); pw.y = pk2(a[8 * st + 2], a[8 * st + 3]); pw.z = pk2(a[8 * st + 4], a[8 * st + 5]); pw.w = pk2(a[8 * st + 6], a[8 * st + 7]);
                const bf16x8 pb = __builtin_bit_cast(bf16x8, pw);
                const bf16x8 va0 = __builtin_shufflevector(vlo[st][0], vhi[st][0], 0, 1, 2, 3, 4, 5, 6, 7), va1 = __builtin_shufflevector(vlo[st][1], vhi[st][1], 0, 1, 2, 3, 4, 5, 6, 7);
                o0 = __builtin_amdgcn_mfma_f32_32x32x16_bf16(va0, pb, o0, 0, 0, 0);
                o1 = __builtin_amdgcn_mfma_f32_32x32x16_bf16(va1, pb, o1, 0, 0, 0);
            }
            if (__all(C < STICK_EXIT)) break;
        }
        bf16_t* orow = AP + (trow0 + q0 + r) * D + h * HD;
#pragma unroll
        for (int gq = 0; gq < 4; ++gq) { u32x2 w0, w1; w0.x = pk2(o0[4 * gq], o0[4 * gq + 1]); w0.y = pk2(o0[4 * gq + 2], o0[4 * gq + 3]); w1.x = pk2(o1[4 * gq], o1[4 * gq + 1]); w1.y = pk2(o1[4 * gq + 2], o1[4 * gq + 3]);
            *(u32x2*)(orow + 8 * gq + 4 * hh) = w0; *(u32x2*)(orow + 32 + 8 * gq + 4 * hh) = w1; }
    }
}

__device__ __forceinline__ void poolmix_phase(Frame& F, const bf16_t* U, bf16_t* MIX) {
    const int gt = F.vcu * NTHREADS + F.tid, NGT = F.G * NTHREADS;
    constexpr int OCT = PW / 8;
    for (int idx = gt; idx < T * OCT; idx += NGT) {
        const int t = idx / OCT, o = idx % OCT, gidx = o / (PGD / 8), w = 2 << gidx, s = t % SEQ, cnt = (s + 1) < w ? (s + 1) : w;
        const bf16_t* up = U + (size_t)t * PW + o * 8;
        float acc[8], self[8];
        { const u32x4 q = *(const u32x4*)up; self[0] = bf_lo(q.x); self[1] = bf_hi(q.x); self[2] = bf_lo(q.y); self[3] = bf_hi(q.y); self[4] = bf_lo(q.z); self[5] = bf_hi(q.z); self[6] = bf_lo(q.w); self[7] = bf_hi(q.w); }
#pragma unroll
        for (int j = 0; j < 8; ++j) acc[j] = self[j];
        for (int i = 1; i < cnt; ++i) { const u32x4 q = *(const u32x4*)(up - (size_t)i * PW);
            acc[0] += bf_lo(q.x); acc[1] += bf_hi(q.x); acc[2] += bf_lo(q.y); acc[3] += bf_hi(q.y); acc[4] += bf_lo(q.z); acc[5] += bf_hi(q.z); acc[6] += bf_lo(q.w); acc[7] += bf_hi(q.w); }
        const float inv = 1.0f / (float)cnt;
        u32x4 ow; ow.x = pk2(acc[0] * inv - self[0], acc[1] * inv - self[1]); ow.y = pk2(acc[2] * inv - self[2], acc[3] * inv - self[3]);
        ow.z = pk2(acc[4] * inv - self[4], acc[5] * inv - self[5]); ow.w = pk2(acc[6] * inv - self[6], acc[7] * inv - self[7]);
        *(u32x4*)(MIX + (size_t)t * PW + o * 8) = ow;
    }
}

__device__ __forceinline__ void router_phase(Frame& F, const bf16_t* H, const bf16_t* RT, const float* rb, unsigned* cnt, int* TOPE, int* TOPS, int* ROWTOK, float* ROWGATE) {
    const int gw = F.vcu * NWAVES + F.wave, NGW = F.G * NWAVES;
    LAS float* lg = (LAS float*)(F.lds + F.wave * 4096);
    const int fr = F.lane & 15, fq = F.lane >> 4;
    for (int task = gw; task < T / 16; task += NGW) {
        const int t0 = task * 16;
        f32x4 a0 = {0.f, 0.f, 0.f, 0.f}, a1 = {0.f, 0.f, 0.f, 0.f};
        const bf16_t* hp = H + (size_t)(t0 + fr) * D + fq * 8; const bf16_t* w0 = RT + (size_t)fr * D + fq * 8; const bf16_t* w1 = RT + (size_t)(16 + fr) * D + fq * 8;
#pragma unroll 4
        for (int k = 0; k < D; k += 32) { const bf16x8 av = *(const bf16x8*)(hp + k), b0 = *(const bf16x8*)(w0 + k), b1 = *(const bf16x8*)(w1 + k);
            a0 = __builtin_amdgcn_mfma_f32_16x16x32_bf16(av, b0, a0, 0, 0, 0); a1 = __builtin_amdgcn_mfma_f32_16x16x32_bf16(av, b1, a1, 0, 0, 0); }
        const float rb0 = rb[fr], rb1 = rb[16 + fr];
#pragma unroll
        for (int j = 0; j < 4; ++j) { lg[(4 * fq + j) * 33 + fr] = a0[j] + rb0; lg[(4 * fq + j) * 33 + 16 + fr] = a1[j] + rb1; }
        LDS_WAIT(); asm volatile("" ::: "memory");
        float bv[4] = {-INFINITY, -INFINITY, -INFINITY, -INFINITY}; int bi[4] = {0, 0, 0, 0};
        if (F.lane < 16) {
            for (int e = 0; e < NE; ++e) { const float v = lg[F.lane * 33 + e];
                if (v > bv[3]) { bv[3] = v; bi[3] = e;
                    if (bv[3] > bv[2]) { float tv = bv[2]; bv[2] = bv[3]; bv[3] = tv; int ti = bi[2]; bi[2] = bi[3]; bi[3] = ti;
                        if (bv[2] > bv[1]) { tv = bv[1]; bv[1] = bv[2]; bv[2] = tv; ti = bi[1]; bi[1] = bi[2]; bi[2] = ti;
                            if (bv[1] > bv[0]) { tv = bv[0]; bv[0] = bv[1]; bv[1] = tv; ti = bi[0]; bi[0] = bi[1]; bi[1] = ti; } } } } }
        }
        LDS_WAIT(); asm volatile("" ::: "memory");
        float gt[4]; { float sum = 0.f;
#pragma unroll
            for (int k = 0; k < 4; ++k) { gt[k] = fast_exp(bv[k] - bv[0]); sum += gt[k]; }
            const float inv = 1.0f / sum;
#pragma unroll
            for (int k = 0; k < 4; ++k) gt[k] *= inv; }
#pragma unroll
        for (int k = 0; k < 4; ++k) {
            const int e = F.lane < 16 ? bi[k] : -1; int slot = 0;
            unsigned long long todo = __ballot(e >= 0);
            while (todo) { const int leader = __builtin_ctzll(todo); const int le = __shfl(e, leader); const unsigned long long mm = __ballot(e == le);
                int base = 0; if (F.lane == leader) base = (int)__hip_atomic_fetch_add(cnt + le, (unsigned)__builtin_popcountll(mm), __ATOMIC_RELAXED, __HIP_MEMORY_SCOPE_AGENT);
                base = __shfl(base, leader);
                if (e == le) slot = base + __builtin_popcountll(mm & ((1ull << F.lane) - 1ull));
                todo &= ~mm; }
            if (F.lane < 16) { const int t = t0 + F.lane; TOPE[t * TOPK + k] = e; TOPS[t * TOPK + k] = slot; ROWTOK[(size_t)e * T + slot] = t; ROWGATE[(size_t)e * T + slot] = gt[k]; }
        }
    }
}
__device__ __forceinline__ void moe_table(Frame& F, const unsigned* cnt) {
    __syncthreads();
    if (F.tid < 64) { const int e = F.lane; const int c = e < NE ? (int)cnt[e] : 0; int tl = (c + 255) >> 8, pre = tl;
#pragma unroll
        for (int o = 1; o < 64; o <<= 1) { const int v = __shfl_up(pre, o); if (F.lane >= o) pre += v; }
        if (e < NE) { F.MISC[MISC_TB + e] = (unsigned)(pre - tl); F.MISC[MISC_CNT + e] = (unsigned)c; }
        if (e == NE - 1) F.MISC[MISC_TB + NE] = (unsigned)pre; }
    __syncthreads();
}

constexpr int PH_PRO = 0, PH_PRE = 1, PH_L0 = 2, NPL = 10, NPHASES = PH_L0 + DEPTH * NPL;
__global__ void __launch_bounds__(NTHREADS, 2) fwd(Args args) {
    extern __shared__ __attribute__((aligned(16))) unsigned char lds_raw[];
    Frame F;
    F.lds = (LAS unsigned char*)lds_raw; F.MISC = (volatile LAS unsigned*)(F.lds + LDSCTL_OFF);
    F.tid = threadIdx.x; F.lane = F.tid & 63; F.wave = __builtin_amdgcn_readfirstlane(F.tid >> 6);
    F.G = gridDim.x; { const int bx = blockIdx.x; F.vcu = (F.G % 8 == 0) ? (bx % 8) * (F.G / 8) + bx / 8 : bx; }
    unsigned char* ws = args.ws;
    F.ctl = (unsigned*)(ws + WS_CTL);
    for (int u = F.tid; u < (LDS_BYTES - LDSCTL_OFF) / 4; u += NTHREADS) ((LAS unsigned*)(F.lds + LDSCTL_OFF))[u] = 0u;
    __syncthreads();
    XcdBarrier bar = xcd_barrier_post(F.ctl + CW_BAR, F.MISC + MISC_BAR);
    const int lo = args.ph_lo, hi = args.ph_hi;
#define IN(k) (lo <= (k) && (k) < hi)
#define SEAM(k) do { if (IN(k) && IN((k) + 1)) xcd_barrier(bar); } while (0)

    float* MOD = (float*)(ws + WS_MOD);
    bf16_t* H = (bf16_t*)(ws + WS_H); bf16_t* Qb = (bf16_t*)(ws + WS_Q); bf16_t* Kb = (bf16_t*)(ws + WS_K); bf16_t* VT = (bf16_t*)(ws + WS_VT);
    bf16_t* U = (bf16_t*)(ws + WS_U); bf16_t* GT = (bf16_t*)(ws + WS_G); bf16_t* AP = (bf16_t*)(ws + WS_AP); bf16_t* MIX = (bf16_t*)(ws + WS_MIX);
    bf16_t* MRG = (bf16_t*)(ws + WS_MRG); bf16_t* Y = (bf16_t*)(ws + WS_Y); bf16_t* ACT = (bf16_t*)(ws + WS_ACT); bf16_t* YR = (bf16_t*)(ws + WS_YR);
    int* TOPE = (int*)(ws + WS_TOPE); int* TOPS = (int*)(ws + WS_TOPS); int* ROWTOK = (int*)(ws + WS_ROWTOK); float* ROWGATE = (float*)(ws + WS_ROWGATE);
    const int cb = (int)blockIdx.x;

    if (IN(PH_PRO)) { mods_phase(F, args.in[1], args.in[2], args.in[3], MOD); convert_phase(F, args); }
    SEAM(PH_PRO);
    if (IN(PH_PRE)) rowpass_pre(F, args.in[0], args.in[4], MOD, H);
    SEAM(PH_PRE);

#pragma unroll 1
    for (int l = 0; l < DEPTH; ++l) {
        const int pb = PH_L0 + l * NPL;
        unsigned char* wl = ws + WS_W + (size_t)l * WL_STRIDE;
        const bf16_t* WIN = (const bf16_t*)(wl + WO_WIN);
        const float* MODl = MOD + (size_t)l * BATCH * 6 * D;
        unsigned* cnt = F.ctl + CW_CNT + 64 * l;
#define PHASE_FRAME() Frame P = F; P.tid = launder_v(F.tid); P.lane = P.tid & 63; P.wave = __builtin_amdgcn_readfirstlane(P.tid >> 6)
        if (IN(pb + 0)) {
            { pg8::Gemm g{H, WIN, D, D, D, nullptr}; pg8::StaticOrder S{T / 256, 13, F.G, cb, D, D, 0}; pg8::EpiIn E{Qb, Kb, U, GT};
              pg8::gemm_phase<pg8::EpiIn, pg8::StaticOrder>(F.lds, g, S, E); }
            { pg8::Gemm g{WIN + (size_t)3328 * D, H, D, D, D, nullptr}; pg8::StaticOrder S{1, T / 256, F.G, (cb + F.G / 2) % F.G, D, D, 0}; pg8::EpiPlain E{VT, T, 0, nullptr, nullptr};
              pg8::gemm_phase<pg8::EpiPlain, pg8::StaticOrder>(F.lds, g, S, E); }
        }
        SEAM(pb + 0);
        if (IN(pb + 1)) { { PHASE_FRAME(); attn_phase(P, Qb, Kb, VT, AP); } { PHASE_FRAME(); poolmix_phase(P, U, MIX); } }
        SEAM(pb + 1);
        if (IN(pb + 2)) {
            { pg8::Gemm g{AP, (const bf16_t*)(wl + WO_BRA), D, SBW, SBW, nullptr}; pg8::StaticOrder S{T / 256, 4, F.G, cb, D, SBW, 0}; pg8::EpiBranch<false> E{MRG, GT, 0};
              pg8::gemm_phase<pg8::EpiBranch<false>, pg8::StaticOrder>(F.lds, g, S, E); }
            { pg8::Gemm g{MIX, (const bf16_t*)(wl + WO_POOL), PW, PW, 384, nullptr}; pg8::StaticOrder S{T / 256, 3, F.G, cb, PW, PW, PGD};
              pg8::EpiPlain E{AP, D, SBW, args.in[10] + (size_t)l * PW, args.in[11] + (size_t)l * PW};
              pg8::gemm_phase<pg8::EpiPlain, pg8::StaticOrder>(F.lds, g, S, E); }
        }
        SEAM(pb + 2);
        if (IN(pb + 3)) { pg8::Gemm g{AP + SBW, (const bf16_t*)(wl + WO_BRP), D, PW, PW, nullptr}; pg8::StaticOrder S{T / 256, 4, F.G, cb, D, PW, 0}; pg8::EpiBranch<true> E{MRG, GT, D};
            pg8::gemm_phase<pg8::EpiBranch<true>, pg8::StaticOrder>(F.lds, g, S, E); }
        SEAM(pb + 3);
        if (IN(pb + 4)) { pg8::Gemm g{MRG, (const bf16_t*)(wl + WO_OUT), D, D, D, nullptr}; pg8::StaticOrder S{T / 256, 4, F.G, cb, D, D, 0}; pg8::EpiPlain E{Y, D, 0, nullptr, nullptr};
            pg8::gemm_phase<pg8::EpiPlain, pg8::StaticOrder>(F.lds, g, S, E); }
        SEAM(pb + 4);
        if (IN(pb + 5)) { PHASE_FRAME(); rowpass_mid(P, l == 0 ? args.in[0] : args.out, args.out, Y, args.in[5] + (size_t)l * D, args.in[6] + (size_t)l * D, MODl, H); }
        SEAM(pb + 5);
        if (IN(pb + 6)) { PHASE_FRAME(); router_phase(P, H, (const bf16_t*)(wl + WO_ROUTER), args.in[16] + (size_t)l * NE, cnt, TOPE, TOPS, ROWTOK, ROWGATE); }
        SEAM(pb + 6);
        if (IN(pb + 7)) { { PHASE_FRAME(); moe_table(P, cnt); }
            pg8::Gemm g{H, (const bf16_t*)(wl + WO_GU), D, D, D, ROWTOK}; pg8::MoeOrder S{(const volatile LAS int*)(F.MISC + MISC_TB), (const volatile LAS int*)(F.MISC + MISC_CNT), 8, F.G, cb, 2 * D};
            pg8::EpiGU E{ACT, args.in[18] + (size_t)l * NE * 2 * D};
            pg8::gemm_phase<pg8::EpiGU, pg8::MoeOrder>(F.lds, g, S, E); }
        SEAM(pb + 7);
        if (IN(pb + 8)) { { PHASE_FRAME(); moe_table(P, cnt); }
            pg8::Gemm g{ACT, (const bf16_t*)(wl + WO_DN), D, D, D, nullptr}; pg8::MoeOrder S{(const volatile LAS int*)(F.MISC + MISC_TB), (const volatile LAS int*)(F.MISC + MISC_CNT), 4, F.G, cb, D};
            pg8::EpiDN E{YR, args.in[20] + (size_t)l * NE * D, ROWGATE};
            pg8::gemm_phase<pg8::EpiDN, pg8::MoeOrder>(F.lds, g, S, E); }
        SEAM(pb + 8);
        if (IN(pb + 9)) { PHASE_FRAME(); moe_table(P, cnt);
            const bool hn = (l + 1 < DEPTH);
            rowpass_comb(P, args.out, YR, TOPE, TOPS, args.in[7] + (size_t)l * D, MODl, hn, args.in[4] + (size_t)(hn ? l + 1 : l) * D, MOD + (size_t)(hn ? l + 1 : l) * BATCH * 6 * D, H); }
        SEAM(pb + 9);
    }
#undef IN
#undef SEAM
}

extern "C" void kernel_launch(void* const* d_in, const int* in_sizes, int n_in, void* d_out, int out_size, void* d_ws, size_t ws_size, hipStream_t stream) {
    static int grid = 0;
    if (grid == 0) {
        if (n_in != 21 || in_sizes[0] != T * D || out_size != T * D || ws_size < WS_END) { fprintf(stderr, "kernel_launch: unexpected shapes (n_in %d, in0 %d, out %d, ws %zu < %zu); nothing launched\n", n_in, n_in > 0 ? in_sizes[0] : -1, out_size, ws_size, (size_t)WS_END); grid = -1; return; }
        int dev = 0, cus = 0, per_cu = 0;
        if (hipGetDevice(&dev) != hipSuccess || hipDeviceGetAttribute(&cus, hipDeviceAttributeMultiprocessorCount, dev) != hipSuccess) { grid = -1; return; }
        if (hipFuncSetAttribute((const void*)fwd, hipFuncAttributeMaxDynamicSharedMemorySize, LDS_BYTES) != hipSuccess) { fprintf(stderr, "kernel_launch: hipFuncSetAttribute failed\n"); grid = -1; return; }
        if (hipOccupancyMaxActiveBlocksPerMultiprocessor(&per_cu, (const void*)fwd, NTHREADS, LDS_BYTES) != hipSuccess || per_cu < 1) { fprintf(stderr, "kernel_launch: occupancy query says %d\n", per_cu); }
        (void)hipGetLastError();
        grid = cus;
    }
    if (grid < 0) return;
    if (hipMemsetAsync((char*)d_ws + WS_CTL, 0, CTL_ZERO_BYTES, stream) != hipSuccess) return;
    Args a{};
    for (int i = 0; i < 21; ++i) a.in[i] = (const float*)d_in[i];
    a.out = (float*)d_out; a.ws = (unsigned char*)d_ws;
#if N_LAUNCHES == 1
    a.ph_lo = 0; a.ph_hi = NPHASES;
    hipLaunchKernelGGL(fwd, dim3(grid), dim3(NTHREADS), LDS_BYTES, stream, a);
#else
    for (int p = 0; p < NPHASES; ++p) { a.ph_lo = p; a.ph_hi = p + 1; hipLaunchKernelGGL(fwd, dim3(grid), dim3(NTHREADS), LDS_BYTES, stream, a); }
#endif
}
```

```cpp
#include <hip/hip_runtime.h>
#include <cstdio>
#include <cstdint>

#ifndef N_LAUNCHES
#define N_LAUNCHES 1
#endif
#ifndef FAST_GEMM
#define FAST_GEMM 0
#endif

#define LAS __attribute__((address_space(3)))
#define GAS __attribute__((address_space(1)))
typedef unsigned short bf16_t;
typedef short bf16x8 __attribute__((ext_vector_type(8)));
typedef short s16x4 __attribute__((ext_vector_type(4)));
typedef float f32x4 __attribute__((ext_vector_type(4)));
typedef float f32x2 __attribute__((ext_vector_type(2)));
typedef float f32x16 __attribute__((ext_vector_type(16)));
typedef unsigned u32x4 __attribute__((ext_vector_type(4)));
typedef unsigned u32x2 __attribute__((ext_vector_type(2)));

constexpr int D = 1024, BATCH = 2, SEQ = 16384, T = BATCH * SEQ, DEPTH = 2;
constexpr int SBW = 256, NH = 4, HD = 64, PW = 768, PGD = 192, INW = 3584;
constexpr int NE = 32, TOPK = 4;
constexpr float NORM_EPS = 1e-6f, SW_LIMIT = 7.0f, SW_ALPHA = 1.702f;
constexpr float STICK_EXIT = -40.0f;
constexpr int NWAVES = 8, NTHREADS = 512;
constexpr int MAXTILES = (T * TOPK) / 256 + NE;

constexpr size_t MiB = 1u << 20;
constexpr size_t WS_CTL = 0, CTL_ZERO_BYTES = 1 * MiB;
constexpr size_t WS_MOD = 1 * MiB;
constexpr size_t WS_W = 2 * MiB, WL_STRIDE = 205 * MiB;
constexpr size_t WO_WIN = 0, WO_BRA = 7 * MiB, WO_BRP = 7 * MiB + MiB / 2, WO_OUT = 9 * MiB, WO_POOL = 11 * MiB, WO_ROUTER = 12 * MiB + MiB / 2, WO_GU = 13 * MiB, WO_DN = 141 * MiB;
constexpr size_t WS_H = 416 * MiB, WS_Q = 480 * MiB, WS_K = 496 * MiB, WS_VT = 512 * MiB, WS_U = 528 * MiB, WS_G = 576 * MiB;
constexpr size_t WS_AP = 704 * MiB, WS_MIX = 768 * MiB, WS_MRG = 816 * MiB, WS_Y = 880 * MiB;
constexpr size_t WS_TOPE = 944 * MiB, WS_TOPS = 944 * MiB + MiB / 2, WS_ROWTOK = 946 * MiB, WS_ROWGATE = 950 * MiB;
constexpr size_t WS_ACT = 960 * MiB, WS_YR = 1232 * MiB, WS_END = 1504 * MiB;
static_assert(WO_DN + (size_t)NE * D * D * 2 <= WL_STRIDE && WS_W + DEPTH * WL_STRIDE <= WS_H, "weights map");
static_assert(WS_ACT + (size_t)MAXTILES * 256 * D * 2 <= WS_YR && WS_YR + (size_t)MAXTILES * 256 * D * 2 <= WS_END, "act map");
constexpr int CW_BAR = 4096, CW_CNT = 8192;

constexpr int RING_BYTES = 131072, LDSCTL_OFF = RING_BYTES, LDS_BYTES = 147456;
constexpr int MISC_BAR = 8;
constexpr int MISC_TB = 64, MISC_CNT = 128;

__device__ __forceinline__ unsigned f2bf(float f) { unsigned u = __builtin_bit_cast(unsigned, f); return (u + 0x7fffu + ((u >> 16) & 1u)) >> 16; }
__device__ __forceinline__ unsigned pk2(float lo, float hi) { return f2bf(lo) | (f2bf(hi) << 16); }
__device__ __forceinline__ float bf_lo(unsigned w) { return __builtin_bit_cast(float, w << 16); }
__device__ __forceinline__ float bf_hi(unsigned w) { return __builtin_bit_cast(float, w & 0xffff0000u); }
__device__ __forceinline__ float fast_exp(float x) { return __builtin_amdgcn_exp2f(x * 1.4426950408889634f); }
__device__ __forceinline__ float fast_sigmoid(float x) { return __builtin_amdgcn_rcpf(1.0f + fast_exp(-x)); }
__device__ __forceinline__ float softplus_f(float z) { return fmaxf(z, 0.f) + 0.6931471805599453f * __builtin_amdgcn_logf(1.0f + fast_exp(-fabsf(z))); }
__device__ __forceinline__ float wave_sum(float v) {
#pragma unroll
    for (int o = 1; o < 64; o <<= 1) v += __shfl_xor(v, o);
    return v;
}
__device__ __forceinline__ int launder_v(int x) { asm volatile("" : "+v"(x)); return x; }
#define LDS_WAIT() asm volatile("s_waitcnt lgkmcnt(0)" ::: "memory")
#define VM_WAIT() asm volatile("s_waitcnt vmcnt(0)" ::: "memory")

#define XB_TMO      128
#define XB_XCNT(j)  (256  + 64 * (j))
#define XB_XSUB(j)  (1280 + 64 * (j))
#define XB_XGEN(j)  (2304 + 64 * (j))
#define XB_TOP      3328
#define XB_TOPGEN   3392
#define XCD_BAR_WORDS 3456
#define XB_SPIN_CAP (1u << 18)
__device__ __forceinline__ unsigned xb_ld(unsigned* p)              { return __hip_atomic_load(p, __ATOMIC_RELAXED, __HIP_MEMORY_SCOPE_AGENT); }
__device__ __forceinline__ unsigned xb_add(unsigned* p, unsigned v) { return __hip_atomic_fetch_add(p, v, __ATOMIC_RELAXED, __HIP_MEMORY_SCOPE_AGENT); }
__device__ __forceinline__ unsigned xb_xcc_id() { return (unsigned)__builtin_amdgcn_s_getreg((3 << 11) | 20) & 0xFu; }
#define XB_SPIN(cond, bar) do { unsigned _sp = 0; while (cond) { __builtin_amdgcn_s_sleep(1); \
    if ((++_sp & 255u) == 0u) { if (xb_ld(&(bar)[XB_TMO])) break; if (_sp > XB_SPIN_CAP) { atomicAdd(&(bar)[XB_TMO], 1u); break; } } } } while (0)
struct XcdBarrier { unsigned* bar; unsigned x; volatile LAS unsigned* st; };
__device__ __forceinline__ XcdBarrier xcd_barrier_post(unsigned* bar, volatile LAS unsigned* st) {
    XcdBarrier b; b.bar = bar; b.x = xb_xcc_id(); b.st = st;
    if (threadIdx.x == 0) (void)xb_add(&bar[XB_XCNT(b.x)], 1u);
    return b;
}
__device__ __forceinline__ void xcd_barrier_complete(unsigned* bar, unsigned x, unsigned& nloc, unsigned& nx) {
    const unsigned G = gridDim.x * gridDim.y * gridDim.z;
    unsigned sum, cnt, mine, sp = 0u;
    for (;;) {
        sum = 0u; cnt = 0u; mine = 0u;
#pragma unroll
        for (unsigned j = 0; j < 16; ++j) { const unsigned c = xb_ld(&bar[XB_XCNT(j)]); sum += c; cnt += (c > 0u) ? 1u : 0u; mine = (j == x) ? c : mine; }
        if (sum == G) break;
        __builtin_amdgcn_s_sleep(1);
        if ((++sp & 255u) == 0u) { if (xb_ld(&bar[XB_TMO])) break; if (sp > XB_SPIN_CAP) { atomicAdd(&bar[XB_TMO], 1u); break; } }
    }
    nloc = mine > 0u ? mine : 1u; nx = cnt > 0u ? cnt : 1u;
}
__device__ __forceinline__ void xcd_barrier(const XcdBarrier& b) {
    asm volatile("s_waitcnt vmcnt(0)" ::: "memory");
    __syncthreads();
    if (threadIdx.x == 0) {
        unsigned* bar = b.bar;
        __builtin_amdgcn_s_waitcnt(0);
        unsigned nloc = b.st[0], nx = b.st[1];
        if (nloc == 0u) { xcd_barrier_complete(bar, b.x, nloc, nx); b.st[0] = nloc; b.st[1] = nx; }
        const unsigned old = xb_add(&bar[XB_XSUB(b.x)], 1u);
        const unsigned gen = old / nloc;
        if (old + 1u == (gen + 1u) * nloc) {
            __builtin_amdgcn_fence(__ATOMIC_RELEASE, "agent");
            asm volatile("s_waitcnt vmcnt(0)" ::: "memory");
            const unsigned og = xb_add(&bar[XB_TOP], 1u);
            const unsigned tg = og / nx;
            if (og + 1u == (tg + 1u) * nx) xb_add(&bar[XB_TOPGEN], 1u);
            else XB_SPIN(xb_ld(&bar[XB_TOPGEN]) == tg, bar);
            __builtin_amdgcn_fence(__ATOMIC_ACQUIRE, "agent");
            xb_add(&bar[XB_XGEN(b.x)], 1u);
            asm volatile("s_waitcnt vmcnt(0)" ::: "memory");
        } else {
            XB_SPIN(xb_ld(&bar[XB_XGEN(b.x)]) == gen, bar);
            __builtin_amdgcn_fence(__ATOMIC_ACQUIRE, "agent");
            asm volatile("s_waitcnt vmcnt(0)" ::: "memory");
        }
    }
    __syncthreads();
}

namespace pg8 {
constexpr int BM = 256, BK = 64, HALF = 128, HTB = HALF * BK * 2, STAGE_BYTES = 8 * HTB, NXCD = 8, WGM = 8;
__host__ __device__ __forceinline__ int lds_byte(int r, int c) { const int st = (r >> 4) * 2 + (c >> 5), rr = r & 15, cc = c & 31, ob = rr * 64 + cc * 2; return st * 1024 + (ob ^ (((ob >> 9) & 1) << 5)); }
__host__ __device__ __forceinline__ void stage_rc(int b, int& R, int& C) { const int st = b / 1024, sb = b % 1024, swz = sb ^ (((sb >> 9) & 1) << 5); R = (st >> 1) * 16 + swz / 64; C = (st & 1) * 32 + (swz % 64) / 2; }
__host__ __device__ __forceinline__ int perm32(int rho) { const int n = rho >> 4, i = rho & 15; return 8 * (i >> 2) + 4 * n + (i & 3); }

struct Unit { int pm, pn, e, nvalid, slot0; unsigned aoff, boff; };
struct Gemm { const bf16_t* A; const bf16_t* Bt; int lda, ldb, K; const int* gather; };

__device__ __forceinline__ bool order_unit(int i, int G, int c, int nM, int nN, int& pm, int& pn) {
    const int nwg = nM * nN; const long L = (long)i * G + c; if (L >= nwg) return false;
    int wgid = (int)L; { const int q = nwg / NXCD, r = nwg % NXCD, xcd = wgid % NXCD, off = wgid / NXCD; wgid = (xcd < r ? xcd * (q + 1) : r * (q + 1) + (xcd - r) * q) + off; }
    const int nig = WGM * nN, gid = wgid / nig, fm = gid * WGM, gsz = (nM - fm) < WGM ? (nM - fm) : WGM;
    pm = fm + ((wgid % nig) % gsz); pn = (wgid % nig) / gsz; return true;
}
struct StaticOrder {
    int nM, nN, G, c, lda, ldb, kstride;
    __device__ __forceinline__ bool next(int i, Unit& u) const {
        if (!order_unit(i, G, c, nM, nN, u.pm, u.pn)) return false;
        u.e = 0; u.nvalid = 256; u.slot0 = 0;
        u.aoff = (unsigned)(u.pm * BM) * (unsigned)lda + (unsigned)(kstride * u.pn); u.boff = (unsigned)(u.pn * BM) * (unsigned)ldb + (unsigned)(kstride * u.pn); return true;
    }
};
struct MoeOrder {
    const volatile LAS int* tb; const volatile LAS int* cnt; int nN, G, c, nw;
    __device__ __forceinline__ bool next(int i, Unit& u) const {
        const int nM = tb[NE];
        if (!order_unit(i, G, c, nM, nN, u.pm, u.pn)) return false;
        int e = 0;
#pragma unroll 1
        for (int j = 1; j < NE; ++j) e += (tb[j] <= u.pm) ? 1 : 0;
        u.e = e; u.slot0 = (u.pm - tb[e]) * BM; const int left = cnt[e] - u.slot0; u.nvalid = left < BM ? left : BM;
        u.aoff = (unsigned)(u.pm * BM) * (unsigned)D; u.boff = ((unsigned)e * (unsigned)nw + (unsigned)(u.pn * BM)) * (unsigned)D; return true;
    }
};

__device__ __forceinline__ unsigned cvt_pk_bf16(float lo, float hi) { unsigned r; asm volatile("v_cvt_pk_bf16_f32 %0, %1, %2" : "=v"(r) : "v"(lo), "v"(hi)); return r; }
__device__ __forceinline__ u32x4 pack8(const f32x4 a, const f32x4 b) { u32x4 w; w.x = cvt_pk_bf16(a[0], a[1]); w.y = cvt_pk_bf16(a[2], a[3]); w.z = cvt_pk_bf16(b[0], b[1]); w.w = cvt_pk_bf16(b[2], b[3]); return w; }
__device__ __forceinline__ void unpack8(const u32x4 w, f32x4& a, f32x4& b) { a = (f32x4){bf_lo(w.x), bf_hi(w.x), bf_lo(w.y), bf_hi(w.y)}; b = (f32x4){bf_lo(w.z), bf_hi(w.z), bf_lo(w.w), bf_hi(w.w)}; }

#define EPI_LOOP_ROWS for (int ai = 0; ai < 2; ++ai) _Pragma("unroll") for (int m = 0; m < 4; ++m)
struct EpiIn {
    static constexpr bool PERM = true;
    bf16_t *Q, *KB, *U, *G;
    __device__ __forceinline__ void operator()(const f32x4 (&acc)[2][2][4][2], const Unit& u, int wr, int wc, int fr, int fq) const {
        const int pn = u.pn; bf16_t* base; int ld, c0, mode;
        if (pn == 0) { base = Q; ld = SBW; c0 = 0; mode = 1; } else if (pn == 1) { base = KB; ld = SBW; c0 = 0; mode = 0; }
        else if (pn < 5) { base = U; ld = PW; c0 = (pn - 2) * BM; mode = 0; } else { base = G; ld = 2 * D; c0 = (pn - 5) * BM; mode = 2; }
        const int row0 = u.pm * BM + wr * 64 + fr, col0 = c0 + wc * 32 + 8 * fq;
#pragma unroll
        EPI_LOOP_ROWS { bf16_t* rowp = base + (size_t)(row0 + ai * HALF + m * 16) * ld + col0;
#pragma unroll
            for (int bj = 0; bj < 2; ++bj) { f32x4 v0 = acc[ai][bj][m][0], v1 = acc[ai][bj][m][1];
                if (mode == 1) { v0 = v0 * 0.125f; v1 = v1 * 0.125f; }
                if (mode == 2) {
#pragma unroll
                    for (int j = 0; j < 4; ++j) { v0[j] = fast_sigmoid(v0[j]); v1[j] = fast_sigmoid(v1[j]); } }
                *(u32x4*)(rowp + bj * HALF) = pack8(v0, v1); } }
    }
};
struct EpiPlain {
    static constexpr bool PERM = true;
    bf16_t* O; int ldc, coff; const float* bias; const float* scale;
    __device__ __forceinline__ void operator()(const f32x4 (&acc)[2][2][4][2], const Unit& u, int wr, int wc, int fr, int fq) const {
        const int row0 = u.pm * BM + wr * 64 + fr, col0 = u.pn * BM + wc * 32 + 8 * fq;
        f32x4 bv[2][2], sv[2][2];
#pragma unroll
        for (int bj = 0; bj < 2; ++bj)
#pragma unroll
            for (int n = 0; n < 2; ++n) { bv[bj][n] = bias ? *(const f32x4*)(bias + col0 + bj * HALF + 4 * n) : (f32x4){0.f, 0.f, 0.f, 0.f};
                                          sv[bj][n] = scale ? *(const f32x4*)(scale + col0 + bj * HALF + 4 * n) : (f32x4){1.f, 1.f, 1.f, 1.f}; }
#pragma unroll
        EPI_LOOP_ROWS { bf16_t* rowp = O + (size_t)(row0 + ai * HALF + m * 16) * ldc + coff + col0;
#pragma unroll
            for (int bj = 0; bj < 2; ++bj) *(u32x4*)(rowp + bj * HALF) = pack8((acc[ai][bj][m][0] + bv[bj][0]) * sv[bj][0], (acc[ai][bj][m][1] + bv[bj][1]) * sv[bj][1]); }
    }
};
template <bool ADD> struct EpiBranch {
    static constexpr bool PERM = true;
    bf16_t* MRG; const bf16_t* G; int goff;
    __device__ __forceinline__ void operator()(const f32x4 (&acc)[2][2][4][2], const Unit& u, int wr, int wc, int fr, int fq) const {
        const int row0 = u.pm * BM + wr * 64 + fr, col0 = u.pn * BM + wc * 32 + 8 * fq;
#pragma unroll
        EPI_LOOP_ROWS { const size_t r = (size_t)(row0 + ai * HALF + m * 16);
#pragma unroll
            for (int bj = 0; bj < 2; ++bj) { const int c = col0 + bj * HALF;
                f32x4 g0, g1; unpack8(*(const u32x4*)(G + r * (2 * D) + goff + c), g0, g1);
                f32x4 v0 = g0 * acc[ai][bj][m][0], v1 = g1 * acc[ai][bj][m][1];
                if (ADD) { f32x4 p0, p1; unpack8(*(const u32x4*)(MRG + r * D + c), p0, p1); v0 = v0 + p0; v1 = v1 + p1; }
                *(u32x4*)(MRG + r * D + c) = pack8(v0, v1); } }
    }
};
struct EpiGU {
    static constexpr bool PERM = true;
    bf16_t* ACT; const float* bgu;
    __device__ __forceinline__ void operator()(const f32x4 (&acc)[2][2][4][2], const Unit& u, int wr, int wc, int fr, int fq) const {
        const int row0 = u.pm * BM + wr * 64 + fr, col0 = u.pn * HALF + wc * 32 + 8 * fq;
        const float* bg = bgu + (size_t)u.e * (2 * D) + col0;
        f32x4 bgv[2], buv[2];
#pragma unroll
        for (int n = 0; n < 2; ++n) { bgv[n] = *(const f32x4*)(bg + 4 * n); buv[n] = *(const f32x4*)(bg + D + 4 * n); }
#pragma unroll
        EPI_LOOP_ROWS { f32x4 o[2];
#pragma unroll
            for (int n = 0; n < 2; ++n) { f32x4 gt = acc[ai][0][m][n] + bgv[n], up = acc[ai][1][m][n] + buv[n];
#pragma unroll
                for (int j = 0; j < 4; ++j) { const float g = fminf(gt[j], SW_LIMIT), uu = fminf(fmaxf(up[j], -SW_LIMIT), SW_LIMIT); o[n][j] = (uu + 1.0f) * g * fast_sigmoid(SW_ALPHA * g); } }
            *(u32x4*)(ACT + (size_t)(row0 + ai * HALF + m * 16) * D + col0) = pack8(o[0], o[1]); }
    }
};
struct EpiDN {
    static constexpr bool PERM = true;
    bf16_t* YR; const float* bdn; const float* rowgate;
    __device__ __forceinline__ void operator()(const f32x4 (&acc)[2][2][4][2], const Unit& u, int wr, int wc, int fr, int fq) const {
        const int rl0 = wr * 64 + fr, col0 = u.pn * BM + wc * 32 + 8 * fq;
        const float* bp = bdn + (size_t)u.e * D + col0; const float* gp = rowgate + (size_t)u.e * T + u.slot0;
        f32x4 bv[2][2];
#pragma unroll
        for (int bj = 0; bj < 2; ++bj)
#pragma unroll
            for (int n = 0; n < 2; ++n) bv[bj][n] = *(const f32x4*)(bp + bj * HALF + 4 * n);
#pragma unroll
        EPI_LOOP_ROWS { const int rl = rl0 + ai * HALF + m * 16; const float gt = rl < u.nvalid ? gp[rl] : 0.f;
            bf16_t* rowp = YR + (size_t)(u.pm * BM + rl) * D + col0;
#pragma unroll
            for (int bj = 0; bj < 2; ++bj) *(u32x4*)(rowp + bj * HALF) = pack8((acc[ai][bj][m][0] + bv[bj][0]) * gt, (acc[ai][bj][m][1] + bv[bj][1]) * gt); }
    }
};

template <class Epi, class Sched>
__device__ __forceinline__ void gemm_simple(const Gemm g, const Sched& S, const Epi& E) {
    const int tid = launder_v((int)threadIdx.x), wid = __builtin_amdgcn_readfirstlane(tid >> 6), lane = tid & 63, wr = wid >> 2, wc = wid & 3, fr = lane & 15, fq = lane >> 4;
    Unit u;
    for (int ui = 0; S.next(ui, u); ++ui) {
        f32x4 acc[2][2][4][2];
#pragma unroll
        for (int a = 0; a < 2; ++a)
#pragma unroll
            for (int b = 0; b < 2; ++b)
#pragma unroll
                for (int m = 0; m < 4; ++m)
#pragma unroll
                    for (int n = 0; n < 2; ++n) acc[a][b][m][n] = (f32x4){0.f, 0.f, 0.f, 0.f};
        unsigned ao[2][4], bo[2][2];
#pragma unroll
        for (int ai = 0; ai < 2; ++ai)
#pragma unroll
            for (int m = 0; m < 4; ++m) { const int rl = ai * HALF + wr * 64 + m * 16 + fr;
                if (g.gather) { const int tok = rl < u.nvalid ? g.gather[(size_t)u.e * T + u.slot0 + rl] : 0; ao[ai][m] = (unsigned)tok * (unsigned)g.lda + fq * 8; }
                else ao[ai][m] = u.aoff + (unsigned)rl * (unsigned)g.lda + fq * 8; }
#pragma unroll
        for (int bj = 0; bj < 2; ++bj)
#pragma unroll
            for (int n = 0; n < 2; ++n) { const int slot = 16 * n + fr, brow = bj * HALF + wc * 32 + (Epi::PERM ? perm32(slot) : slot); bo[bj][n] = u.boff + (unsigned)brow * (unsigned)g.ldb + fq * 8; }
#pragma unroll 1
        for (int k = 0; k < g.K; k += 32) {
            bf16x8 b[2][2];
#pragma unroll
            for (int bj = 0; bj < 2; ++bj)
#pragma unroll
                for (int n = 0; n < 2; ++n) b[bj][n] = *(const bf16x8*)(g.Bt + (size_t)bo[bj][n] + k);
#pragma unroll
            for (int ai = 0; ai < 2; ++ai) {
                bf16x8 a[4];
#pragma unroll
                for (int m = 0; m < 4; ++m) a[m] = *(const bf16x8*)(g.A + (size_t)ao[ai][m] + k);
#pragma unroll
                for (int bj = 0; bj < 2; ++bj)
#pragma unroll
                    for (int m = 0; m < 4; ++m)
#pragma unroll
                        for (int n = 0; n < 2; ++n) acc[ai][bj][m][n] = __builtin_amdgcn_mfma_f32_16x16x32_bf16(b[bj][n], a[m], acc[ai][bj][m][n], 0, 0, 0);
            }
        }
        E(acc, u, wr, wc, fr, fq);
    }
}

template <class Epi, class Sched>
__device__ __forceinline__ void gemm_phase(LAS unsigned char* lds, const Gemm g, const Sched& S, const Epi& E) {
    gemm_simple<Epi, Sched>(g, S, E);
}
}

struct Frame {
    LAS unsigned char* lds;
    volatile LAS unsigned* MISC;
    unsigned* ctl;
    int tid, lane, wave, vcu, G;
};
struct Args { const float* in[21]; float* out; unsigned char* ws; int ph_lo, ph_hi; };
static_assert(sizeof(Args) == 21 * 8 + 8 + 8 + 8, "Args has no padding");

__device__ __forceinline__ void mods_phase(Frame& F, const float* c, const float* ada_w, const float* ada_b, float* MOD) {
    LAS float* cact = (LAS float*)F.lds;
    LAS float* part = (LAS float*)(F.lds + 8192);
    for (int i = F.tid; i < BATCH * D; i += NTHREADS) { const float v = c[i]; cact[i] = v * fast_sigmoid(v); }
    __syncthreads();
    constexpr int NTASK = DEPTH * (6 * D / 64);
    for (int task = F.vcu; task < NTASK; task += F.G) {
        const int l = task / (6 * D / 64), j0 = (task % (6 * D / 64)) * 64;
        const float* w = ada_w + (size_t)l * D * (6 * D) + j0 + F.lane;
        const int k0 = F.wave * 128;
        float a0 = 0.f, a1 = 0.f;
#pragma unroll 16
        for (int k = 0; k < 128; ++k) { const float wv = w[(size_t)(k0 + k) * (6 * D)]; a0 += cact[k0 + k] * wv; a1 += cact[D + k0 + k] * wv; }
        part[(F.wave * 2 + 0) * 64 + F.lane] = a0; part[(F.wave * 2 + 1) * 64 + F.lane] = a1;
        __syncthreads();
        if (F.tid < 128) { const int b = F.tid >> 6, j = F.tid & 63; float s = 0.f;
#pragma unroll
            for (int w8 = 0; w8 < 8; ++w8) s += part[(w8 * 2 + b) * 64 + j];
            MOD[((size_t)l * BATCH + b) * (6 * D) + j0 + j] = s + ada_b[(size_t)l * (6 * D) + j0 + j]; }
        __syncthreads();
    }
}
__device__ __forceinline__ void tr_item(const float* W, int ldw, bf16_t* WT, int ldt, int k0, int n0, int drow0, int dcol0, LAS float* scr, int lane) {
#pragma unroll 8
    for (int i = 0; i < 32; ++i) { const int kk = 2 * i + (lane >> 5); scr[kk * 33 + (lane & 31)] = W[(size_t)(k0 + kk) * ldw + n0 + (lane & 31)]; }
    LDS_WAIT(); asm volatile("" ::: "memory");
    const int c = lane & 7;
#pragma unroll
    for (int j = 0; j < 4; ++j) { const int n = (lane >> 3) + 8 * j; const LAS float* s = scr + (8 * c) * 33 + n;
        u32x4 o; o.x = pk2(s[0 * 33], s[1 * 33]); o.y = pk2(s[2 * 33], s[3 * 33]); o.z = pk2(s[4 * 33], s[5 * 33]); o.w = pk2(s[6 * 33], s[7 * 33]);
        *(u32x4*)(WT + (size_t)(drow0 + n) * ldt + dcol0 + k0 + 8 * c) = o; }
    LDS_WAIT(); asm volatile("" ::: "memory");
}
__device__ __forceinline__ int win_drow(int n0) {
    if (n0 < 512) return n0; if (n0 < 768) return 3328 + (n0 - 512); if (n0 < 1536) return 512 + (n0 - 768); return 1280 + (n0 - 1536);
}
__device__ __forceinline__ void convert_phase(Frame& F, const Args& args) {
    LAS float* scr = (LAS float*)(F.lds + F.wave * 16384);
    const int gw = F.vcu * NWAVES + F.wave, NGW = F.G * NWAVES;
    constexpr int I_IN = 16 * 112, I_BRA = 4 * 32, I_BRP = 12 * 32, I_OUT = 16 * 32, I_RT = 16, I_PL = 4 * 3 * 6, I_GU = NE * 16 * 64, I_DN = NE * 16 * 32;
    constexpr int I_LAYER = I_IN + I_BRA + I_BRP + I_OUT + I_RT + I_PL + I_GU + I_DN;
    for (int it = gw; it < DEPTH * I_LAYER; it += NGW) {
        const int l = it / I_LAYER; int r = it % I_LAYER;
        unsigned char* wl = args.ws + WS_W + (size_t)l * WL_STRIDE;
        if (r < I_GU) { const int e = r / (16 * 64), q = r % (16 * 64), kb = q / 64, nb = q % 64, n0 = nb * 32, half = n0 / D, cc = n0 % D;
            tr_item(args.in[17] + ((size_t)l * NE + e) * D * (2 * D), 2 * D, (bf16_t*)(wl + WO_GU) + (size_t)e * (2 * D) * D, D, kb * 64, n0, (cc / 128) * 256 + half * 128 + (cc % 128), 0, scr, F.lane); continue; } r -= I_GU;
        if (r < I_DN) { const int e = r / (16 * 32), q = r % (16 * 32), kb = q / 32, nb = q % 32;
            tr_item(args.in[19] + ((size_t)l * NE + e) * D * D, D, (bf16_t*)(wl + WO_DN) + (size_t)e * D * D, D, kb * 64, nb * 32, nb * 32, 0, scr, F.lane); continue; } r -= I_DN;
        if (r < I_IN) { const int kb = r / 112, nb = r % 112;
            tr_item(args.in[8] + (size_t)l * D * INW, INW, (bf16_t*)(wl + WO_WIN), D, kb * 64, nb * 32, win_drow(nb * 32), 0, scr, F.lane); continue; } r -= I_IN;
        if (r < I_BRA) { const int kb = r / 32, nb = r % 32;
            tr_item(args.in[12] + (size_t)l * SBW * D, D, (bf16_t*)(wl + WO_BRA), SBW, kb * 64, nb * 32, nb * 32, 0, scr, F.lane); continue; } r -= I_BRA;
        if (r < I_BRP) { const int kb = r / 32, nb = r % 32;
            tr_item(args.in[13] + (size_t)l * PW * D, D, (bf16_t*)(wl + WO_BRP), PW, kb * 64, nb * 32, nb * 32, 0, scr, F.lane); continue; } r -= I_BRP;
        if (r < I_OUT) { const int kb = r / 32, nb = r % 32;
            tr_item(args.in[14] + (size_t)l * D * D, D, (bf16_t*)(wl + WO_OUT), D, kb * 64, nb * 32, nb * 32, 0, scr, F.lane); continue; } r -= I_OUT;
        if (r < I_RT) { tr_item(args.in[15] + (size_t)l * D * NE, NE, (bf16_t*)(wl + WO_ROUTER), D, r * 64, 0, 0, 0, scr, F.lane); continue; } r -= I_RT;
        { const int gidx = r / 18, q = r % 18, kb = q / 6, nb = q % 6;
            tr_item(args.in[9] + ((size_t)l * 4 + gidx) * PGD * PGD, PGD, (bf16_t*)(wl + WO_POOL), PW, kb * 64, nb * 32, gidx * PGD + nb * 32, gidx * PGD, scr, F.lane); }
    }
    for (int it = gw; it < DEPTH * PW; it += NGW) { const int l = it / PW, n = it % PW, gidx = n / PGD;
        bf16_t* rowp = (bf16_t*)(args.ws + WS_W + (size_t)l * WL_STRIDE + WO_POOL) + (size_t)n * PW;
        for (int ch = F.lane; ch < PW / 8; ch += 64) if (ch / (PGD / 8) != gidx) *(u32x4*)(rowp + ch * 8) = (u32x4){0u, 0u, 0u, 0u}; }
}

__device__ __forceinline__ void norm_mod_store(const f32x4 (&v)[4], const float* g, const float* sc, const float* sh, bf16_t* hrow, int lane) {
    float ss = 0.f;
#pragma unroll
    for (int j = 0; j < 4; ++j) ss += (v[j].x * v[j].x + v[j].y * v[j].y) + (v[j].z * v[j].z + v[j].w * v[j].w);
    const float r = 1.0f / sqrtf(wave_sum(ss) * (1.0f / D) + NORM_EPS);
#pragma unroll
    for (int j = 0; j < 4; ++j) { const int c = 4 * lane + 256 * j; const f32x4 gg = *(const f32x4*)(g + c), s1 = *(const f32x4*)(sc + c), s0 = *(const f32x4*)(sh + c);
        const f32x4 o = v[j] * r * gg * (s1 + 1.0f) + s0; u32x2 w; w.x = pk2(o.x, o.y); w.y = pk2(o.z, o.w); *(u32x2*)(hrow + c) = w; }
}
__device__ __forceinline__ void rowpass_pre(Frame& F, const float* x, const float* g, const float* MODl, bf16_t* H) {
    const int gw = F.vcu * NWAVES + F.wave, NGW = F.G * NWAVES;
    for (int row = gw; row < T; row += NGW) { const int b = row / SEQ; const float* mod = MODl + (size_t)b * 6 * D;
        f32x4 v[4];
#pragma unroll
        for (int j = 0; j < 4; ++j) v[j] = *(const f32x4*)(x + (size_t)row * D + 4 * F.lane + 256 * j);
        norm_mod_store(v, g, mod + 1 * D, mod + 0 * D, H + (size_t)row * D, F.lane); }
}
__device__ __forceinline__ void rowpass_mid(Frame& F, const float* xin, float* xout, const bf16_t* Y, const float* post_g, const float* pre2_g, const float* MODl, bf16_t* H) {
    const int gw = F.vcu * NWAVES + F.wave, NGW = F.G * NWAVES;
    for (int row = gw; row < T; row += NGW) { const int b = row / SEQ; const float* mod = MODl + (size_t)b * 6 * D;
        f32x4 v[4], y[4]; float ss = 0.f;
#pragma unroll
        for (int j = 0; j < 4; ++j) { const int c = 4 * F.lane + 256 * j; v[j] = *(const f32x4*)(xin + (size_t)row * D + c);
            const u32x2 w = *(const u32x2*)(Y + (size_t)row * D + c); y[j] = (f32x4){bf_lo(w.x), bf_hi(w.x), bf_lo(w.y), bf_hi(w.y)};
            ss += (y[j].x * y[j].x + y[j].y * y[j].y) + (y[j].z * y[j].z + y[j].w * y[j].w); }
        const float r = 1.0f / sqrtf(wave_sum(ss) * (1.0f / D) + NORM_EPS);
#pragma unroll
        for (int j = 0; j < 4; ++j) { const int c = 4 * F.lane + 256 * j; const f32x4 pg = *(const f32x4*)(post_g + c), g1 = *(const f32x4*)(mod + 2 * D + c);
            v[j] = v[j] + g1 * (y[j] * r * pg); *(f32x4*)(xout + (size_t)row * D + c) = v[j]; }
        norm_mod_store(v, pre2_g, mod + 4 * D, mod + 3 * D, H + (size_t)row * D, F.lane); }
}
__device__ __forceinline__ void rowpass_comb(Frame& F, float* x, const bf16_t* YR, const int* TOPE, const int* TOPS, const float* post_g, const float* MODl,
                                             bool has_next, const float* pre1_g_next, const float* MODn, bf16_t* H) {
    const int gw = F.vcu * NWAVES + F.wave, NGW = F.G * NWAVES;
    const volatile LAS int* tb = (const volatile LAS int*)(F.MISC + MISC_TB);
    for (int row = gw; row < T; row += NGW) { const int b = row / SEQ; const float* mod = MODl + (size_t)b * 6 * D;
        f32x4 v[4], y[4];
#pragma unroll
        for (int j = 0; j < 4; ++j) { v[j] = *(const f32x4*)(x + (size_t)row * D + 4 * F.lane + 256 * j); y[j] = (f32x4){0.f, 0.f, 0.f, 0.f}; }
#pragma unroll
        for (int k = 0; k < TOPK; ++k) { const int e = TOPE[row * TOPK + k], s = TOPS[row * TOPK + k]; const size_t pr = (size_t)tb[e] * 256 + s;
#pragma unroll
            for (int j = 0; j < 4; ++j) { const u32x2 w = *(const u32x2*)(YR + pr * D + 4 * F.lane + 256 * j); y[j] = y[j] + (f32x4){bf_lo(w.x), bf_hi(w.x), bf_lo(w.y), bf_hi(w.y)}; } }
        float ss = 0.f;
#pragma unroll
        for (int j = 0; j < 4; ++j) ss += (y[j].x * y[j].x + y[j].y * y[j].y) + (y[j].z * y[j].z + y[j].w * y[j].w);
        const float r = 1.0f / sqrtf(wave_sum(ss) * (1.0f / D) + NORM_EPS);
#pragma unroll
        for (int j = 0; j < 4; ++j) { const int c = 4 * F.lane + 256 * j; const f32x4 pg = *(const f32x4*)(post_g + c), g2 = *(const f32x4*)(mod + 5 * D + c);
            v[j] = v[j] + g2 * (y[j] * r * pg); *(f32x4*)(x + (size_t)row * D + c) = v[j]; }
        if (has_next) { const float* modn = MODn + (size_t)b * 6 * D; norm_mod_store(v, pre1_g_next, modn + 1 * D, modn + 0 * D, H + (size_t)row * D, F.lane); } }
}

__device__ __forceinline__ void attn_phase(Frame& F, const bf16_t* Q, const bf16_t* KB, const bf16_t* VT, bf16_t* AP) {
    const int gw = F.vcu * NWAVES + F.wave, NGW = F.G * NWAVES;
    const int r = F.lane & 31, hh = F.lane >> 5;
    constexpr int NQT = SEQ / 32, NTASK = BATCH * NH * NQT;
    for (int task = gw; task < NTASK; task += NGW) {
        const int qt = task % NQT, h = (task / NQT) % NH, b = task / (NQT * NH), q0 = qt * 32;
        const size_t trow0 = (size_t)b * SEQ;
        bf16x8 qf[4];
#pragma unroll
        for (int ks = 0; ks < 4; ++ks) qf[ks] = *(const bf16x8*)(Q + (trow0 + q0 + r) * SBW + h * HD + ks * 16 + hh * 8);
        f32x16 o0, o1;
#pragma unroll
        for (int i = 0; i < 16; ++i) { o0[i] = 0.f; o1[i] = 0.f; }
        float C = 0.f;
        for (int kb = q0; kb >= 0; kb -= 32) {
            const bool diag = (kb == q0);
            f32x16 s;
#pragma unroll
            for (int i = 0; i < 16; ++i) s[i] = 0.f;
            const bf16_t* kp = KB + (trow0 + kb + r) * SBW + h * HD + hh * 8;
#pragma unroll
            for (int ks = 0; ks < 4; ++ks) { const bf16x8 kf = *(const bf16x8*)(kp + ks * 16); s = __builtin_amdgcn_mfma_f32_32x32x16_bf16(kf, qf[ks], s, 0, 0, 0); }
            s16x4 vlo[2][2], vhi[2][2];
#pragma unroll
            for (int st = 0; st < 2; ++st)
#pragma unroll
                for (int dt = 0; dt < 2; ++dt) { const bf16_t* vp = VT + (size_t)(h * HD + dt * 32 + r) * T + trow0 + kb + 16 * st + 4 * hh; vlo[st][dt] = *(const s16x4*)vp; vhi[st][dt] = *(const s16x4*)(vp + 8); }
            float lk[16];
#pragma unroll
            for (int i = 0; i < 16; ++i) { const int kc = 8 * (i >> 2) + 4 * hh + (i & 3); const bool valid = !diag || (kc < r); lk[i] = valid ? -softplus_f(s[i]) : 0.f; }
            float rt[4], pt[4], both[4];
#pragma unroll
            for (int gq = 0; gq < 4; ++gq) { lk[4 * gq + 2] += lk[4 * gq + 3]; lk[4 * gq + 1] += lk[4 * gq + 2]; lk[4 * gq + 0] += lk[4 * gq + 1]; rt[gq] = lk[4 * gq]; }
#pragma unroll
            for (int gq = 0; gq < 4; ++gq) { pt[gq] = __shfl_xor(rt[gq], 32); both[gq] = rt[gq] + pt[gq]; }
            float after[4]; after[3] = 0.f; after[2] = both[3]; after[1] = both[3] + both[2]; after[0] = after[1] + both[1];
            f32x16 a;
#pragma unroll
            for (int gq = 0; gq < 4; ++gq) { const float off = after[gq] + (hh == 0 ? pt[gq] : 0.f) + C;
#pragma unroll
                for (int j = 0; j < 4; ++j) { const int i = 4 * gq + j, kc = 8 * gq + 4 * hh + j; const bool valid = !diag || (kc < r);
                    a[i] = valid ? fast_exp(s[i] + lk[i] + off) : 0.f; } }
            C += both[0] + after[0];
#pragma unroll
            for (int st = 0; st < 2; ++st) {
                u32x4 pw; pw.x = pk2(a[8 * st + 0], a[8 * st + 1]); pw.y = pk2(a[8 * st + 2], a[8 * st + 3]); pw.z = pk2(a[8 * st + 4], a[8 * st + 5]); pw.w = pk2(a[8 * st + 6], a[8 * st + 7]);
                const bf16x8 pb = __builtin_bit_cast(bf16x8, pw);
                const bf16x8 va0 = __builtin_shufflevector(vlo[st][0], vhi[st][0], 0, 1, 2, 3, 4, 5, 6, 7), va1 = __builtin_shufflevector(vlo[st][1], vhi[st][1], 0, 1, 2, 3, 4, 5, 6, 7);
                o0 = __builtin_amdgcn_mfma_f32_32x32x16_bf16(va0, pb, o0, 0, 0, 0);
                o1 = __builtin_amdgcn_mfma_f32_32x32x16_bf16(va1, pb, o1, 0, 0, 0);
            }
            if (__all(C < STICK_EXIT)) break;
        }
        bf16_t* orow = AP + (trow0 + q0 + r) * D + h * HD;
#pragma unroll
        for (int gq = 0; gq < 4; ++gq) { u32x2 w0, w1; w0.x = pk2(o0[4 * gq], o0[4 * gq + 1]); w0.y = pk2(o0[4 * gq + 2], o0[4 * gq + 3]); w1.x = pk2(o1[4 * gq], o1[4 * gq + 1]); w1.y = pk2(o1[4 * gq + 2], o1[4 * gq + 3]);
            *(u32x2*)(orow + 8 * gq + 4 * hh) = w0; *(u32x2*)(orow + 32 + 8 * gq + 4 * hh) = w1; }
    }
}

__device__ __forceinline__ void poolmix_phase(Frame& F, const bf16_t* U, bf16_t* MIX) {
    const int gt = F.vcu * NTHREADS + F.tid, NGT = F.G * NTHREADS;
    constexpr int OCT = PW / 8;
    for (int idx = gt; idx < T * OCT; idx += NGT) {
        const int t = idx / OCT, o = idx % OCT, gidx = o / (PGD / 8), w = 2 << gidx, s = t % SEQ, cnt = (s + 1) < w ? (s + 1) : w;
        const bf16_t* up = U + (size_t)t * PW + o * 8;
        float acc[8], self[8];
        { const u32x4 q = *(const u32x4*)up; self[0] = bf_lo(q.x); self[1] = bf_hi(q.x); self[2] = bf_lo(q.y); self[3] = bf_hi(q.y); self[4] = bf_lo(q.z); self[5] = bf_hi(q.z); self[6] = bf_lo(q.w); self[7] = bf_hi(q.w); }
#pragma unroll
        for (int j = 0; j < 8; ++j) acc[j] = self[j];
        for (int i = 1; i < cnt; ++i) { const u32x4 q = *(const u32x4*)(up - (size_t)i * PW);
            acc[0] += bf_lo(q.x); acc[1] += bf_hi(q.x); acc[2] += bf_lo(q.y); acc[3] += bf_hi(q.y); acc[4] += bf_lo(q.z); acc[5] += bf_hi(q.z); acc[6] += bf_lo(q.w); acc[7] += bf_hi(q.w); }
        const float inv = 1.0f / (float)cnt;
        u32x4 ow; ow.x = pk2(acc[0] * inv - self[0], acc[1] * inv - self[1]); ow.y = pk2(acc[2] * inv - self[2], acc[3] * inv - self[3]);
        ow.z = pk2(acc[4] * inv - self[4], acc[5] * inv - self[5]); ow.w = pk2(acc[6] * inv - self[6], acc[7] * inv - self[7]);
        *(u32x4*)(MIX + (size_t)t * PW + o * 8) = ow;
    }
}

__device__ __forceinline__ void router_phase(Frame& F, const bf16_t* H, const bf16_t* RT, const float* rb, unsigned* cnt, int* TOPE, int* TOPS, int* ROWTOK, float* ROWGATE) {
    const int gw = F.vcu * NWAVES + F.wave, NGW = F.G * NWAVES;
    LAS float* lg = (LAS float*)(F.lds + F.wave * 4096);
    const int fr = F.lane & 15, fq = F.lane >> 4;
    for (int task = gw; task < T / 16; task += NGW) {
        const int t0 = task * 16;
        f32x4 a0 = {0.f, 0.f, 0.f, 0.f}, a1 = {0.f, 0.f, 0.f, 0.f};
        const bf16_t* hp = H + (size_t)(t0 + fr) * D + fq * 8; const bf16_t* w0 = RT + (size_t)fr * D + fq * 8; const bf16_t* w1 = RT + (size_t)(16 + fr) * D + fq * 8;
#pragma unroll 4
        for (int k = 0; k < D; k += 32) { const bf16x8 av = *(const bf16x8*)(hp + k), b0 = *(const bf16x8*)(w0 + k), b1 = *(const bf16x8*)(w1 + k);
            a0 = __builtin_amdgcn_mfma_f32_16x16x32_bf16(av, b0, a0, 0, 0, 0); a1 = __builtin_amdgcn_mfma_f32_16x16x32_bf16(av, b1, a1, 0, 0, 0); }
        const float rb0 = rb[fr], rb1 = rb[16 + fr];
#pragma unroll
        for (int j = 0; j < 4; ++j) { lg[(4 * fq + j) * 33 + fr] = a0[j] + rb0; lg[(4 * fq + j) * 33 + 16 + fr] = a1[j] + rb1; }
        LDS_WAIT(); asm volatile("" ::: "memory");
        float bv[4] = {-INFINITY, -INFINITY, -INFINITY, -INFINITY}; int bi[4] = {0, 0, 0, 0};
        if (F.lane < 16) {
            for (int e = 0; e < NE; ++e) { const float v = lg[F.lane * 33 + e];
                if (v > bv[3]) { bv[3] = v; bi[3] = e;
                    if (bv[3] > bv[2]) { float tv = bv[2]; bv[2] = bv[3]; bv[3] = tv; int ti = bi[2]; bi[2] = bi[3]; bi[3] = ti;
                        if (bv[2] > bv[1]) { tv = bv[1]; bv[1] = bv[2]; bv[2] = tv; ti = bi[1]; bi[1] = bi[2]; bi[2] = ti;
                            if (bv[1] > bv[0]) { tv = bv[0]; bv[0] = bv[1]; bv[1] = tv; ti = bi[0]; bi[0] = bi[1]; bi[1] = ti; } } } } }
        }
        LDS_WAIT(); asm volatile("" ::: "memory");
        float gt[4]; { float sum = 0.f;
#pragma unroll
            for (int k = 0; k < 4; ++k) { gt[k] = fast_exp(bv[k] - bv[0]); sum += gt[k]; }
            const float inv = 1.0f / sum;
#pragma unroll
            for (int k = 0; k < 4; ++k) gt[k] *= inv; }
#pragma unroll
        for (int k = 0; k < 4; ++k) {
            const int e = F.lane < 16 ? bi[k] : -1; int slot = 0;
            unsigned long long todo = __ballot(e >= 0);
            while (todo) { const int leader = __builtin_ctzll(todo); const int le = __shfl(e, leader); const unsigned long long mm = __ballot(e == le);
                int base = 0; if (F.lane == leader) base = (int)__hip_atomic_fetch_add(cnt + le, (unsigned)__builtin_popcountll(mm), __ATOMIC_RELAXED, __HIP_MEMORY_SCOPE_AGENT);
                base = __shfl(base, leader);
                if (e == le) slot = base + __builtin_popcountll(mm & ((1ull << F.lane) - 1ull));
                todo &= ~mm; }
            if (F.lane < 16) { const int t = t0 + F.lane; TOPE[t * TOPK + k] = e; TOPS[t * TOPK + k] = slot; ROWTOK[(size_t)e * T + slot] = t; ROWGATE[(size_t)e * T + slot] = gt[k]; }
        }
    }
}
__device__ __forceinline__ void moe_table(Frame& F, const unsigned* cnt) {
    __syncthreads();
    if (F.tid < 64) { const int e = F.lane; const int c = e < NE ? (int)cnt[e] : 0; int tl = (c + 255) >> 8, pre = tl;
#pragma unroll
        for (int o = 1; o < 64; o <<= 1) { const int v = __shfl_up(pre, o); if (F.lane >= o) pre += v; }
        if (e < NE) { F.MISC[MISC_TB + e] = (unsigned)(pre - tl); F.MISC[MISC_CNT + e] = (unsigned)c; }
        if (e == NE - 1) F.MISC[MISC_TB + NE] = (unsigned)pre; }
    __syncthreads();
}

constexpr int PH_PRO = 0, PH_PRE = 1, PH_L0 = 2, NPL = 10, NPHASES = PH_L0 + DEPTH * NPL;
__global__ void __launch_bounds__(NTHREADS, 2) fwd(Args args) {
    extern __shared__ __attribute__((aligned(16))) unsigned char lds_raw[];
    Frame F;
    F.lds = (LAS unsigned char*)lds_raw; F.MISC = (volatile LAS unsigned*)(F.lds + LDSCTL_OFF);
    F.tid = threadIdx.x; F.lane = F.tid & 63; F.wave = __builtin_amdgcn_readfirstlane(F.tid >> 6);
    F.G = gridDim.x; { const int bx = blockIdx.x; F.vcu = (F.G % 8 == 0) ? (bx % 8) * (F.G / 8) + bx / 8 : bx; }
    unsigned char* ws = args.ws;
    F.ctl = (unsigned*)(ws + WS_CTL);
    for (int u = F.tid; u < (LDS_BYTES - LDSCTL_OFF) / 4; u += NTHREADS) ((LAS unsigned*)(F.lds + LDSCTL_OFF))[u] = 0u;
    __syncthreads();
    XcdBarrier bar = xcd_barrier_post(F.ctl + CW_BAR, F.MISC + MISC_BAR);
    const int lo = args.ph_lo, hi = args.ph_hi;
#define IN(k) (lo <= (k) && (k) < hi)
#define SEAM(k) do { if (IN(k) && IN((k) + 1)) xcd_barrier(bar); } while (0)

    float* MOD = (float*)(ws + WS_MOD);
    bf16_t* H = (bf16_t*)(ws + WS_H); bf16_t* Qb = (bf16_t*)(ws + WS_Q); bf16_t* Kb = (bf16_t*)(ws + WS_K); bf16_t* VT = (bf16_t*)(ws + WS_VT);
    bf16_t* U = (bf16_t*)(ws + WS_U); bf16_t* GT = (bf16_t*)(ws + WS_G); bf16_t* AP = (bf16_t*)(ws + WS_AP); bf16_t* MIX = (bf16_t*)(ws + WS_MIX);
    bf16_t* MRG = (bf16_t*)(ws + WS_MRG); bf16_t* Y = (bf16_t*)(ws + WS_Y); bf16_t* ACT = (bf16_t*)(ws + WS_ACT); bf16_t* YR = (bf16_t*)(ws + WS_YR);
    int* TOPE = (int*)(ws + WS_TOPE); int* TOPS = (int*)(ws + WS_TOPS); int* ROWTOK = (int*)(ws + WS_ROWTOK); float* ROWGATE = (float*)(ws + WS_ROWGATE);
    const int cb = (int)blockIdx.x;

    if (IN(PH_PRO)) { mods_phase(F, args.in[1], args.in[2], args.in[3], MOD); convert_phase(F, args); }
    SEAM(PH_PRO);
    if (IN(PH_PRE)) rowpass_pre(F, args.in[0], args.in[4], MOD, H);
    SEAM(PH_PRE);

#pragma unroll 1
    for (int l = 0; l < DEPTH; ++l) {
        const int pb = PH_L0 + l * NPL;
        unsigned char* wl = ws + WS_W + (size_t)l * WL_STRIDE;
        const bf16_t* WIN = (const bf16_t*)(wl + WO_WIN);
        const float* MODl = MOD + (size_t)l * BATCH * 6 * D;
        unsigned* cnt = F.ctl + CW_CNT + 64 * l;
#define PHASE_FRAME() Frame P = F; P.tid = launder_v(F.tid); P.lane = P.tid & 63; P.wave = __builtin_amdgcn_readfirstlane(P.tid >> 6)
        if (IN(pb + 0)) {
            { pg8::Gemm g{H, WIN, D, D, D, nullptr}; pg8::StaticOrder S{T / 256, 13, F.G, cb, D, D, 0}; pg8::EpiIn E{Qb, Kb, U, GT};
              pg8::gemm_phase<pg8::EpiIn, pg8::StaticOrder>(F.lds, g, S, E); }
            { pg8::Gemm g{WIN + (size_t)3328 * D, H, D, D, D, nullptr}; pg8::StaticOrder S{1, T / 256, F.G, (cb + F.G / 2) % F.G, D, D, 0}; pg8::EpiPlain E{VT, T, 0, nullptr, nullptr};
              pg8::gemm_phase<pg8::EpiPlain, pg8::StaticOrder>(F.lds, g, S, E); }
        }
        SEAM(pb + 0);
        if (IN(pb + 1)) { { PHASE_FRAME(); attn_phase(P, Qb, Kb, VT, AP); } { PHASE_FRAME(); poolmix_phase(P, U, MIX); } }
        SEAM(pb + 1);
        if (IN(pb + 2)) {
            { pg8::Gemm g{AP, (const bf16_t*)(wl + WO_BRA), D, SBW, SBW, nullptr}; pg8::StaticOrder S{T / 256, 4, F.G, cb, D, SBW, 0}; pg8::EpiBranch<false> E{MRG, GT, 0};
              pg8::gemm_phase<pg8::EpiBranch<false>, pg8::StaticOrder>(F.lds, g, S, E); }
            { pg8::Gemm g{MIX, (const bf16_t*)(wl + WO_POOL), PW, PW, 384, nullptr}; pg8::StaticOrder S{T / 256, 3, F.G, cb, PW, PW, PGD};
              pg8::EpiPlain E{AP, D, SBW, args.in[10] + (size_t)l * PW, args.in[11] + (size_t)l * PW};
              pg8::gemm_phase<pg8::EpiPlain, pg8::StaticOrder>(F.lds, g, S, E); }
        }
        SEAM(pb + 2);
        if (IN(pb + 3)) { pg8::Gemm g{AP + SBW, (const bf16_t*)(wl + WO_BRP), D, PW, PW, nullptr}; pg8::StaticOrder S{T / 256, 4, F.G, cb, D, PW, 0}; pg8::EpiBranch<true> E{MRG, GT, D};
            pg8::gemm_phase<pg8::EpiBranch<true>, pg8::StaticOrder>(F.lds, g, S, E); }
        SEAM(pb + 3);
        if (IN(pb + 4)) { pg8::Gemm g{MRG, (const bf16_t*)(wl + WO_OUT), D, D, D, nullptr}; pg8::StaticOrder S{T / 256, 4, F.G, cb, D, D, 0}; pg8::EpiPlain E{Y, D, 0, nullptr, nullptr};
            pg8::gemm_phase<pg8::EpiPlain, pg8::StaticOrder>(F.lds, g, S, E); }
        SEAM(pb + 4);
        if (IN(pb + 5)) { PHASE_FRAME(); rowpass_mid(P, l == 0 ? args.in[0] : args.out, args.out, Y, args.in[5] + (size_t)l * D, args.in[6] + (size_t)l * D, MODl, H); }
        SEAM(pb + 5);
        if (IN(pb + 6)) { PHASE_FRAME(); router_phase(P, H, (const bf16_t*)(wl + WO_ROUTER), args.in[16] + (size_t)l * NE, cnt, TOPE, TOPS, ROWTOK, ROWGATE); }
        SEAM(pb + 6);
        if (IN(pb + 7)) { { PHASE_FRAME(); moe_table(P, cnt); }
            pg8::Gemm g{H, (const bf16_t*)(wl + WO_GU), D, D, D, ROWTOK}; pg8::MoeOrder S{(const volatile LAS int*)(F.MISC + MISC_TB), (const volatile LAS int*)(F.MISC + MISC_CNT), 8, F.G, cb, 2 * D};
            pg8::EpiGU E{ACT, args.in[18] + (size_t)l * NE * 2 * D};
            pg8::gemm_phase<pg8::EpiGU, pg8::MoeOrder>(F.lds, g, S, E); }
        SEAM(pb + 7);
        if (IN(pb + 8)) { { PHASE_FRAME(); moe_table(P, cnt); }
            pg8::Gemm g{ACT, (const bf16_t*)(wl + WO_DN), D, D, D, nullptr}; pg8::MoeOrder S{(const volatile LAS int*)(F.MISC + MISC_TB), (const volatile LAS int*)(F.MISC + MISC_CNT), 4, F.G, cb, D};
            pg8::EpiDN E{YR, args.in[20] + (size_t)l * NE * D, ROWGATE};
            pg8::gemm_phase<pg8::EpiDN, pg8::MoeOrder>(F.lds, g, S, E); }
        SEAM(pb + 8);
        if (IN(pb + 9)) { PHASE_FRAME(); moe_table(P, cnt);
            const bool hn = (l + 1 < DEPTH);
            rowpass_comb(P, args.out, YR, TOPE, TOPS, args.in[7] + (size_t)l * D, MODl, hn, args.in[4] + (size_t)(hn ? l + 1 : l) * D, MOD + (size_t)(hn ? l + 1 : l) * BATCH * 6 * D, H); }
        SEAM(pb + 9);
    }
#undef IN
#undef SEAM
}

extern "C" void kernel_launch(void* const* d_in, const int* in_sizes, int n_in, void* d_out, int out_size, void* d_ws, size_t ws_size, hipStream_t stream) {
    static int grid = 0;
    if (grid == 0) {
        if (n_in != 21 || in_sizes[0] != T * D || out_size != T * D || ws_size < WS_END) { fprintf(stderr, "kernel_launch: unexpected shapes (n_in %d, in0 %d, out %d, ws %zu < %zu); nothing launched\n", n_in, n_in > 0 ? in_sizes[0] : -1, out_size, ws_size, (size_t)WS_END); grid = -1; return; }
        int dev = 0, cus = 0, per_cu = 0;
        if (hipGetDevice(&dev) != hipSuccess || hipDeviceGetAttribute(&cus, hipDeviceAttributeMultiprocessorCount, dev) != hipSuccess) { grid = -1; return; }
        if (hipFuncSetAttribute((const void*)fwd, hipFuncAttributeMaxDynamicSharedMemorySize, LDS_BYTES) != hipSuccess) { fprintf(stderr, "kernel_launch: hipFuncSetAttribute failed\n"); grid = -1; return; }
        if (hipOccupancyMaxActiveBlocksPerMultiprocessor(&per_cu, (const void*)fwd, NTHREADS, LDS_BYTES) != hipSuccess || per_cu < 1) { fprintf(stderr, "kernel_launch: occupancy query says %d\n", per_cu); }
        (void)hipGetLastError();
        grid = cus;
    }
    if (grid < 0) return;
    if (hipMemsetAsync((char*)d_ws + WS_CTL, 0, CTL_ZERO_BYTES, stream) != hipSuccess) return;
    Args a{};
    for (int i = 0; i < 21; ++i) a.in[i] = (const float*)d_in[i];
    a.out = (float*)d_out; a.ws = (unsigned char*)d_ws;
#if N_LAUNCHES == 1
    a.ph_lo = 0; a.ph_hi = NPHASES;
    hipLaunchKernelGGL(fwd, dim3(grid), dim3(NTHREADS), LDS_BYTES, stream, a);
#else
    for (int p = 0; p < NPHASES; ++p) { a.ph_lo = p; a.ph_hi = p + 1; hipLaunchKernelGGL(fwd, dim3(grid), dim3(NTHREADS), LDS_BYTES, stream, a); }
#endif
}
```

```cpp
#include <hip/hip_runtime.h>
#include <cstdio>
#include <cstdint>

#ifndef N_LAUNCHES
#define N_LAUNCHES 1
#endif
#ifndef FAST_MASK
#define FAST_MASK 0xff
#endif

#define LAS __attribute__((address_space(3)))
#define GAS __attribute__((address_space(1)))
typedef unsigned short bf16_t;
typedef short bf16x8 __attribute__((ext_vector_type(8)));
typedef short s16x4 __attribute__((ext_vector_type(4)));
typedef float f32x4 __attribute__((ext_vector_type(4)));
typedef float f32x2 __attribute__((ext_vector_type(2)));
typedef float f32x16 __attribute__((ext_vector_type(16)));
typedef unsigned u32x4 __attribute__((ext_vector_type(4)));
typedef unsigned u32x2 __attribute__((ext_vector_type(2)));

constexpr int D = 1024, BATCH = 2, SEQ = 16384, T = BATCH * SEQ, DEPTH = 2;
constexpr int SBW = 256, NH = 4, HD = 64, PW = 768, PGD = 192, INW = 3584;
constexpr int NE = 32, TOPK = 4;
constexpr float NORM_EPS = 1e-6f, SW_LIMIT = 7.0f, SW_ALPHA = 1.702f;
constexpr float STICK_EXIT = -40.0f;
constexpr int NWAVES = 8, NTHREADS = 512;
constexpr int MAXTILES = (T * TOPK) / 256 + NE;

constexpr size_t MiB = 1u << 20;
constexpr size_t WS_CTL = 0, CTL_ZERO_BYTES = 1 * MiB;
constexpr size_t WS_MOD = 1 * MiB;
constexpr size_t WS_W = 2 * MiB, WL_STRIDE = 205 * MiB;
constexpr size_t WO_WIN = 0, WO_BRA = 7 * MiB, WO_BRP = 7 * MiB + MiB / 2, WO_OUT = 9 * MiB, WO_POOL = 11 * MiB, WO_ROUTER = 12 * MiB + MiB / 2, WO_GU = 13 * MiB, WO_DN = 141 * MiB;
constexpr size_t WS_H = 416 * MiB, WS_Q = 480 * MiB, WS_K = 496 * MiB, WS_VT = 512 * MiB, WS_U = 528 * MiB, WS_G = 576 * MiB;
constexpr size_t WS_AP = 704 * MiB, WS_MIX = 768 * MiB, WS_MRG = 816 * MiB, WS_Y = 880 * MiB;
constexpr size_t WS_TOPE = 944 * MiB, WS_TOPS = 944 * MiB + MiB / 2, WS_ROWTOK = 946 * MiB, WS_ROWGATE = 950 * MiB;
constexpr size_t WS_ACT = 960 * MiB, WS_YR = 1232 * MiB, WS_END = 1504 * MiB;
static_assert(WO_DN + (size_t)NE * D * D * 2 <= WL_STRIDE && WS_W + DEPTH * WL_STRIDE <= WS_H, "weights map");
static_assert(WS_ACT + (size_t)MAXTILES * 256 * D * 2 <= WS_YR && WS_YR + (size_t)MAXTILES * 256 * D * 2 <= WS_END, "act map");
constexpr int CW_BAR = 4096, CW_CNT = 8192;

constexpr int RING_BYTES = 131072, LDSCTL_OFF = RING_BYTES, LDS_BYTES = 147456;
constexpr int MISC_BAR = 8;
constexpr int MISC_TB = 64, MISC_CNT = 128;

__device__ __forceinline__ unsigned f2bf(float f) { unsigned u = __builtin_bit_cast(unsigned, f); return (u + 0x7fffu + ((u >> 16) & 1u)) >> 16; }
__device__ __forceinline__ unsigned pk2(float lo, float hi) { return f2bf(lo) | (f2bf(hi) << 16); }
__device__ __forceinline__ float bf_lo(unsigned w) { return __builtin_bit_cast(float, w << 16); }
__device__ __forceinline__ float bf_hi(unsigned w) { return __builtin_bit_cast(float, w & 0xffff0000u); }
__device__ __forceinline__ float fast_exp(float x) { return __builtin_amdgcn_exp2f(x * 1.4426950408889634f); }
__device__ __forceinline__ float fast_sigmoid(float x) { return __builtin_amdgcn_rcpf(1.0f + fast_exp(-x)); }
__device__ __forceinline__ float softplus_f(float z) { return fmaxf(z, 0.f) + 0.6931471805599453f * __builtin_amdgcn_logf(1.0f + fast_exp(-fabsf(z))); }
__device__ __forceinline__ float wave_sum(float v) {
#pragma unroll
    for (int o = 1; o < 64; o <<= 1) v += __shfl_xor(v, o);
    return v;
}
__device__ __forceinline__ int launder_v(int x) { asm volatile("" : "+v"(x)); return x; }
__device__ __forceinline__ int launder_s(int x) { asm volatile("" : "+s"(x)); return x; }
__device__ __forceinline__ int lane_id_v() { int x; asm volatile("v_mbcnt_lo_u32_b32 %0, -1, 0\n\tv_mbcnt_hi_u32_b32 %0, -1, %0" : "=v"(x)); return x; }
#define LDS_WAIT() asm volatile("s_waitcnt lgkmcnt(0)" ::: "memory")
#define VM_WAIT() asm volatile("s_waitcnt vmcnt(0)" ::: "memory")

#define XB_TMO      128
#define XB_XCNT(j)  (256  + 64 * (j))
#define XB_XSUB(j)  (1280 + 64 * (j))
#define XB_XGEN(j)  (2304 + 64 * (j))
#define XB_TOP      3328
#define XB_TOPGEN   3392
#define XCD_BAR_WORDS 3456
#define XB_SPIN_CAP (1u << 18)
__device__ __forceinline__ unsigned xb_ld(unsigned* p)              { return __hip_atomic_load(p, __ATOMIC_RELAXED, __HIP_MEMORY_SCOPE_AGENT); }
__device__ __forceinline__ unsigned xb_add(unsigned* p, unsigned v) { return __hip_atomic_fetch_add(p, v, __ATOMIC_RELAXED, __HIP_MEMORY_SCOPE_AGENT); }
__device__ __forceinline__ unsigned xb_xcc_id() { return (unsigned)__builtin_amdgcn_s_getreg((3 << 11) | 20) & 0xFu; }
#define XB_SPIN(cond, bar) do { unsigned _sp = 0; while (cond) { __builtin_amdgcn_s_sleep(1); \
    if ((++_sp & 255u) == 0u) { if (xb_ld(&(bar)[XB_TMO])) break; if (_sp > XB_SPIN_CAP) { atomicAdd(&(bar)[XB_TMO], 1u); break; } } } } while (0)
struct XcdBarrier { unsigned* bar; unsigned x; volatile LAS unsigned* st; };
__device__ __forceinline__ XcdBarrier xcd_barrier_post(unsigned* bar, volatile LAS unsigned* st, bool t0) {
    XcdBarrier b; b.bar = bar; b.x = xb_xcc_id(); b.st = st;
    if (t0) (void)xb_add(&bar[XB_XCNT(b.x)], 1u);
    return b;
}
__device__ __forceinline__ void xcd_barrier_complete(unsigned* bar, unsigned x, unsigned& nloc, unsigned& nx) {
    const unsigned G = gridDim.x * gridDim.y * gridDim.z;
    unsigned sum, cnt, mine, sp = 0u;
    for (;;) {
        sum = 0u; cnt = 0u; mine = 0u;
#pragma unroll
        for (unsigned j = 0; j < 16; ++j) { const unsigned c = xb_ld(&bar[XB_XCNT(j)]); sum += c; cnt += (c > 0u) ? 1u : 0u; mine = (j == x) ? c : mine; }
        if (sum == G) break;
        __builtin_amdgcn_s_sleep(1);
        if ((++sp & 255u) == 0u) { if (xb_ld(&bar[XB_TMO])) break; if (sp > XB_SPIN_CAP) { atomicAdd(&bar[XB_TMO], 1u); break; } }
    }
    nloc = mine > 0u ? mine : 1u; nx = cnt > 0u ? cnt : 1u;
}
__device__ __forceinline__ void xcd_barrier(const XcdBarrier& b, bool t0) {
    asm volatile("s_waitcnt vmcnt(0)" ::: "memory");
    __syncthreads();
    if (t0) {
        unsigned* bar = b.bar;
        __builtin_amdgcn_s_waitcnt(0);
        unsigned nloc = b.st[0], nx = b.st[1];
        if (nloc == 0u) { xcd_barrier_complete(bar, b.x, nloc, nx); b.st[0] = nloc; b.st[1] = nx; }
        const unsigned old = xb_add(&bar[XB_XSUB(b.x)], 1u);
        const unsigned gen = old / nloc;
        if (old + 1u == (gen + 1u) * nloc) {
            __builtin_amdgcn_fence(__ATOMIC_RELEASE, "agent");
            asm volatile("s_waitcnt vmcnt(0)" ::: "memory");
            const unsigned og = xb_add(&bar[XB_TOP], 1u);
            const unsigned tg = og / nx;
            if (og + 1u == (tg + 1u) * nx) xb_add(&bar[XB_TOPGEN], 1u);
            else XB_SPIN(xb_ld(&bar[XB_TOPGEN]) == tg, bar);
            __builtin_amdgcn_fence(__ATOMIC_ACQUIRE, "agent");
            xb_add(&bar[XB_XGEN(b.x)], 1u);
            asm volatile("s_waitcnt vmcnt(0)" ::: "memory");
        } else {
            XB_SPIN(xb_ld(&bar[XB_XGEN(b.x)]) == gen, bar);
            __builtin_amdgcn_fence(__ATOMIC_ACQUIRE, "agent");
            asm volatile("s_waitcnt vmcnt(0)" ::: "memory");
        }
    }
    __syncthreads();
}

namespace pg8 {
constexpr int BM = 256, BK = 64, HALF = 128, HTB = HALF * BK * 2, STAGE_BYTES = 8 * HTB, NXCD = 8, WGM = 8;
__host__ __device__ __forceinline__ int lds_byte(int r, int c) { const int st = (r >> 4) * 2 + (c >> 5), rr = r & 15, cc = c & 31, ob = rr * 64 + cc * 2; return st * 1024 + (ob ^ (((ob >> 9) & 1) << 5)); }
__host__ __device__ __forceinline__ void stage_rc(int b, int& R, int& C) { const int st = b / 1024, sb = b % 1024, swz = sb ^ (((sb >> 9) & 1) << 5); R = (st >> 1) * 16 + swz / 64; C = (st & 1) * 32 + (swz % 64) / 2; }
__host__ __device__ __forceinline__ int perm32(int rho) { const int n = rho >> 4, i = rho & 15; return 8 * (i >> 2) + 4 * n + (i & 3); }

struct Unit { int pm, pn, e, nvalid, slot0; unsigned aoff, boff; };
struct Gemm { const bf16_t* A; const bf16_t* Bt; int lda, ldb, K; const int* gather; };

__device__ __forceinline__ bool order_unit(int i, int G, int c, int nM, int nN, int& pm, int& pn) {
    const int nwg = nM * nN; const long L = (long)i * G + c; if (L >= nwg) return false;
    int wgid = (int)L; { const int q = nwg / NXCD, r = nwg % NXCD, xcd = wgid % NXCD, off = wgid / NXCD; wgid = (xcd < r ? xcd * (q + 1) : r * (q + 1) + (xcd - r) * q) + off; }
    const int nig = WGM * nN, gid = wgid / nig, fm = gid * WGM, gsz = (nM - fm) < WGM ? (nM - fm) : WGM;
    pm = fm + ((wgid % nig) % gsz); pn = (wgid % nig) / gsz; return true;
}
struct StaticOrder {
    int nM, nN, G, c, lda, ldb, kstride;
    __device__ __forceinline__ bool next(int i, Unit& u) const {
        if (!order_unit(i, G, c, nM, nN, u.pm, u.pn)) return false;
        u.e = 0; u.nvalid = 256; u.slot0 = 0;
        u.aoff = (unsigned)(u.pm * BM) * (unsigned)lda + (unsigned)(kstride * u.pn); u.boff = (unsigned)(u.pn * BM) * (unsigned)ldb + (unsigned)(kstride * u.pn); return true;
    }
};
struct MoeOrder {
    const volatile LAS int* tb; const volatile LAS int* cnt; int nN, G, c, nw;
    __device__ __forceinline__ bool next(int i, Unit& u) const {
        const int nM = tb[NE];
        if (!order_unit(i, G, c, nM, nN, u.pm, u.pn)) return false;
        int e = 0;
#pragma unroll 1
        for (int j = 1; j < NE; ++j) e += (tb[j] <= u.pm) ? 1 : 0;
        u.e = e; u.slot0 = (u.pm - tb[e]) * BM; const int left = cnt[e] - u.slot0; u.nvalid = left < BM ? left : BM;
        u.aoff = (unsigned)(u.pm * BM) * (unsigned)D; u.boff = ((unsigned)e * (unsigned)nw + (unsigned)(u.pn * BM)) * (unsigned)D; return true;
    }
};

__device__ __forceinline__ unsigned cvt_pk_bf16(float lo, float hi) { unsigned r; asm volatile("v_cvt_pk_bf16_f32 %0, %1, %2" : "=v"(r) : "v"(lo), "v"(hi)); return r; }
__device__ __forceinline__ u32x4 pack8(const f32x4 a, const f32x4 b) { u32x4 w; w.x = cvt_pk_bf16(a[0], a[1]); w.y = cvt_pk_bf16(a[2], a[3]); w.z = cvt_pk_bf16(b[0], b[1]); w.w = cvt_pk_bf16(b[2], b[3]); return w; }
__device__ __forceinline__ void unpack8(const u32x4 w, f32x4& a, f32x4& b) { a = (f32x4){bf_lo(w.x), bf_hi(w.x), bf_lo(w.y), bf_hi(w.y)}; b = (f32x4){bf_lo(w.z), bf_hi(w.z), bf_lo(w.w), bf_hi(w.w)}; }

#define EPI_LOOP_ROWS for (int ai = 0; ai < 2; ++ai) _Pragma("unroll") for (int m = 0; m < 4; ++m)
struct EpiIn {
    static constexpr bool PERM = true;
    bf16_t *Q, *KB, *U, *G;
    __device__ __forceinline__ void operator()(const f32x4 (&acc)[2][2][4][2], const Unit& u, int wr, int wc, int fr, int fq) const {
        const int pn = u.pn; bf16_t* base; int ld, c0, mode;
        if (pn == 0) { base = Q; ld = SBW; c0 = 0; mode = 1; } else if (pn == 1) { base = KB; ld = SBW; c0 = 0; mode = 0; }
        else if (pn < 5) { base = U; ld = PW; c0 = (pn - 2) * BM; mode = 0; } else { base = G; ld = 2 * D; c0 = (pn - 5) * BM; mode = 2; }
        const int row0 = u.pm * BM + wr * 64 + fr, col0 = c0 + wc * 32 + 8 * fq;
#pragma unroll
        EPI_LOOP_ROWS { bf16_t* rowp = base + (size_t)(row0 + ai * HALF + m * 16) * ld + col0;
#pragma unroll
            for (int bj = 0; bj < 2; ++bj) { f32x4 v0 = acc[ai][bj][m][0], v1 = acc[ai][bj][m][1];
                if (mode == 1) { v0 = v0 * 0.125f; v1 = v1 * 0.125f; }
                if (mode == 2) {
#pragma unroll
                    for (int j = 0; j < 4; ++j) { v0[j] = fast_sigmoid(v0[j]); v1[j] = fast_sigmoid(v1[j]); } }
                *(u32x4*)(rowp + bj * HALF) = pack8(v0, v1); } }
    }
};
struct EpiPlain {
    static constexpr bool PERM = true;
    bf16_t* O; int ldc, coff; const float* bias; const float* scale;
    __device__ __forceinline__ void operator()(const f32x4 (&acc)[2][2][4][2], const Unit& u, int wr, int wc, int fr, int fq) const {
        const int row0 = u.pm * BM + wr * 64 + fr, col0 = u.pn * BM + wc * 32 + 8 * fq;
        f32x4 bv[2][2], sv[2][2];
#pragma unroll
        for (int bj = 0; bj < 2; ++bj)
#pragma unroll
            for (int n = 0; n < 2; ++n) { bv[bj][n] = bias ? *(const f32x4*)(bias + col0 + bj * HALF + 4 * n) : (f32x4){0.f, 0.f, 0.f, 0.f};
                                          sv[bj][n] = scale ? *(const f32x4*)(scale + col0 + bj * HALF + 4 * n) : (f32x4){1.f, 1.f, 1.f, 1.f}; }
#pragma unroll
        EPI_LOOP_ROWS { bf16_t* rowp = O + (size_t)(row0 + ai * HALF + m * 16) * ldc + coff + col0;
#pragma unroll
            for (int bj = 0; bj < 2; ++bj) *(u32x4*)(rowp + bj * HALF) = pack8((acc[ai][bj][m][0] + bv[bj][0]) * sv[bj][0], (acc[ai][bj][m][1] + bv[bj][1]) * sv[bj][1]); }
    }
};
template <bool ADD> struct EpiBranch {
    static constexpr bool PERM = true;
    bf16_t* MRG; const bf16_t* G; int goff;
    __device__ __forceinline__ void operator()(const f32x4 (&acc)[2][2][4][2], const Unit& u, int wr, int wc, int fr, int fq) const {
        const int row0 = u.pm * BM + wr * 64 + fr, col0 = u.pn * BM + wc * 32 + 8 * fq;
#pragma unroll
        EPI_LOOP_ROWS { const size_t r = (size_t)(row0 + ai * HALF + m * 16);
#pragma unroll
            for (int bj = 0; bj < 2; ++bj) { const int c = col0 + bj * HALF;
                f32x4 g0, g1; unpack8(*(const u32x4*)(G + r * (2 * D) + goff + c), g0, g1);
                f32x4 v0 = g0 * acc[ai][bj][m][0], v1 = g1 * acc[ai][bj][m][1];
                if (ADD) { f32x4 p0, p1; unpack8(*(const u32x4*)(MRG + r * D + c), p0, p1); v0 = v0 + p0; v1 = v1 + p1; }
                *(u32x4*)(MRG + r * D + c) = pack8(v0, v1); } }
    }
};
struct EpiGU {
    static constexpr bool PERM = true;
    bf16_t* ACT; const float* bgu;
    __device__ __forceinline__ void operator()(const f32x4 (&acc)[2][2][4][2], const Unit& u, int wr, int wc, int fr, int fq) const {
        const int row0 = u.pm * BM + wr * 64 + fr, col0 = u.pn * HALF + wc * 32 + 8 * fq;
        const float* bg = bgu + (size_t)u.e * (2 * D) + col0;
        f32x4 bgv[2], buv[2];
#pragma unroll
        for (int n = 0; n < 2; ++n) { bgv[n] = *(const f32x4*)(bg + 4 * n); buv[n] = *(const f32x4*)(bg + D + 4 * n); }
#pragma unroll
        EPI_LOOP_ROWS { f32x4 o[2];
#pragma unroll
            for (int n = 0; n < 2; ++n) { f32x4 gt = acc[ai][0][m][n] + bgv[n], up = acc[ai][1][m][n] + buv[n];
#pragma unroll
                for (int j = 0; j < 4; ++j) { const float g = fminf(gt[j], SW_LIMIT), uu = fminf(fmaxf(up[j], -SW_LIMIT), SW_LIMIT); o[n][j] = (uu + 1.0f) * g * fast_sigmoid(SW_ALPHA * g); } }
            *(u32x4*)(ACT + (size_t)(row0 + ai * HALF + m * 16) * D + col0) = pack8(o[0], o[1]); }
    }
};
struct EpiDN {
    static constexpr bool PERM = true;
    bf16_t* YR; const float* bdn; const float* rowgate;
    __device__ __forceinline__ void operator()(const f32x4 (&acc)[2][2][4][2], const Unit& u, int wr, int wc, int fr, int fq) const {
        const int rl0 = wr * 64 + fr, col0 = u.pn * BM + wc * 32 + 8 * fq;
        const float* bp = bdn + (size_t)u.e * D + col0; const float* gp = rowgate + (size_t)u.e * T + u.slot0;
        f32x4 bv[2][2];
#pragma unroll
        for (int bj = 0; bj < 2; ++bj)
#pragma unroll
            for (int n = 0; n < 2; ++n) bv[bj][n] = *(const f32x4*)(bp + bj * HALF + 4 * n);
#pragma unroll
        EPI_LOOP_ROWS { const int rl = rl0 + ai * HALF + m * 16; const float gt = rl < u.nvalid ? gp[rl] : 0.f;
            bf16_t* rowp = YR + (size_t)(u.pm * BM + rl) * D + col0;
#pragma unroll
            for (int bj = 0; bj < 2; ++bj) *(u32x4*)(rowp + bj * HALF) = pack8((acc[ai][bj][m][0] + bv[bj][0]) * gt, (acc[ai][bj][m][1] + bv[bj][1]) * gt); }
    }
};

template <class Epi, class Sched>
__device__ __forceinline__ void gemm_simple(int wave, const Gemm g, const Sched& S, const Epi& E) {
    const int wid = launder_s(wave), lane = lane_id_v(), wr = wid >> 2, wc = wid & 3, fr = lane & 15, fq = lane >> 4;
    Unit u;
    for (int ui = 0; S.next(ui, u); ++ui) {
        f32x4 acc[2][2][4][2];
#pragma unroll
        for (int a = 0; a < 2; ++a)
#pragma unroll
            for (int b = 0; b < 2; ++b)
#pragma unroll
                for (int m = 0; m < 4; ++m)
#pragma unroll
                    for (int n = 0; n < 2; ++n) acc[a][b][m][n] = (f32x4){0.f, 0.f, 0.f, 0.f};
        unsigned ao[2][4], bo[2][2];
#pragma unroll
        for (int ai = 0; ai < 2; ++ai)
#pragma unroll
            for (int m = 0; m < 4; ++m) { const int rl = ai * HALF + wr * 64 + m * 16 + fr;
                if (g.gather) { const int tok = rl < u.nvalid ? g.gather[(size_t)u.e * T + u.slot0 + rl] : 0; ao[ai][m] = (unsigned)tok * (unsigned)g.lda + fq * 8; }
                else ao[ai][m] = u.aoff + (unsigned)rl * (unsigned)g.lda + fq * 8; }
#pragma unroll
        for (int bj = 0; bj < 2; ++bj)
#pragma unroll
            for (int n = 0; n < 2; ++n) { const int slot = 16 * n + fr, brow = bj * HALF + wc * 32 + (Epi::PERM ? perm32(slot) : slot); bo[bj][n] = u.boff + (unsigned)brow * (unsigned)g.ldb + fq * 8; }
#pragma unroll 1
        for (int k = 0; k < g.K; k += 32) {
            bf16x8 b[2][2];
#pragma unroll
            for (int bj = 0; bj < 2; ++bj)
#pragma unroll
                for (int n = 0; n < 2; ++n) b[bj][n] = *(const bf16x8*)(g.Bt + (size_t)bo[bj][n] + k);
#pragma unroll
            for (int ai = 0; ai < 2; ++ai) {
                bf16x8 a[4];
#pragma unroll
                for (int m = 0; m < 4; ++m) a[m] = *(const bf16x8*)(g.A + (size_t)ao[ai][m] + k);
#pragma unroll
                for (int bj = 0; bj < 2; ++bj)
#pragma unroll
                    for (int m = 0; m < 4; ++m)
#pragma unroll
                        for (int n = 0; n < 2; ++n) acc[ai][bj][m][n] = __builtin_amdgcn_mfma_f32_16x16x32_bf16(b[bj][n], a[m], acc[ai][bj][m][n], 0, 0, 0);
            }
        }
        E(acc, u, wr, wc, fr, fq);
    }
}

template <class Epi, class Sched>
__device__ __forceinline__ void gemm_fast(LAS unsigned char* lds, int wave, const Gemm g, const Sched& S, const Epi& E) {
    const int wid = launder_s(wave), lane = lane_id_v(), tid = wid * 64 + lane, wr = wid >> 2, wc = wid & 3, fr = lane & 15, fq = lane >> 4;
    const int K = launder_s(g.K), nt = K / BK;
    unsigned voffB[2];
#pragma unroll
    for (int i = 0; i < 2; ++i) { int R, C; stage_rc(tid * 16 + i * 8192, R, C); const int Rb = Epi::PERM ? ((R & ~31) + perm32(R & 31)) : R; voffB[i] = ((unsigned)Rb * (unsigned)g.ldb + (unsigned)C) * 2u; }
    const size_t kstep = (size_t)(BK * 2);
    const size_t hstepB = (size_t)HALF * g.ldb * 2;
    const unsigned ldsw = (unsigned)wid * 1024u;
    const int aoff = lds_byte(wr * 64 + fr, fq * 8), boff = lds_byte(wc * 32 + fr, fq * 8);
    const char* const Abase = (const char*)g.A; const char* const Bbase = (const char*)g.Bt;
#define PG8_SA(b, h) (((b) * 2 + (h)) * HTB)
#define PG8_SB(b, h) ((4 + (b) * 2 + (h)) * HTB)
#define PG8_STAGE_A(bufoff, ao, kb) do { _Pragma("unroll") for (int _i = 0; _i < 2; ++_i) \
        __builtin_amdgcn_global_load_lds((const unsigned*)(Abase + (size_t)(ao)[_i] + (size_t)(kb)), (LAS unsigned*)(lds + (bufoff) + ldsw + _i * 8192), 16, 0, 0); } while (0)
#define PG8_STAGE_B(bufoff, gbase) do { _Pragma("unroll") for (int _i = 0; _i < 2; ++_i) \
        __builtin_amdgcn_global_load_lds((const unsigned*)((const char*)(gbase) + voffB[_i]), (LAS unsigned*)(lds + (bufoff) + ldsw + _i * 8192), 16, 0, 0); } while (0)
#define PG8_LDA(dst, b, h) do { _Pragma("unroll") for (int m = 0; m < 4; ++m) _Pragma("unroll") for (int k = 0; k < 2; ++k) dst[m][k] = *(const LAS bf16x8*)(lds + PG8_SA(b, h) + aoff + m * 2048 + k * 1024); } while (0)
#define PG8_LDB(dst, b, h) do { _Pragma("unroll") for (int n = 0; n < 2; ++n) _Pragma("unroll") for (int k = 0; k < 2; ++k) dst[n][k] = *(const LAS bf16x8*)(lds + PG8_SB(b, h) + boff + n * 2048 + k * 1024); } while (0)
#define PG8_MMA(ai, bj, At, Bt) do { __builtin_amdgcn_s_setprio(1); _Pragma("unroll") for (int m = 0; m < 4; ++m) _Pragma("unroll") for (int n = 0; n < 2; ++n) _Pragma("unroll") for (int k = 0; k < 2; ++k) \
        acc[ai][bj][m][n] = __builtin_amdgcn_mfma_f32_16x16x32_bf16(Bt[n][k], At[m][k], acc[ai][bj][m][n], 0, 0, 0); __builtin_amdgcn_s_setprio(0); } while (0)
#define PG8_WAIT_V(n) asm volatile("s_waitcnt vmcnt(" #n ")" ::: "memory")
#define PG8_WAIT_L(n) asm volatile("s_waitcnt lgkmcnt(" #n ")" ::: "memory")
#define PG8_BAR __builtin_amdgcn_s_barrier()
#define PG8_SCHED __builtin_amdgcn_sched_barrier(0)
#define PG8_AOFFS(u, ao) do { _Pragma("unroll") for (int _h = 0; _h < 2; ++_h) _Pragma("unroll") for (int _i = 0; _i < 2; ++_i) { int _R, _C; stage_rc(tid * 16 + _i * 8192, _R, _C); const int _rl = _h * HALF + _R; \
        if (g.gather) { const int _tok = _rl < (u).nvalid ? g.gather[(size_t)(u).e * T + (u).slot0 + _rl] : 0; ao[_h][_i] = ((unsigned)_tok * (unsigned)g.lda + (unsigned)_C) * 2u; } \
        else ao[_h][_i] = ((u).aoff + (unsigned)_rl * (unsigned)g.lda + (unsigned)_C) * 2u; } } while (0)
    Unit cur, nxt; int ui = 0;
    if (!S.next(0, cur)) return;
    f32x4 acc[2][2][4][2];
#pragma unroll
    for (int a = 0; a < 2; ++a)
#pragma unroll
        for (int b = 0; b < 2; ++b)
#pragma unroll
            for (int m = 0; m < 4; ++m)
#pragma unroll
                for (int n = 0; n < 2; ++n) acc[a][b][m][n] = (f32x4){0.f, 0.f, 0.f, 0.f};
    bf16x8 At[4][2], B0[2][2], B1[2][2];
    unsigned aC[2][2], aN[2][2];
    PG8_AOFFS(cur, aC);
    const char* cB = Bbase + (size_t)cur.boff * 2;
    PG8_STAGE_B(PG8_SB(0, 0), cB); PG8_STAGE_B(PG8_SB(0, 1), cB + hstepB); PG8_STAGE_A(PG8_SA(0, 0), aC[0], 0); PG8_STAGE_A(PG8_SA(0, 1), aC[1], 0);
    if (wr == 1) PG8_BAR;
    PG8_WAIT_V(2); PG8_BAR;
    PG8_STAGE_B(PG8_SB(1, 0), cB + kstep); PG8_STAGE_A(PG8_SA(1, 0), aC[0], kstep); PG8_STAGE_B(PG8_SB(1, 1), cB + hstepB + kstep);
    PG8_WAIT_V(6); PG8_BAR;
    for (;;) {
        const bool has_next = S.next(ui + 1, nxt);
        if (has_next) { PG8_AOFFS(nxt, aN); } else {
#pragma unroll
            for (int h = 0; h < 2; ++h)
#pragma unroll
                for (int i = 0; i < 2; ++i) aN[h][i] = aC[h][i]; }
        const char* nB = has_next ? Bbase + (size_t)nxt.boff * 2 : cB;
#pragma unroll 1
        for (int t = 0; t < nt; t += 2) {
            const bool last = (t == nt - 2);
            const size_t k1 = (size_t)(t + 1) * kstep, k2 = last ? 0 : (size_t)(t + 2) * kstep, k3 = k2 + kstep;
            unsigned a2[2][2];
#pragma unroll
            for (int h = 0; h < 2; ++h)
#pragma unroll
                for (int i = 0; i < 2; ++i) a2[h][i] = last ? aN[h][i] : aC[h][i];
            const char* b2 = last ? nB : cB + (size_t)(t + 2) * kstep; const char* b3 = b2 + kstep;
            PG8_LDB(B0, 0, 0); PG8_LDB(B1, 0, 1); PG8_SCHED; PG8_LDA(At, 0, 0); PG8_STAGE_A(PG8_SA(1, 1), aC[1], k1);
            PG8_WAIT_V(8); PG8_WAIT_L(0); PG8_BAR; PG8_MMA(0, 0, At, B0); PG8_MMA(0, 1, At, B1); PG8_BAR; PG8_SCHED;
            PG8_LDA(At, 0, 1); PG8_STAGE_B(PG8_SB(0, 0), b2); PG8_STAGE_B(PG8_SB(0, 1), b2 + hstepB); PG8_STAGE_A(PG8_SA(0, 0), a2[0], k2);
            PG8_WAIT_V(8); PG8_WAIT_L(0); PG8_BAR; PG8_MMA(1, 0, At, B0); PG8_MMA(1, 1, At, B1); PG8_BAR; PG8_SCHED;
            PG8_LDB(B0, 1, 0); PG8_LDB(B1, 1, 1); PG8_SCHED; PG8_LDA(At, 1, 0); PG8_STAGE_A(PG8_SA(0, 1), a2[1], k2);
            PG8_WAIT_V(8); PG8_WAIT_L(0); PG8_BAR; PG8_MMA(0, 0, At, B0); PG8_MMA(0, 1, At, B1); PG8_BAR; PG8_SCHED;
            PG8_LDA(At, 1, 1); PG8_STAGE_B(PG8_SB(1, 0), b3); PG8_STAGE_B(PG8_SB(1, 1), b3 + hstepB); PG8_STAGE_A(PG8_SA(1, 0), a2[0], k3);
            PG8_WAIT_V(8); PG8_WAIT_L(0); PG8_BAR; PG8_MMA(1, 0, At, B0); PG8_MMA(1, 1, At, B1); PG8_BAR; PG8_SCHED;
        }
        if (wr == 0) PG8_BAR;
        E(acc, cur, wr, wc, fr, fq);
        if (!has_next) break;
#pragma unroll
        for (int a = 0; a < 2; ++a)
#pragma unroll
            for (int b = 0; b < 2; ++b)
#pragma unroll
                for (int m = 0; m < 4; ++m)
#pragma unroll
                    for (int n = 0; n < 2; ++n) acc[a][b][m][n] = (f32x4){0.f, 0.f, 0.f, 0.f};
        cur = nxt; cB = nB; ++ui;
#pragma unroll
        for (int h = 0; h < 2; ++h)
#pragma unroll
            for (int i = 0; i < 2; ++i) aC[h][i] = aN[h][i];
        if (wr == 1) PG8_BAR;
    }
    PG8_WAIT_V(0);
    PG8_BAR;
#undef PG8_SA
#undef PG8_SB
#undef PG8_STAGE_A
#undef PG8_STAGE_B
#undef PG8_LDA
#undef PG8_LDB
#undef PG8_MMA
#undef PG8_WAIT_V
#undef PG8_WAIT_L
#undef PG8_BAR
#undef PG8_SCHED
#undef PG8_AOFFS
}

template <class Epi, class Sched, int SITE>
__device__ __forceinline__ void gemm_phase(LAS unsigned char* lds, int wave, const Gemm g, const Sched& S, const Epi& E) {
    if constexpr ((FAST_MASK >> SITE) & 1) gemm_fast<Epi, Sched>(lds, wave, g, S, E); else gemm_simple<Epi, Sched>(wave, g, S, E);
}
}

struct Frame {
    LAS unsigned char* lds;
    volatile LAS unsigned* MISC;
    unsigned* ctl;
    int tid, lane, wave, vcu, G;
};
struct Args { const float* in[21]; float* out; unsigned char* ws; int ph_lo, ph_hi; };
static_assert(sizeof(Args) == 21 * 8 + 8 + 8 + 8, "Args has no padding");

__device__ __forceinline__ void mods_phase(Frame& F, const float* c, const float* ada_w, const float* ada_b, float* MOD) {
    LAS float* cact = (LAS float*)F.lds;
    LAS float* part = (LAS float*)(F.lds + 8192);
    for (int i = F.tid; i < BATCH * D; i += NTHREADS) { const float v = c[i]; cact[i] = v * fast_sigmoid(v); }
    __syncthreads();
    constexpr int NTASK = DEPTH * (6 * D / 64);
    for (int task = F.vcu; task < NTASK; task += F.G) {
        const int l = task / (6 * D / 64), j0 = (task % (6 * D / 64)) * 64;
        const float* w = ada_w + (size_t)l * D * (6 * D) + j0 + F.lane;
        const int k0 = F.wave * 128;
        float a0 = 0.f, a1 = 0.f;
#pragma unroll 16
        for (int k = 0; k < 128; ++k) { const float wv = w[(size_t)(k0 + k) * (6 * D)]; a0 += cact[k0 + k] * wv; a1 += cact[D + k0 + k] * wv; }
        part[(F.wave * 2 + 0) * 64 + F.lane] = a0; part[(F.wave * 2 + 1) * 64 + F.lane] = a1;
        __syncthreads();
        if (F.tid < 128) { const int b = F.tid >> 6, j = F.tid & 63; float s = 0.f;
#pragma unroll
            for (int w8 = 0; w8 < 8; ++w8) s += part[(w8 * 2 + b) * 64 + j];
            MOD[((size_t)l * BATCH + b) * (6 * D) + j0 + j] = s + ada_b[(size_t)l * (6 * D) + j0 + j]; }
        __syncthreads();
    }
}
__device__ __forceinline__ void tr_item(const float* W, int ldw, bf16_t* WT, int ldt, int k0, int n0, int drow0, int dcol0, LAS float* scr, int lane) {
#pragma unroll 8
    for (int i = 0; i < 32; ++i) { const int kk = 2 * i + (lane >> 5); scr[kk * 33 + (lane & 31)] = W[(size_t)(k0 + kk) * ldw + n0 + (lane & 31)]; }
    LDS_WAIT(); asm volatile("" ::: "memory");
    const int c = lane & 7;
#pragma unroll
    for (int j = 0; j < 4; ++j) { const int n = (lane >> 3) + 8 * j; const LAS float* s = scr + (8 * c) * 33 + n;
        u32x4 o; o.x = pk2(s[0 * 33], s[1 * 33]); o.y = pk2(s[2 * 33], s[3 * 33]); o.z = pk2(s[4 * 33], s[5 * 33]); o.w = pk2(s[6 * 33], s[7 * 33]);
        *(u32x4*)(WT + (size_t)(drow0 + n) * ldt + dcol0 + k0 + 8 * c) = o; }
    LDS_WAIT(); asm volatile("" ::: "memory");
}
__device__ __forceinline__ int win_drow(int n0) {
    if (n0 < 512) return n0; if (n0 < 768) return 3328 + (n0 - 512); if (n0 < 1536) return 512 + (n0 - 768); return 1280 + (n0 - 1536);
}
typedef const volatile __attribute__((address_space(4))) Args* KArgs;
__device__ __forceinline__ void convert_phase(Frame& F, KArgs ka) {
    unsigned char* wsb = (unsigned char*)ka->ws; const float *in8 = (const float*)ka->in[8], *in9 = (const float*)ka->in[9], *in12 = (const float*)ka->in[12], *in13 = (const float*)ka->in[13], *in14 = (const float*)ka->in[14], *in15 = (const float*)ka->in[15], *in17 = (const float*)ka->in[17], *in19 = (const float*)ka->in[19];
    LAS float* scr = (LAS float*)(F.lds + F.wave * 16384);
    const int gw = F.vcu * NWAVES + F.wave, NGW = F.G * NWAVES;
    constexpr int I_IN = 16 * 112, I_BRA = 4 * 32, I_BRP = 12 * 32, I_OUT = 16 * 32, I_RT = 16, I_PL = 4 * 3 * 6, I_GU = NE * 16 * 64, I_DN = NE * 16 * 32;
    constexpr int I_LAYER = I_IN + I_BRA + I_BRP + I_OUT + I_RT + I_PL + I_GU + I_DN;
    for (int it = gw; it < DEPTH * I_LAYER; it += NGW) {
        const int l = it / I_LAYER; int r = it % I_LAYER;
        unsigned char* wl = wsb + WS_W + (size_t)l * WL_STRIDE;
        if (r < I_GU) { const int e = r / (16 * 64), q = r % (16 * 64), kb = q / 64, nb = q % 64, n0 = nb * 32, half = n0 / D, cc = n0 % D;
            tr_item(in17 + ((size_t)l * NE + e) * D * (2 * D), 2 * D, (bf16_t*)(wl + WO_GU) + (size_t)e * (2 * D) * D, D, kb * 64, n0, (cc / 128) * 256 + half * 128 + (cc % 128), 0, scr, F.lane); continue; } r -= I_GU;
        if (r < I_DN) { const int e = r / (16 * 32), q = r % (16 * 32), kb = q / 32, nb = q % 32;
            tr_item(in19 + ((size_t)l * NE + e) * D * D, D, (bf16_t*)(wl + WO_DN) + (size_t)e * D * D, D, kb * 64, nb * 32, nb * 32, 0, scr, F.lane); continue; } r -= I_DN;
        if (r < I_IN) { const int kb = r / 112, nb = r % 112;
            tr_item(in8 + (size_t)l * D * INW, INW, (bf16_t*)(wl + WO_WIN), D, kb * 64, nb * 32, win_drow(nb * 32), 0, scr, F.lane); continue; } r -= I_IN;
        if (r < I_BRA) { const int kb = r / 32, nb = r % 32;
            tr_item(in12 + (size_t)l * SBW * D, D, (bf16_t*)(wl + WO_BRA), SBW, kb * 64, nb * 32, nb * 32, 0, scr, F.lane); continue; } r -= I_BRA;
        if (r < I_BRP) { const int kb = r / 32, nb = r % 32;
            tr_item(in13 + (size_t)l * PW * D, D, (bf16_t*)(wl + WO_BRP), PW, kb * 64, nb * 32, nb * 32, 0, scr, F.lane); continue; } r -= I_BRP;
        if (r < I_OUT) { const int kb = r / 32, nb = r % 32;
            tr_item(in14 + (size_t)l * D * D, D, (bf16_t*)(wl + WO_OUT), D, kb * 64, nb * 32, nb * 32, 0, scr, F.lane); continue; } r -= I_OUT;
        if (r < I_RT) { tr_item(in15 + (size_t)l * D * NE, NE, (bf16_t*)(wl + WO_ROUTER), D, r * 64, 0, 0, 0, scr, F.lane); continue; } r -= I_RT;
        { const int gidx = r / 18, q = r % 18, kb = q / 6, nb = q % 6;
            tr_item(in9 + ((size_t)l * 4 + gidx) * PGD * PGD, PGD, (bf16_t*)(wl + WO_POOL), PW, kb * 64, nb * 32, gidx * PGD + nb * 32, gidx * PGD, scr, F.lane); }
    }
    for (int it = gw; it < DEPTH * PW; it += NGW) { const int l = it / PW, n = it % PW, gidx = n / PGD;
        bf16_t* rowp = (bf16_t*)(wsb + WS_W + (size_t)l * WL_STRIDE + WO_POOL) + (size_t)n * PW;
        for (int ch = F.lane; ch < PW / 8; ch += 64) if (ch / (PGD / 8) != gidx) *(u32x4*)(rowp + ch * 8) = (u32x4){0u, 0u, 0u, 0u}; }
}

__device__ __forceinline__ void norm_mod_store(const f32x4 (&v)[4], const float* g, const float* sc, const float* sh, bf16_t* hrow, int lane) {
    float ss = 0.f;
#pragma unroll
    for (int j = 0; j < 4; ++j) ss += (v[j].x * v[j].x + v[j].y * v[j].y) + (v[j].z * v[j].z + v[j].w * v[j].w);
    const float r = 1.0f / sqrtf(wave_sum(ss) * (1.0f / D) + NORM_EPS);
#pragma unroll
    for (int j = 0; j < 4; ++j) { const int c = 4 * lane + 256 * j; const f32x4 gg = *(const f32x4*)(g + c), s1 = *(const f32x4*)(sc + c), s0 = *(const f32x4*)(sh + c);
        const f32x4 o = v[j] * r * gg * (s1 + 1.0f) + s0; u32x2 w; w.x = pk2(o.x, o.y); w.y = pk2(o.z, o.w); *(u32x2*)(hrow + c) = w; }
}
__device__ __forceinline__ void rowpass_pre(Frame& F, const float* x, const float* g, const float* MODl, bf16_t* H) {
    const int gw = F.vcu * NWAVES + F.wave, NGW = F.G * NWAVES;
    for (int row = gw; row < T; row += NGW) { const int b = row / SEQ; const float* mod = MODl + (size_t)b * 6 * D;
        f32x4 v[4];
#pragma unroll
        for (int j = 0; j < 4; ++j) v[j] = *(const f32x4*)(x + (size_t)row * D + 4 * F.lane + 256 * j);
        norm_mod_store(v, g, mod + 1 * D, mod + 0 * D, H + (size_t)row * D, F.lane); }
}
__device__ __forceinline__ void rowpass_mid(Frame& F, const float* xin, float* xout, const bf16_t* Y, const float* post_g, const float* pre2_g, const float* MODl, bf16_t* H) {
    const int gw = F.vcu * NWAVES + F.wave, NGW = F.G * NWAVES;
    for (int row = gw; row < T; row += NGW) { const int b = row / SEQ; const float* mod = MODl + (size_t)b * 6 * D;
        f32x4 v[4], y[4]; float ss = 0.f;
#pragma unroll
        for (int j = 0; j < 4; ++j) { const int c = 4 * F.lane + 256 * j; v[j] = *(const f32x4*)(xin + (size_t)row * D + c);
            const u32x2 w = *(const u32x2*)(Y + (size_t)row * D + c); y[j] = (f32x4){bf_lo(w.x), bf_hi(w.x), bf_lo(w.y), bf_hi(w.y)};
            ss += (y[j].x * y[j].x + y[j].y * y[j].y) + (y[j].z * y[j].z + y[j].w * y[j].w); }
        const float r = 1.0f / sqrtf(wave_sum(ss) * (1.0f / D) + NORM_EPS);
#pragma unroll
        for (int j = 0; j < 4; ++j) { const int c = 4 * F.lane + 256 * j; const f32x4 pg = *(const f32x4*)(post_g + c), g1 = *(const f32x4*)(mod + 2 * D + c);
            v[j] = v[j] + g1 * (y[j] * r * pg); *(f32x4*)(xout + (size_t)row * D + c) = v[j]; }
        norm_mod_store(v, pre2_g, mod + 4 * D, mod + 3 * D, H + (size_t)row * D, F.lane); }
}
__device__ __forceinline__ void rowpass_comb(Frame& F, float* x, const bf16_t* YR, const int* TOPE, const int* TOPS, const float* post_g, const float* MODl,
                                             bool has_next, const float* pre1_g_next, const float* MODn, bf16_t* H) {
    const int gw = F.vcu * NWAVES + F.wave, NGW = F.G * NWAVES;
    const volatile LAS int* tb = (const volatile LAS int*)(F.MISC + MISC_TB);
    for (int row = gw; row < T; row += NGW) { const int b = row / SEQ; const float* mod = MODl + (size_t)b * 6 * D;
        f32x4 v[4], y[4];
#pragma unroll
        for (int j = 0; j < 4; ++j) { v[j] = *(const f32x4*)(x + (size_t)row * D + 4 * F.lane + 256 * j); y[j] = (f32x4){0.f, 0.f, 0.f, 0.f}; }
#pragma unroll
        for (int k = 0; k < TOPK; ++k) { const int e = TOPE[row * TOPK + k], s = TOPS[row * TOPK + k]; const size_t pr = (size_t)tb[e] * 256 + s;
#pragma unroll
            for (int j = 0; j < 4; ++j) { const u32x2 w = *(const u32x2*)(YR + pr * D + 4 * F.lane + 256 * j); y[j] = y[j] + (f32x4){bf_lo(w.x), bf_hi(w.x), bf_lo(w.y), bf_hi(w.y)}; } }
        float ss = 0.f;
#pragma unroll
        for (int j = 0; j < 4; ++j) ss += (y[j].x * y[j].x + y[j].y * y[j].y) + (y[j].z * y[j].z + y[j].w * y[j].w);
        const float r = 1.0f / sqrtf(wave_sum(ss) * (1.0f / D) + NORM_EPS);
#pragma unroll
        for (int j = 0; j < 4; ++j) { const int c = 4 * F.lane + 256 * j; const f32x4 pg = *(const f32x4*)(post_g + c), g2 = *(const f32x4*)(mod + 5 * D + c);
            v[j] = v[j] + g2 * (y[j] * r * pg); *(f32x4*)(x + (size_t)row * D + c) = v[j]; }
        if (has_next) { const float* modn = MODn + (size_t)b * 6 * D; norm_mod_store(v, pre1_g_next, modn + 1 * D, modn + 0 * D, H + (size_t)row * D, F.lane); } }
}

__device__ __forceinline__ void attn_phase(Frame& F, const bf16_t* Q, const bf16_t* KB, const bf16_t* VT, bf16_t* AP) {
    const int gw = F.vcu * NWAVES + F.wave, NGW = F.G * NWAVES;
    const int r = F.lane & 31, hh = F.lane >> 5;
    constexpr int NQT = SEQ / 32, NTASK = BATCH * NH * NQT;
    for (int task = gw; task < NTASK; task += NGW) {
        const int qt = task % NQT, h = (task / NQT) % NH, b = task / (NQT * NH), q0 = qt * 32;
        const size_t trow0 = (size_t)b * SEQ;
        bf16x8 qf[4];
#pragma unroll
        for (int ks = 0; ks < 4; ++ks) qf[ks] = *(const bf16x8*)(Q + (trow0 + q0 + r) * SBW + h * HD + ks * 16 + hh * 8);
        f32x16 o0, o1;
#pragma unroll
        for (int i = 0; i < 16; ++i) { o0[i] = 0.f; o1[i] = 0.f; }
        float C = 0.f;
        for (int kb = q0; kb >= 0; kb -= 32) {
            const bool diag = (kb == q0);
            f32x16 s;
#pragma unroll
            for (int i = 0; i < 16; ++i) s[i] = 0.f;
            const bf16_t* kp = KB + (trow0 + kb + r) * SBW + h * HD + hh * 8;
#pragma unroll
            for (int ks = 0; ks < 4; ++ks) { const bf16x8 kf = *(const bf16x8*)(kp + ks * 16); s = __builtin_amdgcn_mfma_f32_32x32x16_bf16(kf, qf[ks], s, 0, 0, 0); }
            s16x4 vlo[2][2], vhi[2][2];
#pragma unroll
            for (int st = 0; st < 2; ++st)
#pragma unroll
                for (int dt = 0; dt < 2; ++dt) { const bf16_t* vp = VT + (size_t)(h * HD + dt * 32 + r) * T + trow0 + kb + 16 * st + 4 * hh; vlo[st][dt] = *(const s16x4*)vp; vhi[st][dt] = *(const s16x4*)(vp + 8); }
            float lk[16];
#pragma unroll
            for (int i = 0; i < 16; ++i) { const int kc = 8 * (i >> 2) + 4 * hh + (i & 3); const bool valid = !diag || (kc < r); lk[i] = valid ? -softplus_f(s[i]) : 0.f; }
            float rt[4], pt[4], both[4];
#pragma unroll
            for (int gq = 0; gq < 4; ++gq) { lk[4 * gq + 2] += lk[4 * gq + 3]; lk[4 * gq + 1] += lk[4 * gq + 2]; lk[4 * gq + 0] += lk[4 * gq + 1]; rt[gq] = lk[4 * gq]; }
#pragma unroll
            for (int gq = 0; gq < 4; ++gq) { pt[gq] = __shfl_xor(rt[gq], 32); both[gq] = rt[gq] + pt[gq]; }
            float after[4]; after[3] = 0.f; after[2] = both[3]; after[1] = both[3] + both[2]; after[0] = after[1] + both[1];
            f32x16 a;
#pragma unroll
            for (int gq = 0; gq < 4; ++gq) { const float off = after[gq] + (hh == 0 ? pt[gq] : 0.f) + C;
#pragma unroll
                for (int j = 0; j < 4; ++j) { const int i = 4 * gq + j, kc = 8 * gq + 4 * hh + j; const bool valid = !diag || (kc < r);
                    a[i] = valid ? fast_exp(s[i] + lk[i] + off) : 0.f; } }
            C += both[0] + after[0];
#pragma unroll
            for (int st = 0; st < 2; ++st) {
                u32x4 pw; pw.x = pk2(a[8 * st + 0], a[8 * st + 1]); pw.y = pk2(a[8 * st + 2], a[8 * st + 3]); pw.z = pk2(a[8 * st + 4], a[8 * st + 5]); pw.w = pk2(a[8 * st + 6], a[8 * st + 7]);
                const bf16x8 pb = __builtin_bit_cast(bf16x8, pw);
                const bf16x8 va0 = __builtin_shufflevector(vlo[st][0], vhi[st][0], 0, 1, 2, 3, 4, 5, 6, 7), va1 = __builtin_shufflevector(vlo[st][1], vhi[st][1], 0, 1, 2, 3, 4, 5, 6, 7);
                o0 = __builtin_amdgcn_mfma_f32_32x32x16_bf16(va0, pb, o0, 0, 0, 0);
                o1 = __builtin_amdgcn_mfma_f32_32x32x16_bf16(va1, pb, o1, 0, 0, 0);
            }
            if (__all(C < STICK_EXIT)) break;
        }
        bf16_t* orow = AP + (trow0 + q0 + r) * D + h * HD;
#pragma unroll
        for (int gq = 0; gq < 4; ++gq) { u32x2 w0, w1; w0.x = pk2(o0[4 * gq], o0[4 * gq + 1]); w0.y = pk2(o0[4 * gq + 2], o0[4 * gq + 3]); w1.x = pk2(o1[4 * gq], o1[4 * gq + 1]); w1.y = pk2(o1[4 * gq + 2], o1[4 * gq + 3]);
            *(u32x2*)(orow + 8 * gq + 4 * hh) = w0; *(u32x2*)(orow + 32 + 8 * gq + 4 * hh) = w1; }
    }
}

__device__ __forceinline__ void poolmix_phase(Frame& F, const bf16_t* U, bf16_t* MIX) {
    const int gt = F.vcu * NTHREADS + F.tid, NGT = F.G * NTHREADS;
    constexpr int OCT = PW / 8;
    for (int idx = gt; idx < T * OCT; idx += NGT) {
        const int t = idx / OCT, o = idx % OCT, gidx = o / (PGD / 8), w = 2 << gidx, s = t % SEQ, cnt = (s + 1) < w ? (s + 1) : w;
        const bf16_t* up = U + (size_t)t * PW + o * 8;
        float acc[8], self[8];
        { const u32x4 q = *(const u32x4*)up; self[0] = bf_lo(q.x); self[1] = bf_hi(q.x); self[2] = bf_lo(q.y); self[3] = bf_hi(q.y); self[4] = bf_lo(q.z); self[5] = bf_hi(q.z); self[6] = bf_lo(q.w); self[7] = bf_hi(q.w); }
#pragma unroll
        for (int j = 0; j < 8; ++j) acc[j] = self[j];
        for (int i = 1; i < cnt; ++i) { const u32x4 q = *(const u32x4*)(up - (size_t)i * PW);
            acc[0] += bf_lo(q.x); acc[1] += bf_hi(q.x); acc[2] += bf_lo(q.y); acc[3] += bf_hi(q.y); acc[4] += bf_lo(q.z); acc[5] += bf_hi(q.z); acc[6] += bf_lo(q.w); acc[7] += bf_hi(q.w); }
        const float inv = 1.0f / (float)cnt;
        u32x4 ow; ow.x = pk2(acc[0] * inv - self[0], acc[1] * inv - self[1]); ow.y = pk2(acc[2] * inv - self[2], acc[3] * inv - self[3]);
        ow.z = pk2(acc[4] * inv - self[4], acc[5] * inv - self[5]); ow.w = pk2(acc[6] * inv - self[6], acc[7] * inv - self[7]);
        *(u32x4*)(MIX + (size_t)t * PW + o * 8) = ow;
    }
}

__device__ __forceinline__ void router_phase(Frame& F, const bf16_t* H, const bf16_t* RT, const float* rb, unsigned* cnt, int* TOPE, int* TOPS, int* ROWTOK, float* ROWGATE) {
    const int gw = F.vcu * NWAVES + F.wave, NGW = F.G * NWAVES;
    LAS float* lg = (LAS float*)(F.lds + F.wave * 4096);
    const int fr = F.lane & 15, fq = F.lane >> 4;
    for (int task = gw; task < T / 16; task += NGW) {
        const int t0 = task * 16;
        f32x4 a0 = {0.f, 0.f, 0.f, 0.f}, a1 = {0.f, 0.f, 0.f, 0.f};
        const bf16_t* hp = H + (size_t)(t0 + fr) * D + fq * 8; const bf16_t* w0 = RT + (size_t)fr * D + fq * 8; const bf16_t* w1 = RT + (size_t)(16 + fr) * D + fq * 8;
#pragma unroll 4
        for (int k = 0; k < D; k += 32) { const bf16x8 av = *(const bf16x8*)(hp + k), b0 = *(const bf16x8*)(w0 + k), b1 = *(const bf16x8*)(w1 + k);
            a0 = __builtin_amdgcn_mfma_f32_16x16x32_bf16(av, b0, a0, 0, 0, 0); a1 = __builtin_amdgcn_mfma_f32_16x16x32_bf16(av, b1, a1, 0, 0, 0); }
        const float rb0 = rb[fr], rb1 = rb[16 + fr];
#pragma unroll
        for (int j = 0; j < 4; ++j) { lg[(4 * fq + j) * 33 + fr] = a0[j] + rb0; lg[(4 * fq + j) * 33 + 16 + fr] = a1[j] + rb1; }
        LDS_WAIT(); asm volatile("" ::: "memory");
        float bv[4] = {-INFINITY, -INFINITY, -INFINITY, -INFINITY}; int bi[4] = {0, 0, 0, 0};
        if (F.lane < 16) {
            for (int e = 0; e < NE; ++e) { const float v = lg[F.lane * 33 + e];
                if (v > bv[3]) { bv[3] = v; bi[3] = e;
                    if (bv[3] > bv[2]) { float tv = bv[2]; bv[2] = bv[3]; bv[3] = tv; int ti = bi[2]; bi[2] = bi[3]; bi[3] = ti;
                        if (bv[2] > bv[1]) { tv = bv[1]; bv[1] = bv[2]; bv[2] = tv; ti = bi[1]; bi[1] = bi[2]; bi[2] = ti;
                            if (bv[1] > bv[0]) { tv = bv[0]; bv[0] = bv[1]; bv[1] = tv; ti = bi[0]; bi[0] = bi[1]; bi[1] = ti; } } } } }
        }
        LDS_WAIT(); asm volatile("" ::: "memory");
        float gt[4]; { float sum = 0.f;
#pragma unroll
            for (int k = 0; k < 4; ++k) { gt[k] = fast_exp(bv[k] - bv[0]); sum += gt[k]; }
            const float inv = 1.0f / sum;
#pragma unroll
            for (int k = 0; k < 4; ++k) gt[k] *= inv; }
#pragma unroll
        for (int k = 0; k < 4; ++k) {
            const int e = F.lane < 16 ? bi[k] : -1; int slot = 0;
            unsigned long long todo = __ballot(e >= 0);
            while (todo) { const int leader = __builtin_ctzll(todo); const int le = __shfl(e, leader); const unsigned long long mm = __ballot(e == le);
                int base = 0; if (F.lane == leader) base = (int)__hip_atomic_fetch_add(cnt + le, (unsigned)__builtin_popcountll(mm), __ATOMIC_RELAXED, __HIP_MEMORY_SCOPE_AGENT);
                base = __shfl(base, leader);
                if (e == le) slot = base + __builtin_popcountll(mm & ((1ull << F.lane) - 1ull));
                todo &= ~mm; }
            if (F.lane < 16) { const int t = t0 + F.lane; TOPE[t * TOPK + k] = e; TOPS[t * TOPK + k] = slot; ROWTOK[(size_t)e * T + slot] = t; ROWGATE[(size_t)e * T + slot] = gt[k]; }
        }
    }
}
__device__ __forceinline__ void moe_table(Frame& F, const unsigned* cnt) {
    __syncthreads();
    if (F.tid < 64) { const int e = F.lane; const int c = e < NE ? (int)cnt[e] : 0; int tl = (c + 255) >> 8, pre = tl;
#pragma unroll
        for (int o = 1; o < 64; o <<= 1) { const int v = __shfl_up(pre, o); if (F.lane >= o) pre += v; }
        if (e < NE) { F.MISC[MISC_TB + e] = (unsigned)(pre - tl); F.MISC[MISC_CNT + e] = (unsigned)c; }
        if (e == NE - 1) F.MISC[MISC_TB + NE] = (unsigned)pre; }
    __syncthreads();
}

constexpr int PH_PRO = 0, PH_PRE = 1, PH_L0 = 2, NPL = 10, NPHASES = PH_L0 + DEPTH * NPL;
__global__ void __launch_bounds__(NTHREADS, 2) fwd(Args args_unused) {
    extern __shared__ __attribute__((aligned(16))) unsigned char lds_raw[];
    const volatile __attribute__((address_space(4))) Args* ka = (const volatile __attribute__((address_space(4))) Args*)__builtin_amdgcn_kernarg_segment_ptr();
#define INP(i) ((const float*)ka->in[i])
#define WSB() ((unsigned char*)ka->ws)
#define OUTP() ((float*)ka->out)
    Frame F;
    F.lds = (LAS unsigned char*)lds_raw; F.MISC = (volatile LAS unsigned*)(F.lds + LDSCTL_OFF);
    F.wave = __builtin_amdgcn_readfirstlane((int)threadIdx.x >> 6); F.lane = lane_id_v(); F.tid = F.wave * 64 + F.lane;
    F.G = gridDim.x; { const int bx = blockIdx.x; F.vcu = (F.G % 8 == 0) ? (bx % 8) * (F.G / 8) + bx / 8 : bx; }
    F.ctl = (unsigned*)(WSB() + WS_CTL);
    for (int u = F.tid; u < (LDS_BYTES - LDSCTL_OFF) / 4; u += NTHREADS) ((LAS unsigned*)(F.lds + LDSCTL_OFF))[u] = 0u;
    __syncthreads();
    XcdBarrier bar = xcd_barrier_post(F.ctl + CW_BAR, F.MISC + MISC_BAR, F.tid == 0);
    const int lo = ka->ph_lo, hi = ka->ph_hi;
#define IN(k) (lo <= (k) && (k) < hi)
#define SEAM(k) do { if (IN(k) && IN((k) + 1)) xcd_barrier(bar, F.wave == 0 && lane_id_v() == 0); } while (0)
#define PHASE_FRAME() Frame P = F; P.wave = launder_s(F.wave); P.lane = lane_id_v(); P.tid = P.wave * 64 + P.lane
    const int cb = (int)blockIdx.x;

    if (IN(PH_PRO)) { unsigned char* ws = WSB(); { PHASE_FRAME(); mods_phase(P, INP(1), INP(2), INP(3), (float*)(ws + WS_MOD)); } { PHASE_FRAME(); convert_phase(P, ka); } }
    SEAM(PH_PRO);
    if (IN(PH_PRE)) { unsigned char* ws = WSB(); PHASE_FRAME(); rowpass_pre(P, INP(0), INP(4), (const float*)(ws + WS_MOD), (bf16_t*)(ws + WS_H)); }
    SEAM(PH_PRE);

#pragma unroll 1
    for (int l = 0; l < DEPTH; ++l) {
        const int pb = PH_L0 + l * NPL;
        if (IN(pb + 0)) { unsigned char* ws = WSB(); unsigned char* wl = ws + WS_W + (size_t)l * WL_STRIDE; const bf16_t* WIN = (const bf16_t*)(wl + WO_WIN); bf16_t* H = (bf16_t*)(ws + WS_H);
            { pg8::Gemm g{H, WIN, D, D, D, nullptr}; pg8::StaticOrder S{T / 256, 13, launder_s(F.G), launder_s(cb), D, D, 0}; pg8::EpiIn E{(bf16_t*)(ws + WS_Q), (bf16_t*)(ws + WS_K), (bf16_t*)(ws + WS_U), (bf16_t*)(ws + WS_G)};
              pg8::gemm_phase<pg8::EpiIn, pg8::StaticOrder, 0>(F.lds, F.wave, g, S, E); }
            { pg8::Gemm g{WIN + (size_t)3328 * D, H, D, D, D, nullptr}; pg8::StaticOrder S{1, T / 256, launder_s(F.G), (launder_s(cb) + launder_s(F.G) / 2) % launder_s(F.G), D, D, 0}; pg8::EpiPlain E{(bf16_t*)(ws + WS_VT), T, 0, nullptr, nullptr};
              pg8::gemm_phase<pg8::EpiPlain, pg8::StaticOrder, 1>(F.lds, F.wave, g, S, E); }
        }
        SEAM(pb + 0);
        if (IN(pb + 1)) { unsigned char* ws = WSB();
            { PHASE_FRAME(); attn_phase(P, (const bf16_t*)(ws + WS_Q), (const bf16_t*)(ws + WS_K), (const bf16_t*)(ws + WS_VT), (bf16_t*)(ws + WS_AP)); }
            { PHASE_FRAME(); poolmix_phase(P, (const bf16_t*)(ws + WS_U), (bf16_t*)(ws + WS_MIX)); } }
        SEAM(pb + 1);
        if (IN(pb + 2)) { unsigned char* ws = WSB(); unsigned char* wl = ws + WS_W + (size_t)l * WL_STRIDE; bf16_t* AP = (bf16_t*)(ws + WS_AP);
            { pg8::Gemm g{AP, (const bf16_t*)(wl + WO_BRA), D, SBW, SBW, nullptr}; pg8::StaticOrder S{T / 256, 4, launder_s(F.G), launder_s(cb), D, SBW, 0}; pg8::EpiBranch<false> E{(bf16_t*)(ws + WS_MRG), (const bf16_t*)(ws + WS_G), 0};
              pg8::gemm_phase<pg8::EpiBranch<false>, pg8::StaticOrder, 2>(F.lds, F.wave, g, S, E); }
            { pg8::Gemm g{(const bf16_t*)(ws + WS_MIX), (const bf16_t*)(wl + WO_POOL), PW, PW, 384, nullptr}; pg8::StaticOrder S{T / 256, 3, launder_s(F.G), launder_s(cb), PW, PW, PGD};
              pg8::EpiPlain E{AP, D, SBW, INP(10) + (size_t)l * PW, INP(11) + (size_t)l * PW};
              pg8::gemm_phase<pg8::EpiPlain, pg8::StaticOrder, 3>(F.lds, F.wave, g, S, E); }
        }
        SEAM(pb + 2);
        if (IN(pb + 3)) { unsigned char* ws = WSB(); unsigned char* wl = ws + WS_W + (size_t)l * WL_STRIDE;
            pg8::Gemm g{(const bf16_t*)(ws + WS_AP) + SBW, (const bf16_t*)(wl + WO_BRP), D, PW, PW, nullptr}; pg8::StaticOrder S{T / 256, 4, launder_s(F.G), launder_s(cb), D, PW, 0}; pg8::EpiBranch<true> E{(bf16_t*)(ws + WS_MRG), (const bf16_t*)(ws + WS_G), D};
            pg8::gemm_phase<pg8::EpiBranch<true>, pg8::StaticOrder, 4>(F.lds, F.wave, g, S, E); }
        SEAM(pb + 3);
        if (IN(pb + 4)) { unsigned char* ws = WSB(); unsigned char* wl = ws + WS_W + (size_t)l * WL_STRIDE;
            pg8::Gemm g{(const bf16_t*)(ws + WS_MRG), (const bf16_t*)(wl + WO_OUT), D, D, D, nullptr}; pg8::StaticOrder S{T / 256, 4, launder_s(F.G), launder_s(cb), D, D, 0}; pg8::EpiPlain E{(bf16_t*)(ws + WS_Y), D, 0, nullptr, nullptr};
            pg8::gemm_phase<pg8::EpiPlain, pg8::StaticOrder, 5>(F.lds, F.wave, g, S, E); }
        SEAM(pb + 4);
        if (IN(pb + 5)) { unsigned char* ws = WSB(); PHASE_FRAME();
            rowpass_mid(P, l == 0 ? INP(0) : (const float*)OUTP(), OUTP(), (const bf16_t*)(ws + WS_Y), INP(5) + (size_t)l * D, INP(6) + (size_t)l * D, (const float*)(ws + WS_MOD) + (size_t)l * BATCH * 6 * D, (bf16_t*)(ws + WS_H)); }
        SEAM(pb + 5);
        if (IN(pb + 6)) { unsigned char* ws = WSB(); unsigned char* wl = ws + WS_W + (size_t)l * WL_STRIDE; PHASE_FRAME();
            router_phase(P, (const bf16_t*)(ws + WS_H), (const bf16_t*)(wl + WO_ROUTER), INP(16) + (size_t)l * NE, F.ctl + CW_CNT + 64 * l, (int*)(ws + WS_TOPE), (int*)(ws + WS_TOPS), (int*)(ws + WS_ROWTOK), (float*)(ws + WS_ROWGATE)); }
        SEAM(pb + 6);
        if (IN(pb + 7)) { unsigned char* ws = WSB(); unsigned char* wl = ws + WS_W + (size_t)l * WL_STRIDE; { PHASE_FRAME(); moe_table(P, F.ctl + CW_CNT + 64 * l); }
            pg8::Gemm g{(const bf16_t*)(ws + WS_H), (const bf16_t*)(wl + WO_GU), D, D, D, (const int*)(ws + WS_ROWTOK)};
            pg8::MoeOrder S{(const volatile LAS int*)(F.MISC + MISC_TB), (const volatile LAS int*)(F.MISC + MISC_CNT), 8, launder_s(F.G), launder_s(cb), 2 * D};
            pg8::EpiGU E{(bf16_t*)(ws + WS_ACT), INP(18) + (size_t)l * NE * 2 * D};
            pg8::gemm_phase<pg8::EpiGU, pg8::MoeOrder, 6>(F.lds, F.wave, g, S, E); }
        SEAM(pb + 7);
        if (IN(pb + 8)) { unsigned char* ws = WSB(); unsigned char* wl = ws + WS_W + (size_t)l * WL_STRIDE; { PHASE_FRAME(); moe_table(P, F.ctl + CW_CNT + 64 * l); }
            pg8::Gemm g{(const bf16_t*)(ws + WS_ACT), (const bf16_t*)(wl + WO_DN), D, D, D, nullptr};
            pg8::MoeOrder S{(const volatile LAS int*)(F.MISC + MISC_TB), (const volatile LAS int*)(F.MISC + MISC_CNT), 4, launder_s(F.G), launder_s(cb), D};
            pg8::EpiDN E{(bf16_t*)(ws + WS_YR), INP(20) + (size_t)l * NE * D, (const float*)(ws + WS_ROWGATE)};
            pg8::gemm_phase<pg8::EpiDN, pg8::MoeOrder, 7>(F.lds, F.wave, g, S, E); }
        SEAM(pb + 8);
        if (IN(pb + 9)) { unsigned char* ws = WSB(); PHASE_FRAME(); moe_table(P, F.ctl + CW_CNT + 64 * l);
            const bool hn = (l + 1 < DEPTH); const float* MOD = (const float*)(ws + WS_MOD);
            rowpass_comb(P, OUTP(), (const bf16_t*)(ws + WS_YR), (const int*)(ws + WS_TOPE), (const int*)(ws + WS_TOPS), INP(7) + (size_t)l * D, MOD + (size_t)l * BATCH * 6 * D,
                         hn, INP(4) + (size_t)(hn ? l + 1 : l) * D, MOD + (size_t)(hn ? l + 1 : l) * BATCH * 6 * D, (bf16_t*)(ws + WS_H)); }
        SEAM(pb + 9);
    }
#undef IN
#undef SEAM
}

extern "C" void kernel_launch(void* const* d_in, const int* in_sizes, int n_in, void* d_out, int out_size, void* d_ws, size_t ws_size, hipStream_t stream) {
    static int grid = 0;
    if (grid == 0) {
        if (n_in != 21 || in_sizes[0] != T * D || out_size != T * D || ws_size < WS_END) { fprintf(stderr, "kernel_launch: unexpected shapes (n_in %d, in0 %d, out %d, ws %zu < %zu); nothing launched\n", n_in, n_in > 0 ? in_sizes[0] : -1, out_size, ws_size, (size_t)WS_END); grid = -1; return; }
        int dev = 0, cus = 0, per_cu = 0;
        if (hipGetDevice(&dev) != hipSuccess || hipDeviceGetAttribute(&cus, hipDeviceAttributeMultiprocessorCount, dev) != hipSuccess) { grid = -1; return; }
        if (hipFuncSetAttribute((const void*)fwd, hipFuncAttributeMaxDynamicSharedMemorySize, LDS_BYTES) != hipSuccess) { fprintf(stderr, "kernel_launch: hipFuncSetAttribute failed\n"); grid = -1; return; }
        if (hipOccupancyMaxActiveBlocksPerMultiprocessor(&per_cu, (const void*)fwd, NTHREADS, LDS_BYTES) != hipSuccess || per_cu < 1) { fprintf(stderr, "kernel_launch: occupancy query says %d\n", per_cu); }
        (void)hipGetLastError();
        grid = cus;
    }
    if (grid < 0) return;
    if (hipMemsetAsync((char*)d_ws + WS_CTL, 0, CTL_ZERO_BYTES, stream) != hipSuccess) return;
    Args a{};
    for (int i = 0; i < 21; ++i) a.in[i] = (const float*)d_in[i];
    a.out = (float*)d_out; a.ws = (unsigned char*)d_ws;
#if N_LAUNCHES == 1
    a.ph_lo = 0; a.ph_hi = NPHASES;
    hipLaunchKernelGGL(fwd, dim3(grid), dim3(NTHREADS), LDS_BYTES, stream, a);
#else
    for (int p = 0; p < NPHASES; ++p) { a.ph_lo = p; a.ph_hi = p + 1; hipLaunchKernelGGL(fwd, dim3(grid), dim3(NTHREADS), LDS_BYTES, stream, a); }
#endif
}
```

```cpp
#include <hip/hip_runtime.h>
#include <cstdio>
#include <cstdint>

#ifndef N_LAUNCHES
#define N_LAUNCHES 1
#endif
#ifndef REP_MASK
#define REP_MASK 0
#endif
#define REPEAT(b) _Pragma("unroll 1") for (int _rep = 0; _rep < (((REP_MASK >> (b)) & 1) ? 2 : 1); ++_rep)
#ifndef FAST_MASK
#define FAST_MASK 0xff
#endif

#define LAS __attribute__((address_space(3)))
#define GAS __attribute__((address_space(1)))
typedef unsigned short bf16_t;
typedef short bf16x8 __attribute__((ext_vector_type(8)));
typedef short s16x4 __attribute__((ext_vector_type(4)));
typedef float f32x4 __attribute__((ext_vector_type(4)));
typedef float f32x2 __attribute__((ext_vector_type(2)));
typedef float f32x16 __attribute__((ext_vector_type(16)));
typedef unsigned u32x4 __attribute__((ext_vector_type(4)));
typedef unsigned u32x2 __attribute__((ext_vector_type(2)));

constexpr int D = 1024, BATCH = 2, SEQ = 16384, T = BATCH * SEQ, DEPTH = 2;
constexpr int SBW = 256, NH = 4, HD = 64, PW = 768, PGD = 192, INW = 3584;
constexpr int NE = 32, TOPK = 4;
constexpr float NORM_EPS = 1e-6f, SW_LIMIT = 7.0f, SW_ALPHA = 1.702f;
constexpr float STICK_EXIT = -40.0f;
constexpr int NWAVES = 8, NTHREADS = 512;
constexpr int MAXTILES = (T * TOPK) / 256 + NE;

constexpr size_t MiB = 1u << 20;
constexpr size_t WS_CTL = 0, CTL_ZERO_BYTES = 1 * MiB;
constexpr size_t WS_MOD = 1 * MiB;
constexpr size_t WS_W = 2 * MiB, WL_STRIDE = 205 * MiB;
constexpr size_t WO_WIN = 0, WO_BRA = 7 * MiB, WO_BRP = 7 * MiB + MiB / 2, WO_OUT = 9 * MiB, WO_POOL = 11 * MiB, WO_ROUTER = 12 * MiB + MiB / 2, WO_GU = 13 * MiB, WO_DN = 141 * MiB;
constexpr size_t WS_H = 416 * MiB, WS_Q = 480 * MiB, WS_K = 496 * MiB, WS_VT = 512 * MiB, WS_U = 528 * MiB, WS_G = 576 * MiB;
constexpr size_t WS_AP = 704 * MiB, WS_MIX = 768 * MiB, WS_MRG = 816 * MiB, WS_Y = 880 * MiB;
constexpr size_t WS_TOPE = 944 * MiB, WS_TOPS = 944 * MiB + MiB / 2, WS_TOPL = 945 * MiB, WS_TOPG = 945 * MiB + MiB / 2, WS_ROWTOK = 946 * MiB, WS_ROWGATE = 950 * MiB;
constexpr size_t WS_HIST = 954 * MiB;
constexpr size_t WS_ACT = 960 * MiB, WS_YR = 1232 * MiB, WS_END = 1504 * MiB;
static_assert(WO_DN + (size_t)NE * D * D * 2 <= WL_STRIDE && WS_W + DEPTH * WL_STRIDE <= WS_H, "weights map");
static_assert(WS_ACT + (size_t)MAXTILES * 256 * D * 2 <= WS_YR && WS_YR + (size_t)MAXTILES * 256 * D * 2 <= WS_END, "act map");
constexpr int CW_BAR = 4096, CW_CNT = 8192;

constexpr int RING_BYTES = 131072, LDSCTL_OFF = RING_BYTES, LDS_BYTES = 147456;
constexpr int MISC_BAR = 8;
constexpr int MISC_TB = 64, MISC_CNT = 128;

__device__ __forceinline__ unsigned f2bf(float f) { unsigned u = __builtin_bit_cast(unsigned, f); return (u + 0x7fffu + ((u >> 16) & 1u)) >> 16; }
__device__ __forceinline__ unsigned pk2(float lo, float hi) { return f2bf(lo) | (f2bf(hi) << 16); }
__device__ __forceinline__ float bf_lo(unsigned w) { return __builtin_bit_cast(float, w << 16); }
__device__ __forceinline__ float bf_hi(unsigned w) { return __builtin_bit_cast(float, w & 0xffff0000u); }
__device__ __forceinline__ float fast_exp(float x) { return __builtin_amdgcn_exp2f(x * 1.4426950408889634f); }
__device__ __forceinline__ float fast_sigmoid(float x) { return __builtin_amdgcn_rcpf(1.0f + fast_exp(-x)); }
__device__ __forceinline__ float softplus_f(float z) { return fmaxf(z, 0.f) + 0.6931471805599453f * __builtin_amdgcn_logf(1.0f + fast_exp(-fabsf(z))); }
__device__ __forceinline__ float wave_sum(float v) {
#pragma unroll
    for (int o = 1; o < 64; o <<= 1) v += __shfl_xor(v, o);
    return v;
}
__device__ __forceinline__ int launder_v(int x) { asm volatile("" : "+v"(x)); return x; }
__device__ __forceinline__ int launder_s(int x) { asm volatile("" : "+s"(x)); return x; }
__device__ __forceinline__ int lane_id_v() { int x; asm volatile("v_mbcnt_lo_u32_b32 %0, -1, 0\n\tv_mbcnt_hi_u32_b32 %0, -1, %0" : "=v"(x)); return x; }
#define LDS_WAIT() asm volatile("s_waitcnt lgkmcnt(0)" ::: "memory")
#define VM_WAIT() asm volatile("s_waitcnt vmcnt(0)" ::: "memory")

#define XB_TMO      128
#define XB_XCNT(j)  (256  + 64 * (j))
#define XB_XSUB(j)  (1280 + 64 * (j))
#define XB_XGEN(j)  (2304 + 64 * (j))
#define XB_TOP      3328
#define XB_TOPGEN   3392
#define XCD_BAR_WORDS 3456
#define XB_SPIN_CAP (1u << 18)
__device__ __forceinline__ unsigned xb_ld(unsigned* p)              { return __hip_atomic_load(p, __ATOMIC_RELAXED, __HIP_MEMORY_SCOPE_AGENT); }
__device__ __forceinline__ unsigned xb_add(unsigned* p, unsigned v) { return __hip_atomic_fetch_add(p, v, __ATOMIC_RELAXED, __HIP_MEMORY_SCOPE_AGENT); }
__device__ __forceinline__ unsigned xb_xcc_id() { return (unsigned)__builtin_amdgcn_s_getreg((3 << 11) | 20) & 0xFu; }
#define XB_SPIN(cond, bar) do { unsigned _sp = 0; while (cond) { __builtin_amdgcn_s_sleep(1); \
    if ((++_sp & 255u) == 0u) { if (xb_ld(&(bar)[XB_TMO])) break; if (_sp > XB_SPIN_CAP) { atomicAdd(&(bar)[XB_TMO], 1u); break; } } } } while (0)
struct XcdBarrier { unsigned* bar; unsigned x; volatile LAS unsigned* st; };
__device__ __forceinline__ XcdBarrier xcd_barrier_post(unsigned* bar, volatile LAS unsigned* st, bool t0) {
    XcdBarrier b; b.bar = bar; b.x = xb_xcc_id(); b.st = st;
    if (t0) (void)xb_add(&bar[XB_XCNT(b.x)], 1u);
    return b;
}
__device__ __forceinline__ void xcd_barrier_complete(unsigned* bar, unsigned x, unsigned& nloc, unsigned& nx) {
    const unsigned G = gridDim.x * gridDim.y * gridDim.z;
    unsigned sum, cnt, mine, sp = 0u;
    for (;;) {
        sum = 0u; cnt = 0u; mine = 0u;
#pragma unroll
        for (unsigned j = 0; j < 16; ++j) { const unsigned c = xb_ld(&bar[XB_XCNT(j)]); sum += c; cnt += (c > 0u) ? 1u : 0u; mine = (j == x) ? c : mine; }
        if (sum == G) break;
        __builtin_amdgcn_s_sleep(1);
        if ((++sp & 255u) == 0u) { if (xb_ld(&bar[XB_TMO])) break; if (sp > XB_SPIN_CAP) { atomicAdd(&bar[XB_TMO], 1u); break; } }
    }
    nloc = mine > 0u ? mine : 1u; nx = cnt > 0u ? cnt : 1u;
}
__device__ __forceinline__ void xcd_barrier(const XcdBarrier& b, bool t0) {
    asm volatile("s_waitcnt vmcnt(0)" ::: "memory");
    __syncthreads();
    if (t0) {
        unsigned* bar = b.bar;
        __builtin_amdgcn_s_waitcnt(0);
        unsigned nloc = b.st[0], nx = b.st[1];
        if (nloc == 0u) { xcd_barrier_complete(bar, b.x, nloc, nx); b.st[0] = nloc; b.st[1] = nx; }
        const unsigned old = xb_add(&bar[XB_XSUB(b.x)], 1u);
        const unsigned gen = old / nloc;
        if (old + 1u == (gen + 1u) * nloc) {
            __builtin_amdgcn_fence(__ATOMIC_RELEASE, "agent");
            asm volatile("s_waitcnt vmcnt(0)" ::: "memory");
            const unsigned og = xb_add(&bar[XB_TOP], 1u);
            const unsigned tg = og / nx;
            if (og + 1u == (tg + 1u) * nx) xb_add(&bar[XB_TOPGEN], 1u);
            else XB_SPIN(xb_ld(&bar[XB_TOPGEN]) == tg, bar);
            __builtin_amdgcn_fence(__ATOMIC_ACQUIRE, "agent");
            xb_add(&bar[XB_XGEN(b.x)], 1u);
            asm volatile("s_waitcnt vmcnt(0)" ::: "memory");
        } else {
            XB_SPIN(xb_ld(&bar[XB_XGEN(b.x)]) == gen, bar);
            __builtin_amdgcn_fence(__ATOMIC_ACQUIRE, "agent");
            asm volatile("s_waitcnt vmcnt(0)" ::: "memory");
        }
    }
    __syncthreads();
}

namespace pg8 {
constexpr int BM = 256, BK = 64, HALF = 128, HTB = HALF * BK * 2, STAGE_BYTES = 8 * HTB, NXCD = 8, WGM = 8;
__host__ __device__ __forceinline__ int lds_byte(int r, int c) { const int st = (r >> 4) * 2 + (c >> 5), rr = r & 15, cc = c & 31, ob = rr * 64 + cc * 2; return st * 1024 + (ob ^ (((ob >> 9) & 1) << 5)); }
__host__ __device__ __forceinline__ void stage_rc(int b, int& R, int& C) { const int st = b / 1024, sb = b % 1024, swz = sb ^ (((sb >> 9) & 1) << 5); R = (st >> 1) * 16 + swz / 64; C = (st & 1) * 32 + (swz % 64) / 2; }
__host__ __device__ __forceinline__ int perm32(int rho) { const int n = rho >> 4, i = rho & 15; return 8 * (i >> 2) + 4 * n + (i & 3); }

struct Unit { int pm, pn, e, nvalid, slot0; unsigned aoff, boff; };
struct Gemm { const bf16_t* A; const bf16_t* Bt; int lda, ldb, K; const int* gather; };

__device__ __forceinline__ bool order_unit(int i, int G, int c, int nM, int nN, int& pm, int& pn) {
    const int nwg = nM * nN; const long L = (long)i * G + c; if (L >= nwg) return false;
    int wgid = (int)L; { const int q = nwg / NXCD, r = nwg % NXCD, xcd = wgid % NXCD, off = wgid / NXCD; wgid = (xcd < r ? xcd * (q + 1) : r * (q + 1) + (xcd - r) * q) + off; }
    const int nig = WGM * nN, gid = wgid / nig, fm = gid * WGM, gsz = (nM - fm) < WGM ? (nM - fm) : WGM;
    pm = fm + ((wgid % nig) % gsz); pn = (wgid % nig) / gsz; return true;
}
struct StaticOrder {
    int nM, nN, G, c, lda, ldb, kstride;
    __device__ __forceinline__ bool next(int i, Unit& u) const {
        if (!order_unit(i, G, c, nM, nN, u.pm, u.pn)) return false;
        u.e = 0; u.nvalid = 256; u.slot0 = 0;
        u.aoff = (unsigned)(u.pm * BM) * (unsigned)lda + (unsigned)(kstride * u.pn); u.boff = (unsigned)(u.pn * BM) * (unsigned)ldb + (unsigned)(kstride * u.pn); return true;
    }
};
struct MoeOrder {
    const volatile LAS int* tb; const volatile LAS int* cnt; int nN, G, c, nw;
    __device__ __forceinline__ bool next(int i, Unit& u) const {
        const int nM = tb[NE];
        if (!order_unit(i, G, c, nM, nN, u.pm, u.pn)) return false;
        int e = 0;
#pragma unroll 1
        for (int j = 1; j < NE; ++j) e += (tb[j] <= u.pm) ? 1 : 0;
        u.e = e; u.slot0 = (u.pm - tb[e]) * BM; const int left = cnt[e] - u.slot0; u.nvalid = left < BM ? left : BM;
        u.aoff = (unsigned)(u.pm * BM) * (unsigned)D; u.boff = ((unsigned)e * (unsigned)nw + (unsigned)(u.pn * BM)) * (unsigned)D; return true;
    }
};

__device__ __forceinline__ unsigned cvt_pk_bf16(float lo, float hi) { unsigned r; asm volatile("v_cvt_pk_bf16_f32 %0, %1, %2" : "=v"(r) : "v"(lo), "v"(hi)); return r; }
__device__ __forceinline__ u32x4 pack8(const f32x4 a, const f32x4 b) { u32x4 w; w.x = cvt_pk_bf16(a[0], a[1]); w.y = cvt_pk_bf16(a[2], a[3]); w.z = cvt_pk_bf16(b[0], b[1]); w.w = cvt_pk_bf16(b[2], b[3]); return w; }
__device__ __forceinline__ void unpack8(const u32x4 w, f32x4& a, f32x4& b) { a = (f32x4){bf_lo(w.x), bf_hi(w.x), bf_lo(w.y), bf_hi(w.y)}; b = (f32x4){bf_lo(w.z), bf_hi(w.z), bf_lo(w.w), bf_hi(w.w)}; }

#define EPI_LOOP_ROWS for (int ai = 0; ai < 2; ++ai) _Pragma("unroll") for (int m = 0; m < 4; ++m)
struct EpiIn {
    static constexpr bool PERM = true;
    bf16_t *Q, *KB, *U, *G;
    __device__ __forceinline__ void operator()(const f32x4 (&acc)[2][2][4][2], const Unit& u, int wr, int wc, int fr, int fq) const {
        const int pn = u.pn; bf16_t* base; int ld, c0, mode;
        if (pn == 0) { base = Q; ld = SBW; c0 = 0; mode = 1; } else if (pn == 1) { base = KB; ld = SBW; c0 = 0; mode = 0; }
        else if (pn < 5) { base = U; ld = PW; c0 = (pn - 2) * BM; mode = 0; } else { base = G; ld = 2 * D; c0 = (pn - 5) * BM; mode = 2; }
        const int row0 = u.pm * BM + wr * 64 + fr, col0 = c0 + wc * 32 + 8 * fq;
#pragma unroll
        EPI_LOOP_ROWS { bf16_t* rowp = base + (size_t)(row0 + ai * HALF + m * 16) * ld + col0;
#pragma unroll
            for (int bj = 0; bj < 2; ++bj) { f32x4 v0 = acc[ai][bj][m][0], v1 = acc[ai][bj][m][1];
                if (mode == 1) { v0 = v0 * 0.125f; v1 = v1 * 0.125f; }
                if (mode == 2) {
#pragma unroll
                    for (int j = 0; j < 4; ++j) { v0[j] = fast_sigmoid(v0[j]); v1[j] = fast_sigmoid(v1[j]); } }
                *(u32x4*)(rowp + bj * HALF) = pack8(v0, v1); } }
    }
};
struct EpiPlain {
    static constexpr bool PERM = true;
    bf16_t* O; int ldc, coff; const float* bias; const float* scale;
    __device__ __forceinline__ void operator()(const f32x4 (&acc)[2][2][4][2], const Unit& u, int wr, int wc, int fr, int fq) const {
        const int row0 = u.pm * BM + wr * 64 + fr, col0 = u.pn * BM + wc * 32 + 8 * fq;
        f32x4 bv[2][2], sv[2][2];
#pragma unroll
        for (int bj = 0; bj < 2; ++bj)
#pragma unroll
            for (int n = 0; n < 2; ++n) { bv[bj][n] = bias ? *(const f32x4*)(bias + col0 + bj * HALF + 4 * n) : (f32x4){0.f, 0.f, 0.f, 0.f};
                                          sv[bj][n] = scale ? *(const f32x4*)(scale + col0 + bj * HALF + 4 * n) : (f32x4){1.f, 1.f, 1.f, 1.f}; }
#pragma unroll
        EPI_LOOP_ROWS { bf16_t* rowp = O + (size_t)(row0 + ai * HALF + m * 16) * ldc + coff + col0;
#pragma unroll
            for (int bj = 0; bj < 2; ++bj) *(u32x4*)(rowp + bj * HALF) = pack8((acc[ai][bj][m][0] + bv[bj][0]) * sv[bj][0], (acc[ai][bj][m][1] + bv[bj][1]) * sv[bj][1]); }
    }
};
template <bool ADD> struct EpiBranch {
    static constexpr bool PERM = true;
    bf16_t* MRG; const bf16_t* G; int goff;
    __device__ __forceinline__ void operator()(const f32x4 (&acc)[2][2][4][2], const Unit& u, int wr, int wc, int fr, int fq) const {
        const int row0 = u.pm * BM + wr * 64 + fr, col0 = u.pn * BM + wc * 32 + 8 * fq;
#pragma unroll
        EPI_LOOP_ROWS { const size_t r = (size_t)(row0 + ai * HALF + m * 16);
#pragma unroll
            for (int bj = 0; bj < 2; ++bj) { const int c = col0 + bj * HALF;
                f32x4 g0, g1; unpack8(*(const u32x4*)(G + r * (2 * D) + goff + c), g0, g1);
                f32x4 v0 = g0 * acc[ai][bj][m][0], v1 = g1 * acc[ai][bj][m][1];
                if (ADD) { f32x4 p0, p1; unpack8(*(const u32x4*)(MRG + r * D + c), p0, p1); v0 = v0 + p0; v1 = v1 + p1; }
                *(u32x4*)(MRG + r * D + c) = pack8(v0, v1); } }
    }
};
struct EpiGU {
    static constexpr bool PERM = true;
    bf16_t* ACT; const float* bgu;
    __device__ __forceinline__ void operator()(const f32x4 (&acc)[2][2][4][2], const Unit& u, int wr, int wc, int fr, int fq) const {
        const int row0 = u.pm * BM + wr * 64 + fr, col0 = u.pn * HALF + wc * 32 + 8 * fq;
        const float* bg = bgu + (size_t)u.e * (2 * D) + col0;
        f32x4 bgv[2], buv[2];
#pragma unroll
        for (int n = 0; n < 2; ++n) { bgv[n] = *(const f32x4*)(bg + 4 * n); buv[n] = *(const f32x4*)(bg + D + 4 * n); }
#pragma unroll
        EPI_LOOP_ROWS { f32x4 o[2];
#pragma unroll
            for (int n = 0; n < 2; ++n) { f32x4 gt = acc[ai][0][m][n] + bgv[n], up = acc[ai][1][m][n] + buv[n];
#pragma unroll
                for (int j = 0; j < 4; ++j) { const float g = fminf(gt[j], SW_LIMIT), uu = fminf(fmaxf(up[j], -SW_LIMIT), SW_LIMIT); o[n][j] = (uu + 1.0f) * g * fast_sigmoid(SW_ALPHA * g); } }
            *(u32x4*)(ACT + (size_t)(row0 + ai * HALF + m * 16) * D + col0) = pack8(o[0], o[1]); }
    }
};
struct EpiDN {
    static constexpr bool PERM = true;
    bf16_t* YR; const float* bdn; const float* rowgate;
    __device__ __forceinline__ void operator()(const f32x4 (&acc)[2][2][4][2], const Unit& u, int wr, int wc, int fr, int fq) const {
        const int rl0 = wr * 64 + fr, col0 = u.pn * BM + wc * 32 + 8 * fq;
        const float* bp = bdn + (size_t)u.e * D + col0; const float* gp = rowgate + (size_t)u.e * T + u.slot0;
        f32x4 bv[2][2];
#pragma unroll
        for (int bj = 0; bj < 2; ++bj)
#pragma unroll
            for (int n = 0; n < 2; ++n) bv[bj][n] = *(const f32x4*)(bp + bj * HALF + 4 * n);
#pragma unroll
        EPI_LOOP_ROWS { const int rl = rl0 + ai * HALF + m * 16; const float gt = rl < u.nvalid ? gp[rl] : 0.f;
            bf16_t* rowp = YR + (size_t)(u.pm * BM + rl) * D + col0;
#pragma unroll
            for (int bj = 0; bj < 2; ++bj) *(u32x4*)(rowp + bj * HALF) = pack8((acc[ai][bj][m][0] + bv[bj][0]) * gt, (acc[ai][bj][m][1] + bv[bj][1]) * gt); }
    }
};

template <class Epi, class Sched>
__device__ __forceinline__ void gemm_simple(int wave, const Gemm g, const Sched& S, const Epi& E) {
    const int wid = launder_s(wave), lane = lane_id_v(), wr = wid >> 2, wc = wid & 3, fr = lane & 15, fq = lane >> 4;
    Unit u;
    for (int ui = 0; S.next(ui, u); ++ui) {
        f32x4 acc[2][2][4][2];
#pragma unroll
        for (int a = 0; a < 2; ++a)
#pragma unroll
            for (int b = 0; b < 2; ++b)
#pragma unroll
                for (int m = 0; m < 4; ++m)
#pragma unroll
                    for (int n = 0; n < 2; ++n) acc[a][b][m][n] = (f32x4){0.f, 0.f, 0.f, 0.f};
        unsigned ao[2][4], bo[2][2];
#pragma unroll
        for (int ai = 0; ai < 2; ++ai)
#pragma unroll
            for (int m = 0; m < 4; ++m) { const int rl = ai * HALF + wr * 64 + m * 16 + fr;
                if (g.gather) { const int tok = rl < u.nvalid ? g.gather[(size_t)u.e * T + u.slot0 + rl] : 0; ao[ai][m] = (unsigned)tok * (unsigned)g.lda + fq * 8; }
                else ao[ai][m] = u.aoff + (unsigned)rl * (unsigned)g.lda + fq * 8; }
#pragma unroll
        for (int bj = 0; bj < 2; ++bj)
#pragma unroll
            for (int n = 0; n < 2; ++n) { const int slot = 16 * n + fr, brow = bj * HALF + wc * 32 + (Epi::PERM ? perm32(slot) : slot); bo[bj][n] = u.boff + (unsigned)brow * (unsigned)g.ldb + fq * 8; }
#pragma unroll 1
        for (int k = 0; k < g.K; k += 32) {
            bf16x8 b[2][2];
#pragma unroll
            for (int bj = 0; bj < 2; ++bj)
#pragma unroll
                for (int n = 0; n < 2; ++n) b[bj][n] = *(const bf16x8*)(g.Bt + (size_t)bo[bj][n] + k);
#pragma unroll
            for (int ai = 0; ai < 2; ++ai) {
                bf16x8 a[4];
#pragma unroll
                for (int m = 0; m < 4; ++m) a[m] = *(const bf16x8*)(g.A + (size_t)ao[ai][m] + k);
#pragma unroll
                for (int bj = 0; bj < 2; ++bj)
#pragma unroll
                    for (int m = 0; m < 4; ++m)
#pragma unroll
                        for (int n = 0; n < 2; ++n) acc[ai][bj][m][n] = __builtin_amdgcn_mfma_f32_16x16x32_bf16(b[bj][n], a[m], acc[ai][bj][m][n], 0, 0, 0);
            }
        }
        E(acc, u, wr, wc, fr, fq);
    }
}

template <class Epi, class Sched>
__device__ __forceinline__ void gemm_fast(LAS unsigned char* lds, int wave, const Gemm g, const Sched& S, const Epi& E) {
    const int wid = launder_s(wave), lane = lane_id_v(), tid = wid * 64 + lane, wr = wid >> 2, wc = wid & 3, fr = lane & 15, fq = lane >> 4;
    const int K = launder_s(g.K), nt = K / BK;
    unsigned voffB[2];
#pragma unroll
    for (int i = 0; i < 2; ++i) { int R, C; stage_rc(tid * 16 + i * 8192, R, C); const int Rb = Epi::PERM ? ((R & ~31) + perm32(R & 31)) : R; voffB[i] = ((unsigned)Rb * (unsigned)g.ldb + (unsigned)C) * 2u; }
    const size_t kstep = (size_t)(BK * 2);
    const size_t hstepB = (size_t)HALF * g.ldb * 2;
    const unsigned ldsw = (unsigned)wid * 1024u;
    const int aoff = lds_byte(wr * 64 + fr, fq * 8), boff = lds_byte(wc * 32 + fr, fq * 8);
    const char* const Abase = (const char*)g.A; const char* const Bbase = (const char*)g.Bt;
#define PG8_SA(b, h) (((b) * 2 + (h)) * HTB)
#define PG8_SB(b, h) ((4 + (b) * 2 + (h)) * HTB)
#define PG8_STAGE_A(bufoff, ao, kb) do { _Pragma("unroll") for (int _i = 0; _i < 2; ++_i) \
        __builtin_amdgcn_global_load_lds((const unsigned*)(Abase + (size_t)(ao)[_i] + (size_t)(kb)), (LAS unsigned*)(lds + (bufoff) + ldsw + _i * 8192), 16, 0, 0); } while (0)
#define PG8_STAGE_B(bufoff, gbase) do { _Pragma("unroll") for (int _i = 0; _i < 2; ++_i) \
        __builtin_amdgcn_global_load_lds((const unsigned*)((const char*)(gbase) + voffB[_i]), (LAS unsigned*)(lds + (bufoff) + ldsw + _i * 8192), 16, 0, 0); } while (0)
#define PG8_LDA(dst, b, h) do { _Pragma("unroll") for (int m = 0; m < 4; ++m) _Pragma("unroll") for (int k = 0; k < 2; ++k) dst[m][k] = *(const LAS bf16x8*)(lds + PG8_SA(b, h) + aoff + m * 2048 + k * 1024); } while (0)
#define PG8_LDB(dst, b, h) do { _Pragma("unroll") for (int n = 0; n < 2; ++n) _Pragma("unroll") for (int k = 0; k < 2; ++k) dst[n][k] = *(const LAS bf16x8*)(lds + PG8_SB(b, h) + boff + n * 2048 + k * 1024); } while (0)
#define PG8_MMA(ai, bj, At, Bt) do { __builtin_amdgcn_s_setprio(1); _Pragma("unroll") for (int m = 0; m < 4; ++m) _Pragma("unroll") for (int n = 0; n < 2; ++n) _Pragma("unroll") for (int k = 0; k < 2; ++k) \
        acc[ai][bj][m][n] = __builtin_amdgcn_mfma_f32_16x16x32_bf16(Bt[n][k], At[m][k], acc[ai][bj][m][n], 0, 0, 0); __builtin_amdgcn_s_setprio(0); } while (0)
#define PG8_WAIT_V(n) asm volatile("s_waitcnt vmcnt(" #n ")" ::: "memory")
#define PG8_WAIT_L(n) asm volatile("s_waitcnt lgkmcnt(" #n ")" ::: "memory")
#define PG8_BAR __builtin_amdgcn_s_barrier()
#define PG8_SCHED __builtin_amdgcn_sched_barrier(0)
#define PG8_AOFFS(u, ao) do { _Pragma("unroll") for (int _h = 0; _h < 2; ++_h) _Pragma("unroll") for (int _i = 0; _i < 2; ++_i) { int _R, _C; stage_rc(tid * 16 + _i * 8192, _R, _C); const int _rl = _h * HALF + _R; \
        if (g.gather) { const int _tok = _rl < (u).nvalid ? g.gather[(size_t)(u).e * T + (u).slot0 + _rl] : 0; ao[_h][_i] = ((unsigned)_tok * (unsigned)g.lda + (unsigned)_C) * 2u; } \
        else ao[_h][_i] = ((u).aoff + (unsigned)_rl * (unsigned)g.lda + (unsigned)_C) * 2u; } } while (0)
    Unit cur, nxt; int ui = 0;
    if (!S.next(0, cur)) return;
    f32x4 acc[2][2][4][2];
#pragma unroll
    for (int a = 0; a < 2; ++a)
#pragma unroll
        for (int b = 0; b < 2; ++b)
#pragma unroll
            for (int m = 0; m < 4; ++m)
#pragma unroll
                for (int n = 0; n < 2; ++n) acc[a][b][m][n] = (f32x4){0.f, 0.f, 0.f, 0.f};
    bf16x8 At[4][2], B0[2][2], B1[2][2];
    unsigned aC[2][2], aN[2][2];
    PG8_AOFFS(cur, aC);
    const char* cB = Bbase + (size_t)cur.boff * 2;
    PG8_STAGE_B(PG8_SB(0, 0), cB); PG8_STAGE_B(PG8_SB(0, 1), cB + hstepB); PG8_STAGE_A(PG8_SA(0, 0), aC[0], 0); PG8_STAGE_A(PG8_SA(0, 1), aC[1], 0);
    if (wr == 1) PG8_BAR;
    PG8_WAIT_V(2); PG8_BAR;
    PG8_STAGE_B(PG8_SB(1, 0), cB + kstep); PG8_STAGE_A(PG8_SA(1, 0), aC[0], kstep); PG8_STAGE_B(PG8_SB(1, 1), cB + hstepB + kstep);
    PG8_WAIT_V(6); PG8_BAR;
    for (;;) {
        const bool has_next = S.next(ui + 1, nxt);
        if (has_next) { PG8_AOFFS(nxt, aN); } else {
#pragma unroll
            for (int h = 0; h < 2; ++h)
#pragma unroll
                for (int i = 0; i < 2; ++i) aN[h][i] = aC[h][i]; }
        const char* nB = has_next ? Bbase + (size_t)nxt.boff * 2 : cB;
#pragma unroll 1
        for (int t = 0; t < nt; t += 2) {
            const bool last = (t == nt - 2);
            const size_t k1 = (size_t)(t + 1) * kstep, k2 = last ? 0 : (size_t)(t + 2) * kstep, k3 = k2 + kstep;
            unsigned a2[2][2];
#pragma unroll
            for (int h = 0; h < 2; ++h)
#pragma unroll
                for (int i = 0; i < 2; ++i) a2[h][i] = last ? aN[h][i] : aC[h][i];
            const char* b2 = last ? nB : cB + (size_t)(t + 2) * kstep; const char* b3 = b2 + kstep;
            PG8_LDB(B0, 0, 0); PG8_LDB(B1, 0, 1); PG8_SCHED; PG8_LDA(At, 0, 0); PG8_STAGE_A(PG8_SA(1, 1), aC[1], k1);
            PG8_WAIT_V(8); PG8_WAIT_L(0); PG8_BAR; PG8_MMA(0, 0, At, B0); PG8_MMA(0, 1, At, B1); PG8_BAR; PG8_SCHED;
            PG8_LDA(At, 0, 1); PG8_STAGE_B(PG8_SB(0, 0), b2); PG8_STAGE_B(PG8_SB(0, 1), b2 + hstepB); PG8_STAGE_A(PG8_SA(0, 0), a2[0], k2);
            PG8_WAIT_V(8); PG8_WAIT_L(0); PG8_BAR; PG8_MMA(1, 0, At, B0); PG8_MMA(1, 1, At, B1); PG8_BAR; PG8_SCHED;
            PG8_LDB(B0, 1, 0); PG8_LDB(B1, 1, 1); PG8_SCHED; PG8_LDA(At, 1, 0); PG8_STAGE_A(PG8_SA(0, 1), a2[1], k2);
            PG8_WAIT_V(8); PG8_WAIT_L(0); PG8_BAR; PG8_MMA(0, 0, At, B0); PG8_MMA(0, 1, At, B1); PG8_BAR; PG8_SCHED;
            PG8_LDA(At, 1, 1); PG8_STAGE_B(PG8_SB(1, 0), b3); PG8_STAGE_B(PG8_SB(1, 1), b3 + hstepB); PG8_STAGE_A(PG8_SA(1, 0), a2[0], k3);
            PG8_WAIT_V(8); PG8_WAIT_L(0); PG8_BAR; PG8_MMA(1, 0, At, B0); PG8_MMA(1, 1, At, B1); PG8_BAR; PG8_SCHED;
        }
        if (wr == 0) PG8_BAR;
        E(acc, cur, wr, wc, fr, fq);
        if (!has_next) break;
#pragma unroll
        for (int a = 0; a < 2; ++a)
#pragma unroll
            for (int b = 0; b < 2; ++b)
#pragma unroll
                for (int m = 0; m < 4; ++m)
#pragma unroll
                    for (int n = 0; n < 2; ++n) acc[a][b][m][n] = (f32x4){0.f, 0.f, 0.f, 0.f};
        cur = nxt; cB = nB; ++ui;
#pragma unroll
        for (int h = 0; h < 2; ++h)
#pragma unroll
            for (int i = 0; i < 2; ++i) aC[h][i] = aN[h][i];
        if (wr == 1) PG8_BAR;
    }
    PG8_WAIT_V(0);
    PG8_BAR;
#undef PG8_SA
#undef PG8_SB
#undef PG8_STAGE_A
#undef PG8_STAGE_B
#undef PG8_LDA
#undef PG8_LDB
#undef PG8_MMA
#undef PG8_WAIT_V
#undef PG8_WAIT_L
#undef PG8_BAR
#undef PG8_SCHED
#undef PG8_AOFFS
}

template <class Epi, class Sched, int SITE>
__device__ __forceinline__ void gemm_phase(LAS unsigned char* lds, int wave, const Gemm g, const Sched& S, const Epi& E) {
    if constexpr ((FAST_MASK >> SITE) & 1) gemm_fast<Epi, Sched>(lds, wave, g, S, E); else gemm_simple<Epi, Sched>(wave, g, S, E);
}
}

struct Frame {
    LAS unsigned char* lds;
    volatile LAS unsigned* MISC;
    unsigned* ctl;
    int tid, lane, wave, vcu, G;
};
struct Args { const float* in[21]; float* out; unsigned char* ws; int ph_lo, ph_hi; };
static_assert(sizeof(Args) == 21 * 8 + 8 + 8 + 8, "Args has no padding");

__device__ __forceinline__ void mods_phase(Frame& F, const float* c, const float* ada_w, const float* ada_b, float* MOD) {
    LAS float* cact = (LAS float*)F.lds;
    LAS float* part = (LAS float*)(F.lds + 8192);
    for (int i = F.tid; i < BATCH * D; i += NTHREADS) { const float v = c[i]; cact[i] = v * fast_sigmoid(v); }
    __syncthreads();
    constexpr int NTASK = DEPTH * (6 * D / 64);
    for (int task = F.vcu; task < NTASK; task += F.G) {
        const int l = task / (6 * D / 64), j0 = (task % (6 * D / 64)) * 64;
        const float* w = ada_w + (size_t)l * D * (6 * D) + j0 + F.lane;
        const int k0 = F.wave * 128;
        float a0 = 0.f, a1 = 0.f;
#pragma unroll 16
        for (int k = 0; k < 128; ++k) { const float wv = w[(size_t)(k0 + k) * (6 * D)]; a0 += cact[k0 + k] * wv; a1 += cact[D + k0 + k] * wv; }
        part[(F.wave * 2 + 0) * 64 + F.lane] = a0; part[(F.wave * 2 + 1) * 64 + F.lane] = a1;
        __syncthreads();
        if (F.tid < 128) { const int b = F.tid >> 6, j = F.tid & 63; float s = 0.f;
#pragma unroll
            for (int w8 = 0; w8 < 8; ++w8) s += part[(w8 * 2 + b) * 64 + j];
            MOD[((size_t)l * BATCH + b) * (6 * D) + j0 + j] = s + ada_b[(size_t)l * (6 * D) + j0 + j]; }
        __syncthreads();
    }
}
__device__ __forceinline__ void tr_item(const float* W, int ldw, bf16_t* WT, int ldt, int k0, int n0, int drow0, int dcol0, LAS float* scr, int lane) {
#pragma unroll 8
    for (int i = 0; i < 32; ++i) { const int kk = 2 * i + (lane >> 5); scr[kk * 33 + (lane & 31)] = W[(size_t)(k0 + kk) * ldw + n0 + (lane & 31)]; }
    LDS_WAIT(); asm volatile("" ::: "memory");
    const int c = lane & 7;
#pragma unroll
    for (int j = 0; j < 4; ++j) { const int n = (lane >> 3) + 8 * j; const LAS float* s = scr + (8 * c) * 33 + n;
        u32x4 o; o.x = pk2(s[0 * 33], s[1 * 33]); o.y = pk2(s[2 * 33], s[3 * 33]); o.z = pk2(s[4 * 33], s[5 * 33]); o.w = pk2(s[6 * 33], s[7 * 33]);
        *(u32x4*)(WT + (size_t)(drow0 + n) * ldt + dcol0 + k0 + 8 * c) = o; }
    LDS_WAIT(); asm volatile("" ::: "memory");
}
__device__ __forceinline__ int win_drow(int n0) {
    if (n0 < 512) return n0; if (n0 < 768) return 3328 + (n0 - 512); if (n0 < 1536) return 512 + (n0 - 768); return 1280 + (n0 - 1536);
}
typedef const volatile __attribute__((address_space(4))) Args* KArgs;
__device__ __forceinline__ void convert_phase(Frame& F, KArgs ka) {
    unsigned char* wsb = (unsigned char*)ka->ws; const float *in8 = (const float*)ka->in[8], *in9 = (const float*)ka->in[9], *in12 = (const float*)ka->in[12], *in13 = (const float*)ka->in[13], *in14 = (const float*)ka->in[14], *in15 = (const float*)ka->in[15], *in17 = (const float*)ka->in[17], *in19 = (const float*)ka->in[19];
    LAS float* scr = (LAS float*)(F.lds + F.wave * 16384);
    const int gw = F.vcu * NWAVES + F.wave, NGW = F.G * NWAVES;
    constexpr int I_IN = 16 * 112, I_BRA = 4 * 32, I_BRP = 12 * 32, I_OUT = 16 * 32, I_RT = 16, I_PL = 4 * 3 * 6, I_GU = NE * 16 * 64, I_DN = NE * 16 * 32;
    constexpr int I_LAYER = I_IN + I_BRA + I_BRP + I_OUT + I_RT + I_PL + I_GU + I_DN;
    for (int it = gw; it < DEPTH * I_LAYER; it += NGW) {
        const int l = it / I_LAYER; int r = it % I_LAYER;
        unsigned char* wl = wsb + WS_W + (size_t)l * WL_STRIDE;
        if (r < I_GU) { const int e = r / (16 * 64), q = r % (16 * 64), kb = q / 64, nb = q % 64, n0 = nb * 32, half = n0 / D, cc = n0 % D;
            tr_item(in17 + ((size_t)l * NE + e) * D * (2 * D), 2 * D, (bf16_t*)(wl + WO_GU) + (size_t)e * (2 * D) * D, D, kb * 64, n0, (cc / 128) * 256 + half * 128 + (cc % 128), 0, scr, F.lane); continue; } r -= I_GU;
        if (r < I_DN) { const int e = r / (16 * 32), q = r % (16 * 32), kb = q / 32, nb = q % 32;
            tr_item(in19 + ((size_t)l * NE + e) * D * D, D, (bf16_t*)(wl + WO_DN) + (size_t)e * D * D, D, kb * 64, nb * 32, nb * 32, 0, scr, F.lane); continue; } r -= I_DN;
        if (r < I_IN) { const int kb = r / 112, nb = r % 112;
            tr_item(in8 + (size_t)l * D * INW, INW, (bf16_t*)(wl + WO_WIN), D, kb * 64, nb * 32, win_drow(nb * 32), 0, scr, F.lane); continue; } r -= I_IN;
        if (r < I_BRA) { const int kb = r / 32, nb = r % 32;
            tr_item(in12 + (size_t)l * SBW * D, D, (bf16_t*)(wl + WO_BRA), SBW, kb * 64, nb * 32, nb * 32, 0, scr, F.lane); continue; } r -= I_BRA;
        if (r < I_BRP) { const int kb = r / 32, nb = r % 32;
            tr_item(in13 + (size_t)l * PW * D, D, (bf16_t*)(wl + WO_BRP), PW, kb * 64, nb * 32, nb * 32, 0, scr, F.lane); continue; } r -= I_BRP;
        if (r < I_OUT) { const int kb = r / 32, nb = r % 32;
            tr_item(in14 + (size_t)l * D * D, D, (bf16_t*)(wl + WO_OUT), D, kb * 64, nb * 32, nb * 32, 0, scr, F.lane); continue; } r -= I_OUT;
        if (r < I_RT) { tr_item(in15 + (size_t)l * D * NE, NE, (bf16_t*)(wl + WO_ROUTER), D, r * 64, 0, 0, 0, scr, F.lane); continue; } r -= I_RT;
        { const int gidx = r / 18, q = r % 18, kb = q / 6, nb = q % 6;
            tr_item(in9 + ((size_t)l * 4 + gidx) * PGD * PGD, PGD, (bf16_t*)(wl + WO_POOL), PW, kb * 64, nb * 32, gidx * PGD + nb * 32, gidx * PGD, scr, F.lane); }
    }
    for (int it = gw; it < DEPTH * PW; it += NGW) { const int l = it / PW, n = it % PW, gidx = n / PGD;
        bf16_t* rowp = (bf16_t*)(wsb + WS_W + (size_t)l * WL_STRIDE + WO_POOL) + (size_t)n * PW;
        for (int ch = F.lane; ch < PW / 8; ch += 64) if (ch / (PGD / 8) != gidx) *(u32x4*)(rowp + ch * 8) = (u32x4){0u, 0u, 0u, 0u}; }
}

__device__ __forceinline__ void norm_mod_store(const f32x4 (&v)[4], const float* g, const float* sc, const float* sh, bf16_t* hrow, int lane) {
    float ss = 0.f;
#pragma unroll
    for (int j = 0; j < 4; ++j) ss += (v[j].x * v[j].x + v[j].y * v[j].y) + (v[j].z * v[j].z + v[j].w * v[j].w);
    const float r = 1.0f / sqrtf(wave_sum(ss) * (1.0f / D) + NORM_EPS);
#pragma unroll
    for (int j = 0; j < 4; ++j) { const int c = 4 * lane + 256 * j; const f32x4 gg = *(const f32x4*)(g + c), s1 = *(const f32x4*)(sc + c), s0 = *(const f32x4*)(sh + c);
        const f32x4 o = v[j] * r * gg * (s1 + 1.0f) + s0; u32x2 w; w.x = pk2(o.x, o.y); w.y = pk2(o.z, o.w); *(u32x2*)(hrow + c) = w; }
}
__device__ __forceinline__ void rowpass_pre(Frame& F, const float* x, const float* g, const float* MODl, bf16_t* H) {
    const int gw = F.vcu * NWAVES + F.wave, NGW = F.G * NWAVES;
    for (int row = gw; row < T; row += NGW) { const int b = row / SEQ; const float* mod = MODl + (size_t)b * 6 * D;
        f32x4 v[4];
#pragma unroll
        for (int j = 0; j < 4; ++j) v[j] = *(const f32x4*)(x + (size_t)row * D + 4 * F.lane + 256 * j);
        norm_mod_store(v, g, mod + 1 * D, mod + 0 * D, H + (size_t)row * D, F.lane); }
}
__device__ __forceinline__ void rowpass_mid(Frame& F, const float* xin, float* xout, const bf16_t* Y, const float* post_g, const float* pre2_g, const float* MODl, bf16_t* H) {
    const int gw = F.vcu * NWAVES + F.wave, NGW = F.G * NWAVES;
    for (int row = gw; row < T; row += NGW) { const int b = row / SEQ; const float* mod = MODl + (size_t)b * 6 * D;
        f32x4 v[4], y[4]; float ss = 0.f;
#pragma unroll
        for (int j = 0; j < 4; ++j) { const int c = 4 * F.lane + 256 * j; v[j] = *(const f32x4*)(xin + (size_t)row * D + c);
            const u32x2 w = *(const u32x2*)(Y + (size_t)row * D + c); y[j] = (f32x4){bf_lo(w.x), bf_hi(w.x), bf_lo(w.y), bf_hi(w.y)};
            ss += (y[j].x * y[j].x + y[j].y * y[j].y) + (y[j].z * y[j].z + y[j].w * y[j].w); }
        const float r = 1.0f / sqrtf(wave_sum(ss) * (1.0f / D) + NORM_EPS);
#pragma unroll
        for (int j = 0; j < 4; ++j) { const int c = 4 * F.lane + 256 * j; const f32x4 pg = *(const f32x4*)(post_g + c), g1 = *(const f32x4*)(mod + 2 * D + c);
            v[j] = v[j] + g1 * (y[j] * r * pg); *(f32x4*)(xout + (size_t)row * D + c) = v[j]; }
        norm_mod_store(v, pre2_g, mod + 4 * D, mod + 3 * D, H + (size_t)row * D, F.lane); }
}
__device__ __forceinline__ void rowpass_comb(Frame& F, float* x, const bf16_t* YR, const int* TOPE, const int* TOPS, const float* post_g, const float* MODl,
                                             bool has_next, const float* pre1_g_next, const float* MODn, bf16_t* H) {
    const int gw = F.vcu * NWAVES + F.wave, NGW = F.G * NWAVES;
    const volatile LAS int* tb = (const volatile LAS int*)(F.MISC + MISC_TB);
    for (int row = gw; row < T; row += NGW) { const int b = row / SEQ; const float* mod = MODl + (size_t)b * 6 * D;
        f32x4 v[4], y[4];
#pragma unroll
        for (int j = 0; j < 4; ++j) { v[j] = *(const f32x4*)(x + (size_t)row * D + 4 * F.lane + 256 * j); y[j] = (f32x4){0.f, 0.f, 0.f, 0.f}; }
#pragma unroll
        for (int k = 0; k < TOPK; ++k) { const int e = TOPE[row * TOPK + k], s = TOPS[row * TOPK + k]; const size_t pr = (size_t)tb[e] * 256 + s;
#pragma unroll
            for (int j = 0; j < 4; ++j) { const u32x2 w = *(const u32x2*)(YR + pr * D + 4 * F.lane + 256 * j); y[j] = y[j] + (f32x4){bf_lo(w.x), bf_hi(w.x), bf_lo(w.y), bf_hi(w.y)}; } }
        float ss = 0.f;
#pragma unroll
        for (int j = 0; j < 4; ++j) ss += (y[j].x * y[j].x + y[j].y * y[j].y) + (y[j].z * y[j].z + y[j].w * y[j].w);
        const float r = 1.0f / sqrtf(wave_sum(ss) * (1.0f / D) + NORM_EPS);
#pragma unroll
        for (int j = 0; j < 4; ++j) { const int c = 4 * F.lane + 256 * j; const f32x4 pg = *(const f32x4*)(post_g + c), g2 = *(const f32x4*)(mod + 5 * D + c);
            v[j] = v[j] + g2 * (y[j] * r * pg); *(f32x4*)(x + (size_t)row * D + c) = v[j]; }
        if (has_next) { const float* modn = MODn + (size_t)b * 6 * D; norm_mod_store(v, pre1_g_next, modn + 1 * D, modn + 0 * D, H + (size_t)row * D, F.lane); } }
}

__device__ __forceinline__ void attn_phase(Frame& F, const bf16_t* Q, const bf16_t* KB, const bf16_t* VT, bf16_t* AP) {
    const int gw = F.vcu * NWAVES + F.wave, NGW = F.G * NWAVES;
    const int r = F.lane & 31, hh = F.lane >> 5;
    constexpr int NQT = SEQ / 32, NTASK = BATCH * NH * NQT;
    for (int task = gw; task < NTASK; task += NGW) {
        const int qt = task % NQT, h = (task / NQT) % NH, b = task / (NQT * NH), q0 = qt * 32;
        const size_t trow0 = (size_t)b * SEQ;
        bf16x8 qf[4];
#pragma unroll
        for (int ks = 0; ks < 4; ++ks) qf[ks] = *(const bf16x8*)(Q + (trow0 + q0 + r) * SBW + h * HD + ks * 16 + hh * 8);
        f32x16 o0, o1;
#pragma unroll
        for (int i = 0; i < 16; ++i) { o0[i] = 0.f; o1[i] = 0.f; }
        float C = 0.f;
        for (int kb = q0; kb >= 0; kb -= 32) {
            const bool diag = (kb == q0);
            f32x16 s;
#pragma unroll
            for (int i = 0; i < 16; ++i) s[i] = 0.f;
            const bf16_t* kp = KB + (trow0 + kb + r) * SBW + h * HD + hh * 8;
#pragma unroll
            for (int ks = 0; ks < 4; ++ks) { const bf16x8 kf = *(const bf16x8*)(kp + ks * 16); s = __builtin_amdgcn_mfma_f32_32x32x16_bf16(kf, qf[ks], s, 0, 0, 0); }
            s16x4 vlo[2][2], vhi[2][2];
#pragma unroll
            for (int st = 0; st < 2; ++st)
#pragma unroll
                for (int dt = 0; dt < 2; ++dt) { const bf16_t* vp = VT + (size_t)(h * HD + dt * 32 + r) * T + trow0 + kb + 16 * st + 4 * hh; vlo[st][dt] = *(const s16x4*)vp; vhi[st][dt] = *(const s16x4*)(vp + 8); }
            float lk[16];
#pragma unroll
            for (int i = 0; i < 16; ++i) { const int kc = 8 * (i >> 2) + 4 * hh + (i & 3); const bool valid = !diag || (kc < r); lk[i] = valid ? -softplus_f(s[i]) : 0.f; }
            float rt[4], pt[4], both[4];
#pragma unroll
            for (int gq = 0; gq < 4; ++gq) { lk[4 * gq + 2] += lk[4 * gq + 3]; lk[4 * gq + 1] += lk[4 * gq + 2]; lk[4 * gq + 0] += lk[4 * gq + 1]; rt[gq] = lk[4 * gq]; }
#pragma unroll
            for (int gq = 0; gq < 4; ++gq) { pt[gq] = __shfl_xor(rt[gq], 32); both[gq] = rt[gq] + pt[gq]; }
            float after[4]; after[3] = 0.f; after[2] = both[3]; after[1] = both[3] + both[2]; after[0] = after[1] + both[1];
            f32x16 a;
#pragma unroll
            for (int gq = 0; gq < 4; ++gq) { const float off = after[gq] + (hh == 0 ? pt[gq] : 0.f) + C;
#pragma unroll
                for (int j = 0; j < 4; ++j) { const int i = 4 * gq + j, kc = 8 * gq + 4 * hh + j; const bool valid = !diag || (kc < r);
                    a[i] = valid ? fast_exp(s[i] + lk[i] + off) : 0.f; } }
            C += both[0] + after[0];
#pragma unroll
            for (int st = 0; st < 2; ++st) {
                u32x4 pw; pw.x = pk2(a[8 * st + 0], a[8 * st + 1]); pw.y = pk2(a[8 * st + 2], a[8 * st + 3]); pw.z = pk2(a[8 * st + 4], a[8 * st + 5]); pw.w = pk2(a[8 * st + 6], a[8 * st + 7]);
                const bf16x8 pb = __builtin_bit_cast(bf16x8, pw);
                const bf16x8 va0 = __builtin_shufflevector(vlo[st][0], vhi[st][0], 0, 1, 2, 3, 4, 5, 6, 7), va1 = __builtin_shufflevector(vlo[st][1], vhi[st][1], 0, 1, 2, 3, 4, 5, 6, 7);
                o0 = __builtin_amdgcn_mfma_f32_32x32x16_bf16(va0, pb, o0, 0, 0, 0);
                o1 = __builtin_amdgcn_mfma_f32_32x32x16_bf16(va1, pb, o1, 0, 0, 0);
            }
            if (__all(C < STICK_EXIT)) break;
        }
        bf16_t* orow = AP + (trow0 + q0 + r) * D + h * HD;
#pragma unroll
        for (int gq = 0; gq < 4; ++gq) { u32x2 w0, w1; w0.x = pk2(o0[4 * gq], o0[4 * gq + 1]); w0.y = pk2(o0[4 * gq + 2], o0[4 * gq + 3]); w1.x = pk2(o1[4 * gq], o1[4 * gq + 1]); w1.y = pk2(o1[4 * gq + 2], o1[4 * gq + 3]);
            *(u32x2*)(orow + 8 * gq + 4 * hh) = w0; *(u32x2*)(orow + 32 + 8 * gq + 4 * hh) = w1; }
    }
}

__device__ __forceinline__ void poolmix_phase(Frame& F, const bf16_t* U, bf16_t* MIX) {
    const int gt = F.vcu * NTHREADS + F.tid, NGT = F.G * NTHREADS;
    constexpr int OCT = PW / 8;
    for (int idx = gt; idx < T * OCT; idx += NGT) {
        const int t = idx / OCT, o = idx % OCT, gidx = o / (PGD / 8), w = 2 << gidx, s = t % SEQ, cnt = (s + 1) < w ? (s + 1) : w;
        const bf16_t* up = U + (size_t)t * PW + o * 8;
        float acc[8], self[8];
        { const u32x4 q = *(const u32x4*)up; self[0] = bf_lo(q.x); self[1] = bf_hi(q.x); self[2] = bf_lo(q.y); self[3] = bf_hi(q.y); self[4] = bf_lo(q.z); self[5] = bf_hi(q.z); self[6] = bf_lo(q.w); self[7] = bf_hi(q.w); }
#pragma unroll
        for (int j = 0; j < 8; ++j) acc[j] = self[j];
        for (int i = 1; i < cnt; ++i) { const u32x4 q = *(const u32x4*)(up - (size_t)i * PW);
            acc[0] += bf_lo(q.x); acc[1] += bf_hi(q.x); acc[2] += bf_lo(q.y); acc[3] += bf_hi(q.y); acc[4] += bf_lo(q.z); acc[5] += bf_hi(q.z); acc[6] += bf_lo(q.w); acc[7] += bf_hi(q.w); }
        const float inv = 1.0f / (float)cnt;
        u32x4 ow; ow.x = pk2(acc[0] * inv - self[0], acc[1] * inv - self[1]); ow.y = pk2(acc[2] * inv - self[2], acc[3] * inv - self[3]);
        ow.z = pk2(acc[4] * inv - self[4], acc[5] * inv - self[5]); ow.w = pk2(acc[6] * inv - self[6], acc[7] * inv - self[7]);
        *(u32x4*)(MIX + (size_t)t * PW + o * 8) = ow;
    }
}

constexpr int NBLK = T / 128;
__device__ __forceinline__ void router_phase_a(Frame& F, const bf16_t* H, const bf16_t* RT, const float* rb, int* HIST, int* TOPE, int* TOPL, float* TOPG) {
    LAS float* lg = (LAS float*)(F.lds + F.wave * 4096);
    volatile LAS int* whist = (volatile LAS int*)(F.lds + 65536);
    const int fr = F.lane & 15, fq = F.lane >> 4;
    for (int blk = F.vcu; blk < NBLK; blk += F.G) {
        const int t0 = blk * 128 + F.wave * 16;
        if (F.lane < NE) whist[F.wave * NE + F.lane] = 0;
        f32x4 a0 = {0.f, 0.f, 0.f, 0.f}, a1 = {0.f, 0.f, 0.f, 0.f};
        const bf16_t* hp = H + (size_t)(t0 + fr) * D + fq * 8; const bf16_t* w0 = RT + (size_t)fr * D + fq * 8; const bf16_t* w1 = RT + (size_t)(16 + fr) * D + fq * 8;
#pragma unroll 4
        for (int k = 0; k < D; k += 32) { const bf16x8 av = *(const bf16x8*)(hp + k), b0 = *(const bf16x8*)(w0 + k), b1 = *(const bf16x8*)(w1 + k);
            a0 = __builtin_amdgcn_mfma_f32_16x16x32_bf16(av, b0, a0, 0, 0, 0); a1 = __builtin_amdgcn_mfma_f32_16x16x32_bf16(av, b1, a1, 0, 0, 0); }
        const float rb0 = rb[fr], rb1 = rb[16 + fr];
#pragma unroll
        for (int j = 0; j < 4; ++j) { lg[(4 * fq + j) * 33 + fr] = a0[j] + rb0; lg[(4 * fq + j) * 33 + 16 + fr] = a1[j] + rb1; }
        LDS_WAIT(); asm volatile("" ::: "memory");
        float bv[4] = {-INFINITY, -INFINITY, -INFINITY, -INFINITY}; int bi[4] = {0, 0, 0, 0};
        if (F.lane < 16) {
            for (int e = 0; e < NE; ++e) { const float v = lg[F.lane * 33 + e];
                if (v > bv[3]) { bv[3] = v; bi[3] = e;
                    if (bv[3] > bv[2]) { float tv = bv[2]; bv[2] = bv[3]; bv[3] = tv; int ti = bi[2]; bi[2] = bi[3]; bi[3] = ti;
                        if (bv[2] > bv[1]) { tv = bv[1]; bv[1] = bv[2]; bv[2] = tv; ti = bi[1]; bi[1] = bi[2]; bi[2] = ti;
                            if (bv[1] > bv[0]) { tv = bv[0]; bv[0] = bv[1]; bv[1] = tv; ti = bi[0]; bi[0] = bi[1]; bi[1] = ti; } } } } }
        }
        float gt[4]; { float sum = 0.f;
#pragma unroll
            for (int k = 0; k < 4; ++k) { gt[k] = fast_exp(bv[k] - bv[0]); sum += gt[k]; }
            const float inv = 1.0f / sum;
#pragma unroll
            for (int k = 0; k < 4; ++k) gt[k] *= inv; }
        int rk[4];
#pragma unroll
        for (int k = 0; k < 4; ++k) {
            const int e = F.lane < 16 ? bi[k] : -1; int rank = 0;
            unsigned long long todo = __ballot(e >= 0);
            while (todo) { const int leader = __builtin_ctzll(todo); const int le = __shfl(e, leader); const unsigned long long mm = __ballot(e == le);
                const int base = whist[F.wave * NE + le];
                if (e == le) rank = base + __builtin_popcountll(mm & ((1ull << F.lane) - 1ull));
                if (F.lane == leader) whist[F.wave * NE + le] = base + __builtin_popcountll(mm);
                todo &= ~mm; }
            rk[k] = rank;
        }
        __syncthreads();
        if (F.tid < NE) { int run = 0;
#pragma unroll
            for (int w = 0; w < NWAVES; ++w) { const int v = whist[w * NE + F.tid]; whist[w * NE + F.tid] = run; run += v; }
            HIST[blk * NE + F.tid] = run; }
        __syncthreads();
        if (F.lane < 16) { const int t = t0 + F.lane;
#pragma unroll
            for (int k = 0; k < 4; ++k) { TOPE[t * TOPK + k] = bi[k]; TOPL[t * TOPK + k] = whist[F.wave * NE + bi[k]] + rk[k]; TOPG[t * TOPK + k] = gt[k]; } }
        __syncthreads();
    }
}
__device__ __forceinline__ void router_phase_b(Frame& F, const int* HIST, const int* TOPE, const int* TOPL, const float* TOPG, int* TOPS, int* ROWTOK, float* ROWGATE) {
    volatile LAS int* part = (volatile LAS int*)(F.lds + 65536);
    for (int blk = F.vcu; blk < NBLK; blk += F.G) {
        { const int e = F.tid & 31, pt = F.tid >> 5; int sacc = 0;
            for (int b = pt * 16; b < pt * 16 + 16; ++b) sacc += (b < blk) ? HIST[b * NE + e] : 0;
            part[pt * NE + e] = sacc; }
        __syncthreads();
        if (F.tid < NE) { int sacc = 0;
#pragma unroll
            for (int pt = 0; pt < 16; ++pt) sacc += part[pt * NE + F.tid];
            part[512 + F.tid] = sacc; }
        __syncthreads();
        { const int t = blk * 128 + (F.tid >> 2), k = F.tid & 3; const int e = TOPE[t * TOPK + k]; const int slot = part[512 + e] + TOPL[t * TOPK + k];
            TOPS[t * TOPK + k] = slot; ROWTOK[(size_t)e * T + slot] = t; ROWGATE[(size_t)e * T + slot] = TOPG[t * TOPK + k]; }
        __syncthreads();
    }
}
__device__ __forceinline__ void moe_table(Frame& F, const int* HIST) {
    volatile LAS int* part = (volatile LAS int*)(F.MISC + 256);
    __syncthreads();
    { const int e = F.tid & 31, pt = F.tid >> 5; int sacc = 0;
        for (int b = pt * 16; b < pt * 16 + 16; ++b) sacc += HIST[b * NE + e];
        part[pt * NE + e] = sacc; }
    __syncthreads();
    if (F.tid < 64) { const int e = F.lane; int c = 0;
        if (e < NE) {
#pragma unroll
            for (int pt = 0; pt < 16; ++pt) c += part[pt * NE + e]; }
        int tl = (c + 255) >> 8, pre = tl;
#pragma unroll
        for (int o = 1; o < 64; o <<= 1) { const int v = __shfl_up(pre, o); if (F.lane >= o) pre += v; }
        if (e < NE) { F.MISC[MISC_TB + e] = (unsigned)(pre - tl); F.MISC[MISC_CNT + e] = (unsigned)c; }
        if (e == NE - 1) F.MISC[MISC_TB + NE] = (unsigned)pre; }
    __syncthreads();
}

constexpr int PH_PRO = 0, PH_PRE = 1, PH_L0 = 2, NPL = 11, NPHASES = PH_L0 + DEPTH * NPL;
__global__ void __launch_bounds__(NTHREADS, 2) fwd(Args args_unused) {
    extern __shared__ __attribute__((aligned(16))) unsigned char lds_raw[];
    const volatile __attribute__((address_space(4))) Args* ka = (const volatile __attribute__((address_space(4))) Args*)__builtin_amdgcn_kernarg_segment_ptr();
#define INP(i) ((const float*)ka->in[i])
#define WSB() ((unsigned char*)ka->ws)
#define OUTP() ((float*)ka->out)
    Frame F;
    F.lds = (LAS unsigned char*)lds_raw; F.MISC = (volatile LAS unsigned*)(F.lds + LDSCTL_OFF);
    F.wave = __builtin_amdgcn_readfirstlane((int)threadIdx.x >> 6); F.lane = lane_id_v(); F.tid = F.wave * 64 + F.lane;
    F.G = gridDim.x; { const int bx = blockIdx.x; F.vcu = (F.G % 8 == 0) ? (bx % 8) * (F.G / 8) + bx / 8 : bx; }
    F.ctl = (unsigned*)(WSB() + WS_CTL);
    for (int u = F.tid; u < (LDS_BYTES - LDSCTL_OFF) / 4; u += NTHREADS) ((LAS unsigned*)(F.lds + LDSCTL_OFF))[u] = 0u;
    __syncthreads();
    XcdBarrier bar = xcd_barrier_post(F.ctl + CW_BAR, F.MISC + MISC_BAR, F.tid == 0);
    const int lo = ka->ph_lo, hi = ka->ph_hi;
#define IN(k) (lo <= (k) && (k) < hi)
#define SEAM(k) do { if (IN(k) && IN((k) + 1)) xcd_barrier(bar, F.wave == 0 && lane_id_v() == 0); } while (0)
#define PHASE_FRAME() Frame P = F; P.wave = launder_s(F.wave); P.lane = lane_id_v(); P.tid = P.wave * 64 + P.lane
    const int cb = (int)blockIdx.x;

    if (IN(PH_PRO)) REPEAT(0) { __syncthreads(); unsigned char* ws = WSB(); { PHASE_FRAME(); mods_phase(P, INP(1), INP(2), INP(3), (float*)(ws + WS_MOD)); } { PHASE_FRAME(); convert_phase(P, ka); } }
    SEAM(PH_PRO);
    if (IN(PH_PRE)) REPEAT(1) { unsigned char* ws = WSB(); PHASE_FRAME(); rowpass_pre(P, INP(0), INP(4), (const float*)(ws + WS_MOD), (bf16_t*)(ws + WS_H)); }
    SEAM(PH_PRE);

#pragma unroll 1
    for (int l = 0; l < DEPTH; ++l) {
        const int pb = PH_L0 + l * NPL;
        if (IN(pb + 0)) { unsigned char* ws = WSB(); unsigned char* wl = ws + WS_W + (size_t)l * WL_STRIDE; const bf16_t* WIN = (const bf16_t*)(wl + WO_WIN); bf16_t* H = (bf16_t*)(ws + WS_H);
            REPEAT(2) { pg8::Gemm g{H, WIN, D, D, D, nullptr}; pg8::StaticOrder S{T / 256, 13, launder_s(F.G), launder_s(cb), D, D, 0}; pg8::EpiIn E{(bf16_t*)(ws + WS_Q), (bf16_t*)(ws + WS_K), (bf16_t*)(ws + WS_U), (bf16_t*)(ws + WS_G)};
              pg8::gemm_phase<pg8::EpiIn, pg8::StaticOrder, 0>(F.lds, F.wave, g, S, E); }
            REPEAT(3) { pg8::Gemm g{WIN + (size_t)3328 * D, H, D, D, D, nullptr}; pg8::StaticOrder S{1, T / 256, launder_s(F.G), (launder_s(cb) + launder_s(F.G) / 2) % launder_s(F.G), D, D, 0}; pg8::EpiPlain E{(bf16_t*)(ws + WS_VT), T, 0, nullptr, nullptr};
              pg8::gemm_phase<pg8::EpiPlain, pg8::StaticOrder, 1>(F.lds, F.wave, g, S, E); }
        }
        SEAM(pb + 0);
        if (IN(pb + 1)) { unsigned char* ws = WSB();
            REPEAT(4) { PHASE_FRAME(); attn_phase(P, (const bf16_t*)(ws + WS_Q), (const bf16_t*)(ws + WS_K), (const bf16_t*)(ws + WS_VT), (bf16_t*)(ws + WS_AP)); }
            REPEAT(5) { PHASE_FRAME(); poolmix_phase(P, (const bf16_t*)(ws + WS_U), (bf16_t*)(ws + WS_MIX)); } }
        SEAM(pb + 1);
        if (IN(pb + 2)) { unsigned char* ws = WSB(); unsigned char* wl = ws + WS_W + (size_t)l * WL_STRIDE; bf16_t* AP = (bf16_t*)(ws + WS_AP);
            REPEAT(6) { pg8::Gemm g{AP, (const bf16_t*)(wl + WO_BRA), D, SBW, SBW, nullptr}; pg8::StaticOrder S{T / 256, 4, launder_s(F.G), launder_s(cb), D, SBW, 0}; pg8::EpiBranch<false> E{(bf16_t*)(ws + WS_MRG), (const bf16_t*)(ws + WS_G), 0};
              pg8::gemm_phase<pg8::EpiBranch<false>, pg8::StaticOrder, 2>(F.lds, F.wave, g, S, E); }
            REPEAT(7) { pg8::Gemm g{(const bf16_t*)(ws + WS_MIX), (const bf16_t*)(wl + WO_POOL), PW, PW, 384, nullptr}; pg8::StaticOrder S{T / 256, 3, launder_s(F.G), launder_s(cb), PW, PW, PGD};
              pg8::EpiPlain E{AP, D, SBW, INP(10) + (size_t)l * PW, INP(11) + (size_t)l * PW};
              pg8::gemm_phase<pg8::EpiPlain, pg8::StaticOrder, 3>(F.lds, F.wave, g, S, E); }
        }
        SEAM(pb + 2);
        if (IN(pb + 3)) { unsigned char* ws = WSB(); unsigned char* wl = ws + WS_W + (size_t)l * WL_STRIDE;
            pg8::Gemm g{(const bf16_t*)(ws + WS_AP) + SBW, (const bf16_t*)(wl + WO_BRP), D, PW, PW, nullptr}; pg8::StaticOrder S{T / 256, 4, launder_s(F.G), launder_s(cb), D, PW, 0}; pg8::EpiBranch<true> E{(bf16_t*)(ws + WS_MRG), (const bf16_t*)(ws + WS_G), D};
            pg8::gemm_phase<pg8::EpiBranch<true>, pg8::StaticOrder, 4>(F.lds, F.wave, g, S, E); }
        SEAM(pb + 3);
        if (IN(pb + 4)) REPEAT(8) { unsigned char* ws = WSB(); unsigned char* wl = ws + WS_W + (size_t)l * WL_STRIDE;
            pg8::Gemm g{(const bf16_t*)(ws + WS_MRG), (const bf16_t*)(wl + WO_OUT), D, D, D, nullptr}; pg8::StaticOrder S{T / 256, 4, launder_s(F.G), launder_s(cb), D, D, 0}; pg8::EpiPlain E{(bf16_t*)(ws + WS_Y), D, 0, nullptr, nullptr};
            pg8::gemm_phase<pg8::EpiPlain, pg8::StaticOrder, 5>(F.lds, F.wave, g, S, E); }
        SEAM(pb + 4);
        if (IN(pb + 5)) for (int _rep = 0; _rep < ((((REP_MASK >> 9) & 1) && l == 0) ? 2 : 1); ++_rep) { unsigned char* ws = WSB(); PHASE_FRAME();
            rowpass_mid(P, l == 0 ? INP(0) : (const float*)OUTP(), OUTP(), (const bf16_t*)(ws + WS_Y), INP(5) + (size_t)l * D, INP(6) + (size_t)l * D, (const float*)(ws + WS_MOD) + (size_t)l * BATCH * 6 * D, (bf16_t*)(ws + WS_H)); }
        SEAM(pb + 5);
        if (IN(pb + 6)) { unsigned char* ws = WSB(); unsigned char* wl = ws + WS_W + (size_t)l * WL_STRIDE; PHASE_FRAME();
            router_phase_a(P, (const bf16_t*)(ws + WS_H), (const bf16_t*)(wl + WO_ROUTER), INP(16) + (size_t)l * NE, (int*)(ws + WS_HIST) + (size_t)l * NBLK * NE, (int*)(ws + WS_TOPE), (int*)(ws + WS_TOPL), (float*)(ws + WS_TOPG)); }
        SEAM(pb + 6);
        if (IN(pb + 7)) { unsigned char* ws = WSB(); PHASE_FRAME();
            router_phase_b(P, (const int*)(ws + WS_HIST) + (size_t)l * NBLK * NE, (const int*)(ws + WS_TOPE), (const int*)(ws + WS_TOPL), (const float*)(ws + WS_TOPG), (int*)(ws + WS_TOPS), (int*)(ws + WS_ROWTOK), (float*)(ws + WS_ROWGATE)); }
        SEAM(pb + 7);
        if (IN(pb + 8)) REPEAT(10) { unsigned char* ws = WSB(); unsigned char* wl = ws + WS_W + (size_t)l * WL_STRIDE; { PHASE_FRAME(); moe_table(P, (const int*)(ws + WS_HIST) + (size_t)l * NBLK * NE); }
            pg8::Gemm g{(const bf16_t*)(ws + WS_H), (const bf16_t*)(wl + WO_GU), D, D, D, (const int*)(ws + WS_ROWTOK)};
            pg8::MoeOrder S{(const volatile LAS int*)(F.MISC + MISC_TB), (const volatile LAS int*)(F.MISC + MISC_CNT), 8, launder_s(F.G), launder_s(cb), 2 * D};
            pg8::EpiGU E{(bf16_t*)(ws + WS_ACT), INP(18) + (size_t)l * NE * 2 * D};
            pg8::gemm_phase<pg8::EpiGU, pg8::MoeOrder, 6>(F.lds, F.wave, g, S, E); }
        SEAM(pb + 8);
        if (IN(pb + 9)) REPEAT(11) { unsigned char* ws = WSB(); unsigned char* wl = ws + WS_W + (size_t)l * WL_STRIDE; { PHASE_FRAME(); moe_table(P, (const int*)(ws + WS_HIST) + (size_t)l * NBLK * NE); }
            pg8::Gemm g{(const bf16_t*)(ws + WS_ACT), (const bf16_t*)(wl + WO_DN), D, D, D, nullptr};
            pg8::MoeOrder S{(const volatile LAS int*)(F.MISC + MISC_TB), (const volatile LAS int*)(F.MISC + MISC_CNT), 4, launder_s(F.G), launder_s(cb), D};
            pg8::EpiDN E{(bf16_t*)(ws + WS_YR), INP(20) + (size_t)l * NE * D, (const float*)(ws + WS_ROWGATE)};
            pg8::gemm_phase<pg8::EpiDN, pg8::MoeOrder, 7>(F.lds, F.wave, g, S, E); }
        SEAM(pb + 9);
        if (IN(pb + 10)) { unsigned char* ws = WSB(); PHASE_FRAME(); moe_table(P, (const int*)(ws + WS_HIST) + (size_t)l * NBLK * NE);
            const bool hn = (l + 1 < DEPTH); const float* MOD = (const float*)(ws + WS_MOD);
            rowpass_comb(P, OUTP(), (const bf16_t*)(ws + WS_YR), (const int*)(ws + WS_TOPE), (const int*)(ws + WS_TOPS), INP(7) + (size_t)l * D, MOD + (size_t)l * BATCH * 6 * D,
                         hn, INP(4) + (size_t)(hn ? l + 1 : l) * D, MOD + (size_t)(hn ? l + 1 : l) * BATCH * 6 * D, (bf16_t*)(ws + WS_H)); }
        SEAM(pb + 10);
    }
#undef IN
#undef SEAM
}

extern "C" void kernel_launch(void* const* d_in, const int* in_sizes, int n_in, void* d_out, int out_size, void* d_ws, size_t ws_size, hipStream_t stream) {
    static int grid = 0;
    if (grid == 0) {
        if (n_in != 21 || in_sizes[0] != T * D || out_size != T * D || ws_size < WS_END) { fprintf(stderr, "kernel_launch: unexpected shapes (n_in %d, in0 %d, out %d, ws %zu < %zu); nothing launched\n", n_in, n_in > 0 ? in_sizes[0] : -1, out_size, ws_size, (size_t)WS_END); grid = -1; return; }
        int dev = 0, cus = 0, per_cu = 0;
        if (hipGetDevice(&dev) != hipSuccess || hipDeviceGetAttribute(&cus, hipDeviceAttributeMultiprocessorCount, dev) != hipSuccess) { grid = -1; return; }
        if (hipFuncSetAttribute((const void*)fwd, hipFuncAttributeMaxDynamicSharedMemorySize, LDS_BYTES) != hipSuccess) { fprintf(stderr, "kernel_launch: hipFuncSetAttribute failed\n"); grid = -1; return; }
        if (hipOccupancyMaxActiveBlocksPerMultiprocessor(&per_cu, (const void*)fwd, NTHREADS, LDS_BYTES) != hipSuccess || per_cu < 1) { fprintf(stderr, "kernel_launch: occupancy query says %d\n", per_cu); }
        (void)hipGetLastError();
        grid = cus;
    }
    if (grid < 0) return;
    if (hipMemsetAsync((char*)d_ws + WS_CTL, 0, CTL_ZERO_BYTES, stream) != hipSuccess) return;
    Args a{};
    for (int i = 0; i < 21; ++i) a.in[i] = (const float*)d_in[i];
    a.out = (float*)d_out; a.ws = (unsigned char*)d_ws;
#if N_LAUNCHES == 1
    a.ph_lo = 0; a.ph_hi = NPHASES;
    hipLaunchKernelGGL(fwd, dim3(grid), dim3(NTHREADS), LDS_BYTES, stream, a);
#else
    for (int p = 0; p < NPHASES; ++p) { a.ph_lo = p; a.ph_hi = p + 1; hipLaunchKernelGGL(fwd, dim3(grid), dim3(NTHREADS), LDS_BYTES, stream, a); }
#endif
}
```

```cpp
#include <hip/hip_runtime.h>
#include <cstdio>
#include <cstdint>

#ifndef N_LAUNCHES
#define N_LAUNCHES 1
#endif
#ifndef REP_MASK
#define REP_MASK 0
#endif
#define REPEAT(b) _Pragma("unroll 1") for (int _rep = 0; _rep < (((REP_MASK >> (b)) & 1) ? 2 : 1); ++_rep)
#ifndef FAST_MASK
#define FAST_MASK 0xff
#endif

#define LAS __attribute__((address_space(3)))
#define GAS __attribute__((address_space(1)))
typedef unsigned short bf16_t;
typedef short bf16x8 __attribute__((ext_vector_type(8)));
typedef short s16x4 __attribute__((ext_vector_type(4)));
typedef float f32x4 __attribute__((ext_vector_type(4)));
typedef float f32x2 __attribute__((ext_vector_type(2)));
typedef float f32x16 __attribute__((ext_vector_type(16)));
typedef unsigned u32x4 __attribute__((ext_vector_type(4)));
typedef unsigned u32x2 __attribute__((ext_vector_type(2)));

constexpr int D = 1024, BATCH = 2, SEQ = 16384, T = BATCH * SEQ, DEPTH = 2;
constexpr int SBW = 256, NH = 4, HD = 64, PW = 768, PGD = 192, INW = 3584;
constexpr int NE = 32, TOPK = 4;
constexpr float NORM_EPS = 1e-6f, SW_LIMIT = 7.0f, SW_ALPHA = 1.702f;
constexpr float STICK_EXIT = -40.0f;
constexpr int NWAVES = 8, NTHREADS = 512;
constexpr int MAXTILES = (T * TOPK) / 256 + NE;

constexpr size_t MiB = 1u << 20;
constexpr size_t WS_CTL = 0, CTL_ZERO_BYTES = 1 * MiB;
constexpr size_t WS_MOD = 1 * MiB;
constexpr size_t WS_W = 2 * MiB, WL_STRIDE = 205 * MiB;
constexpr size_t WO_WIN = 0, WO_BRA = 7 * MiB, WO_BRP = 7 * MiB + MiB / 2, WO_OUT = 9 * MiB, WO_POOL = 11 * MiB, WO_ROUTER = 12 * MiB + MiB / 2, WO_GU = 13 * MiB, WO_DN = 141 * MiB;
constexpr size_t WS_H = 416 * MiB, WS_Q = 480 * MiB, WS_K = 496 * MiB, WS_VT = 512 * MiB, WS_U = 528 * MiB, WS_G = 576 * MiB;
constexpr size_t WS_AP = 704 * MiB, WS_MIX = 768 * MiB, WS_MRG = 816 * MiB, WS_Y = 880 * MiB;
constexpr size_t WS_TOPE = 944 * MiB, WS_TOPS = 944 * MiB + MiB / 2, WS_TOPL = 945 * MiB, WS_TOPG = 945 * MiB + MiB / 2, WS_ROWTOK = 946 * MiB, WS_ROWGATE = 950 * MiB;
constexpr size_t WS_HIST = 954 * MiB;
constexpr size_t WS_ACT = 960 * MiB, WS_YR = 1232 * MiB, WS_END = 1504 * MiB;
static_assert(WO_DN + (size_t)NE * D * D * 2 <= WL_STRIDE && WS_W + DEPTH * WL_STRIDE <= WS_H, "weights map");
static_assert(WS_ACT + (size_t)MAXTILES * 256 * D * 2 <= WS_YR && WS_YR + (size_t)MAXTILES * 256 * D * 2 <= WS_END, "act map");
constexpr int CW_BAR = 4096, CW_CNT = 8192;

constexpr int RING_BYTES = 131072, LDSCTL_OFF = RING_BYTES, LDS_BYTES = 147456;
constexpr int MISC_BAR = 8;
constexpr int MISC_TB = 64, MISC_CNT = 128;

__device__ __forceinline__ unsigned f2bf(float f) { unsigned u = __builtin_bit_cast(unsigned, f); return (u + 0x7fffu + ((u >> 16) & 1u)) >> 16; }
__device__ __forceinline__ unsigned pk2(float lo, float hi) { return f2bf(lo) | (f2bf(hi) << 16); }
__device__ __forceinline__ float bf_lo(unsigned w) { return __builtin_bit_cast(float, w << 16); }
__device__ __forceinline__ float bf_hi(unsigned w) { return __builtin_bit_cast(float, w & 0xffff0000u); }
__device__ __forceinline__ float fast_exp(float x) { return __builtin_amdgcn_exp2f(x * 1.4426950408889634f); }
__device__ __forceinline__ float fast_sigmoid(float x) { return __builtin_amdgcn_rcpf(1.0f + fast_exp(-x)); }
__device__ __forceinline__ float softplus_f(float z) { return fmaxf(z, 0.f) + 0.6931471805599453f * __builtin_amdgcn_logf(1.0f + fast_exp(-fabsf(z))); }
__device__ __forceinline__ float wave_sum(float v) {
#pragma unroll
    for (int o = 1; o < 64; o <<= 1) v += __shfl_xor(v, o);
    return v;
}
__device__ __forceinline__ int launder_v(int x) { asm volatile("" : "+v"(x)); return x; }
__device__ __forceinline__ int launder_s(int x) { asm volatile("" : "+s"(x)); return x; }
__device__ __forceinline__ int lane_id_v() { int x; asm volatile("v_mbcnt_lo_u32_b32 %0, -1, 0\n\tv_mbcnt_hi_u32_b32 %0, -1, %0" : "=v"(x)); return x; }
#define LDS_WAIT() asm volatile("s_waitcnt lgkmcnt(0)" ::: "memory")
#define VM_WAIT() asm volatile("s_waitcnt vmcnt(0)" ::: "memory")

#define XB_TMO      128
#define XB_XCNT(j)  (256  + 64 * (j))
#define XB_XSUB(j)  (1280 + 64 * (j))
#define XB_XGEN(j)  (2304 + 64 * (j))
#define XB_TOP      3328
#define XB_TOPGEN   3392
#define XCD_BAR_WORDS 3456
#define XB_SPIN_CAP (1u << 18)
__device__ __forceinline__ unsigned xb_ld(unsigned* p)              { return __hip_atomic_load(p, __ATOMIC_RELAXED, __HIP_MEMORY_SCOPE_AGENT); }
__device__ __forceinline__ unsigned xb_add(unsigned* p, unsigned v) { return __hip_atomic_fetch_add(p, v, __ATOMIC_RELAXED, __HIP_MEMORY_SCOPE_AGENT); }
__device__ __forceinline__ unsigned xb_xcc_id() { return (unsigned)__builtin_amdgcn_s_getreg((3 << 11) | 20) & 0xFu; }
#define XB_SPIN(cond, bar) do { unsigned _sp = 0; while (cond) { __builtin_amdgcn_s_sleep(1); \
    if ((++_sp & 255u) == 0u) { if (xb_ld(&(bar)[XB_TMO])) break; if (_sp > XB_SPIN_CAP) { atomicAdd(&(bar)[XB_TMO], 1u); break; } } } } while (0)
struct XcdBarrier { unsigned* bar; unsigned x; volatile LAS unsigned* st; };
__device__ __forceinline__ XcdBarrier xcd_barrier_post(unsigned* bar, volatile LAS unsigned* st, bool t0) {
    XcdBarrier b; b.bar = bar; b.x = xb_xcc_id(); b.st = st;
    if (t0) (void)xb_add(&bar[XB_XCNT(b.x)], 1u);
    return b;
}
__device__ __forceinline__ void xcd_barrier_complete(unsigned* bar, unsigned x, unsigned& nloc, unsigned& nx) {
    const unsigned G = gridDim.x * gridDim.y * gridDim.z;
    unsigned sum, cnt, mine, sp = 0u;
    for (;;) {
        sum = 0u; cnt = 0u; mine = 0u;
#pragma unroll
        for (unsigned j = 0; j < 16; ++j) { const unsigned c = xb_ld(&bar[XB_XCNT(j)]); sum += c; cnt += (c > 0u) ? 1u : 0u; mine = (j == x) ? c : mine; }
        if (sum == G) break;
        __builtin_amdgcn_s_sleep(1);
        if ((++sp & 255u) == 0u) { if (xb_ld(&bar[XB_TMO])) break; if (sp > XB_SPIN_CAP) { atomicAdd(&bar[XB_TMO], 1u); break; } }
    }
    nloc = mine > 0u ? mine : 1u; nx = cnt > 0u ? cnt : 1u;
}
__device__ __forceinline__ void xcd_barrier(const XcdBarrier& b, bool t0) {
    asm volatile("s_waitcnt vmcnt(0)" ::: "memory");
    __syncthreads();
    if (t0) {
        unsigned* bar = b.bar;
        __builtin_amdgcn_s_waitcnt(0);
        unsigned nloc = b.st[0], nx = b.st[1];
        if (nloc == 0u) { xcd_barrier_complete(bar, b.x, nloc, nx); b.st[0] = nloc; b.st[1] = nx; }
        const unsigned old = xb_add(&bar[XB_XSUB(b.x)], 1u);
        const unsigned gen = old / nloc;
        if (old + 1u == (gen + 1u) * nloc) {
            __builtin_amdgcn_fence(__ATOMIC_RELEASE, "agent");
            asm volatile("s_waitcnt vmcnt(0)" ::: "memory");
            const unsigned og = xb_add(&bar[XB_TOP], 1u);
            const unsigned tg = og / nx;
            if (og + 1u == (tg + 1u) * nx) xb_add(&bar[XB_TOPGEN], 1u);
            else XB_SPIN(xb_ld(&bar[XB_TOPGEN]) == tg, bar);
            __builtin_amdgcn_fence(__ATOMIC_ACQUIRE, "agent");
            xb_add(&bar[XB_XGEN(b.x)], 1u);
            asm volatile("s_waitcnt vmcnt(0)" ::: "memory");
        } else {
            XB_SPIN(xb_ld(&bar[XB_XGEN(b.x)]) == gen, bar);
            __builtin_amdgcn_fence(__ATOMIC_ACQUIRE, "agent");
            asm volatile("s_waitcnt vmcnt(0)" ::: "memory");
        }
    }
    __syncthreads();
}

namespace pg8 {
constexpr int BM = 256, BK = 64, HALF = 128, HTB = HALF * BK * 2, STAGE_BYTES = 8 * HTB, NXCD = 8, WGM = 8;
__host__ __device__ __forceinline__ int lds_byte(int r, int c) { const int st = (r >> 4) * 2 + (c >> 5), rr = r & 15, cc = c & 31, ob = rr * 64 + cc * 2; return st * 1024 + (ob ^ (((ob >> 9) & 1) << 5)); }
__host__ __device__ __forceinline__ void stage_rc(int b, int& R, int& C) { const int st = b / 1024, sb = b % 1024, swz = sb ^ (((sb >> 9) & 1) << 5); R = (st >> 1) * 16 + swz / 64; C = (st & 1) * 32 + (swz % 64) / 2; }
__host__ __device__ __forceinline__ int perm32(int rho) { const int n = rho >> 4, i = rho & 15; return 8 * (i >> 2) + 4 * n + (i & 3); }

struct Unit { int pm, pn, e, nvalid, slot0; unsigned aoff, boff; };
struct Gemm { const bf16_t* A; const bf16_t* Bt; int lda, ldb, K; const int* gather; };

__device__ __forceinline__ bool order_unit(int i, int G, int c, int nM, int nN, int& pm, int& pn) {
    const int nwg = nM * nN; const long L = (long)i * G + c; if (L >= nwg) return false;
    int wgid = (int)L; { const int q = nwg / NXCD, r = nwg % NXCD, xcd = wgid % NXCD, off = wgid / NXCD; wgid = (xcd < r ? xcd * (q + 1) : r * (q + 1) + (xcd - r) * q) + off; }
    const int nig = WGM * nN, gid = wgid / nig, fm = gid * WGM, gsz = (nM - fm) < WGM ? (nM - fm) : WGM;
    pm = fm + ((wgid % nig) % gsz); pn = (wgid % nig) / gsz; return true;
}
struct StaticOrder {
    int nM, nN, G, c, lda, ldb, kstride;
    __device__ __forceinline__ bool next(int i, Unit& u) const {
        if (!order_unit(i, G, c, nM, nN, u.pm, u.pn)) return false;
        u.e = 0; u.nvalid = 256; u.slot0 = 0;
        u.aoff = (unsigned)(u.pm * BM) * (unsigned)lda + (unsigned)(kstride * u.pn); u.boff = (unsigned)(u.pn * BM) * (unsigned)ldb + (unsigned)(kstride * u.pn); return true;
    }
};
struct MoeOrder {
    const volatile LAS int* tb; const volatile LAS int* cnt; int nN, G, c, nw;
    __device__ __forceinline__ bool next(int i, Unit& u) const {
        const int nM = tb[NE];
        if (!order_unit(i, G, c, nM, nN, u.pm, u.pn)) return false;
        int e = 0;
#pragma unroll 1
        for (int j = 1; j < NE; ++j) e += (tb[j] <= u.pm) ? 1 : 0;
        u.e = e; u.slot0 = (u.pm - tb[e]) * BM; const int left = cnt[e] - u.slot0; u.nvalid = left < BM ? left : BM;
        u.aoff = (unsigned)(u.pm * BM) * (unsigned)D; u.boff = ((unsigned)e * (unsigned)nw + (unsigned)(u.pn * BM)) * (unsigned)D; return true;
    }
};

__device__ __forceinline__ unsigned cvt_pk_bf16(float lo, float hi) { unsigned r; asm volatile("v_cvt_pk_bf16_f32 %0, %1, %2" : "=v"(r) : "v"(lo), "v"(hi)); return r; }
__device__ __forceinline__ u32x4 pack8(const f32x4 a, const f32x4 b) { u32x4 w; w.x = cvt_pk_bf16(a[0], a[1]); w.y = cvt_pk_bf16(a[2], a[3]); w.z = cvt_pk_bf16(b[0], b[1]); w.w = cvt_pk_bf16(b[2], b[3]); return w; }
__device__ __forceinline__ void unpack8(const u32x4 w, f32x4& a, f32x4& b) { a = (f32x4){bf_lo(w.x), bf_hi(w.x), bf_lo(w.y), bf_hi(w.y)}; b = (f32x4){bf_lo(w.z), bf_hi(w.z), bf_lo(w.w), bf_hi(w.w)}; }

#define EPI_LOOP_ROWS for (int ai = 0; ai < 2; ++ai) _Pragma("unroll") for (int m = 0; m < 4; ++m)
struct EpiIn {
    static constexpr bool PERM = true;
    bf16_t *Q, *KB, *U, *G;
    __device__ __forceinline__ void operator()(const f32x4 (&acc)[2][2][4][2], const Unit& u, int wr, int wc, int fr, int fq) const {
        const int pn = u.pn; bf16_t* base; int ld, c0, mode;
        if (pn == 0) { base = Q; ld = SBW; c0 = 0; mode = 1; } else if (pn == 1) { base = KB; ld = SBW; c0 = 0; mode = 0; }
        else if (pn < 5) { base = U; ld = PW; c0 = (pn - 2) * BM; mode = 0; } else { base = G; ld = 2 * D; c0 = (pn - 5) * BM; mode = 2; }
        const int row0 = u.pm * BM + wr * 64 + fr, col0 = c0 + wc * 32 + 8 * fq;
#pragma unroll
        EPI_LOOP_ROWS { bf16_t* rowp = base + (size_t)(row0 + ai * HALF + m * 16) * ld + col0;
#pragma unroll
            for (int bj = 0; bj < 2; ++bj) { f32x4 v0 = acc[ai][bj][m][0], v1 = acc[ai][bj][m][1];
                if (mode == 1) { v0 = v0 * 0.125f; v1 = v1 * 0.125f; }
                if (mode == 2) {
#pragma unroll
                    for (int j = 0; j < 4; ++j) { v0[j] = fast_sigmoid(v0[j]); v1[j] = fast_sigmoid(v1[j]); } }
                *(u32x4*)(rowp + bj * HALF) = pack8(v0, v1); } }
    }
};
struct EpiPlain {
    static constexpr bool PERM = true;
    bf16_t* O; int ldc, coff; const float* bias; const float* scale;
    __device__ __forceinline__ void operator()(const f32x4 (&acc)[2][2][4][2], const Unit& u, int wr, int wc, int fr, int fq) const {
        const int row0 = u.pm * BM + wr * 64 + fr, col0 = u.pn * BM + wc * 32 + 8 * fq;
        f32x4 bv[2][2], sv[2][2];
#pragma unroll
        for (int bj = 0; bj < 2; ++bj)
#pragma unroll
            for (int n = 0; n < 2; ++n) { bv[bj][n] = bias ? *(const f32x4*)(bias + col0 + bj * HALF + 4 * n) : (f32x4){0.f, 0.f, 0.f, 0.f};
                                          sv[bj][n] = scale ? *(const f32x4*)(scale + col0 + bj * HALF + 4 * n) : (f32x4){1.f, 1.f, 1.f, 1.f}; }
#pragma unroll
        EPI_LOOP_ROWS { bf16_t* rowp = O + (size_t)(row0 + ai * HALF + m * 16) * ldc + coff + col0;
#pragma unroll
            for (int bj = 0; bj < 2; ++bj) *(u32x4*)(rowp + bj * HALF) = pack8((acc[ai][bj][m][0] + bv[bj][0]) * sv[bj][0], (acc[ai][bj][m][1] + bv[bj][1]) * sv[bj][1]); }
    }
};
template <bool ADD> struct EpiBranch {
    static constexpr bool PERM = true;
    bf16_t* MRG; const bf16_t* G; int goff; bf16_t* MRGout;
    __device__ __forceinline__ void operator()(const f32x4 (&acc)[2][2][4][2], const Unit& u, int wr, int wc, int fr, int fq) const {
        const int row0 = u.pm * BM + wr * 64 + fr, col0 = u.pn * BM + wc * 32 + 8 * fq;
#pragma unroll
        EPI_LOOP_ROWS { const size_t r = (size_t)(row0 + ai * HALF + m * 16);
#pragma unroll
            for (int bj = 0; bj < 2; ++bj) { const int c = col0 + bj * HALF;
                f32x4 g0, g1; unpack8(*(const u32x4*)(G + r * (2 * D) + goff + c), g0, g1);
                f32x4 v0 = g0 * acc[ai][bj][m][0], v1 = g1 * acc[ai][bj][m][1];
                if (ADD) { f32x4 p0, p1; unpack8(*(const u32x4*)(MRG + r * D + c), p0, p1); v0 = v0 + p0; v1 = v1 + p1; }
                *(u32x4*)(MRGout + r * D + c) = pack8(v0, v1); } }
    }
};
struct EpiGU {
    static constexpr bool PERM = true;
    bf16_t* ACT; const float* bgu;
    __device__ __forceinline__ void operator()(const f32x4 (&acc)[2][2][4][2], const Unit& u, int wr, int wc, int fr, int fq) const {
        const int row0 = u.pm * BM + wr * 64 + fr, col0 = u.pn * HALF + wc * 32 + 8 * fq;
        const float* bg = bgu + (size_t)u.e * (2 * D) + col0;
        f32x4 bgv[2], buv[2];
#pragma unroll
        for (int n = 0; n < 2; ++n) { bgv[n] = *(const f32x4*)(bg + 4 * n); buv[n] = *(const f32x4*)(bg + D + 4 * n); }
#pragma unroll
        EPI_LOOP_ROWS { f32x4 o[2];
#pragma unroll
            for (int n = 0; n < 2; ++n) { f32x4 gt = acc[ai][0][m][n] + bgv[n], up = acc[ai][1][m][n] + buv[n];
#pragma unroll
                for (int j = 0; j < 4; ++j) { const float g = fminf(gt[j], SW_LIMIT), uu = fminf(fmaxf(up[j], -SW_LIMIT), SW_LIMIT); o[n][j] = (uu + 1.0f) * g * fast_sigmoid(SW_ALPHA * g); } }
            *(u32x4*)(ACT + (size_t)(row0 + ai * HALF + m * 16) * D + col0) = pack8(o[0], o[1]); }
    }
};
struct EpiDN {
    static constexpr bool PERM = true;
    bf16_t* YR4; const float* bdn; const float* rowgate; const int* rowtk;
    __device__ __forceinline__ void operator()(const f32x4 (&acc)[2][2][4][2], const Unit& u, int wr, int wc, int fr, int fq) const {
        const int rl0 = wr * 64 + fr, col0 = u.pn * BM + wc * 32 + 8 * fq;
        const float* bp = bdn + (size_t)u.e * D + col0; const float* gp = rowgate + (size_t)u.e * T + u.slot0; const int* tp = rowtk + (size_t)u.e * T + u.slot0;
        f32x4 bv[2][2];
#pragma unroll
        for (int bj = 0; bj < 2; ++bj)
#pragma unroll
            for (int n = 0; n < 2; ++n) bv[bj][n] = *(const f32x4*)(bp + bj * HALF + 4 * n);
#pragma unroll
        EPI_LOOP_ROWS { const int rl = rl0 + ai * HALF + m * 16;
            if (rl < u.nvalid) { const float gt = gp[rl]; bf16_t* rowp = YR4 + (size_t)tp[rl] * D + col0;
#pragma unroll
                for (int bj = 0; bj < 2; ++bj) *(u32x4*)(rowp + bj * HALF) = pack8((acc[ai][bj][m][0] + bv[bj][0]) * gt, (acc[ai][bj][m][1] + bv[bj][1]) * gt); } }
    }
};

template <class Epi, class Sched>
__device__ __forceinline__ void gemm_simple(int wave, const Gemm g, const Sched& S, const Epi& E) {
    const int wid = launder_s(wave), lane = lane_id_v(), wr = wid >> 2, wc = wid & 3, fr = lane & 15, fq = lane >> 4;
    Unit u;
    for (int ui = 0; S.next(ui, u); ++ui) {
        f32x4 acc[2][2][4][2];
#pragma unroll
        for (int a = 0; a < 2; ++a)
#pragma unroll
            for (int b = 0; b < 2; ++b)
#pragma unroll
                for (int m = 0; m < 4; ++m)
#pragma unroll
                    for (int n = 0; n < 2; ++n) acc[a][b][m][n] = (f32x4){0.f, 0.f, 0.f, 0.f};
        unsigned ao[2][4], bo[2][2];
#pragma unroll
        for (int ai = 0; ai < 2; ++ai)
#pragma unroll
            for (int m = 0; m < 4; ++m) { const int rl = ai * HALF + wr * 64 + m * 16 + fr;
                if (g.gather) { const int tok = rl < u.nvalid ? (g.gather[(size_t)u.e * T + u.slot0 + rl] >> 2) : 0; ao[ai][m] = (unsigned)tok * (unsigned)g.lda + fq * 8; }
                else ao[ai][m] = u.aoff + (unsigned)rl * (unsigned)g.lda + fq * 8; }
#pragma unroll
        for (int bj = 0; bj < 2; ++bj)
#pragma unroll
            for (int n = 0; n < 2; ++n) { const int slot = 16 * n + fr, brow = bj * HALF + wc * 32 + (Epi::PERM ? perm32(slot) : slot); bo[bj][n] = u.boff + (unsigned)brow * (unsigned)g.ldb + fq * 8; }
#pragma unroll 1
        for (int k = 0; k < g.K; k += 32) {
            bf16x8 b[2][2];
#pragma unroll
            for (int bj = 0; bj < 2; ++bj)
#pragma unroll
                for (int n = 0; n < 2; ++n) b[bj][n] = *(const bf16x8*)(g.Bt + (size_t)bo[bj][n] + k);
#pragma unroll
            for (int ai = 0; ai < 2; ++ai) {
                bf16x8 a[4];
#pragma unroll
                for (int m = 0; m < 4; ++m) a[m] = *(const bf16x8*)(g.A + (size_t)ao[ai][m] + k);
#pragma unroll
                for (int bj = 0; bj < 2; ++bj)
#pragma unroll
                    for (int m = 0; m < 4; ++m)
#pragma unroll
                        for (int n = 0; n < 2; ++n) acc[ai][bj][m][n] = __builtin_amdgcn_mfma_f32_16x16x32_bf16(b[bj][n], a[m], acc[ai][bj][m][n], 0, 0, 0);
            }
        }
        E(acc, u, wr, wc, fr, fq);
    }
}

template <class Epi, class Sched>
__device__ __forceinline__ void gemm_fast(LAS unsigned char* lds, int wave, const Gemm g, const Sched& S, const Epi& E) {
    const int wid = launder_s(wave), lane = lane_id_v(), tid = wid * 64 + lane, wr = wid >> 2, wc = wid & 3, fr = lane & 15, fq = lane >> 4;
    const int K = launder_s(g.K), nt = K / BK;
    unsigned voffB[2];
#pragma unroll
    for (int i = 0; i < 2; ++i) { int R, C; stage_rc(tid * 16 + i * 8192, R, C); const int Rb = Epi::PERM ? ((R & ~31) + perm32(R & 31)) : R; voffB[i] = ((unsigned)Rb * (unsigned)g.ldb + (unsigned)C) * 2u; }
    const size_t kstep = (size_t)(BK * 2);
    const size_t hstepB = (size_t)HALF * g.ldb * 2;
    const unsigned ldsw = (unsigned)wid * 1024u;
    const int aoff = lds_byte(wr * 64 + fr, fq * 8), boff = lds_byte(wc * 32 + fr, fq * 8);
    const char* const Abase = (const char*)g.A; const char* const Bbase = (const char*)g.Bt;
#define PG8_SA(b, h) (((b) * 2 + (h)) * HTB)
#define PG8_SB(b, h) ((4 + (b) * 2 + (h)) * HTB)
#define PG8_STAGE_A(bufoff, ao, kb) do { _Pragma("unroll") for (int _i = 0; _i < 2; ++_i) \
        __builtin_amdgcn_global_load_lds((const unsigned*)(Abase + (size_t)(ao)[_i] + (size_t)(kb)), (LAS unsigned*)(lds + (bufoff) + ldsw + _i * 8192), 16, 0, 0); } while (0)
#define PG8_STAGE_B(bufoff, gbase) do { _Pragma("unroll") for (int _i = 0; _i < 2; ++_i) \
        __builtin_amdgcn_global_load_lds((const unsigned*)((const char*)(gbase) + voffB[_i]), (LAS unsigned*)(lds + (bufoff) + ldsw + _i * 8192), 16, 0, 0); } while (0)
#define PG8_LDA(dst, b, h) do { _Pragma("unroll") for (int m = 0; m < 4; ++m) _Pragma("unroll") for (int k = 0; k < 2; ++k) dst[m][k] = *(const LAS bf16x8*)(lds + PG8_SA(b, h) + aoff + m * 2048 + k * 1024); } while (0)
#define PG8_LDB(dst, b, h) do { _Pragma("unroll") for (int n = 0; n < 2; ++n) _Pragma("unroll") for (int k = 0; k < 2; ++k) dst[n][k] = *(const LAS bf16x8*)(lds + PG8_SB(b, h) + boff + n * 2048 + k * 1024); } while (0)
#define PG8_MMA(ai, bj, At, Bt) do { __builtin_amdgcn_s_setprio(1); _Pragma("unroll") for (int m = 0; m < 4; ++m) _Pragma("unroll") for (int n = 0; n < 2; ++n) _Pragma("unroll") for (int k = 0; k < 2; ++k) \
        acc[ai][bj][m][n] = __builtin_amdgcn_mfma_f32_16x16x32_bf16(Bt[n][k], At[m][k], acc[ai][bj][m][n], 0, 0, 0); __builtin_amdgcn_s_setprio(0); } while (0)
#define PG8_WAIT_V(n) asm volatile("s_waitcnt vmcnt(" #n ")" ::: "memory")
#define PG8_WAIT_L(n) asm volatile("s_waitcnt lgkmcnt(" #n ")" ::: "memory")
#define PG8_BAR __builtin_amdgcn_s_barrier()
#define PG8_SCHED __builtin_amdgcn_sched_barrier(0)
#define PG8_AOFFS(u, ao) do { _Pragma("unroll") for (int _h = 0; _h < 2; ++_h) _Pragma("unroll") for (int _i = 0; _i < 2; ++_i) { int _R, _C; stage_rc(tid * 16 + _i * 8192, _R, _C); const int _rl = _h * HALF + _R; \
        if (g.gather) { const int _tok = _rl < (u).nvalid ? (g.gather[(size_t)(u).e * T + (u).slot0 + _rl] >> 2) : 0; ao[_h][_i] = ((unsigned)_tok * (unsigned)g.lda + (unsigned)_C) * 2u; } \
        else ao[_h][_i] = ((u).aoff + (unsigned)_rl * (unsigned)g.lda + (unsigned)_C) * 2u; } } while (0)
    Unit cur, nxt; int ui = 0;
    if (!S.next(0, cur)) return;
    f32x4 acc[2][2][4][2];
#pragma unroll
    for (int a = 0; a < 2; ++a)
#pragma unroll
        for (int b = 0; b < 2; ++b)
#pragma unroll
            for (int m = 0; m < 4; ++m)
#pragma unroll
                for (int n = 0; n < 2; ++n) acc[a][b][m][n] = (f32x4){0.f, 0.f, 0.f, 0.f};
    bf16x8 At[4][2], B0[2][2], B1[2][2];
    unsigned aC[2][2], aN[2][2];
    PG8_AOFFS(cur, aC);
    const char* cB = Bbase + (size_t)cur.boff * 2;
    PG8_STAGE_B(PG8_SB(0, 0), cB); PG8_STAGE_B(PG8_SB(0, 1), cB + hstepB); PG8_STAGE_A(PG8_SA(0, 0), aC[0], 0); PG8_STAGE_A(PG8_SA(0, 1), aC[1], 0);
    if (wr == 1) PG8_BAR;
    PG8_WAIT_V(2); PG8_BAR;
    PG8_STAGE_B(PG8_SB(1, 0), cB + kstep); PG8_STAGE_A(PG8_SA(1, 0), aC[0], kstep); PG8_STAGE_B(PG8_SB(1, 1), cB + hstepB + kstep);
    PG8_WAIT_V(6); PG8_BAR;
    for (;;) {
        const bool has_next = S.next(ui + 1, nxt);
        if (has_next) { PG8_AOFFS(nxt, aN); } else {
#pragma unroll
            for (int h = 0; h < 2; ++h)
#pragma unroll
                for (int i = 0; i < 2; ++i) aN[h][i] = aC[h][i]; }
        const char* nB = has_next ? Bbase + (size_t)nxt.boff * 2 : cB;
#pragma unroll 1
        for (int t = 0; t < nt; t += 2) {
            const bool last = (t == nt - 2);
            const size_t k1 = (size_t)(t + 1) * kstep, k2 = last ? 0 : (size_t)(t + 2) * kstep, k3 = k2 + kstep;
            unsigned a2[2][2];
#pragma unroll
            for (int h = 0; h < 2; ++h)
#pragma unroll
                for (int i = 0; i < 2; ++i) a2[h][i] = last ? aN[h][i] : aC[h][i];
            const char* b2 = last ? nB : cB + (size_t)(t + 2) * kstep; const char* b3 = b2 + kstep;
            PG8_LDB(B0, 0, 0); PG8_LDB(B1, 0, 1); PG8_SCHED; PG8_LDA(At, 0, 0); PG8_STAGE_A(PG8_SA(1, 1), aC[1], k1);
            PG8_WAIT_V(8); PG8_WAIT_L(0); PG8_BAR; PG8_MMA(0, 0, At, B0); PG8_MMA(0, 1, At, B1); PG8_BAR; PG8_SCHED;
            PG8_LDA(At, 0, 1); PG8_STAGE_B(PG8_SB(0, 0), b2); PG8_STAGE_B(PG8_SB(0, 1), b2 + hstepB); PG8_STAGE_A(PG8_SA(0, 0), a2[0], k2);
            PG8_WAIT_V(8); PG8_WAIT_L(0); PG8_BAR; PG8_MMA(1, 0, At, B0); PG8_MMA(1, 1, At, B1); PG8_BAR; PG8_SCHED;
            PG8_LDB(B0, 1, 0); PG8_LDB(B1, 1, 1); PG8_SCHED; PG8_LDA(At, 1, 0); PG8_STAGE_A(PG8_SA(0, 1), a2[1], k2);
            PG8_WAIT_V(8); PG8_WAIT_L(0); PG8_BAR; PG8_MMA(0, 0, At, B0); PG8_MMA(0, 1, At, B1); PG8_BAR; PG8_SCHED;
            PG8_LDA(At, 1, 1); PG8_STAGE_B(PG8_SB(1, 0), b3); PG8_STAGE_B(PG8_SB(1, 1), b3 + hstepB); PG8_STAGE_A(PG8_SA(1, 0), a2[0], k3);
            PG8_WAIT_V(8); PG8_WAIT_L(0); PG8_BAR; PG8_MMA(1, 0, At, B0); PG8_MMA(1, 1, At, B1); PG8_BAR; PG8_SCHED;
        }
        if (wr == 0) PG8_BAR;
        E(acc, cur, wr, wc, fr, fq);
        if (!has_next) break;
#pragma unroll
        for (int a = 0; a < 2; ++a)
#pragma unroll
            for (int b = 0; b < 2; ++b)
#pragma unroll
                for (int m = 0; m < 4; ++m)
#pragma unroll
                    for (int n = 0; n < 2; ++n) acc[a][b][m][n] = (f32x4){0.f, 0.f, 0.f, 0.f};
        cur = nxt; cB = nB; ++ui;
#pragma unroll
        for (int h = 0; h < 2; ++h)
#pragma unroll
            for (int i = 0; i < 2; ++i) aC[h][i] = aN[h][i];
        if (wr == 1) PG8_BAR;
    }
    PG8_WAIT_V(0);
    PG8_BAR;
#undef PG8_SA
#undef PG8_SB
#undef PG8_STAGE_A
#undef PG8_STAGE_B
#undef PG8_LDA
#undef PG8_LDB
#undef PG8_MMA
#undef PG8_WAIT_V
#undef PG8_WAIT_L
#undef PG8_BAR
#undef PG8_SCHED
#undef PG8_AOFFS
}

template <class Epi, class Sched, int SITE>
__device__ __forceinline__ void gemm_phase(LAS unsigned char* lds, int wave, const Gemm g, const Sched& S, const Epi& E) {
    if constexpr ((FAST_MASK >> SITE) & 1) gemm_fast<Epi, Sched>(lds, wave, g, S, E); else gemm_simple<Epi, Sched>(wave, g, S, E);
}
}

struct Frame {
    LAS unsigned char* lds;
    volatile LAS unsigned* MISC;
    unsigned* ctl;
    int tid, lane, wave, vcu, G;
};
struct Args { const float* in[21]; float* out; unsigned char* ws; int ph_lo, ph_hi; };
static_assert(sizeof(Args) == 21 * 8 + 8 + 8 + 8, "Args has no padding");

__device__ __forceinline__ void mods_phase(Frame& F, const float* c, const float* ada_w, const float* ada_b, float* MOD) {
    LAS float* cact = (LAS float*)F.lds;
    LAS float* part = (LAS float*)(F.lds + 8192);
    for (int i = F.tid; i < BATCH * D; i += NTHREADS) { const float v = c[i]; cact[i] = v * fast_sigmoid(v); }
    __syncthreads();
    constexpr int NTASK = DEPTH * (6 * D / 64);
    for (int task = F.vcu; task < NTASK; task += F.G) {
        const int l = task / (6 * D / 64), j0 = (task % (6 * D / 64)) * 64;
        const float* w = ada_w + (size_t)l * D * (6 * D) + j0 + F.lane;
        const int k0 = F.wave * 128;
        float a0 = 0.f, a1 = 0.f;
#pragma unroll 16
        for (int k = 0; k < 128; ++k) { const float wv = w[(size_t)(k0 + k) * (6 * D)]; a0 += cact[k0 + k] * wv; a1 += cact[D + k0 + k] * wv; }
        part[(F.wave * 2 + 0) * 64 + F.lane] = a0; part[(F.wave * 2 + 1) * 64 + F.lane] = a1;
        __syncthreads();
        if (F.tid < 128) { const int b = F.tid >> 6, j = F.tid & 63; float s = 0.f;
#pragma unroll
            for (int w8 = 0; w8 < 8; ++w8) s += part[(w8 * 2 + b) * 64 + j];
            MOD[((size_t)l * BATCH + b) * (6 * D) + j0 + j] = s + ada_b[(size_t)l * (6 * D) + j0 + j]; }
        __syncthreads();
    }
}
__device__ __forceinline__ void tr_item(const float* W, int ldw, bf16_t* WT, int ldt, int k0, int n0, int drow0, int dcol0, LAS float* scr, int lane) {
#pragma unroll 8
    for (int i = 0; i < 32; ++i) { const int kk = 2 * i + (lane >> 5); scr[kk * 33 + (lane & 31)] = W[(size_t)(k0 + kk) * ldw + n0 + (lane & 31)]; }
    LDS_WAIT(); asm volatile("" ::: "memory");
    const int c = lane & 7;
#pragma unroll
    for (int j = 0; j < 4; ++j) { const int n = (lane >> 3) + 8 * j; const LAS float* s = scr + (8 * c) * 33 + n;
        u32x4 o; o.x = pk2(s[0 * 33], s[1 * 33]); o.y = pk2(s[2 * 33], s[3 * 33]); o.z = pk2(s[4 * 33], s[5 * 33]); o.w = pk2(s[6 * 33], s[7 * 33]);
        *(u32x4*)(WT + (size_t)(drow0 + n) * ldt + dcol0 + k0 + 8 * c) = o; }
    LDS_WAIT(); asm volatile("" ::: "memory");
}
__device__ __forceinline__ int win_drow(int n0) {
    if (n0 < 512) return n0; if (n0 < 768) return 3328 + (n0 - 512); if (n0 < 1536) return 512 + (n0 - 768); return 1280 + (n0 - 1536);
}
typedef const volatile __attribute__((address_space(4))) Args* KArgs;
__device__ __forceinline__ void convert_phase(Frame& F, KArgs ka) {
    unsigned char* wsb = (unsigned char*)ka->ws; const float *in8 = (const float*)ka->in[8], *in9 = (const float*)ka->in[9], *in12 = (const float*)ka->in[12], *in13 = (const float*)ka->in[13], *in14 = (const float*)ka->in[14], *in15 = (const float*)ka->in[15], *in17 = (const float*)ka->in[17], *in19 = (const float*)ka->in[19];
    LAS float* scr = (LAS float*)(F.lds + F.wave * 16384);
    const int gw = F.vcu * NWAVES + F.wave, NGW = F.G * NWAVES;
    constexpr int I_IN = 16 * 112, I_BRA = 4 * 32, I_BRP = 12 * 32, I_OUT = 16 * 32, I_RT = 16, I_PL = 4 * 3 * 6, I_GU = NE * 16 * 64, I_DN = NE * 16 * 32;
    constexpr int I_LAYER = I_IN + I_BRA + I_BRP + I_OUT + I_RT + I_PL + I_GU + I_DN;
    for (int it = gw; it < DEPTH * I_LAYER; it += NGW) {
        const int l = it / I_LAYER; int r = it % I_LAYER;
        unsigned char* wl = wsb + WS_W + (size_t)l * WL_STRIDE;
        if (r < I_GU) { const int e = r / (16 * 64), q = r % (16 * 64), kb = q / 64, nb = q % 64, n0 = nb * 32, half = n0 / D, cc = n0 % D;
            tr_item(in17 + ((size_t)l * NE + e) * D * (2 * D), 2 * D, (bf16_t*)(wl + WO_GU) + (size_t)e * (2 * D) * D, D, kb * 64, n0, (cc / 128) * 256 + half * 128 + (cc % 128), 0, scr, F.lane); continue; } r -= I_GU;
        if (r < I_DN) { const int e = r / (16 * 32), q = r % (16 * 32), kb = q / 32, nb = q % 32;
            tr_item(in19 + ((size_t)l * NE + e) * D * D, D, (bf16_t*)(wl + WO_DN) + (size_t)e * D * D, D, kb * 64, nb * 32, nb * 32, 0, scr, F.lane); continue; } r -= I_DN;
        if (r < I_IN) { const int kb = r / 112, nb = r % 112;
            tr_item(in8 + (size_t)l * D * INW, INW, (bf16_t*)(wl + WO_WIN), D, kb * 64, nb * 32, win_drow(nb * 32), 0, scr, F.lane); continue; } r -= I_IN;
        if (r < I_BRA) { const int kb = r / 32, nb = r % 32;
            tr_item(in12 + (size_t)l * SBW * D, D, (bf16_t*)(wl + WO_BRA), SBW, kb * 64, nb * 32, nb * 32, 0, scr, F.lane); continue; } r -= I_BRA;
        if (r < I_BRP) { const int kb = r / 32, nb = r % 32;
            tr_item(in13 + (size_t)l * PW * D, D, (bf16_t*)(wl + WO_BRP), PW, kb * 64, nb * 32, nb * 32, 0, scr, F.lane); continue; } r -= I_BRP;
        if (r < I_OUT) { const int kb = r / 32, nb = r % 32;
            tr_item(in14 + (size_t)l * D * D, D, (bf16_t*)(wl + WO_OUT), D, kb * 64, nb * 32, nb * 32, 0, scr, F.lane); continue; } r -= I_OUT;
        if (r < I_RT) { tr_item(in15 + (size_t)l * D * NE, NE, (bf16_t*)(wl + WO_ROUTER), D, r * 64, 0, 0, 0, scr, F.lane); continue; } r -= I_RT;
        { const int gidx = r / 18, q = r % 18, kb = q / 6, nb = q % 6;
            tr_item(in9 + ((size_t)l * 4 + gidx) * PGD * PGD, PGD, (bf16_t*)(wl + WO_POOL), PW, kb * 64, nb * 32, gidx * PGD + nb * 32, gidx * PGD, scr, F.lane); }
    }
    for (int it = gw; it < DEPTH * PW; it += NGW) { const int l = it / PW, n = it % PW, gidx = n / PGD;
        bf16_t* rowp = (bf16_t*)(wsb + WS_W + (size_t)l * WL_STRIDE + WO_POOL) + (size_t)n * PW;
        for (int ch = F.lane; ch < PW / 8; ch += 64) if (ch / (PGD / 8) != gidx) *(u32x4*)(rowp + ch * 8) = (u32x4){0u, 0u, 0u, 0u}; }
}

struct Row16 { f32x4 a[4]; };
__device__ __forceinline__ void ld_row_f32(const float* p, int lane, Row16& v) {
#pragma unroll
    for (int j = 0; j < 2; ++j) { v.a[2 * j] = *(const f32x4*)(p + 8 * lane + 512 * j); v.a[2 * j + 1] = *(const f32x4*)(p + 8 * lane + 512 * j + 4); } }
__device__ __forceinline__ void st_row_f32(float* p, int lane, const Row16& v) {
#pragma unroll
    for (int j = 0; j < 2; ++j) { *(f32x4*)(p + 8 * lane + 512 * j) = v.a[2 * j]; *(f32x4*)(p + 8 * lane + 512 * j + 4) = v.a[2 * j + 1]; } }
__device__ __forceinline__ void ld_row_bf16(const bf16_t* p, int lane, u32x4 (&w)[2]) {
#pragma unroll
    for (int j = 0; j < 2; ++j) w[j] = *(const u32x4*)(p + 8 * lane + 512 * j); }
__device__ __forceinline__ void acc_row_bf16(const u32x4 (&w)[2], Row16& y) {
#pragma unroll
    for (int j = 0; j < 2; ++j) { f32x4 lo, hi; pg8::unpack8(w[j], lo, hi); y.a[2 * j] = y.a[2 * j] + lo; y.a[2 * j + 1] = y.a[2 * j + 1] + hi; } }
__device__ __forceinline__ float row_sumsq(const Row16& v) { float ss = 0.f;
#pragma unroll
    for (int q = 0; q < 4; ++q) ss += (v.a[q].x * v.a[q].x + v.a[q].y * v.a[q].y) + (v.a[q].z * v.a[q].z + v.a[q].w * v.a[q].w);
    return ss; }
__device__ __forceinline__ void norm_mod_store(const Row16& v, float ss_wave, const Row16& gg, const Row16& s1, const Row16& s0, bf16_t* hrow, int lane) {
    const float r = 1.0f / sqrtf(ss_wave * (1.0f / D) + NORM_EPS);
#pragma unroll
    for (int j = 0; j < 2; ++j) { const f32x4 o0 = v.a[2 * j] * r * gg.a[2 * j] * (s1.a[2 * j] + 1.0f) + s0.a[2 * j], o1 = v.a[2 * j + 1] * r * gg.a[2 * j + 1] * (s1.a[2 * j + 1] + 1.0f) + s0.a[2 * j + 1];
        u32x4 w; w.x = pk2(o0.x, o0.y); w.y = pk2(o0.z, o0.w); w.z = pk2(o1.x, o1.y); w.w = pk2(o1.z, o1.w); *(u32x4*)(hrow + 8 * lane + 512 * j) = w; }
}
constexpr int RP = 2;
__device__ __forceinline__ void rowpass_pre(Frame& F, const float* x, const float* g, const float* MODl, bf16_t* H) {
    const int gw = F.vcu * NWAVES + F.wave, NGW = F.G * NWAVES;
    Row16 gg; ld_row_f32(g, F.lane, gg);
    for (int row0 = gw * RP; row0 < T; row0 += NGW * RP) { const int b = row0 / SEQ; const float* mod = MODl + (size_t)b * 6 * D;
        Row16 v[RP], s1, s0; float ss[RP];
#pragma unroll
        for (int q = 0; q < RP; ++q) ld_row_f32(x + (size_t)(row0 + q) * D, F.lane, v[q]);
        ld_row_f32(mod + 1 * D, F.lane, s1); ld_row_f32(mod + 0 * D, F.lane, s0);
#pragma unroll
        for (int q = 0; q < RP; ++q) ss[q] = row_sumsq(v[q]);
#pragma unroll
        for (int o = 1; o < 64; o <<= 1) {
#pragma unroll
            for (int q = 0; q < RP; ++q) ss[q] += __shfl_xor(ss[q], o); }
#pragma unroll
        for (int q = 0; q < RP; ++q) norm_mod_store(v[q], ss[q], gg, s1, s0, H + (size_t)(row0 + q) * D, F.lane); }
}
__device__ __forceinline__ void rowpass_mid(Frame& F, const float* xin, float* xout, const bf16_t* Y, const float* post_g, const float* pre2_g, const float* MODl, bf16_t* H) {
    const int gw = F.vcu * NWAVES + F.wave, NGW = F.G * NWAVES;
    for (int row0 = gw * RP; row0 < T; row0 += NGW * RP) { const int b = row0 / SEQ; const float* mod = MODl + (size_t)b * 6 * D;
        Row16 v[RP], y[RP]; float ss[RP];
#pragma unroll
        for (int q = 0; q < RP; ++q) { ld_row_f32(xin + (size_t)(row0 + q) * D, F.lane, v[q]); u32x4 w[2]; ld_row_bf16(Y + (size_t)(row0 + q) * D, F.lane, w);
#pragma unroll
            for (int i = 0; i < 4; ++i) y[q].a[i] = (f32x4){0.f, 0.f, 0.f, 0.f};
            acc_row_bf16(w, y[q]); }
        { Row16 pg, g1; ld_row_f32(post_g, F.lane, pg); ld_row_f32(mod + 2 * D, F.lane, g1);
#pragma unroll
            for (int q = 0; q < RP; ++q) ss[q] = row_sumsq(y[q]);
#pragma unroll
            for (int o = 1; o < 64; o <<= 1) {
#pragma unroll
                for (int q = 0; q < RP; ++q) ss[q] += __shfl_xor(ss[q], o); }
#pragma unroll
            for (int q = 0; q < RP; ++q) { const float r = 1.0f / sqrtf(ss[q] * (1.0f / D) + NORM_EPS);
#pragma unroll
                for (int i = 0; i < 4; ++i) v[q].a[i] = v[q].a[i] + g1.a[i] * (y[q].a[i] * r * pg.a[i]);
                st_row_f32(xout + (size_t)(row0 + q) * D, F.lane, v[q]); } }
        { Row16 gg, s1, s0; ld_row_f32(pre2_g, F.lane, gg); ld_row_f32(mod + 4 * D, F.lane, s1); ld_row_f32(mod + 3 * D, F.lane, s0);
#pragma unroll
            for (int q = 0; q < RP; ++q) ss[q] = row_sumsq(v[q]);
#pragma unroll
            for (int o = 1; o < 64; o <<= 1) {
#pragma unroll
                for (int q = 0; q < RP; ++q) ss[q] += __shfl_xor(ss[q], o); }
#pragma unroll
            for (int q = 0; q < RP; ++q) norm_mod_store(v[q], ss[q], gg, s1, s0, H + (size_t)(row0 + q) * D, F.lane); } }
}
__device__ __forceinline__ void rowpass_comb(Frame& F, const float* x, float* xout, const bf16_t* YR4, const float* post_g, const float* MODl,
                                             bool has_next, const float* pre1_g_next, const float* MODn, bf16_t* H) {
    const int gw = F.vcu * NWAVES + F.wave, NGW = F.G * NWAVES;
    for (int row0 = gw * RP; row0 < T; row0 += NGW * RP) { const int b = row0 / SEQ; const float* mod = MODl + (size_t)b * 6 * D;
        Row16 v[RP], y[RP]; float ss[RP]; u32x4 w[RP][TOPK][2];
#pragma unroll
        for (int q = 0; q < RP; ++q) { ld_row_f32(x + (size_t)(row0 + q) * D, F.lane, v[q]);
#pragma unroll
            for (int k = 0; k < TOPK; ++k) ld_row_bf16(YR4 + ((size_t)(row0 + q) * TOPK + k) * D, F.lane, w[q][k]); }
#pragma unroll
        for (int q = 0; q < RP; ++q) {
#pragma unroll
            for (int i = 0; i < 4; ++i) y[q].a[i] = (f32x4){0.f, 0.f, 0.f, 0.f};
#pragma unroll
            for (int k = 0; k < TOPK; ++k) acc_row_bf16(w[q][k], y[q]); }
        { Row16 pg, g2; ld_row_f32(post_g, F.lane, pg); ld_row_f32(mod + 5 * D, F.lane, g2);
#pragma unroll
            for (int q = 0; q < RP; ++q) ss[q] = row_sumsq(y[q]);
#pragma unroll
            for (int o = 1; o < 64; o <<= 1) {
#pragma unroll
                for (int q = 0; q < RP; ++q) ss[q] += __shfl_xor(ss[q], o); }
#pragma unroll
            for (int q = 0; q < RP; ++q) { const float r = 1.0f / sqrtf(ss[q] * (1.0f / D) + NORM_EPS);
#pragma unroll
                for (int i = 0; i < 4; ++i) v[q].a[i] = v[q].a[i] + g2.a[i] * (y[q].a[i] * r * pg.a[i]);
                st_row_f32(xout + (size_t)(row0 + q) * D, F.lane, v[q]); } }
        if (has_next) { const float* modn = MODn + (size_t)b * 6 * D; Row16 gg, s1, s0; ld_row_f32(pre1_g_next, F.lane, gg); ld_row_f32(modn + 1 * D, F.lane, s1); ld_row_f32(modn + 0 * D, F.lane, s0);
#pragma unroll
            for (int q = 0; q < RP; ++q) ss[q] = row_sumsq(v[q]);
#pragma unroll
            for (int o = 1; o < 64; o <<= 1) {
#pragma unroll
                for (int q = 0; q < RP; ++q) ss[q] += __shfl_xor(ss[q], o); }
#pragma unroll
            for (int q = 0; q < RP; ++q) norm_mod_store(v[q], ss[q], gg, s1, s0, H + (size_t)(row0 + q) * D, F.lane); } }
}

__device__ __forceinline__ void attn_phase(Frame& F, const bf16_t* Q, const bf16_t* KB, const bf16_t* VT, bf16_t* AP) {
    const int gw = F.vcu * NWAVES + F.wave, NGW = F.G * NWAVES;
    const int r = F.lane & 31, hh = F.lane >> 5;
    constexpr int NQT = SEQ / 32, NTASK = BATCH * NH * NQT;
    for (int task = gw; task < NTASK; task += NGW) {
        const int qt = task % NQT, h = (task / NQT) % NH, b = task / (NQT * NH), q0 = qt * 32;
        const size_t trow0 = (size_t)b * SEQ;
        bf16x8 qf[4];
#pragma unroll
        for (int ks = 0; ks < 4; ++ks) qf[ks] = *(const bf16x8*)(Q + (trow0 + q0 + r) * SBW + h * HD + ks * 16 + hh * 8);
        f32x16 o0, o1;
#pragma unroll
        for (int i = 0; i < 16; ++i) { o0[i] = 0.f; o1[i] = 0.f; }
        float C = 0.f;
        for (int kb = q0; kb >= 0; kb -= 32) {
            const bool diag = (kb == q0);
            f32x16 s;
#pragma unroll
            for (int i = 0; i < 16; ++i) s[i] = 0.f;
            const bf16_t* kp = KB + (trow0 + kb + r) * SBW + h * HD + hh * 8;
#pragma unroll
            for (int ks = 0; ks < 4; ++ks) { const bf16x8 kf = *(const bf16x8*)(kp + ks * 16); s = __builtin_amdgcn_mfma_f32_32x32x16_bf16(kf, qf[ks], s, 0, 0, 0); }
            s16x4 vlo[2][2], vhi[2][2];
#pragma unroll
            for (int st = 0; st < 2; ++st)
#pragma unroll
                for (int dt = 0; dt < 2; ++dt) { const bf16_t* vp = VT + (size_t)(h * HD + dt * 32 + r) * T + trow0 + kb + 16 * st + 4 * hh; vlo[st][dt] = *(const s16x4*)vp; vhi[st][dt] = *(const s16x4*)(vp + 8); }
            float lk[16];
#pragma unroll
            for (int i = 0; i < 16; ++i) { const int kc = 8 * (i >> 2) + 4 * hh + (i & 3); const bool valid = !diag || (kc < r); lk[i] = valid ? -softplus_f(s[i]) : 0.f; }
            float rt[4], pt[4], both[4];
#pragma unroll
            for (int gq = 0; gq < 4; ++gq) { lk[4 * gq + 2] += lk[4 * gq + 3]; lk[4 * gq + 1] += lk[4 * gq + 2]; lk[4 * gq + 0] += lk[4 * gq + 1]; rt[gq] = lk[4 * gq]; }
#pragma unroll
            for (int gq = 0; gq < 4; ++gq) { pt[gq] = __shfl_xor(rt[gq], 32); both[gq] = rt[gq] + pt[gq]; }
            float after[4]; after[3] = 0.f; after[2] = both[3]; after[1] = both[3] + both[2]; after[0] = after[1] + both[1];
            f32x16 a;
#pragma unroll
            for (int gq = 0; gq < 4; ++gq) { const float off = after[gq] + (hh == 0 ? pt[gq] : 0.f) + C;
#pragma unroll
                for (int j = 0; j < 4; ++j) { const int i = 4 * gq + j, kc = 8 * gq + 4 * hh + j; const bool valid = !diag || (kc < r);
                    a[i] = valid ? fast_exp(s[i] + lk[i] + off) : 0.f; } }
            C += both[0] + after[0];
#pragma unroll
            for (int st = 0; st < 2; ++st) {
                u32x4 pw; pw.x = pk2(a[8 * st + 0], a[8 * st + 1]); pw.y = pk2(a[8 * st + 2], a[8 * st + 3]); pw.z = pk2(a[8 * st + 4], a[8 * st + 5]); pw.w = pk2(a[8 * st + 6], a[8 * st + 7]);
                const bf16x8 pb = __builtin_bit_cast(bf16x8, pw);
                const bf16x8 va0 = __builtin_shufflevector(vlo[st][0], vhi[st][0], 0, 1, 2, 3, 4, 5, 6, 7), va1 = __builtin_shufflevector(vlo[st][1], vhi[st][1], 0, 1, 2, 3, 4, 5, 6, 7);
                o0 = __builtin_amdgcn_mfma_f32_32x32x16_bf16(va0, pb, o0, 0, 0, 0);
                o1 = __builtin_amdgcn_mfma_f32_32x32x16_bf16(va1, pb, o1, 0, 0, 0);
            }
            if (__all(C < STICK_EXIT)) break;
        }
        bf16_t* orow = AP + (trow0 + q0 + r) * D + h * HD;
#pragma unroll
        for (int gq = 0; gq < 4; ++gq) { u32x2 w0, w1; w0.x = pk2(o0[4 * gq], o0[4 * gq + 1]); w0.y = pk2(o0[4 * gq + 2], o0[4 * gq + 3]); w1.x = pk2(o1[4 * gq], o1[4 * gq + 1]); w1.y = pk2(o1[4 * gq + 2], o1[4 * gq + 3]);
            *(u32x2*)(orow + 8 * gq + 4 * hh) = w0; *(u32x2*)(orow + 32 + 8 * gq + 4 * hh) = w1; }
    }
}

__device__ __forceinline__ void poolmix_phase(Frame& F, const bf16_t* U, bf16_t* MIX) {
    const int gt = F.vcu * NTHREADS + F.tid, NGT = F.G * NTHREADS;
    constexpr int OCT = PW / 8;
    for (int idx = gt; idx < T * OCT; idx += NGT) {
        const int t = idx / OCT, o = idx % OCT, gidx = o / (PGD / 8), w = 2 << gidx, s = t % SEQ, cnt = (s + 1) < w ? (s + 1) : w;
        const bf16_t* up = U + (size_t)t * PW + o * 8;
        float acc[8], self[8];
        { const u32x4 q = *(const u32x4*)up; self[0] = bf_lo(q.x); self[1] = bf_hi(q.x); self[2] = bf_lo(q.y); self[3] = bf_hi(q.y); self[4] = bf_lo(q.z); self[5] = bf_hi(q.z); self[6] = bf_lo(q.w); self[7] = bf_hi(q.w); }
#pragma unroll
        for (int j = 0; j < 8; ++j) acc[j] = self[j];
        for (int i = 1; i < cnt; ++i) { const u32x4 q = *(const u32x4*)(up - (size_t)i * PW);
            acc[0] += bf_lo(q.x); acc[1] += bf_hi(q.x); acc[2] += bf_lo(q.y); acc[3] += bf_hi(q.y); acc[4] += bf_lo(q.z); acc[5] += bf_hi(q.z); acc[6] += bf_lo(q.w); acc[7] += bf_hi(q.w); }
        const float inv = 1.0f / (float)cnt;
        u32x4 ow; ow.x = pk2(acc[0] * inv - self[0], acc[1] * inv - self[1]); ow.y = pk2(acc[2] * inv - self[2], acc[3] * inv - self[3]);
        ow.z = pk2(acc[4] * inv - self[4], acc[5] * inv - self[5]); ow.w = pk2(acc[6] * inv - self[6], acc[7] * inv - self[7]);
        *(u32x4*)(MIX + (size_t)t * PW + o * 8) = ow;
    }
}

constexpr int NBLK = T / 128;
__device__ __forceinline__ void router_phase_a(Frame& F, const bf16_t* H, const bf16_t* RT, const float* rb, int* HIST, int* TOPE, int* TOPL, float* TOPG) {
    LAS float* lg = (LAS float*)(F.lds + F.wave * 4096);
    volatile LAS int* whist = (volatile LAS int*)(F.lds + 65536);
    const int fr = F.lane & 15, fq = F.lane >> 4;
    for (int blk = F.vcu; blk < NBLK; blk += F.G) {
        const int t0 = blk * 128 + F.wave * 16;
        if (F.lane < NE) whist[F.wave * NE + F.lane] = 0;
        f32x4 a0 = {0.f, 0.f, 0.f, 0.f}, a1 = {0.f, 0.f, 0.f, 0.f};
        const bf16_t* hp = H + (size_t)(t0 + fr) * D + fq * 8; const bf16_t* w0 = RT + (size_t)fr * D + fq * 8; const bf16_t* w1 = RT + (size_t)(16 + fr) * D + fq * 8;
#pragma unroll 4
        for (int k = 0; k < D; k += 32) { const bf16x8 av = *(const bf16x8*)(hp + k), b0 = *(const bf16x8*)(w0 + k), b1 = *(const bf16x8*)(w1 + k);
            a0 = __builtin_amdgcn_mfma_f32_16x16x32_bf16(av, b0, a0, 0, 0, 0); a1 = __builtin_amdgcn_mfma_f32_16x16x32_bf16(av, b1, a1, 0, 0, 0); }
        const float rb0 = rb[fr], rb1 = rb[16 + fr];
#pragma unroll
        for (int j = 0; j < 4; ++j) { lg[(4 * fq + j) * 33 + fr] = a0[j] + rb0; lg[(4 * fq + j) * 33 + 16 + fr] = a1[j] + rb1; }
        LDS_WAIT(); asm volatile("" ::: "memory");
        float bv[4] = {-INFINITY, -INFINITY, -INFINITY, -INFINITY}; int bi[4] = {0, 0, 0, 0};
        if (F.lane < 16) {
            for (int e = 0; e < NE; ++e) { const float v = lg[F.lane * 33 + e];
                if (v > bv[3]) { bv[3] = v; bi[3] = e;
                    if (bv[3] > bv[2]) { float tv = bv[2]; bv[2] = bv[3]; bv[3] = tv; int ti = bi[2]; bi[2] = bi[3]; bi[3] = ti;
                        if (bv[2] > bv[1]) { tv = bv[1]; bv[1] = bv[2]; bv[2] = tv; ti = bi[1]; bi[1] = bi[2]; bi[2] = ti;
                            if (bv[1] > bv[0]) { tv = bv[0]; bv[0] = bv[1]; bv[1] = tv; ti = bi[0]; bi[0] = bi[1]; bi[1] = ti; } } } } }
        }
        float gt[4]; { float sum = 0.f;
#pragma unroll
            for (int k = 0; k < 4; ++k) { gt[k] = fast_exp(bv[k] - bv[0]); sum += gt[k]; }
            const float inv = 1.0f / sum;
#pragma unroll
            for (int k = 0; k < 4; ++k) gt[k] *= inv; }
        int rk[4];
#pragma unroll
        for (int k = 0; k < 4; ++k) {
            const int e = F.lane < 16 ? bi[k] : -1; int rank = 0;
            unsigned long long todo = __ballot(e >= 0);
            while (todo) { const int leader = __builtin_ctzll(todo); const int le = __shfl(e, leader); const unsigned long long mm = __ballot(e == le);
                const int base = whist[F.wave * NE + le];
                if (e == le) rank = base + __builtin_popcountll(mm & ((1ull << F.lane) - 1ull));
                if (F.lane == leader) whist[F.wave * NE + le] = base + __builtin_popcountll(mm);
                todo &= ~mm; }
            rk[k] = rank;
        }
        __syncthreads();
        if (F.tid < NE) { int run = 0;
#pragma unroll
            for (int w = 0; w < NWAVES; ++w) { const int v = whist[w * NE + F.tid]; whist[w * NE + F.tid] = run; run += v; }
            HIST[blk * NE + F.tid] = run; }
        __syncthreads();
        if (F.lane < 16) { const int t = t0 + F.lane;
#pragma unroll
            for (int k = 0; k < 4; ++k) { TOPE[t * TOPK + k] = bi[k]; TOPL[t * TOPK + k] = whist[F.wave * NE + bi[k]] + rk[k]; TOPG[t * TOPK + k] = gt[k]; } }
        __syncthreads();
    }
}
__device__ __forceinline__ void router_phase_b(Frame& F, const int* HIST, const int* TOPE, const int* TOPL, const float* TOPG, int* TOPS, int* ROWTOK, float* ROWGATE) {
    volatile LAS int* part = (volatile LAS int*)(F.lds + 65536);
    for (int blk = F.vcu; blk < NBLK; blk += F.G) {
        { const int e = F.tid & 31, pt = F.tid >> 5; int sacc = 0;
            for (int b = pt * 16; b < pt * 16 + 16; ++b) sacc += (b < blk) ? HIST[b * NE + e] : 0;
            part[pt * NE + e] = sacc; }
        __syncthreads();
        if (F.tid < NE) { int sacc = 0;
#pragma unroll
            for (int pt = 0; pt < 16; ++pt) sacc += part[pt * NE + F.tid];
            part[512 + F.tid] = sacc; }
        __syncthreads();
        { const int t = blk * 128 + (F.tid >> 2), k = F.tid & 3; const int e = TOPE[t * TOPK + k]; const int slot = part[512 + e] + TOPL[t * TOPK + k];
            TOPS[t * TOPK + k] = slot; ROWTOK[(size_t)e * T + slot] = t * TOPK + k; ROWGATE[(size_t)e * T + slot] = TOPG[t * TOPK + k]; }
        __syncthreads();
    }
}
__device__ __forceinline__ void moe_table(Frame& F, const int* HIST) {
    volatile LAS int* part = (volatile LAS int*)(F.MISC + 256);
    __syncthreads();
    { const int e = F.tid & 31, pt = F.tid >> 5; int sacc = 0;
        for (int b = pt * 16; b < pt * 16 + 16; ++b) sacc += HIST[b * NE + e];
        part[pt * NE + e] = sacc; }
    __syncthreads();
    if (F.tid < 64) { const int e = F.lane; int c = 0;
        if (e < NE) {
#pragma unroll
            for (int pt = 0; pt < 16; ++pt) c += part[pt * NE + e]; }
        int tl = (c + 255) >> 8, pre = tl;
#pragma unroll
        for (int o = 1; o < 64; o <<= 1) { const int v = __shfl_up(pre, o); if (F.lane >= o) pre += v; }
        if (e < NE) { F.MISC[MISC_TB + e] = (unsigned)(pre - tl); F.MISC[MISC_CNT + e] = (unsigned)c; }
        if (e == NE - 1) F.MISC[MISC_TB + NE] = (unsigned)pre; }
    __syncthreads();
}

constexpr int PH_PRO = 0, PH_PRE = 1, PH_L0 = 2, NPL = 11, NPHASES = PH_L0 + DEPTH * NPL;
__global__ void __launch_bounds__(NTHREADS, 2) fwd(Args args_unused) {
    extern __shared__ __attribute__((aligned(16))) unsigned char lds_raw[];
    const volatile __attribute__((address_space(4))) Args* ka = (const volatile __attribute__((address_space(4))) Args*)__builtin_amdgcn_kernarg_segment_ptr();
#define INP(i) ((const float*)ka->in[i])
#define WSB() ((unsigned char*)ka->ws)
#define OUTP() ((float*)ka->out)
    Frame F;
    F.lds = (LAS unsigned char*)lds_raw; F.MISC = (volatile LAS unsigned*)(F.lds + LDSCTL_OFF);
    F.wave = __builtin_amdgcn_readfirstlane((int)threadIdx.x >> 6); F.lane = lane_id_v(); F.tid = F.wave * 64 + F.lane;
    F.G = gridDim.x; { const int bx = blockIdx.x; F.vcu = (F.G % 8 == 0) ? (bx % 8) * (F.G / 8) + bx / 8 : bx; }
    F.ctl = (unsigned*)(WSB() + WS_CTL);
    for (int u = F.tid; u < (LDS_BYTES - LDSCTL_OFF) / 4; u += NTHREADS) ((LAS unsigned*)(F.lds + LDSCTL_OFF))[u] = 0u;
    __syncthreads();
    XcdBarrier bar = xcd_barrier_post(F.ctl + CW_BAR, F.MISC + MISC_BAR, F.tid == 0);
    const int lo = ka->ph_lo, hi = ka->ph_hi;
#define IN(k) (lo <= (k) && (k) < hi)
#define SEAM(k) do { if (IN(k) && IN((k) + 1)) xcd_barrier(bar, F.wave == 0 && lane_id_v() == 0); } while (0)
#define PHASE_FRAME() Frame P = F; P.wave = launder_s(F.wave); P.lane = lane_id_v(); P.tid = P.wave * 64 + P.lane
    const int cb = (int)blockIdx.x;

    if (IN(PH_PRO)) REPEAT(0) { __syncthreads(); unsigned char* ws = WSB(); { PHASE_FRAME(); mods_phase(P, INP(1), INP(2), INP(3), (float*)(ws + WS_MOD)); } { PHASE_FRAME(); convert_phase(P, ka); } }
    SEAM(PH_PRO);
    if (IN(PH_PRE)) REPEAT(1) { unsigned char* ws = WSB(); PHASE_FRAME(); rowpass_pre(P, INP(0), INP(4), (const float*)(ws + WS_MOD), (bf16_t*)(ws + WS_H)); }
    SEAM(PH_PRE);

#pragma unroll 1
    for (int l = 0; l < DEPTH; ++l) {
        const int pb = PH_L0 + l * NPL;
        if (IN(pb + 0)) { unsigned char* ws = WSB(); unsigned char* wl = ws + WS_W + (size_t)l * WL_STRIDE; const bf16_t* WIN = (const bf16_t*)(wl + WO_WIN); bf16_t* H = (bf16_t*)(ws + WS_H);
            REPEAT(2) { pg8::Gemm g{H, WIN, D, D, D, nullptr}; pg8::StaticOrder S{T / 256, 13, launder_s(F.G), launder_s(cb), D, D, 0}; pg8::EpiIn E{(bf16_t*)(ws + WS_Q), (bf16_t*)(ws + WS_K), (bf16_t*)(ws + WS_U), (bf16_t*)(ws + WS_G)};
              pg8::gemm_phase<pg8::EpiIn, pg8::StaticOrder, 0>(F.lds, F.wave, g, S, E); }
            REPEAT(3) { pg8::Gemm g{WIN + (size_t)3328 * D, H, D, D, D, nullptr}; pg8::StaticOrder S{1, T / 256, launder_s(F.G), (launder_s(cb) + launder_s(F.G) / 2) % launder_s(F.G), D, D, 0}; pg8::EpiPlain E{(bf16_t*)(ws + WS_VT), T, 0, nullptr, nullptr};
              pg8::gemm_phase<pg8::EpiPlain, pg8::StaticOrder, 1>(F.lds, F.wave, g, S, E); }
        }
        SEAM(pb + 0);
        if (IN(pb + 1)) { unsigned char* ws = WSB();
            REPEAT(4) { PHASE_FRAME(); attn_phase(P, (const bf16_t*)(ws + WS_Q), (const bf16_t*)(ws + WS_K), (const bf16_t*)(ws + WS_VT), (bf16_t*)(ws + WS_AP)); }
            REPEAT(5) { PHASE_FRAME(); poolmix_phase(P, (const bf16_t*)(ws + WS_U), (bf16_t*)(ws + WS_MIX)); } }
        SEAM(pb + 1);
        if (IN(pb + 2)) { unsigned char* ws = WSB(); unsigned char* wl = ws + WS_W + (size_t)l * WL_STRIDE; bf16_t* AP = (bf16_t*)(ws + WS_AP);
            REPEAT(6) { pg8::Gemm g{AP, (const bf16_t*)(wl + WO_BRA), D, SBW, SBW, nullptr}; pg8::StaticOrder S{T / 256, 4, launder_s(F.G), launder_s(cb), D, SBW, 0}; pg8::EpiBranch<false> E{(bf16_t*)(ws + WS_MRG), (const bf16_t*)(ws + WS_G), 0, (bf16_t*)(ws + WS_MRG)};
              pg8::gemm_phase<pg8::EpiBranch<false>, pg8::StaticOrder, 2>(F.lds, F.wave, g, S, E); }
            REPEAT(7) { pg8::Gemm g{(const bf16_t*)(ws + WS_MIX), (const bf16_t*)(wl + WO_POOL), PW, PW, 384, nullptr}; pg8::StaticOrder S{T / 256, 3, launder_s(F.G), launder_s(cb), PW, PW, PGD};
              pg8::EpiPlain E{AP, D, SBW, INP(10) + (size_t)l * PW, INP(11) + (size_t)l * PW};
              pg8::gemm_phase<pg8::EpiPlain, pg8::StaticOrder, 3>(F.lds, F.wave, g, S, E); }
        }
        SEAM(pb + 2);
        if (IN(pb + 3)) for (int _rep = ((REP_MASK >> 15) & 1) ? 0 : 1; _rep < 2; ++_rep) { unsigned char* ws = WSB(); unsigned char* wl = ws + WS_W + (size_t)l * WL_STRIDE;
            pg8::Gemm g{(const bf16_t*)(ws + WS_AP) + SBW, (const bf16_t*)(wl + WO_BRP), D, PW, PW, nullptr}; pg8::StaticOrder S{T / 256, 4, launder_s(F.G), launder_s(cb), D, PW, 0}; pg8::EpiBranch<true> E{(bf16_t*)(ws + WS_MRG), (const bf16_t*)(ws + WS_G), D, (bf16_t*)(ws + (_rep == 0 ? WS_Y : WS_MRG))};
            pg8::gemm_phase<pg8::EpiBranch<true>, pg8::StaticOrder, 4>(F.lds, F.wave, g, S, E); }
        SEAM(pb + 3);
        if (IN(pb + 4)) REPEAT(8) { unsigned char* ws = WSB(); unsigned char* wl = ws + WS_W + (size_t)l * WL_STRIDE;
            pg8::Gemm g{(const bf16_t*)(ws + WS_MRG), (const bf16_t*)(wl + WO_OUT), D, D, D, nullptr}; pg8::StaticOrder S{T / 256, 4, launder_s(F.G), launder_s(cb), D, D, 0}; pg8::EpiPlain E{(bf16_t*)(ws + WS_Y), D, 0, nullptr, nullptr};
            pg8::gemm_phase<pg8::EpiPlain, pg8::StaticOrder, 5>(F.lds, F.wave, g, S, E); }
        SEAM(pb + 4);
        if (IN(pb + 5)) for (int _rep = 0; _rep < ((((REP_MASK >> 9) & 1) && l == 0) ? 2 : 1); ++_rep) { unsigned char* ws = WSB(); PHASE_FRAME();
            rowpass_mid(P, l == 0 ? INP(0) : (const float*)OUTP(), OUTP(), (const bf16_t*)(ws + WS_Y), INP(5) + (size_t)l * D, INP(6) + (size_t)l * D, (const float*)(ws + WS_MOD) + (size_t)l * BATCH * 6 * D, (bf16_t*)(ws + WS_H)); }
        SEAM(pb + 5);
        if (IN(pb + 6)) REPEAT(12) { unsigned char* ws = WSB(); unsigned char* wl = ws + WS_W + (size_t)l * WL_STRIDE; PHASE_FRAME();
            router_phase_a(P, (const bf16_t*)(ws + WS_H), (const bf16_t*)(wl + WO_ROUTER), INP(16) + (size_t)l * NE, (int*)(ws + WS_HIST) + (size_t)l * NBLK * NE, (int*)(ws + WS_TOPE), (int*)(ws + WS_TOPL), (float*)(ws + WS_TOPG)); }
        SEAM(pb + 6);
        if (IN(pb + 7)) REPEAT(13) { unsigned char* ws = WSB(); PHASE_FRAME();
            router_phase_b(P, (const int*)(ws + WS_HIST) + (size_t)l * NBLK * NE, (const int*)(ws + WS_TOPE), (const int*)(ws + WS_TOPL), (const float*)(ws + WS_TOPG), (int*)(ws + WS_TOPS), (int*)(ws + WS_ROWTOK), (float*)(ws + WS_ROWGATE)); }
        SEAM(pb + 7);
        if (IN(pb + 8)) REPEAT(10) { unsigned char* ws = WSB(); unsigned char* wl = ws + WS_W + (size_t)l * WL_STRIDE; { PHASE_FRAME(); moe_table(P, (const int*)(ws + WS_HIST) + (size_t)l * NBLK * NE); }
            pg8::Gemm g{(const bf16_t*)(ws + WS_H), (const bf16_t*)(wl + WO_GU), D, D, D, (const int*)(ws + WS_ROWTOK)};
            pg8::MoeOrder S{(const volatile LAS int*)(F.MISC + MISC_TB), (const volatile LAS int*)(F.MISC + MISC_CNT), 8, launder_s(F.G), launder_s(cb), 2 * D};
            pg8::EpiGU E{(bf16_t*)(ws + WS_ACT), INP(18) + (size_t)l * NE * 2 * D};
            pg8::gemm_phase<pg8::EpiGU, pg8::MoeOrder, 6>(F.lds, F.wave, g, S, E); }
        SEAM(pb + 8);
        if (IN(pb + 9)) REPEAT(11) { unsigned char* ws = WSB(); unsigned char* wl = ws + WS_W + (size_t)l * WL_STRIDE; { PHASE_FRAME(); moe_table(P, (const int*)(ws + WS_HIST) + (size_t)l * NBLK * NE); }
            pg8::Gemm g{(const bf16_t*)(ws + WS_ACT), (const bf16_t*)(wl + WO_DN), D, D, D, nullptr};
            pg8::MoeOrder S{(const volatile LAS int*)(F.MISC + MISC_TB), (const volatile LAS int*)(F.MISC + MISC_CNT), 4, launder_s(F.G), launder_s(cb), D};
            pg8::EpiDN E{(bf16_t*)(ws + WS_YR), INP(20) + (size_t)l * NE * D, (const float*)(ws + WS_ROWGATE), (const int*)(ws + WS_ROWTOK)};
            pg8::gemm_phase<pg8::EpiDN, pg8::MoeOrder, 7>(F.lds, F.wave, g, S, E); }
        SEAM(pb + 9);
        if (IN(pb + 10)) for (int _rep = ((REP_MASK >> 14) & 1) ? 0 : 1; _rep < 2; ++_rep) { unsigned char* ws = WSB(); PHASE_FRAME();
            const bool hn = (l + 1 < DEPTH); const float* MOD = (const float*)(ws + WS_MOD);
            rowpass_comb(P, OUTP(), _rep == 0 ? (float*)(ws + WS_ACT) : OUTP(), (const bf16_t*)(ws + WS_YR), INP(7) + (size_t)l * D, MOD + (size_t)l * BATCH * 6 * D,
                         hn, INP(4) + (size_t)(hn ? l + 1 : l) * D, MOD + (size_t)(hn ? l + 1 : l) * BATCH * 6 * D, (bf16_t*)(ws + WS_H)); }
        SEAM(pb + 10);
    }
#undef IN
#undef SEAM
}

extern "C" void kernel_launch(void* const* d_in, const int* in_sizes, int n_in, void* d_out, int out_size, void* d_ws, size_t ws_size, hipStream_t stream) {
    static int grid = 0;
    if (grid == 0) {
        if (n_in != 21 || in_sizes[0] != T * D || out_size != T * D || ws_size < WS_END) { fprintf(stderr, "kernel_launch: unexpected shapes (n_in %d, in0 %d, out %d, ws %zu < %zu); nothing launched\n", n_in, n_in > 0 ? in_sizes[0] : -1, out_size, ws_size, (size_t)WS_END); grid = -1; return; }
        int dev = 0, cus = 0, per_cu = 0;
        if (hipGetDevice(&dev) != hipSuccess || hipDeviceGetAttribute(&cus, hipDeviceAttributeMultiprocessorCount, dev) != hipSuccess) { grid = -1; return; }
        if (hipFuncSetAttribute((const void*)fwd, hipFuncAttributeMaxDynamicSharedMemorySize, LDS_BYTES) != hipSuccess) { fprintf(stderr, "kernel_launch: hipFuncSetAttribute failed\n"); grid = -1; return; }
        if (hipOccupancyMaxActiveBlocksPerMultiprocessor(&per_cu, (const void*)fwd, NTHREADS, LDS_BYTES) != hipSuccess || per_cu < 1) { fprintf(stderr, "kernel_launch: occupancy query says %d\n", per_cu); }
        (void)hipGetLastError();
        grid = cus;
    }
    if (grid < 0) return;
    if (hipMemsetAsync((char*)d_ws + WS_CTL, 0, CTL_ZERO_BYTES, stream) != hipSuccess) return;
    Args a{};
    for (int i = 0; i < 21; ++i) a.in[i] = (const float*)d_in[i];
    a.out = (float*)d_out; a.ws = (unsigned char*)d_ws;
#if N_LAUNCHES == 1
    a.ph_lo = 0; a.ph_hi = NPHASES;
    hipLaunchKernelGGL(fwd, dim3(grid), dim3(NTHREADS), LDS_BYTES, stream, a);
#else
    for (int p = 0; p < NPHASES; ++p) { a.ph_lo = p; a.ph_hi = p + 1; hipLaunchKernelGGL(fwd, dim3(grid), dim3(NTHREADS), LDS_BYTES, stream, a); }
#endif
}
```

```cpp
#include <hip/hip_runtime.h>
#include <cstdio>
#include <cstdint>

#ifndef N_LAUNCHES
#define N_LAUNCHES 1
#endif
#ifndef REP_MASK
#define REP_MASK 0
#endif
#define REPEAT(b) _Pragma("unroll 1") for (int _rep = 0; _rep < (((REP_MASK >> (b)) & 1) ? 2 : 1); ++_rep)
#ifndef FAST_MASK
#define FAST_MASK 0xff
#endif

#define LAS __attribute__((address_space(3)))
#define GAS __attribute__((address_space(1)))
typedef unsigned short bf16_t;
typedef short bf16x8 __attribute__((ext_vector_type(8)));
typedef short s16x4 __attribute__((ext_vector_type(4)));
typedef float f32x4 __attribute__((ext_vector_type(4)));
typedef float f32x2 __attribute__((ext_vector_type(2)));
typedef float f32x16 __attribute__((ext_vector_type(16)));
typedef unsigned u32x4 __attribute__((ext_vector_type(4)));
typedef unsigned u32x2 __attribute__((ext_vector_type(2)));

constexpr int D = 1024, BATCH = 2, SEQ = 16384, T = BATCH * SEQ, DEPTH = 2;
constexpr int SBW = 256, NH = 4, HD = 64, PW = 768, PGD = 192, INW = 3584;
constexpr int NE = 32, TOPK = 4;
constexpr float NORM_EPS = 1e-6f, SW_LIMIT = 7.0f, SW_ALPHA = 1.702f;
constexpr float STICK_EXIT = -40.0f;
constexpr int NWAVES = 8, NTHREADS = 512;
constexpr int MAXTILES = (T * TOPK) / 256 + NE;

constexpr size_t MiB = 1u << 20;
constexpr size_t WS_CTL = 0, CTL_ZERO_BYTES = 1 * MiB;
constexpr size_t WS_MOD = 1 * MiB;
constexpr size_t WS_W = 2 * MiB, WL_STRIDE = 205 * MiB;
constexpr size_t WO_WIN = 0, WO_BRA = 7 * MiB, WO_BRP = 7 * MiB + MiB / 2, WO_OUT = 9 * MiB, WO_POOL = 11 * MiB, WO_ROUTER = 12 * MiB + MiB / 2, WO_GU = 13 * MiB, WO_DN = 141 * MiB;
constexpr size_t WS_H = 416 * MiB, WS_Q = 480 * MiB, WS_K = 496 * MiB, WS_VT = 512 * MiB, WS_U = 528 * MiB, WS_G = 576 * MiB;
constexpr size_t WS_AP = 704 * MiB, WS_MIX = 768 * MiB, WS_MRG = 816 * MiB, WS_Y = 880 * MiB;
constexpr size_t WS_TOPE = 944 * MiB, WS_TOPS = 944 * MiB + MiB / 2, WS_TOPL = 945 * MiB, WS_TOPG = 945 * MiB + MiB / 2, WS_ROWTOK = 946 * MiB, WS_ROWGATE = 950 * MiB;
constexpr size_t WS_HIST = 954 * MiB;
constexpr size_t WS_ACT = 960 * MiB, WS_YR = 1232 * MiB, WS_H8 = 1504 * MiB, WS_END = 1536 * MiB;
static_assert(WO_DN + (size_t)NE * D * D * 2 <= WL_STRIDE && WS_W + DEPTH * WL_STRIDE <= WS_H, "weights map");
static_assert(WS_ACT + (size_t)MAXTILES * 256 * D * 2 <= WS_YR && WS_YR + (size_t)MAXTILES * 256 * D * 2 <= WS_END, "act map");
constexpr int CW_BAR = 4096, CW_CNT = 8192;

constexpr int RING_BYTES = 131072, LDSCTL_OFF = RING_BYTES, LDS_BYTES = 147456;
constexpr int MISC_BAR = 8;
constexpr int MISC_TB = 64, MISC_CNT = 128;

__device__ __forceinline__ unsigned f2bf(float f) { unsigned u = __builtin_bit_cast(unsigned, f); return (u + 0x7fffu + ((u >> 16) & 1u)) >> 16; }
__device__ __forceinline__ unsigned pk2(float lo, float hi) { return f2bf(lo) | (f2bf(hi) << 16); }
__device__ __forceinline__ float bf_lo(unsigned w) { return __builtin_bit_cast(float, w << 16); }
__device__ __forceinline__ float bf_hi(unsigned w) { return __builtin_bit_cast(float, w & 0xffff0000u); }
__device__ __forceinline__ unsigned pk4_fp8(float a, float b, float c, float d) { int w = 0; w = __builtin_amdgcn_cvt_pk_fp8_f32(a, b, w, false); w = __builtin_amdgcn_cvt_pk_fp8_f32(c, d, w, true); return (unsigned)w; }
constexpr float W8_SCALE = 32.0f, W8_INV = 1.0f / 32.0f;
__device__ __forceinline__ float fast_exp(float x) { return __builtin_amdgcn_exp2f(x * 1.4426950408889634f); }
__device__ __forceinline__ float fast_sigmoid(float x) { return __builtin_amdgcn_rcpf(1.0f + fast_exp(-x)); }
__device__ __forceinline__ float softplus_f(float z) { return fmaxf(z, 0.f) + 0.6931471805599453f * __builtin_amdgcn_logf(1.0f + fast_exp(-fabsf(z))); }
__device__ __forceinline__ float wave_sum(float v) {
#pragma unroll
    for (int o = 1; o < 64; o <<= 1) v += __shfl_xor(v, o);
    return v;
}
__device__ __forceinline__ int launder_v(int x) { asm volatile("" : "+v"(x)); return x; }
__device__ __forceinline__ int launder_s(int x) { asm volatile("" : "+s"(x)); return x; }
__device__ __forceinline__ int lane_id_v() { int x; asm volatile("v_mbcnt_lo_u32_b32 %0, -1, 0\n\tv_mbcnt_hi_u32_b32 %0, -1, %0" : "=v"(x)); return x; }
#define LDS_WAIT() asm volatile("s_waitcnt lgkmcnt(0)" ::: "memory")
#define VM_WAIT() asm volatile("s_waitcnt vmcnt(0)" ::: "memory")

#define XB_TMO      128
#define XB_XCNT(j)  (256  + 64 * (j))
#define XB_XSUB(j)  (1280 + 64 * (j))
#define XB_XGEN(j)  (2304 + 64 * (j))
#define XB_TOP      3328
#define XB_TOPGEN   3392
#define XCD_BAR_WORDS 3456
#define XB_SPIN_CAP (1u << 18)
__device__ __forceinline__ unsigned xb_ld(unsigned* p)              { return __hip_atomic_load(p, __ATOMIC_RELAXED, __HIP_MEMORY_SCOPE_AGENT); }
__device__ __forceinline__ unsigned xb_add(unsigned* p, unsigned v) { return __hip_atomic_fetch_add(p, v, __ATOMIC_RELAXED, __HIP_MEMORY_SCOPE_AGENT); }
__device__ __forceinline__ unsigned xb_xcc_id() { return (unsigned)__builtin_amdgcn_s_getreg((3 << 11) | 20) & 0xFu; }
#define XB_SPIN(cond, bar) do { unsigned _sp = 0; while (cond) { __builtin_amdgcn_s_sleep(1); \
    if ((++_sp & 255u) == 0u) { if (xb_ld(&(bar)[XB_TMO])) break; if (_sp > XB_SPIN_CAP) { atomicAdd(&(bar)[XB_TMO], 1u); break; } } } } while (0)
struct XcdBarrier { unsigned* bar; unsigned x; volatile LAS unsigned* st; };
__device__ __forceinline__ XcdBarrier xcd_barrier_post(unsigned* bar, volatile LAS unsigned* st, bool t0) {
    XcdBarrier b; b.bar = bar; b.x = xb_xcc_id(); b.st = st;
    if (t0) (void)xb_add(&bar[XB_XCNT(b.x)], 1u);
    return b;
}
__device__ __forceinline__ void xcd_barrier_complete(unsigned* bar, unsigned x, unsigned& nloc, unsigned& nx) {
    const unsigned G = gridDim.x * gridDim.y * gridDim.z;
    unsigned sum, cnt, mine, sp = 0u;
    for (;;) {
        sum = 0u; cnt = 0u; mine = 0u;
#pragma unroll
        for (unsigned j = 0; j < 16; ++j) { const unsigned c = xb_ld(&bar[XB_XCNT(j)]); sum += c; cnt += (c > 0u) ? 1u : 0u; mine = (j == x) ? c : mine; }
        if (sum == G) break;
        __builtin_amdgcn_s_sleep(1);
        if ((++sp & 255u) == 0u) { if (xb_ld(&bar[XB_TMO])) break; if (sp > XB_SPIN_CAP) { atomicAdd(&bar[XB_TMO], 1u); break; } }
    }
    nloc = mine > 0u ? mine : 1u; nx = cnt > 0u ? cnt : 1u;
}
__device__ __forceinline__ void xcd_barrier(const XcdBarrier& b, bool t0) {
    asm volatile("s_waitcnt vmcnt(0)" ::: "memory");
    __syncthreads();
    if (t0) {
        unsigned* bar = b.bar;
        __builtin_amdgcn_s_waitcnt(0);
        unsigned nloc = b.st[0], nx = b.st[1];
        if (nloc == 0u) { xcd_barrier_complete(bar, b.x, nloc, nx); b.st[0] = nloc; b.st[1] = nx; }
        const unsigned old = xb_add(&bar[XB_XSUB(b.x)], 1u);
        const unsigned gen = old / nloc;
        if (old + 1u == (gen + 1u) * nloc) {
            __builtin_amdgcn_fence(__ATOMIC_RELEASE, "agent");
            asm volatile("s_waitcnt vmcnt(0)" ::: "memory");
            const unsigned og = xb_add(&bar[XB_TOP], 1u);
            const unsigned tg = og / nx;
            if (og + 1u == (tg + 1u) * nx) xb_add(&bar[XB_TOPGEN], 1u);
            else XB_SPIN(xb_ld(&bar[XB_TOPGEN]) == tg, bar);
            __builtin_amdgcn_fence(__ATOMIC_ACQUIRE, "agent");
            xb_add(&bar[XB_XGEN(b.x)], 1u);
            asm volatile("s_waitcnt vmcnt(0)" ::: "memory");
        } else {
            XB_SPIN(xb_ld(&bar[XB_XGEN(b.x)]) == gen, bar);
            __builtin_amdgcn_fence(__ATOMIC_ACQUIRE, "agent");
            asm volatile("s_waitcnt vmcnt(0)" ::: "memory");
        }
    }
    __syncthreads();
}

namespace pg8 {
constexpr int BM = 256, BK = 64, HALF = 128, HTB = HALF * BK * 2, STAGE_BYTES = 8 * HTB, NXCD = 8, WGM = 8;
__host__ __device__ __forceinline__ int lds_byte(int r, int c) { const int st = (r >> 4) * 2 + (c >> 5), rr = r & 15, cc = c & 31, ob = rr * 64 + cc * 2; return st * 1024 + (ob ^ (((ob >> 9) & 1) << 5)); }
__host__ __device__ __forceinline__ void stage_rc(int b, int& R, int& C) { const int st = b / 1024, sb = b % 1024, swz = sb ^ (((sb >> 9) & 1) << 5); R = (st >> 1) * 16 + swz / 64; C = (st & 1) * 32 + (swz % 64) / 2; }
__host__ __device__ __forceinline__ int perm32(int rho) { const int n = rho >> 4, i = rho & 15; return 8 * (i >> 2) + 4 * n + (i & 3); }

struct Unit { int pm, pn, e, nvalid, slot0; unsigned aoff, boff; };
struct Gemm { const bf16_t* A; const bf16_t* Bt; int lda, ldb, K; const int* gather; };

__device__ __forceinline__ bool order_unit(int i, int G, int c, int nM, int nN, int& pm, int& pn) {
    const int nwg = nM * nN; const long L = (long)i * G + c; if (L >= nwg) return false;
    int wgid = (int)L; { const int q = nwg / NXCD, r = nwg % NXCD, xcd = wgid % NXCD, off = wgid / NXCD; wgid = (xcd < r ? xcd * (q + 1) : r * (q + 1) + (xcd - r) * q) + off; }
    const int nig = WGM * nN, gid = wgid / nig, fm = gid * WGM, gsz = (nM - fm) < WGM ? (nM - fm) : WGM;
    pm = fm + ((wgid % nig) % gsz); pn = (wgid % nig) / gsz; return true;
}
struct StaticOrder {
    int nM, nN, G, c, lda, ldb, kstride;
    __device__ __forceinline__ bool next(int i, Unit& u) const {
        if (!order_unit(i, G, c, nM, nN, u.pm, u.pn)) return false;
        u.e = 0; u.nvalid = 256; u.slot0 = 0;
        u.aoff = (unsigned)(u.pm * BM) * (unsigned)lda + (unsigned)(kstride * u.pn); u.boff = (unsigned)(u.pn * BM) * (unsigned)ldb + (unsigned)(kstride * u.pn); return true;
    }
};
struct MoeOrder {
    const volatile LAS int* tb; const volatile LAS int* cnt; int nN, G, c, nw;
    __device__ __forceinline__ bool next(int i, Unit& u) const {
        const int nM = tb[NE];
        if (!order_unit(i, G, c, nM, nN, u.pm, u.pn)) return false;
        int e = 0;
#pragma unroll 1
        for (int j = 1; j < NE; ++j) e += (tb[j] <= u.pm) ? 1 : 0;
        u.e = e; u.slot0 = (u.pm - tb[e]) * BM; const int left = cnt[e] - u.slot0; u.nvalid = left < BM ? left : BM;
        u.aoff = (unsigned)(u.pm * BM) * (unsigned)D; u.boff = ((unsigned)e * (unsigned)nw + (unsigned)(u.pn * BM)) * (unsigned)D; return true;
    }
};

__device__ __forceinline__ unsigned cvt_pk_bf16(float lo, float hi) { unsigned r; asm volatile("v_cvt_pk_bf16_f32 %0, %1, %2" : "=v"(r) : "v"(lo), "v"(hi)); return r; }
__device__ __forceinline__ u32x4 pack8(const f32x4 a, const f32x4 b) { u32x4 w; w.x = cvt_pk_bf16(a[0], a[1]); w.y = cvt_pk_bf16(a[2], a[3]); w.z = cvt_pk_bf16(b[0], b[1]); w.w = cvt_pk_bf16(b[2], b[3]); return w; }
__device__ __forceinline__ void unpack8(const u32x4 w, f32x4& a, f32x4& b) { a = (f32x4){bf_lo(w.x), bf_hi(w.x), bf_lo(w.y), bf_hi(w.y)}; b = (f32x4){bf_lo(w.z), bf_hi(w.z), bf_lo(w.w), bf_hi(w.w)}; }

#define EPI_LOOP_ROWS for (int ai = 0; ai < 2; ++ai) _Pragma("unroll") for (int m = 0; m < 4; ++m)
struct EpiIn {
    static constexpr bool PERM = true; static constexpr int ES = 2;
    bf16_t *Q, *KB, *U, *G;
    __device__ __forceinline__ void operator()(const f32x4 (&acc)[2][2][4][2], const Unit& u, int wr, int wc, int fr, int fq) const {
        const int pn = u.pn; bf16_t* base; int ld, c0, mode;
        if (pn == 0) { base = Q; ld = SBW; c0 = 0; mode = 1; } else if (pn == 1) { base = KB; ld = SBW; c0 = 0; mode = 0; }
        else if (pn < 5) { base = U; ld = PW; c0 = (pn - 2) * BM; mode = 0; } else { base = G; ld = 2 * D; c0 = (pn - 5) * BM; mode = 2; }
        const int row0 = u.pm * BM + wr * 64 + fr, col0 = c0 + wc * 32 + 8 * fq;
#pragma unroll
        EPI_LOOP_ROWS { bf16_t* rowp = base + (size_t)(row0 + ai * HALF + m * 16) * ld + col0;
#pragma unroll
            for (int bj = 0; bj < 2; ++bj) { f32x4 v0 = acc[ai][bj][m][0], v1 = acc[ai][bj][m][1];
                if (mode == 1) { v0 = v0 * 0.125f; v1 = v1 * 0.125f; }
                if (mode == 2) {
#pragma unroll
                    for (int j = 0; j < 4; ++j) { v0[j] = fast_sigmoid(v0[j]); v1[j] = fast_sigmoid(v1[j]); } }
                *(u32x4*)(rowp + bj * HALF) = pack8(v0, v1); } }
    }
};
struct EpiPlain {
    static constexpr bool PERM = true; static constexpr int ES = 2;
    bf16_t* O; int ldc, coff; const float* bias; const float* scale;
    __device__ __forceinline__ void operator()(const f32x4 (&acc)[2][2][4][2], const Unit& u, int wr, int wc, int fr, int fq) const {
        const int row0 = u.pm * BM + wr * 64 + fr, col0 = u.pn * BM + wc * 32 + 8 * fq;
        f32x4 bv[2][2], sv[2][2];
#pragma unroll
        for (int bj = 0; bj < 2; ++bj)
#pragma unroll
            for (int n = 0; n < 2; ++n) { bv[bj][n] = bias ? *(const f32x4*)(bias + col0 + bj * HALF + 4 * n) : (f32x4){0.f, 0.f, 0.f, 0.f};
                                          sv[bj][n] = scale ? *(const f32x4*)(scale + col0 + bj * HALF + 4 * n) : (f32x4){1.f, 1.f, 1.f, 1.f}; }
#pragma unroll
        EPI_LOOP_ROWS { bf16_t* rowp = O + (size_t)(row0 + ai * HALF + m * 16) * ldc + coff + col0;
#pragma unroll
            for (int bj = 0; bj < 2; ++bj) *(u32x4*)(rowp + bj * HALF) = pack8((acc[ai][bj][m][0] + bv[bj][0]) * sv[bj][0], (acc[ai][bj][m][1] + bv[bj][1]) * sv[bj][1]); }
    }
};
template <bool ADD> struct EpiBranch {
    static constexpr bool PERM = true; static constexpr int ES = 2;
    bf16_t* MRG; const bf16_t* G; int goff; bf16_t* MRGout;
    __device__ __forceinline__ void operator()(const f32x4 (&acc)[2][2][4][2], const Unit& u, int wr, int wc, int fr, int fq) const {
        const int row0 = u.pm * BM + wr * 64 + fr, col0 = u.pn * BM + wc * 32 + 8 * fq;
#pragma unroll
        EPI_LOOP_ROWS { const size_t r = (size_t)(row0 + ai * HALF + m * 16);
#pragma unroll
            for (int bj = 0; bj < 2; ++bj) { const int c = col0 + bj * HALF;
                f32x4 g0, g1; unpack8(*(const u32x4*)(G + r * (2 * D) + goff + c), g0, g1);
                f32x4 v0 = g0 * acc[ai][bj][m][0], v1 = g1 * acc[ai][bj][m][1];
                if (ADD) { f32x4 p0, p1; unpack8(*(const u32x4*)(MRG + r * D + c), p0, p1); v0 = v0 + p0; v1 = v1 + p1; }
                *(u32x4*)(MRGout + r * D + c) = pack8(v0, v1); } }
    }
};
struct EpiGU {
    static constexpr bool PERM = true; static constexpr int ES = 1;
    unsigned char* ACT8; const float* bgu;
    __device__ __forceinline__ void operator()(const f32x4 (&acc)[2][2][4][2], const Unit& u, int wr, int wc, int fr, int fq) const {
        const int row0 = u.pm * BM + wr * 64 + fr, col0 = u.pn * HALF + wc * 32 + 8 * fq;
        const float* bg = bgu + (size_t)u.e * (2 * D) + col0;
        f32x4 bgv[2], buv[2];
#pragma unroll
        for (int n = 0; n < 2; ++n) { bgv[n] = *(const f32x4*)(bg + 4 * n); buv[n] = *(const f32x4*)(bg + D + 4 * n); }
#pragma unroll
        EPI_LOOP_ROWS { f32x4 o[2];
#pragma unroll
            for (int n = 0; n < 2; ++n) { f32x4 gt = acc[ai][0][m][n] * W8_INV + bgv[n], up = acc[ai][1][m][n] * W8_INV + buv[n];
#pragma unroll
                for (int j = 0; j < 4; ++j) { const float g = fminf(gt[j], SW_LIMIT), uu = fminf(fmaxf(up[j], -SW_LIMIT), SW_LIMIT); o[n][j] = (uu + 1.0f) * g * fast_sigmoid(SW_ALPHA * g); } }
            u32x2 w; w.x = pk4_fp8(o[0][0], o[0][1], o[0][2], o[0][3]); w.y = pk4_fp8(o[1][0], o[1][1], o[1][2], o[1][3]);
            *(u32x2*)(ACT8 + (size_t)(row0 + ai * HALF + m * 16) * D + col0) = w; }
    }
};
struct EpiDN {
    static constexpr bool PERM = true; static constexpr int ES = 1;
    bf16_t* YR4; const float* bdn; const float* rowgate; const int* rowtk;
    __device__ __forceinline__ void operator()(const f32x4 (&acc)[2][2][4][2], const Unit& u, int wr, int wc, int fr, int fq) const {
        const int rl0 = wr * 64 + fr, col0 = u.pn * BM + wc * 32 + 8 * fq;
        const float* bp = bdn + (size_t)u.e * D + col0; const float* gp = rowgate + (size_t)u.e * T + u.slot0; const int* tp = rowtk + (size_t)u.e * T + u.slot0;
        f32x4 bv[2][2];
#pragma unroll
        for (int bj = 0; bj < 2; ++bj)
#pragma unroll
            for (int n = 0; n < 2; ++n) bv[bj][n] = *(const f32x4*)(bp + bj * HALF + 4 * n);
#pragma unroll
        EPI_LOOP_ROWS { const int rl = rl0 + ai * HALF + m * 16;
            if (rl < u.nvalid) { const float gt = gp[rl]; bf16_t* rowp = YR4 + (size_t)tp[rl] * D + col0;
#pragma unroll
                for (int bj = 0; bj < 2; ++bj) *(u32x4*)(rowp + bj * HALF) = pack8((acc[ai][bj][m][0] * W8_INV + bv[bj][0]) * gt, (acc[ai][bj][m][1] * W8_INV + bv[bj][1]) * gt); } }
    }
};

template <class Epi, class Sched>
__device__ __forceinline__ void gemm_simple(int wave, const Gemm g, const Sched& S, const Epi& E) {
    const int wid = launder_s(wave), lane = lane_id_v(), wr = wid >> 2, wc = wid & 3, fr = lane & 15, fq = lane >> 4;
    Unit u;
    for (int ui = 0; S.next(ui, u); ++ui) {
        f32x4 acc[2][2][4][2];
#pragma unroll
        for (int a = 0; a < 2; ++a)
#pragma unroll
            for (int b = 0; b < 2; ++b)
#pragma unroll
                for (int m = 0; m < 4; ++m)
#pragma unroll
                    for (int n = 0; n < 2; ++n) acc[a][b][m][n] = (f32x4){0.f, 0.f, 0.f, 0.f};
        unsigned ao[2][4], bo[2][2];
#pragma unroll
        for (int ai = 0; ai < 2; ++ai)
#pragma unroll
            for (int m = 0; m < 4; ++m) { const int rl = ai * HALF + wr * 64 + m * 16 + fr;
                if (g.gather) { const int tok = g.gather[(size_t)u.e * T + u.slot0 + (rl < u.nvalid ? rl : u.nvalid - 1)] >> 2; ao[ai][m] = (unsigned)tok * (unsigned)g.lda + fq * 8; }
                else ao[ai][m] = u.aoff + (unsigned)rl * (unsigned)g.lda + fq * 8; }
#pragma unroll
        for (int bj = 0; bj < 2; ++bj)
#pragma unroll
            for (int n = 0; n < 2; ++n) { const int slot = 16 * n + fr, brow = bj * HALF + wc * 32 + (Epi::PERM ? perm32(slot) : slot); bo[bj][n] = u.boff + (unsigned)brow * (unsigned)g.ldb + fq * 8; }
#pragma unroll 1
        for (int k = 0; k < g.K; k += 32) {
            bf16x8 b[2][2];
#pragma unroll
            for (int bj = 0; bj < 2; ++bj)
#pragma unroll
                for (int n = 0; n < 2; ++n) b[bj][n] = *(const bf16x8*)(g.Bt + (size_t)bo[bj][n] + k);
#pragma unroll
            for (int ai = 0; ai < 2; ++ai) {
                bf16x8 a[4];
#pragma unroll
                for (int m = 0; m < 4; ++m) a[m] = *(const bf16x8*)(g.A + (size_t)ao[ai][m] + k);
#pragma unroll
                for (int bj = 0; bj < 2; ++bj)
#pragma unroll
                    for (int m = 0; m < 4; ++m)
#pragma unroll
                        for (int n = 0; n < 2; ++n) acc[ai][bj][m][n] = __builtin_amdgcn_mfma_f32_16x16x32_bf16(b[bj][n], a[m], acc[ai][bj][m][n], 0, 0, 0);
            }
        }
        E(acc, u, wr, wc, fr, fq);
    }
}

typedef int v8i32 __attribute__((ext_vector_type(8)));
typedef int v4i32 __attribute__((ext_vector_type(4)));
template <int ES> struct Frag;
template <> struct Frag<2> { bf16x8 k[2]; };
template <> struct Frag<1> { v8i32 v; };
__device__ __forceinline__ void ld_frag(Frag<2>& f, const LAS unsigned char* p) { f.k[0] = *(const LAS bf16x8*)p; f.k[1] = *(const LAS bf16x8*)(p + 1024); }
__device__ __forceinline__ void ld_frag(Frag<1>& f, const LAS unsigned char* p) { const v4i32 lo = *(const LAS v4i32*)p, hi = *(const LAS v4i32*)(p + 1024); f.v = __builtin_shufflevector(lo, hi, 0, 1, 2, 3, 4, 5, 6, 7); }
__device__ __forceinline__ f32x4 mma_frag(const Frag<2>& b, const Frag<2>& a, f32x4 c) { c = __builtin_amdgcn_mfma_f32_16x16x32_bf16(b.k[0], a.k[0], c, 0, 0, 0); return __builtin_amdgcn_mfma_f32_16x16x32_bf16(b.k[1], a.k[1], c, 0, 0, 0); }
#ifndef FP8_ASM
#define FP8_ASM 1
#endif
#if FP8_ASM
__device__ __forceinline__ f32x4 mma_frag(const Frag<1>& b, const Frag<1>& a, f32x4 c) { asm volatile("v_mfma_f32_16x16x128_f8f6f4 %0, %1, %2, %0" : "+v"(c) : "v"(b.v), "v"(a.v)); return c; }
#else
__device__ __forceinline__ f32x4 mma_frag(const Frag<1>& b, const Frag<1>& a, f32x4 c) { return __builtin_amdgcn_mfma_scale_f32_16x16x128_f8f6f4(b.v, a.v, c, 0, 0, 0, 0, 0, 0); }
#endif
template <class Epi, class Sched, int ES  >
__device__ __forceinline__ void gemm_fast(LAS unsigned char* lds, int wave, const Gemm g, const Sched& S, const Epi& E) {
    const int wid = launder_s(wave), lane = lane_id_v(), tid = wid * 64 + lane, wr = wid >> 2, wc = wid & 3, fr = lane & 15, fq = lane >> 4;
    const int K = launder_s(g.K), nt = K * ES / (BK * 2);
    unsigned voffB[2];
#pragma unroll
    for (int i = 0; i < 2; ++i) { int R, C; stage_rc(tid * 16 + i * 8192, R, C); const int Rb = Epi::PERM ? ((R & ~31) + perm32(R & 31)) : R; voffB[i] = (unsigned)Rb * (unsigned)g.ldb * (unsigned)ES + (unsigned)C * 2u; }
    const size_t kstep = (size_t)(BK * 2);
    const size_t hstepB = (size_t)HALF * g.ldb * ES;
    const unsigned ldsw = (unsigned)wid * 1024u;
    const int aoff = lds_byte(wr * 64 + fr, fq * 8), boff = lds_byte(wc * 32 + fr, fq * 8);
    const char* const Abase = (const char*)g.A; const char* const Bbase = (const char*)g.Bt;
#define PG8_SA(b, h) (((b) * 2 + (h)) * HTB)
#define PG8_SB(b, h) ((4 + (b) * 2 + (h)) * HTB)
#define PG8_STAGE_A(bufoff, ao, kb) do { _Pragma("unroll") for (int _i = 0; _i < 2; ++_i) \
        __builtin_amdgcn_global_load_lds((const unsigned*)(Abase + (size_t)(ao)[_i] + (size_t)(kb)), (LAS unsigned*)(lds + (bufoff) + ldsw + _i * 8192), 16, 0, 0); } while (0)
#define PG8_STAGE_B(bufoff, gbase) do { _Pragma("unroll") for (int _i = 0; _i < 2; ++_i) \
        __builtin_amdgcn_global_load_lds((const unsigned*)((const char*)(gbase) + voffB[_i]), (LAS unsigned*)(lds + (bufoff) + ldsw + _i * 8192), 16, 0, 0); } while (0)
#define PG8_LDA(dst, b, h) do { _Pragma("unroll") for (int m = 0; m < 4; ++m) ld_frag(dst[m], lds + PG8_SA(b, h) + aoff + m * 2048); } while (0)
#define PG8_LDB(dst, b, h) do { _Pragma("unroll") for (int n = 0; n < 2; ++n) ld_frag(dst[n], lds + PG8_SB(b, h) + boff + n * 2048); } while (0)
#define PG8_MMA(ai, bj, At, Bt) do { __builtin_amdgcn_s_setprio(1); _Pragma("unroll") for (int m = 0; m < 4; ++m) _Pragma("unroll") for (int n = 0; n < 2; ++n) acc[ai][bj][m][n] = mma_frag(Bt[n], At[m], acc[ai][bj][m][n]); \
        __builtin_amdgcn_s_setprio(0); } while (0)
#define PG8_WAIT_V(n) asm volatile("s_waitcnt vmcnt(" #n ")" ::: "memory")
#define PG8_WAIT_L(n) asm volatile("s_waitcnt lgkmcnt(" #n ")" ::: "memory")
#define PG8_BAR __builtin_amdgcn_s_barrier()
#define PG8_SCHED __builtin_amdgcn_sched_barrier(0)
#define PG8_AOFFS(u, ao) do { if (g.gather) { const int* _gp = g.gather + (size_t)(u).e * T + (u).slot0; const int _nv1 = (u).nvalid - 1; int _tk[2][2]; \
            _Pragma("unroll") for (int _h = 0; _h < 2; ++_h) _Pragma("unroll") for (int _i = 0; _i < 2; ++_i) { int _R, _C; stage_rc(tid * 16 + _i * 8192, _R, _C); const int _rl = _h * HALF + _R; _tk[_h][_i] = _gp[_rl < _nv1 ? _rl : _nv1]; } \
            _Pragma("unroll") for (int _h = 0; _h < 2; ++_h) _Pragma("unroll") for (int _i = 0; _i < 2; ++_i) { int _R, _C; stage_rc(tid * 16 + _i * 8192, _R, _C); ao[_h][_i] = (unsigned)(_tk[_h][_i] >> 2) * (unsigned)g.lda * (unsigned)ES + (unsigned)_C * 2u; } } \
        else { _Pragma("unroll") for (int _h = 0; _h < 2; ++_h) _Pragma("unroll") for (int _i = 0; _i < 2; ++_i) { int _R, _C; stage_rc(tid * 16 + _i * 8192, _R, _C); ao[_h][_i] = ((u).aoff + (unsigned)(_h * HALF + _R) * (unsigned)g.lda) * (unsigned)ES + (unsigned)_C * 2u; } } } while (0)
    Unit cur, nxt; int ui = 0;
    if (!S.next(0, cur)) return;
    f32x4 acc[2][2][4][2];
#pragma unroll
    for (int a = 0; a < 2; ++a)
#pragma unroll
        for (int b = 0; b < 2; ++b)
#pragma unroll
            for (int m = 0; m < 4; ++m)
#pragma unroll
                for (int n = 0; n < 2; ++n) acc[a][b][m][n] = (f32x4){0.f, 0.f, 0.f, 0.f};
    Frag<ES> At[4], B0[2], B1[2];
    unsigned aC[2][2], aN[2][2];
    PG8_AOFFS(cur, aC);
    const char* cB = Bbase + (size_t)cur.boff * ES;
    PG8_STAGE_B(PG8_SB(0, 0), cB); PG8_STAGE_B(PG8_SB(0, 1), cB + hstepB); PG8_STAGE_A(PG8_SA(0, 0), aC[0], 0); PG8_STAGE_A(PG8_SA(0, 1), aC[1], 0);
    if (wr == 1) PG8_BAR;
    PG8_WAIT_V(2); PG8_BAR;
    PG8_STAGE_B(PG8_SB(1, 0), cB + kstep); PG8_STAGE_A(PG8_SA(1, 0), aC[0], kstep); PG8_STAGE_B(PG8_SB(1, 1), cB + hstepB + kstep);
    PG8_WAIT_V(6); PG8_BAR;
    for (;;) {
        const bool has_next = S.next(ui + 1, nxt);
        if (has_next) { PG8_AOFFS(nxt, aN); } else {
#pragma unroll
            for (int h = 0; h < 2; ++h)
#pragma unroll
                for (int i = 0; i < 2; ++i) aN[h][i] = aC[h][i]; }
        const char* nB = has_next ? Bbase + (size_t)nxt.boff * ES : cB;
#pragma unroll 1
        for (int t = 0; t < nt; t += 2) {
            const bool last = (t == nt - 2);
            const size_t k1 = (size_t)(t + 1) * kstep, k2 = last ? 0 : (size_t)(t + 2) * kstep, k3 = k2 + kstep;
            unsigned a2[2][2];
#pragma unroll
            for (int h = 0; h < 2; ++h)
#pragma unroll
                for (int i = 0; i < 2; ++i) a2[h][i] = last ? aN[h][i] : aC[h][i];
            const char* b2 = last ? nB : cB + (size_t)(t + 2) * kstep; const char* b3 = b2 + kstep;
            PG8_LDB(B0, 0, 0); PG8_LDB(B1, 0, 1); PG8_SCHED; PG8_LDA(At, 0, 0); PG8_STAGE_A(PG8_SA(1, 1), aC[1], k1);
            PG8_WAIT_V(8); PG8_WAIT_L(0); PG8_BAR; PG8_MMA(0, 0, At, B0); PG8_MMA(0, 1, At, B1); PG8_BAR; PG8_SCHED;
            PG8_LDA(At, 0, 1); PG8_STAGE_B(PG8_SB(0, 0), b2); PG8_STAGE_B(PG8_SB(0, 1), b2 + hstepB); PG8_STAGE_A(PG8_SA(0, 0), a2[0], k2);
            PG8_WAIT_V(8); PG8_WAIT_L(0); PG8_BAR; PG8_MMA(1, 0, At, B0); PG8_MMA(1, 1, At, B1); PG8_BAR; PG8_SCHED;
            PG8_LDB(B0, 1, 0); PG8_LDB(B1, 1, 1); PG8_SCHED; PG8_LDA(At, 1, 0); PG8_STAGE_A(PG8_SA(0, 1), a2[1], k2);
            PG8_WAIT_V(8); PG8_WAIT_L(0); PG8_BAR; PG8_MMA(0, 0, At, B0); PG8_MMA(0, 1, At, B1); PG8_BAR; PG8_SCHED;
            PG8_LDA(At, 1, 1); PG8_STAGE_B(PG8_SB(1, 0), b3); PG8_STAGE_B(PG8_SB(1, 1), b3 + hstepB); PG8_STAGE_A(PG8_SA(1, 0), a2[0], k3);
            PG8_WAIT_V(8); PG8_WAIT_L(0); PG8_BAR; PG8_MMA(1, 0, At, B0); PG8_MMA(1, 1, At, B1); PG8_BAR; PG8_SCHED;
        }
        if constexpr (ES == 1 && FP8_ASM) asm volatile("s_nop 15\n\ts_nop 15\n\ts_nop 15" ::: "memory");
        if (wr == 0) PG8_BAR;
        E(acc, cur, wr, wc, fr, fq);
        if (!has_next) break;
#pragma unroll
        for (int a = 0; a < 2; ++a)
#pragma unroll
            for (int b = 0; b < 2; ++b)
#pragma unroll
                for (int m = 0; m < 4; ++m)
#pragma unroll
                    for (int n = 0; n < 2; ++n) acc[a][b][m][n] = (f32x4){0.f, 0.f, 0.f, 0.f};
        cur = nxt; cB = nB; ++ui;
#pragma unroll
        for (int h = 0; h < 2; ++h)
#pragma unroll
            for (int i = 0; i < 2; ++i) aC[h][i] = aN[h][i];
        if (wr == 1) PG8_BAR;
    }
    PG8_WAIT_V(0);
    PG8_BAR;
#undef PG8_SA
#undef PG8_SB
#undef PG8_STAGE_A
#undef PG8_STAGE_B
#undef PG8_LDA
#undef PG8_LDB
#undef PG8_MMA
#undef PG8_WAIT_V
#undef PG8_WAIT_L
#undef PG8_BAR
#undef PG8_SCHED
#undef PG8_AOFFS
}

template <class Epi, class Sched, int SITE>
__device__ __forceinline__ void gemm_phase(LAS unsigned char* lds, int wave, const Gemm g, const Sched& S, const Epi& E) {
    if constexpr (Epi::ES == 1) gemm_fast<Epi, Sched, 1>(lds, wave, g, S, E);
    else if constexpr ((FAST_MASK >> SITE) & 1) gemm_fast<Epi, Sched, 2>(lds, wave, g, S, E); else gemm_simple<Epi, Sched>(wave, g, S, E);
}
}

struct Frame {
    LAS unsigned char* lds;
    volatile LAS unsigned* MISC;
    unsigned* ctl;
    int tid, lane, wave, vcu, G;
};
struct Args { const float* in[21]; float* out; unsigned char* ws; int ph_lo, ph_hi; };
static_assert(sizeof(Args) == 21 * 8 + 8 + 8 + 8, "Args has no padding");

__device__ __forceinline__ void mods_phase(Frame& F, const float* c, const float* ada_w, const float* ada_b, float* MOD) {
    LAS float* cact = (LAS float*)F.lds;
    LAS float* part = (LAS float*)(F.lds + 8192);
    for (int i = F.tid; i < BATCH * D; i += NTHREADS) { const float v = c[i]; cact[i] = v * fast_sigmoid(v); }
    __syncthreads();
    constexpr int NTASK = DEPTH * (6 * D / 64);
    for (int task = F.vcu; task < NTASK; task += F.G) {
        const int l = task / (6 * D / 64), j0 = (task % (6 * D / 64)) * 64;
        const float* w = ada_w + (size_t)l * D * (6 * D) + j0 + F.lane;
        const int k0 = F.wave * 128;
        float a0 = 0.f, a1 = 0.f;
#pragma unroll 16
        for (int k = 0; k < 128; ++k) { const float wv = w[(size_t)(k0 + k) * (6 * D)]; a0 += cact[k0 + k] * wv; a1 += cact[D + k0 + k] * wv; }
        part[(F.wave * 2 + 0) * 64 + F.lane] = a0; part[(F.wave * 2 + 1) * 64 + F.lane] = a1;
        __syncthreads();
        if (F.tid < 128) { const int b = F.tid >> 6, j = F.tid & 63; float s = 0.f;
#pragma unroll
            for (int w8 = 0; w8 < 8; ++w8) s += part[(w8 * 2 + b) * 64 + j];
            MOD[((size_t)l * BATCH + b) * (6 * D) + j0 + j] = s + ada_b[(size_t)l * (6 * D) + j0 + j]; }
        __syncthreads();
    }
}
__device__ __forceinline__ void tr_item(const float* W, int ldw, bf16_t* WT, int ldt, int k0, int n0, int drow0, int dcol0, LAS float* scr, int lane) {
#pragma unroll 8
    for (int i = 0; i < 32; ++i) { const int kk = 2 * i + (lane >> 5); scr[kk * 33 + (lane & 31)] = W[(size_t)(k0 + kk) * ldw + n0 + (lane & 31)]; }
    LDS_WAIT(); asm volatile("" ::: "memory");
    const int c = lane & 7;
#pragma unroll
    for (int j = 0; j < 4; ++j) { const int n = (lane >> 3) + 8 * j; const LAS float* s = scr + (8 * c) * 33 + n;
        u32x4 o; o.x = pk2(s[0 * 33], s[1 * 33]); o.y = pk2(s[2 * 33], s[3 * 33]); o.z = pk2(s[4 * 33], s[5 * 33]); o.w = pk2(s[6 * 33], s[7 * 33]);
        *(u32x4*)(WT + (size_t)(drow0 + n) * ldt + dcol0 + k0 + 8 * c) = o; }
    LDS_WAIT(); asm volatile("" ::: "memory");
}
__device__ __forceinline__ void tr_item8(const float* W, int ldw, unsigned char* WT, int ldt, int k0, int n0, int drow0, float scale, LAS float* scr, int lane) {
#pragma unroll 8
    for (int i = 0; i < 32; ++i) { const int kk = 2 * i + (lane >> 5); scr[kk * 33 + (lane & 31)] = W[(size_t)(k0 + kk) * ldw + n0 + (lane & 31)]; }
    LDS_WAIT(); asm volatile("" ::: "memory");
    const int c = lane & 3;
#pragma unroll
    for (int j = 0; j < 2; ++j) { const int n = (lane >> 2) + 16 * j; const LAS float* sp = scr + (16 * c) * 33 + n;
        u32x4 o; o.x = pk4_fp8(sp[0 * 33] * scale, sp[1 * 33] * scale, sp[2 * 33] * scale, sp[3 * 33] * scale); o.y = pk4_fp8(sp[4 * 33] * scale, sp[5 * 33] * scale, sp[6 * 33] * scale, sp[7 * 33] * scale);
        o.z = pk4_fp8(sp[8 * 33] * scale, sp[9 * 33] * scale, sp[10 * 33] * scale, sp[11 * 33] * scale); o.w = pk4_fp8(sp[12 * 33] * scale, sp[13 * 33] * scale, sp[14 * 33] * scale, sp[15 * 33] * scale);
        *(u32x4*)(WT + (size_t)(drow0 + n) * ldt + k0 + 16 * c) = o; }
    LDS_WAIT(); asm volatile("" ::: "memory");
}
__device__ __forceinline__ int win_drow(int n0) {
    if (n0 < 512) return n0; if (n0 < 768) return 3328 + (n0 - 512); if (n0 < 1536) return 512 + (n0 - 768); return 1280 + (n0 - 1536);
}
typedef const volatile __attribute__((address_space(4))) Args* KArgs;
__device__ __forceinline__ void convert_phase(Frame& F, KArgs ka) {
    unsigned char* wsb = (unsigned char*)ka->ws; const float *in8 = (const float*)ka->in[8], *in9 = (const float*)ka->in[9], *in12 = (const float*)ka->in[12], *in13 = (const float*)ka->in[13], *in14 = (const float*)ka->in[14], *in15 = (const float*)ka->in[15], *in17 = (const float*)ka->in[17], *in19 = (const float*)ka->in[19];
    LAS float* scr = (LAS float*)(F.lds + F.wave * 16384);
    const int gw = F.vcu * NWAVES + F.wave, NGW = F.G * NWAVES;
    constexpr int I_IN = 16 * 112, I_BRA = 4 * 32, I_BRP = 12 * 32, I_OUT = 16 * 32, I_RT = 16, I_PL = 4 * 3 * 6, I_GU = NE * 16 * 64, I_DN = NE * 16 * 32;
    constexpr int I_LAYER = I_IN + I_BRA + I_BRP + I_OUT + I_RT + I_PL + I_GU + I_DN;
    for (int it = gw; it < DEPTH * I_LAYER; it += NGW) {
        const int l = it / I_LAYER; int r = it % I_LAYER;
        unsigned char* wl = wsb + WS_W + (size_t)l * WL_STRIDE;
        if (r < I_GU) { const int e = r / (16 * 64), q = r % (16 * 64), kb = q / 64, nb = q % 64, n0 = nb * 32, half = n0 / D, cc = n0 % D;
            tr_item8(in17 + ((size_t)l * NE + e) * D * (2 * D), 2 * D, (unsigned char*)(wl + WO_GU) + (size_t)e * (2 * D) * D, D, kb * 64, n0, (cc / 128) * 256 + half * 128 + (cc % 128), W8_SCALE, scr, F.lane); continue; } r -= I_GU;
        if (r < I_DN) { const int e = r / (16 * 32), q = r % (16 * 32), kb = q / 32, nb = q % 32;
            tr_item8(in19 + ((size_t)l * NE + e) * D * D, D, (unsigned char*)(wl + WO_DN) + (size_t)e * D * D, D, kb * 64, nb * 32, nb * 32, W8_SCALE, scr, F.lane); continue; } r -= I_DN;
        if (r < I_IN) { const int kb = r / 112, nb = r % 112;
            tr_item(in8 + (size_t)l * D * INW, INW, (bf16_t*)(wl + WO_WIN), D, kb * 64, nb * 32, win_drow(nb * 32), 0, scr, F.lane); continue; } r -= I_IN;
        if (r < I_BRA) { const int kb = r / 32, nb = r % 32;
            tr_item(in12 + (size_t)l * SBW * D, D, (bf16_t*)(wl + WO_BRA), SBW, kb * 64, nb * 32, nb * 32, 0, scr, F.lane); continue; } r -= I_BRA;
        if (r < I_BRP) { const int kb = r / 32, nb = r % 32;
            tr_item(in13 + (size_t)l * PW * D, D, (bf16_t*)(wl + WO_BRP), PW, kb * 64, nb * 32, nb * 32, 0, scr, F.lane); continue; } r -= I_BRP;
        if (r < I_OUT) { const int kb = r / 32, nb = r % 32;
            tr_item(in14 + (size_t)l * D * D, D, (bf16_t*)(wl + WO_OUT), D, kb * 64, nb * 32, nb * 32, 0, scr, F.lane); continue; } r -= I_OUT;
        if (r < I_RT) { tr_item(in15 + (size_t)l * D * NE, NE, (bf16_t*)(wl + WO_ROUTER), D, r * 64, 0, 0, 0, scr, F.lane); continue; } r -= I_RT;
        { const int gidx = r / 18, q = r % 18, kb = q / 6, nb = q % 6;
            tr_item(in9 + ((size_t)l * 4 + gidx) * PGD * PGD, PGD, (bf16_t*)(wl + WO_POOL), PW, kb * 64, nb * 32, gidx * PGD + nb * 32, gidx * PGD, scr, F.lane); }
    }
    for (int it = gw; it < DEPTH * PW; it += NGW) { const int l = it / PW, n = it % PW, gidx = n / PGD;
        bf16_t* rowp = (bf16_t*)(wsb + WS_W + (size_t)l * WL_STRIDE + WO_POOL) + (size_t)n * PW;
        for (int ch = F.lane; ch < PW / 8; ch += 64) if (ch / (PGD / 8) != gidx) *(u32x4*)(rowp + ch * 8) = (u32x4){0u, 0u, 0u, 0u}; }
}

struct Row16 { f32x4 a[4]; };
__device__ __forceinline__ void ld_row_f32(const float* p, int lane, Row16& v) {
#pragma unroll
    for (int j = 0; j < 2; ++j) { v.a[2 * j] = *(const f32x4*)(p + 8 * lane + 512 * j); v.a[2 * j + 1] = *(const f32x4*)(p + 8 * lane + 512 * j + 4); } }
__device__ __forceinline__ void st_row_f32(float* p, int lane, const Row16& v) {
#pragma unroll
    for (int j = 0; j < 2; ++j) { *(f32x4*)(p + 8 * lane + 512 * j) = v.a[2 * j]; *(f32x4*)(p + 8 * lane + 512 * j + 4) = v.a[2 * j + 1]; } }
__device__ __forceinline__ void ld_row_bf16(const bf16_t* p, int lane, u32x4 (&w)[2]) {
#pragma unroll
    for (int j = 0; j < 2; ++j) w[j] = *(const u32x4*)(p + 8 * lane + 512 * j); }
__device__ __forceinline__ void acc_row_bf16(const u32x4 (&w)[2], Row16& y) {
#pragma unroll
    for (int j = 0; j < 2; ++j) { f32x4 lo, hi; pg8::unpack8(w[j], lo, hi); y.a[2 * j] = y.a[2 * j] + lo; y.a[2 * j + 1] = y.a[2 * j + 1] + hi; } }
__device__ __forceinline__ float row_sumsq(const Row16& v) { float ss = 0.f;
#pragma unroll
    for (int q = 0; q < 4; ++q) ss += (v.a[q].x * v.a[q].x + v.a[q].y * v.a[q].y) + (v.a[q].z * v.a[q].z + v.a[q].w * v.a[q].w);
    return ss; }
__device__ __forceinline__ void norm_mod_store(const Row16& v, float ss_wave, const Row16& gg, const Row16& s1, const Row16& s0, bf16_t* hrow, int lane, unsigned char* h8row = nullptr) {
    const float r = 1.0f / sqrtf(ss_wave * (1.0f / D) + NORM_EPS);
#pragma unroll
    for (int j = 0; j < 2; ++j) { const f32x4 o0 = v.a[2 * j] * r * gg.a[2 * j] * (s1.a[2 * j] + 1.0f) + s0.a[2 * j], o1 = v.a[2 * j + 1] * r * gg.a[2 * j + 1] * (s1.a[2 * j + 1] + 1.0f) + s0.a[2 * j + 1];
        u32x4 w; w.x = pk2(o0.x, o0.y); w.y = pk2(o0.z, o0.w); w.z = pk2(o1.x, o1.y); w.w = pk2(o1.z, o1.w); *(u32x4*)(hrow + 8 * lane + 512 * j) = w;
        if (h8row) { u32x2 q; q.x = pk4_fp8(o0.x, o0.y, o0.z, o0.w); q.y = pk4_fp8(o1.x, o1.y, o1.z, o1.w); *(u32x2*)(h8row + 8 * lane + 512 * j) = q; } }
}
constexpr int RP = 2;
__device__ __forceinline__ void rowpass_pre(Frame& F, const float* x, const float* g, const float* MODl, bf16_t* H) {
    const int gw = F.vcu * NWAVES + F.wave, NGW = F.G * NWAVES;
    Row16 gg; ld_row_f32(g, F.lane, gg);
    for (int row0 = gw * RP; row0 < T; row0 += NGW * RP) { const int b = row0 / SEQ; const float* mod = MODl + (size_t)b * 6 * D;
        Row16 v[RP], s1, s0; float ss[RP];
#pragma unroll
        for (int q = 0; q < RP; ++q) ld_row_f32(x + (size_t)(row0 + q) * D, F.lane, v[q]);
        ld_row_f32(mod + 1 * D, F.lane, s1); ld_row_f32(mod + 0 * D, F.lane, s0);
#pragma unroll
        for (int q = 0; q < RP; ++q) ss[q] = row_sumsq(v[q]);
#pragma unroll
        for (int o = 1; o < 64; o <<= 1) {
#pragma unroll
            for (int q = 0; q < RP; ++q) ss[q] += __shfl_xor(ss[q], o); }
#pragma unroll
        for (int q = 0; q < RP; ++q) norm_mod_store(v[q], ss[q], gg, s1, s0, H + (size_t)(row0 + q) * D, F.lane); }
}
__device__ __forceinline__ void rowpass_mid(Frame& F, const float* xin, float* xout, const bf16_t* Y, const float* post_g, const float* pre2_g, const float* MODl, bf16_t* H, unsigned char* H8) {
    const int gw = F.vcu * NWAVES + F.wave, NGW = F.G * NWAVES;
    for (int row0 = gw * RP; row0 < T; row0 += NGW * RP) { const int b = row0 / SEQ; const float* mod = MODl + (size_t)b * 6 * D;
        Row16 v[RP], y[RP]; float ss[RP];
#pragma unroll
        for (int q = 0; q < RP; ++q) { ld_row_f32(xin + (size_t)(row0 + q) * D, F.lane, v[q]); u32x4 w[2]; ld_row_bf16(Y + (size_t)(row0 + q) * D, F.lane, w);
#pragma unroll
            for (int i = 0; i < 4; ++i) y[q].a[i] = (f32x4){0.f, 0.f, 0.f, 0.f};
            acc_row_bf16(w, y[q]); }
        { Row16 pg, g1; ld_row_f32(post_g, F.lane, pg); ld_row_f32(mod + 2 * D, F.lane, g1);
#pragma unroll
            for (int q = 0; q < RP; ++q) ss[q] = row_sumsq(y[q]);
#pragma unroll
            for (int o = 1; o < 64; o <<= 1) {
#pragma unroll
                for (int q = 0; q < RP; ++q) ss[q] += __shfl_xor(ss[q], o); }
#pragma unroll
            for (int q = 0; q < RP; ++q) { const float r = 1.0f / sqrtf(ss[q] * (1.0f / D) + NORM_EPS);
#pragma unroll
                for (int i = 0; i < 4; ++i) v[q].a[i] = v[q].a[i] + g1.a[i] * (y[q].a[i] * r * pg.a[i]);
                st_row_f32(xout + (size_t)(row0 + q) * D, F.lane, v[q]); } }
        { Row16 gg, s1, s0; ld_row_f32(pre2_g, F.lane, gg); ld_row_f32(mod + 4 * D, F.lane, s1); ld_row_f32(mod + 3 * D, F.lane, s0);
#pragma unroll
            for (int q = 0; q < RP; ++q) ss[q] = row_sumsq(v[q]);
#pragma unroll
            for (int o = 1; o < 64; o <<= 1) {
#pragma unroll
                for (int q = 0; q < RP; ++q) ss[q] += __shfl_xor(ss[q], o); }
#pragma unroll
            for (int q = 0; q < RP; ++q) norm_mod_store(v[q], ss[q], gg, s1, s0, H + (size_t)(row0 + q) * D, F.lane, H8 + (size_t)(row0 + q) * D); } }
}
__device__ __forceinline__ void rowpass_comb(Frame& F, const float* x, float* xout, const bf16_t* YR4, const float* post_g, const float* MODl,
                                             bool has_next, const float* pre1_g_next, const float* MODn, bf16_t* H) {
    const int gw = F.vcu * NWAVES + F.wave, NGW = F.G * NWAVES;
    for (int row0 = gw * RP; row0 < T; row0 += NGW * RP) { const int b = row0 / SEQ; const float* mod = MODl + (size_t)b * 6 * D;
        Row16 v[RP], y[RP]; float ss[RP]; u32x4 w[RP][TOPK][2];
#pragma unroll
        for (int q = 0; q < RP; ++q) { ld_row_f32(x + (size_t)(row0 + q) * D, F.lane, v[q]);
#pragma unroll
            for (int k = 0; k < TOPK; ++k) ld_row_bf16(YR4 + ((size_t)(row0 + q) * TOPK + k) * D, F.lane, w[q][k]); }
#pragma unroll
        for (int q = 0; q < RP; ++q) {
#pragma unroll
            for (int i = 0; i < 4; ++i) y[q].a[i] = (f32x4){0.f, 0.f, 0.f, 0.f};
#pragma unroll
            for (int k = 0; k < TOPK; ++k) acc_row_bf16(w[q][k], y[q]); }
        { Row16 pg, g2; ld_row_f32(post_g, F.lane, pg); ld_row_f32(mod + 5 * D, F.lane, g2);
#pragma unroll
            for (int q = 0; q < RP; ++q) ss[q] = row_sumsq(y[q]);
#pragma unroll
            for (int o = 1; o < 64; o <<= 1) {
#pragma unroll
                for (int q = 0; q < RP; ++q) ss[q] += __shfl_xor(ss[q], o); }
#pragma unroll
            for (int q = 0; q < RP; ++q) { const float r = 1.0f / sqrtf(ss[q] * (1.0f / D) + NORM_EPS);
#pragma unroll
                for (int i = 0; i < 4; ++i) v[q].a[i] = v[q].a[i] + g2.a[i] * (y[q].a[i] * r * pg.a[i]);
                st_row_f32(xout + (size_t)(row0 + q) * D, F.lane, v[q]); } }
        if (has_next) { const float* modn = MODn + (size_t)b * 6 * D; Row16 gg, s1, s0; ld_row_f32(pre1_g_next, F.lane, gg); ld_row_f32(modn + 1 * D, F.lane, s1); ld_row_f32(modn + 0 * D, F.lane, s0);
#pragma unroll
            for (int q = 0; q < RP; ++q) ss[q] = row_sumsq(v[q]);
#pragma unroll
            for (int o = 1; o < 64; o <<= 1) {
#pragma unroll
                for (int q = 0; q < RP; ++q) ss[q] += __shfl_xor(ss[q], o); }
#pragma unroll
            for (int q = 0; q < RP; ++q) norm_mod_store(v[q], ss[q], gg, s1, s0, H + (size_t)(row0 + q) * D, F.lane); } }
}

__device__ __forceinline__ void attn_phase(Frame& F, const bf16_t* Q, const bf16_t* KB, const bf16_t* VT, bf16_t* AP) {
    const int gw = F.vcu * NWAVES + F.wave, NGW = F.G * NWAVES;
    const int r = F.lane & 31, hh = F.lane >> 5;
    constexpr int NQT = SEQ / 32, NTASK = BATCH * NH * NQT;
    for (int task = gw; task < NTASK; task += NGW) {
        const int qt = task % NQT, h = (task / NQT) % NH, b = task / (NQT * NH), q0 = qt * 32;
        const size_t trow0 = (size_t)b * SEQ;
        bf16x8 qf[4];
#pragma unroll
        for (int ks = 0; ks < 4; ++ks) qf[ks] = *(const bf16x8*)(Q + (trow0 + q0 + r) * SBW + h * HD + ks * 16 + hh * 8);
        f32x16 o0, o1;
#pragma unroll
        for (int i = 0; i < 16; ++i) { o0[i] = 0.f; o1[i] = 0.f; }
        float C = 0.f;
        for (int kb = q0; kb >= 0; kb -= 32) {
            const bool diag = (kb == q0);
            f32x16 s;
#pragma unroll
            for (int i = 0; i < 16; ++i) s[i] = 0.f;
            const bf16_t* kp = KB + (trow0 + kb + r) * SBW + h * HD + hh * 8;
#pragma unroll
            for (int ks = 0; ks < 4; ++ks) { const bf16x8 kf = *(const bf16x8*)(kp + ks * 16); s = __builtin_amdgcn_mfma_f32_32x32x16_bf16(kf, qf[ks], s, 0, 0, 0); }
            s16x4 vlo[2][2], vhi[2][2];
#pragma unroll
            for (int st = 0; st < 2; ++st)
#pragma unroll
                for (int dt = 0; dt < 2; ++dt) { const bf16_t* vp = VT + (size_t)(h * HD + dt * 32 + r) * T + trow0 + kb + 16 * st + 4 * hh; vlo[st][dt] = *(const s16x4*)vp; vhi[st][dt] = *(const s16x4*)(vp + 8); }
            float lk[16];
#pragma unroll
            for (int i = 0; i < 16; ++i) { const int kc = 8 * (i >> 2) + 4 * hh + (i & 3); const bool valid = !diag || (kc < r); lk[i] = valid ? -softplus_f(s[i]) : 0.f; }
            float rt[4], pt[4], both[4];
#pragma unroll
            for (int gq = 0; gq < 4; ++gq) { lk[4 * gq + 2] += lk[4 * gq + 3]; lk[4 * gq + 1] += lk[4 * gq + 2]; lk[4 * gq + 0] += lk[4 * gq + 1]; rt[gq] = lk[4 * gq]; }
#pragma unroll
            for (int gq = 0; gq < 4; ++gq) { pt[gq] = __shfl_xor(rt[gq], 32); both[gq] = rt[gq] + pt[gq]; }
            float after[4]; after[3] = 0.f; after[2] = both[3]; after[1] = both[3] + both[2]; after[0] = after[1] + both[1];
            f32x16 a;
#pragma unroll
            for (int gq = 0; gq < 4; ++gq) { const float off = after[gq] + (hh == 0 ? pt[gq] : 0.f) + C;
#pragma unroll
                for (int j = 0; j < 4; ++j) { const int i = 4 * gq + j, kc = 8 * gq + 4 * hh + j; const bool valid = !diag || (kc < r);
                    a[i] = valid ? fast_exp(s[i] + lk[i] + off) : 0.f; } }
            C += both[0] + after[0];
#pragma unroll
            for (int st = 0; st < 2; ++st) {
                u32x4 pw; pw.x = pk2(a[8 * st + 0], a[8 * st + 1]); pw.y = pk2(a[8 * st + 2], a[8 * st + 3]); pw.z = pk2(a[8 * st + 4], a[8 * st + 5]); pw.w = pk2(a[8 * st + 6], a[8 * st + 7]);
                const bf16x8 pb = __builtin_bit_cast(bf16x8, pw);
                const bf16x8 va0 = __builtin_shufflevector(vlo[st][0], vhi[st][0], 0, 1, 2, 3, 4, 5, 6, 7), va1 = __builtin_shufflevector(vlo[st][1], vhi[st][1], 0, 1, 2, 3, 4, 5, 6, 7);
                o0 = __builtin_amdgcn_mfma_f32_32x32x16_bf16(va0, pb, o0, 0, 0, 0);
                o1 = __builtin_amdgcn_mfma_f32_32x32x16_bf16(va1, pb, o1, 0, 0, 0);
            }
            if (__all(C < STICK_EXIT)) break;
        }
        bf16_t* orow = AP + (trow0 + q0 + r) * D + h * HD;
#pragma unroll
        for (int gq = 0; gq < 4; ++gq) { u32x2 w0, w1; w0.x = pk2(o0[4 * gq], o0[4 * gq + 1]); w0.y = pk2(o0[4 * gq + 2], o0[4 * gq + 3]); w1.x = pk2(o1[4 * gq], o1[4 * gq + 1]); w1.y = pk2(o1[4 * gq + 2], o1[4 * gq + 3]);
            *(u32x2*)(orow + 8 * gq + 4 * hh) = w0; *(u32x2*)(orow + 32 + 8 * gq + 4 * hh) = w1; }
    }
}

__device__ __forceinline__ void poolmix_phase(Frame& F, const bf16_t* U, bf16_t* MIX) {
    const int gt = F.vcu * NTHREADS + F.tid, NGT = F.G * NTHREADS;
    constexpr int OCT = PW / 8;
    for (int idx = gt; idx < T * OCT; idx += NGT) {
        const int t = idx / OCT, o = idx % OCT, gidx = o / (PGD / 8), w = 2 << gidx, s = t % SEQ, cnt = (s + 1) < w ? (s + 1) : w;
        const bf16_t* up = U + (size_t)t * PW + o * 8;
        float acc[8], self[8];
        { const u32x4 q = *(const u32x4*)up; self[0] = bf_lo(q.x); self[1] = bf_hi(q.x); self[2] = bf_lo(q.y); self[3] = bf_hi(q.y); self[4] = bf_lo(q.z); self[5] = bf_hi(q.z); self[6] = bf_lo(q.w); self[7] = bf_hi(q.w); }
#pragma unroll
        for (int j = 0; j < 8; ++j) acc[j] = self[j];
        for (int i = 1; i < cnt; ++i) { const u32x4 q = *(const u32x4*)(up - (size_t)i * PW);
            acc[0] += bf_lo(q.x); acc[1] += bf_hi(q.x); acc[2] += bf_lo(q.y); acc[3] += bf_hi(q.y); acc[4] += bf_lo(q.z); acc[5] += bf_hi(q.z); acc[6] += bf_lo(q.w); acc[7] += bf_hi(q.w); }
        const float inv = 1.0f / (float)cnt;
        u32x4 ow; ow.x = pk2(acc[0] * inv - self[0], acc[1] * inv - self[1]); ow.y = pk2(acc[2] * inv - self[2], acc[3] * inv - self[3]);
        ow.z = pk2(acc[4] * inv - self[4], acc[5] * inv - self[5]); ow.w = pk2(acc[6] * inv - self[6], acc[7] * inv - self[7]);
        *(u32x4*)(MIX + (size_t)t * PW + o * 8) = ow;
    }
}

constexpr int NBLK = T / 128;
__device__ __forceinline__ void router_phase_a(Frame& F, const bf16_t* H, const bf16_t* RT, const float* rb, int* HIST, int* TOPE, int* TOPL, float* TOPG) {
    LAS float* lg = (LAS float*)(F.lds + F.wave * 4096);
    volatile LAS int* whist = (volatile LAS int*)(F.lds + 65536);
    const int fr = F.lane & 15, fq = F.lane >> 4;
    for (int blk = F.vcu; blk < NBLK; blk += F.G) {
        const int t0 = blk * 128 + F.wave * 16;
        if (F.lane < NE) whist[F.wave * NE + F.lane] = 0;
        f32x4 a0 = {0.f, 0.f, 0.f, 0.f}, a1 = {0.f, 0.f, 0.f, 0.f};
        const bf16_t* hp = H + (size_t)(t0 + fr) * D + fq * 8; const bf16_t* w0 = RT + (size_t)fr * D + fq * 8; const bf16_t* w1 = RT + (size_t)(16 + fr) * D + fq * 8;
#pragma unroll 4
        for (int k = 0; k < D; k += 32) { const bf16x8 av = *(const bf16x8*)(hp + k), b0 = *(const bf16x8*)(w0 + k), b1 = *(const bf16x8*)(w1 + k);
            a0 = __builtin_amdgcn_mfma_f32_16x16x32_bf16(av, b0, a0, 0, 0, 0); a1 = __builtin_amdgcn_mfma_f32_16x16x32_bf16(av, b1, a1, 0, 0, 0); }
        const float rb0 = rb[fr], rb1 = rb[16 + fr];
#pragma unroll
        for (int j = 0; j < 4; ++j) { lg[(4 * fq + j) * 33 + fr] = a0[j] + rb0; lg[(4 * fq + j) * 33 + 16 + fr] = a1[j] + rb1; }
        LDS_WAIT(); asm volatile("" ::: "memory");
        float bv[4] = {-INFINITY, -INFINITY, -INFINITY, -INFINITY}; int bi[4] = {0, 0, 0, 0};
        if (F.lane < 16) {
            for (int e = 0; e < NE; ++e) { const float v = lg[F.lane * 33 + e];
                if (v > bv[3]) { bv[3] = v; bi[3] = e;
                    if (bv[3] > bv[2]) { float tv = bv[2]; bv[2] = bv[3]; bv[3] = tv; int ti = bi[2]; bi[2] = bi[3]; bi[3] = ti;
                        if (bv[2] > bv[1]) { tv = bv[1]; bv[1] = bv[2]; bv[2] = tv; ti = bi[1]; bi[1] = bi[2]; bi[2] = ti;
                            if (bv[1] > bv[0]) { tv = bv[0]; bv[0] = bv[1]; bv[1] = tv; ti = bi[0]; bi[0] = bi[1]; bi[1] = ti; } } } } }
        }
        float gt[4]; { float sum = 0.f;
#pragma unroll
            for (int k = 0; k < 4; ++k) { gt[k] = fast_exp(bv[k] - bv[0]); sum += gt[k]; }
            const float inv = 1.0f / sum;
#pragma unroll
            for (int k = 0; k < 4; ++k) gt[k] *= inv; }
        int rk[4];
#pragma unroll
        for (int k = 0; k < 4; ++k) {
            const int e = F.lane < 16 ? bi[k] : -1; int rank = 0;
            unsigned long long todo = __ballot(e >= 0);
            while (todo) { const int leader = __builtin_ctzll(todo); const int le = __shfl(e, leader); const unsigned long long mm = __ballot(e == le);
                const int base = whist[F.wave * NE + le];
                if (e == le) rank = base + __builtin_popcountll(mm & ((1ull << F.lane) - 1ull));
                if (F.lane == leader) whist[F.wave * NE + le] = base + __builtin_popcountll(mm);
                todo &= ~mm; }
            rk[k] = rank;
        }
        __syncthreads();
        if (F.tid < NE) { int run = 0;
#pragma unroll
            for (int w = 0; w < NWAVES; ++w) { const int v = whist[w * NE + F.tid]; whist[w * NE + F.tid] = run; run += v; }
            HIST[blk * NE + F.tid] = run; }
        __syncthreads();
        if (F.lane < 16) { const int t = t0 + F.lane;
#pragma unroll
            for (int k = 0; k < 4; ++k) { TOPE[t * TOPK + k] = bi[k]; TOPL[t * TOPK + k] = whist[F.wave * NE + bi[k]] + rk[k]; TOPG[t * TOPK + k] = gt[k]; } }
        __syncthreads();
    }
}
__device__ __forceinline__ void router_phase_b(Frame& F, const int* HIST, const int* TOPE, const int* TOPL, const float* TOPG, int* TOPS, int* ROWTOK, float* ROWGATE) {
    volatile LAS int* part = (volatile LAS int*)(F.lds + 65536);
    for (int blk = F.vcu; blk < NBLK; blk += F.G) {
        { const int e = F.tid & 31, pt = F.tid >> 5; int sacc = 0;
            for (int b = pt * 16; b < pt * 16 + 16; ++b) sacc += (b < blk) ? HIST[b * NE + e] : 0;
            part[pt * NE + e] = sacc; }
        __syncthreads();
        if (F.tid < NE) { int sacc = 0;
#pragma unroll
            for (int pt = 0; pt < 16; ++pt) sacc += part[pt * NE + F.tid];
            part[512 + F.tid] = sacc; }
        __syncthreads();
        { const int t = blk * 128 + (F.tid >> 2), k = F.tid & 3; const int e = TOPE[t * TOPK + k]; const int slot = part[512 + e] + TOPL[t * TOPK + k];
            TOPS[t * TOPK + k] = slot; ROWTOK[(size_t)e * T + slot] = t * TOPK + k; ROWGATE[(size_t)e * T + slot] = TOPG[t * TOPK + k]; }
        __syncthreads();
    }
}
__device__ __forceinline__ void moe_table(Frame& F, const int* HIST) {
    volatile LAS int* part = (volatile LAS int*)(F.MISC + 256);
    __syncthreads();
    { const int e = F.tid & 31, pt = F.tid >> 5; int sacc = 0;
        for (int b = pt * 16; b < pt * 16 + 16; ++b) sacc += HIST[b * NE + e];
        part[pt * NE + e] = sacc; }
    __syncthreads();
    if (F.tid < 64) { const int e = F.lane; int c = 0;
        if (e < NE) {
#pragma unroll
            for (int pt = 0; pt < 16; ++pt) c += part[pt * NE + e]; }
        int tl = (c + 255) >> 8, pre = tl;
#pragma unroll
        for (int o = 1; o < 64; o <<= 1) { const int v = __shfl_up(pre, o); if (F.lane >= o) pre += v; }
        if (e < NE) { F.MISC[MISC_TB + e] = (unsigned)(pre - tl); F.MISC[MISC_CNT + e] = (unsigned)c; }
        if (e == NE - 1) F.MISC[MISC_TB + NE] = (unsigned)pre; }
    __syncthreads();
}

constexpr int PH_PRO = 0, PH_PRE = 1, PH_L0 = 2, NPL = 11, NPHASES = PH_L0 + DEPTH * NPL;
__global__ void __launch_bounds__(NTHREADS, 2) fwd(Args args_unused) {
    extern __shared__ __attribute__((aligned(16))) unsigned char lds_raw[];
    const volatile __attribute__((address_space(4))) Args* ka = (const volatile __attribute__((address_space(4))) Args*)__builtin_amdgcn_kernarg_segment_ptr();
#define INP(i) ((const float*)ka->in[i])
#define WSB() ((unsigned char*)ka->ws)
#define OUTP() ((float*)ka->out)
    Frame F;
    F.lds = (LAS unsigned char*)lds_raw; F.MISC = (volatile LAS unsigned*)(F.lds + LDSCTL_OFF);
    F.wave = __builtin_amdgcn_readfirstlane((int)threadIdx.x >> 6); F.lane = lane_id_v(); F.tid = F.wave * 64 + F.lane;
    F.G = gridDim.x; { const int bx = blockIdx.x; F.vcu = (F.G % 8 == 0) ? (bx % 8) * (F.G / 8) + bx / 8 : bx; }
    F.ctl = (unsigned*)(WSB() + WS_CTL);
    for (int u = F.tid; u < (LDS_BYTES - LDSCTL_OFF) / 4; u += NTHREADS) ((LAS unsigned*)(F.lds + LDSCTL_OFF))[u] = 0u;
    __syncthreads();
    XcdBarrier bar = xcd_barrier_post(F.ctl + CW_BAR, F.MISC + MISC_BAR, F.tid == 0);
    const int lo = ka->ph_lo, hi = ka->ph_hi;
#define IN(k) (lo <= (k) && (k) < hi)
#define SEAM(k) do { if (IN(k) && IN((k) + 1)) xcd_barrier(bar, F.wave == 0 && lane_id_v() == 0); } while (0)
#define PHASE_FRAME() Frame P = F; P.wave = launder_s(F.wave); P.lane = lane_id_v(); P.tid = P.wave * 64 + P.lane
    const int cb = (int)blockIdx.x;

    if (IN(PH_PRO)) REPEAT(0) { __syncthreads(); unsigned char* ws = WSB(); { PHASE_FRAME(); mods_phase(P, INP(1), INP(2), INP(3), (float*)(ws + WS_MOD)); } { PHASE_FRAME(); convert_phase(P, ka); } }
    SEAM(PH_PRO);
    if (IN(PH_PRE)) REPEAT(1) { unsigned char* ws = WSB(); PHASE_FRAME(); rowpass_pre(P, INP(0), INP(4), (const float*)(ws + WS_MOD), (bf16_t*)(ws + WS_H)); }
    SEAM(PH_PRE);

#pragma unroll 1
    for (int l = 0; l < DEPTH; ++l) {
        const int pb = PH_L0 + l * NPL;
        if (IN(pb + 0)) { unsigned char* ws = WSB(); unsigned char* wl = ws + WS_W + (size_t)l * WL_STRIDE; const bf16_t* WIN = (const bf16_t*)(wl + WO_WIN); bf16_t* H = (bf16_t*)(ws + WS_H);
            REPEAT(2) { pg8::Gemm g{H, WIN, D, D, D, nullptr}; pg8::StaticOrder S{T / 256, 13, launder_s(F.G), launder_s(cb), D, D, 0}; pg8::EpiIn E{(bf16_t*)(ws + WS_Q), (bf16_t*)(ws + WS_K), (bf16_t*)(ws + WS_U), (bf16_t*)(ws + WS_G)};
              pg8::gemm_phase<pg8::EpiIn, pg8::StaticOrder, 0>(F.lds, F.wave, g, S, E); }
            REPEAT(3) { pg8::Gemm g{WIN + (size_t)3328 * D, H, D, D, D, nullptr}; pg8::StaticOrder S{1, T / 256, launder_s(F.G), (launder_s(cb) + launder_s(F.G) / 2) % launder_s(F.G), D, D, 0}; pg8::EpiPlain E{(bf16_t*)(ws + WS_VT), T, 0, nullptr, nullptr};
              pg8::gemm_phase<pg8::EpiPlain, pg8::StaticOrder, 1>(F.lds, F.wave, g, S, E); }
        }
        SEAM(pb + 0);
        if (IN(pb + 1)) { unsigned char* ws = WSB();
            REPEAT(4) { PHASE_FRAME(); attn_phase(P, (const bf16_t*)(ws + WS_Q), (const bf16_t*)(ws + WS_K), (const bf16_t*)(ws + WS_VT), (bf16_t*)(ws + WS_AP)); }
            REPEAT(5) { PHASE_FRAME(); poolmix_phase(P, (const bf16_t*)(ws + WS_U), (bf16_t*)(ws + WS_MIX)); } }
        SEAM(pb + 1);
        if (IN(pb + 2)) { unsigned char* ws = WSB(); unsigned char* wl = ws + WS_W + (size_t)l * WL_STRIDE; bf16_t* AP = (bf16_t*)(ws + WS_AP);
            REPEAT(6) { pg8::Gemm g{AP, (const bf16_t*)(wl + WO_BRA), D, SBW, SBW, nullptr}; pg8::StaticOrder S{T / 256, 4, launder_s(F.G), launder_s(cb), D, SBW, 0}; pg8::EpiBranch<false> E{(bf16_t*)(ws + WS_MRG), (const bf16_t*)(ws + WS_G), 0, (bf16_t*)(ws + WS_MRG)};
              pg8::gemm_phase<pg8::EpiBranch<false>, pg8::StaticOrder, 2>(F.lds, F.wave, g, S, E); }
            REPEAT(7) { pg8::Gemm g{(const bf16_t*)(ws + WS_MIX), (const bf16_t*)(wl + WO_POOL), PW, PW, 384, nullptr}; pg8::StaticOrder S{T / 256, 3, launder_s(F.G), launder_s(cb), PW, PW, PGD};
              pg8::EpiPlain E{AP, D, SBW, INP(10) + (size_t)l * PW, INP(11) + (size_t)l * PW};
              pg8::gemm_phase<pg8::EpiPlain, pg8::StaticOrder, 3>(F.lds, F.wave, g, S, E); }
        }
        SEAM(pb + 2);
        if (IN(pb + 3)) for (int _rep = ((REP_MASK >> 15) & 1) ? 0 : 1; _rep < 2; ++_rep) { unsigned char* ws = WSB(); unsigned char* wl = ws + WS_W + (size_t)l * WL_STRIDE;
            pg8::Gemm g{(const bf16_t*)(ws + WS_AP) + SBW, (const bf16_t*)(wl + WO_BRP), D, PW, PW, nullptr}; pg8::StaticOrder S{T / 256, 4, launder_s(F.G), launder_s(cb), D, PW, 0}; pg8::EpiBranch<true> E{(bf16_t*)(ws + WS_MRG), (const bf16_t*)(ws + WS_G), D, (bf16_t*)(ws + (_rep == 0 ? WS_Y : WS_MRG))};
            pg8::gemm_phase<pg8::EpiBranch<true>, pg8::StaticOrder, 4>(F.lds, F.wave, g, S, E); }
        SEAM(pb + 3);
        if (IN(pb + 4)) REPEAT(8) { unsigned char* ws = WSB(); unsigned char* wl = ws + WS_W + (size_t)l * WL_STRIDE;
            pg8::Gemm g{(const bf16_t*)(ws + WS_MRG), (const bf16_t*)(wl + WO_OUT), D, D, D, nullptr}; pg8::StaticOrder S{T / 256, 4, launder_s(F.G), launder_s(cb), D, D, 0}; pg8::EpiPlain E{(bf16_t*)(ws + WS_Y), D, 0, nullptr, nullptr};
            pg8::gemm_phase<pg8::EpiPlain, pg8::StaticOrder, 5>(F.lds, F.wave, g, S, E); }
        SEAM(pb + 4);
        if (IN(pb + 5)) for (int _rep = 0; _rep < ((((REP_MASK >> 9) & 1) && l == 0) ? 2 : 1); ++_rep) { unsigned char* ws = WSB(); PHASE_FRAME();
            rowpass_mid(P, l == 0 ? INP(0) : (const float*)OUTP(), OUTP(), (const bf16_t*)(ws + WS_Y), INP(5) + (size_t)l * D, INP(6) + (size_t)l * D, (const float*)(ws + WS_MOD) + (size_t)l * BATCH * 6 * D, (bf16_t*)(ws + WS_H), ws + WS_H8); }
        SEAM(pb + 5);
        if (IN(pb + 6)) REPEAT(12) { unsigned char* ws = WSB(); unsigned char* wl = ws + WS_W + (size_t)l * WL_STRIDE; PHASE_FRAME();
            router_phase_a(P, (const bf16_t*)(ws + WS_H), (const bf16_t*)(wl + WO_ROUTER), INP(16) + (size_t)l * NE, (int*)(ws + WS_HIST) + (size_t)l * NBLK * NE, (int*)(ws + WS_TOPE), (int*)(ws + WS_TOPL), (float*)(ws + WS_TOPG)); }
        SEAM(pb + 6);
        if (IN(pb + 7)) REPEAT(13) { unsigned char* ws = WSB(); PHASE_FRAME();
            router_phase_b(P, (const int*)(ws + WS_HIST) + (size_t)l * NBLK * NE, (const int*)(ws + WS_TOPE), (const int*)(ws + WS_TOPL), (const float*)(ws + WS_TOPG), (int*)(ws + WS_TOPS), (int*)(ws + WS_ROWTOK), (float*)(ws + WS_ROWGATE)); }
        SEAM(pb + 7);
        if (IN(pb + 8)) REPEAT(10) { unsigned char* ws = WSB(); unsigned char* wl = ws + WS_W + (size_t)l * WL_STRIDE; { PHASE_FRAME(); moe_table(P, (const int*)(ws + WS_HIST) + (size_t)l * NBLK * NE); }
            pg8::Gemm g{(const bf16_t*)(ws + WS_H8), (const bf16_t*)(wl + WO_GU), D, D, D, (const int*)(ws + WS_ROWTOK)};
            pg8::MoeOrder S{(const volatile LAS int*)(F.MISC + MISC_TB), (const volatile LAS int*)(F.MISC + MISC_CNT), 8, launder_s(F.G), launder_s(cb), 2 * D};
            pg8::EpiGU E{ws + WS_ACT, INP(18) + (size_t)l * NE * 2 * D};
            pg8::gemm_phase<pg8::EpiGU, pg8::MoeOrder, 6>(F.lds, F.wave, g, S, E); }
        SEAM(pb + 8);
        if (IN(pb + 9)) REPEAT(11) { unsigned char* ws = WSB(); unsigned char* wl = ws + WS_W + (size_t)l * WL_STRIDE; { PHASE_FRAME(); moe_table(P, (const int*)(ws + WS_HIST) + (size_t)l * NBLK * NE); }
            pg8::Gemm g{(const bf16_t*)(ws + WS_ACT), (const bf16_t*)(wl + WO_DN), D, D, D, nullptr};
            pg8::MoeOrder S{(const volatile LAS int*)(F.MISC + MISC_TB), (const volatile LAS int*)(F.MISC + MISC_CNT), 4, launder_s(F.G), launder_s(cb), D};
            pg8::EpiDN E{(bf16_t*)(ws + WS_YR), INP(20) + (size_t)l * NE * D, (const float*)(ws + WS_ROWGATE), (const int*)(ws + WS_ROWTOK)};
            pg8::gemm_phase<pg8::EpiDN, pg8::MoeOrder, 7>(F.lds, F.wave, g, S, E); }
        SEAM(pb + 9);
        if (IN(pb + 10)) for (int _rep = ((REP_MASK >> 14) & 1) ? 0 : 1; _rep < 2; ++_rep) { unsigned char* ws = WSB(); PHASE_FRAME();
            const bool hn = (l + 1 < DEPTH); const float* MOD = (const float*)(ws + WS_MOD);
            rowpass_comb(P, OUTP(), _rep == 0 ? (float*)(ws + WS_ACT) : OUTP(), (const bf16_t*)(ws + WS_YR), INP(7) + (size_t)l * D, MOD + (size_t)l * BATCH * 6 * D,
                         hn, INP(4) + (size_t)(hn ? l + 1 : l) * D, MOD + (size_t)(hn ? l + 1 : l) * BATCH * 6 * D, (bf16_t*)(ws + WS_H)); }
        SEAM(pb + 10);
    }
#undef IN
#undef SEAM
}

extern "C" void kernel_launch(void* const* d_in, const int* in_sizes, int n_in, void* d_out, int out_size, void* d_ws, size_t ws_size, hipStream_t stream) {
    static int grid = 0;
    if (grid == 0) {
        if (n_in != 21 || in_sizes[0] != T * D || out_size != T * D || ws_size < WS_END) { fprintf(stderr, "kernel_launch: unexpected shapes (n_in %d, in0 %d, out %d, ws %zu < %zu); nothing launched\n", n_in, n_in > 0 ? in_sizes[0] : -1, out_size, ws_size, (size_t)WS_END); grid = -1; return; }
        int dev = 0, cus = 0, per_cu = 0;
        if (hipGetDevice(&dev) != hipSuccess || hipDeviceGetAttribute(&cus, hipDeviceAttributeMultiprocessorCount, dev) != hipSuccess) { grid = -1; return; }
        if (hipFuncSetAttribute((const void*)fwd, hipFuncAttributeMaxDynamicSharedMemorySize, LDS_BYTES) != hipSuccess) { fprintf(stderr, "kernel_launch: hipFuncSetAttribute failed\n"); grid = -1; return; }
        if (hipOccupancyMaxActiveBlocksPerMultiprocessor(&per_cu, (const void*)fwd, NTHREADS, LDS_BYTES) != hipSuccess || per_cu < 1) { fprintf(stderr, "kernel_launch: occupancy query says %d\n", per_cu); }
        (void)hipGetLastError();
        grid = cus;
    }
    if (grid < 0) return;
    if (hipMemsetAsync((char*)d_ws + WS_CTL, 0, CTL_ZERO_BYTES, stream) != hipSuccess) return;
    Args a{};
    for (int i = 0; i < 21; ++i) a.in[i] = (const float*)d_in[i];
    a.out = (float*)d_out; a.ws = (unsigned char*)d_ws;
#if N_LAUNCHES == 1
    a.ph_lo = 0; a.ph_hi = NPHASES;
    hipLaunchKernelGGL(fwd, dim3(grid), dim3(NTHREADS), LDS_BYTES, stream, a);
#else
    for (int p = 0; p < NPHASES; ++p) { a.ph_lo = p; a.ph_hi = p + 1; hipLaunchKernelGGL(fwd, dim3(grid), dim3(NTHREADS), LDS_BYTES, stream, a); }
#endif
}
```

```cpp
#include <hip/hip_runtime.h>
#include <cstdio>
#include <cstdint>

#ifndef N_LAUNCHES
#define N_LAUNCHES 1
#endif
#ifndef REP_MASK
#define REP_MASK 0
#endif
#ifndef REP_BAR
#define REP_BAR 0
#endif
#define REPEAT(b) _Pragma("unroll 1") for (int _rep = 0; _rep < (((REP_MASK >> (b)) & 1) ? 2 : 1); ((REP_BAR && ((REP_MASK >> (b)) & 1)) ? xcd_barrier(bar, F.wave == 0 && lane_id_v() == 0) : (void)0), ++_rep)
#ifndef TIMER_ON
#define TIMER_ON 0
#endif
#ifndef TIMER_A1
#define TIMER_A1 63
#define TIMER_B1 0
#define TIMER_A2 63
#define TIMER_B2 1
#endif
constexpr int CW_TS = 12288;
#ifndef SPAN_LO
#define SPAN_LO -1
#define SPAN_HI -1
#endif
#ifndef PROF_REGION
#define PROF_REGION 0
#define PROF_SITES 0
#endif
#ifndef FAST_MASK
#define FAST_MASK 0xff
#endif

#define LAS __attribute__((address_space(3)))
#define GAS __attribute__((address_space(1)))
typedef unsigned short bf16_t;
typedef short bf16x8 __attribute__((ext_vector_type(8)));
typedef short s16x4 __attribute__((ext_vector_type(4)));
typedef float f32x4 __attribute__((ext_vector_type(4)));
typedef float f32x2 __attribute__((ext_vector_type(2)));
typedef float f32x16 __attribute__((ext_vector_type(16)));
typedef unsigned u32x4 __attribute__((ext_vector_type(4)));
typedef unsigned u32x2 __attribute__((ext_vector_type(2)));

constexpr int D = 1024, BATCH = 2, SEQ = 16384, T = BATCH * SEQ, DEPTH = 2;
constexpr int SBW = 256, NH = 4, HD = 64, PW = 768, PGD = 192, INW = 3584;
constexpr int NE = 32, TOPK = 4;
constexpr float NORM_EPS = 1e-6f, SW_LIMIT = 7.0f, SW_ALPHA = 1.702f;
constexpr float STICK_EXIT = -24.0f;
constexpr int NWAVES = 8, NTHREADS = 512;
constexpr int MAXTILES = (T * TOPK) / 256 + NE;

constexpr size_t MiB = 1u << 20;
constexpr size_t WS_CTL = 0, CTL_ZERO_BYTES = 65536;
constexpr size_t WS_MOD = 1 * MiB;
constexpr size_t WS_W = 2 * MiB, WL_STRIDE = 205 * MiB;
constexpr size_t WO_WIN = 0, WO_BRA = 7 * MiB, WO_BRP = 7 * MiB + MiB / 2, WO_OUT = 9 * MiB, WO_POOL = 11 * MiB, WO_ROUTER = 12 * MiB + MiB / 2, WO_GU = 13 * MiB, WO_DN = 141 * MiB;
constexpr size_t WS_H = 416 * MiB, WS_Q = 480 * MiB, WS_K = 496 * MiB, WS_U = 528 * MiB, WS_G = 576 * MiB;
constexpr int VTP = T + 64;
constexpr size_t WS_AP = 704 * MiB, WS_MIX = 768 * MiB, WS_MRG = 816 * MiB, WS_Y = 880 * MiB;
constexpr size_t WS_TOPE = 944 * MiB, WS_TOPS = 944 * MiB + MiB / 2, WS_TOPL = 945 * MiB, WS_TOPG = 945 * MiB + MiB / 2, WS_ROWTOK = 946 * MiB, WS_ROWGATE = 950 * MiB;
constexpr size_t WS_HIST = 954 * MiB;
constexpr size_t WS_ACT = 960 * MiB, WS_YR = 1232 * MiB, WS_H8 = 1504 * MiB, WS_XB = 1536 * MiB, WS_VT = 1600 * MiB  , WS_END = 1620 * MiB;
static_assert(WO_DN + (size_t)NE * D * D * 2 <= WL_STRIDE && WS_W + DEPTH * WL_STRIDE <= WS_H, "weights map");
static_assert(WS_ACT + (size_t)MAXTILES * 256 * D * 2 <= WS_YR && WS_YR + (size_t)MAXTILES * 256 * D * 2 <= WS_END, "act map");
constexpr int CW_BAR = 4096, CW_CNT = 8192;

constexpr int RING_BYTES = 131072, LDSCTL_OFF = RING_BYTES, LDS_BYTES = 147456;
constexpr int META_OFF = LDSCTL_OFF + 4096, META_BYTES = 4096;
constexpr int MISC_BAR = 8;
constexpr int MISC_TB = 64, MISC_CNT = 128, MISC_PROF = 200;

__device__ __forceinline__ unsigned f2bf(float f) { unsigned u = __builtin_bit_cast(unsigned, f); return (u + 0x7fffu + ((u >> 16) & 1u)) >> 16; }
__device__ __forceinline__ unsigned pk2(float lo, float hi) { return f2bf(lo) | (f2bf(hi) << 16); }
__device__ __forceinline__ float bf_lo(unsigned w) { return __builtin_bit_cast(float, w << 16); }
__device__ __forceinline__ float bf_hi(unsigned w) { return __builtin_bit_cast(float, w & 0xffff0000u); }
__device__ __forceinline__ unsigned pk4_fp8(float a, float b, float c, float d) { int w = 0; w = __builtin_amdgcn_cvt_pk_fp8_f32(a, b, w, false); w = __builtin_amdgcn_cvt_pk_fp8_f32(c, d, w, true); return (unsigned)w; }
constexpr float W8_SCALE = 32.0f, W8_INV = 1.0f / 32.0f;
__device__ __forceinline__ float fast_exp(float x) { return __builtin_amdgcn_exp2f(x * 1.4426950408889634f); }
__device__ __forceinline__ float fast_sigmoid(float x) { return __builtin_amdgcn_rcpf(1.0f + fast_exp(-x)); }
__device__ __forceinline__ float softplus_f(float z) { return fmaxf(z, 0.f) + 0.6931471805599453f * __builtin_amdgcn_logf(1.0f + fast_exp(-fabsf(z))); }
__device__ __forceinline__ float wave_sum(float v) {
#pragma unroll
    for (int o = 1; o < 64; o <<= 1) v += __shfl_xor(v, o);
    return v;
}
__device__ __forceinline__ int launder_v(int x) { asm volatile("" : "+v"(x)); return x; }
__device__ __forceinline__ int launder_s(int x) { asm volatile("" : "+s"(x)); return x; }
__device__ __forceinline__ int lane_id_v() { int x; asm volatile("v_mbcnt_lo_u32_b32 %0, -1, 0\n\tv_mbcnt_hi_u32_b32 %0, -1, %0" : "=v"(x)); return x; }
#define LDS_WAIT() asm volatile("s_waitcnt lgkmcnt(0)" ::: "memory")
#define VM_WAIT() asm volatile("s_waitcnt vmcnt(0)" ::: "memory")

#define XB_TMO      128
#define XB_XCNT(j)  (256  + 64 * (j))
#define XB_XSUB(j)  (1280 + 64 * (j))
#define XB_XGEN(j)  (2304 + 64 * (j))
#define XB_TOP      3328
#define XB_TOPGEN   3392
#define XCD_BAR_WORDS 3456
#define XB_SPIN_CAP (1u << 18)
__device__ __forceinline__ unsigned xb_ld(unsigned* p)              { return __hip_atomic_load(p, __ATOMIC_RELAXED, __HIP_MEMORY_SCOPE_AGENT); }
__device__ __forceinline__ unsigned xb_add(unsigned* p, unsigned v) { return __hip_atomic_fetch_add(p, v, __ATOMIC_RELAXED, __HIP_MEMORY_SCOPE_AGENT); }
__device__ __forceinline__ unsigned xb_xcc_id() { return (unsigned)__builtin_amdgcn_s_getreg((3 << 11) | 20) & 0xFu; }
#define XB_SPIN(cond, bar) do { unsigned _sp = 0; while (cond) { __builtin_amdgcn_s_sleep(1); \
    if ((++_sp & 255u) == 0u) { if (xb_ld(&(bar)[XB_TMO])) break; if (_sp > XB_SPIN_CAP) { atomicAdd(&(bar)[XB_TMO], 1u); break; } } } } while (0)
struct XcdBarrier { unsigned* bar; unsigned x; volatile LAS unsigned* st; };
__device__ __forceinline__ XcdBarrier xcd_barrier_post(unsigned* bar, volatile LAS unsigned* st, bool t0) {
    XcdBarrier b; b.bar = bar; b.x = xb_xcc_id(); b.st = st;
    if (t0) (void)xb_add(&bar[XB_XCNT(b.x)], 1u);
    return b;
}
__device__ __forceinline__ void xcd_barrier_complete(unsigned* bar, unsigned x, unsigned& nloc, unsigned& nx) {
    const unsigned G = gridDim.x * gridDim.y * gridDim.z;
    unsigned sum, cnt, mine, sp = 0u;
    for (;;) {
        sum = 0u; cnt = 0u; mine = 0u;
#pragma unroll
        for (unsigned j = 0; j < 16; ++j) { const unsigned c = xb_ld(&bar[XB_XCNT(j)]); sum += c; cnt += (c > 0u) ? 1u : 0u; mine = (j == x) ? c : mine; }
        if (sum == G) break;
        __builtin_amdgcn_s_sleep(1);
        if ((++sp & 255u) == 0u) { if (xb_ld(&bar[XB_TMO])) break; if (sp > XB_SPIN_CAP) { atomicAdd(&bar[XB_TMO], 1u); break; } }
    }
    nloc = mine > 0u ? mine : 1u; nx = cnt > 0u ? cnt : 1u;
}
__device__ __forceinline__ void xcd_barrier(const XcdBarrier& b, bool t0) {
    asm volatile("s_waitcnt vmcnt(0)" ::: "memory");
    __syncthreads();
    if (t0) {
        unsigned* bar = b.bar;
        __builtin_amdgcn_s_waitcnt(0);
        unsigned nloc = b.st[0], nx = b.st[1];
        if (nloc == 0u) { xcd_barrier_complete(bar, b.x, nloc, nx); b.st[0] = nloc; b.st[1] = nx; }
        const unsigned old = xb_add(&bar[XB_XSUB(b.x)], 1u);
        const unsigned gen = old / nloc;
        if (old + 1u == (gen + 1u) * nloc) {
            __builtin_amdgcn_fence(__ATOMIC_RELEASE, "agent");
            asm volatile("s_waitcnt vmcnt(0)" ::: "memory");
            const unsigned og = xb_add(&bar[XB_TOP], 1u);
            const unsigned tg = og / nx;
            if (og + 1u == (tg + 1u) * nx) xb_add(&bar[XB_TOPGEN], 1u);
            else XB_SPIN(xb_ld(&bar[XB_TOPGEN]) == tg, bar);
            __builtin_amdgcn_fence(__ATOMIC_ACQUIRE, "agent");
            xb_add(&bar[XB_XGEN(b.x)], 1u);
            asm volatile("s_waitcnt vmcnt(0)" ::: "memory");
        } else {
            XB_SPIN(xb_ld(&bar[XB_XGEN(b.x)]) == gen, bar);
            __builtin_amdgcn_fence(__ATOMIC_ACQUIRE, "agent");
            asm volatile("s_waitcnt vmcnt(0)" ::: "memory");
        }
    }
    __syncthreads();
}

namespace pg8 {
constexpr int BM = 256, BK = 64, HALF = 128, HTB = HALF * BK * 2, STAGE_BYTES = 8 * HTB, NXCD = 8, WGM = 8;
__host__ __device__ __forceinline__ int lds_byte(int r, int c) { const int st = (r >> 4) * 2 + (c >> 5), rr = r & 15, cc = c & 31, ob = rr * 64 + cc * 2; return st * 1024 + (ob ^ (((ob >> 9) & 1) << 5)); }
__host__ __device__ __forceinline__ void stage_rc(int b, int& R, int& C) { const int st = b / 1024, sb = b % 1024, swz = sb ^ (((sb >> 9) & 1) << 5); R = (st >> 1) * 16 + swz / 64; C = (st & 1) * 32 + (swz % 64) / 2; }
__host__ __device__ __forceinline__ int perm32(int rho) { const int n = rho >> 4, i = rho & 15; return 8 * (i >> 2) + 4 * n + (i & 3); }

struct Unit { int pm, pn, e, nvalid, slot0; unsigned aoff, boff; };
struct Gemm { const bf16_t* A; const bf16_t* Bt; int lda, ldb, K; const int* gather; };

__device__ __forceinline__ bool order_unit(int i, int G, int c, int nM, int nN, int& pm, int& pn) {
    const int nwg = nM * nN; const long L = (long)i * G + c; if (L >= nwg) return false;
    int wgid = (int)L; { const int q = nwg / NXCD, r = nwg % NXCD, xcd = wgid % NXCD, off = wgid / NXCD; wgid = (xcd < r ? xcd * (q + 1) : r * (q + 1) + (xcd - r) * q) + off; }
    const int nig = WGM * nN, gid = wgid / nig, fm = gid * WGM, gsz = (nM - fm) < WGM ? (nM - fm) : WGM;
    pm = fm + ((wgid % nig) % gsz); pn = (wgid % nig) / gsz; return true;
}
struct StaticOrder {
    int nM, nN, G, c, lda, ldb, kstride;
    __device__ __forceinline__ bool next(int i, Unit& u) const {
        if (!order_unit(i, G, c, nM, nN, u.pm, u.pn)) return false;
        u.e = 0; u.nvalid = 256; u.slot0 = 0;
        u.aoff = (unsigned)(u.pm * BM) * (unsigned)lda + (unsigned)(kstride * u.pn); u.boff = (unsigned)(u.pn * BM) * (unsigned)ldb + (unsigned)(kstride * u.pn); return true;
    }
};
struct MoeOrder {
    const volatile LAS int* tb; const volatile LAS int* cnt; int nN, G, c, nw;
    __device__ __forceinline__ bool next(int i, Unit& u) const {
        const int nM = tb[NE];
        if (!order_unit(i, G, c, nM, nN, u.pm, u.pn)) return false;
        int e = u.e < 0 ? 0 : (u.e > NE - 1 ? NE - 1 : u.e);
#pragma unroll 1
        while (e < NE - 1 && tb[e + 1] <= u.pm) ++e;
#pragma unroll 1
        while (e > 0 && tb[e] > u.pm) --e;
        u.e = e; u.slot0 = (u.pm - tb[e]) * BM; const int left = cnt[e] - u.slot0; u.nvalid = left < BM ? left : BM;
        u.aoff = (unsigned)(u.pm * BM) * (unsigned)D; u.boff = ((unsigned)e * (unsigned)nw + (unsigned)(u.pn * BM)) * (unsigned)D; return true;
    }
};

__device__ __forceinline__ unsigned cvt_pk_bf16(float lo, float hi) { unsigned r; asm volatile("v_cvt_pk_bf16_f32 %0, %1, %2" : "=v"(r) : "v"(lo), "v"(hi)); return r; }
__device__ __forceinline__ u32x4 pack8(const f32x4 a, const f32x4 b) { u32x4 w; w.x = cvt_pk_bf16(a[0], a[1]); w.y = cvt_pk_bf16(a[2], a[3]); w.z = cvt_pk_bf16(b[0], b[1]); w.w = cvt_pk_bf16(b[2], b[3]); return w; }
__device__ __forceinline__ void unpack8(const u32x4 w, f32x4& a, f32x4& b) { a = (f32x4){bf_lo(w.x), bf_hi(w.x), bf_lo(w.y), bf_hi(w.y)}; b = (f32x4){bf_lo(w.z), bf_hi(w.z), bf_lo(w.w), bf_hi(w.w)}; }

__device__ __forceinline__ f32x2 lo2(const f32x4 v) { return __builtin_shufflevector(v, v, 0, 1); }
__device__ __forceinline__ f32x2 hi2(const f32x4 v) { return __builtin_shufflevector(v, v, 2, 3); }
__device__ __forceinline__ f32x4 cat2(const f32x2 a, const f32x2 b) { return __builtin_shufflevector(a, b, 0, 1, 2, 3); }
__device__ __forceinline__ f32x2 pk_sigmoid(const f32x2 x) {
    const f32x2 t = x * (-1.4426950408889634f); f32x2 e; e.x = __builtin_amdgcn_exp2f(t.x); e.y = __builtin_amdgcn_exp2f(t.y);
    const f32x2 d = e + 1.0f; f32x2 r; r.x = __builtin_amdgcn_rcpf(d.x); r.y = __builtin_amdgcn_rcpf(d.y); return r; }
__device__ __forceinline__ f32x4 pk_sigmoid4(const f32x4 v) { return cat2(pk_sigmoid(lo2(v)), pk_sigmoid(hi2(v))); }
__device__ __forceinline__ f32x2 pk_fma2(const f32x2 a, const f32x2 b, const f32x2 c) { return __builtin_elementwise_fma(a, b, c); }
__device__ __forceinline__ f32x2 swiglu2(f32x2 g, f32x2 u) {
    g.x = fminf(g.x, SW_LIMIT); g.y = fminf(g.y, SW_LIMIT); u.x = fminf(fmaxf(u.x, -SW_LIMIT), SW_LIMIT); u.y = fminf(fmaxf(u.y, -SW_LIMIT), SW_LIMIT);
    const f32x2 t = g * (-SW_ALPHA * 1.4426950408889634f); f32x2 e; e.x = __builtin_amdgcn_exp2f(t.x); e.y = __builtin_amdgcn_exp2f(t.y);
    const f32x2 d = e + 1.0f; f32x2 r; r.x = __builtin_amdgcn_rcpf(d.x); r.y = __builtin_amdgcn_rcpf(d.y);
    return pk_fma2(u, g, g) * r; }
#define EPI_LOOP_ROWS for (int ai = 0; ai < 2; ++ai) _Pragma("unroll") for (int m = 0; m < 4; ++m)
__device__ __forceinline__ void* probe_scratch_ptr() { const volatile __attribute__((address_space(4))) void* const* ka = (const volatile __attribute__((address_space(4))) void* const*)__builtin_amdgcn_kernarg_segment_ptr(); return (unsigned char*)ka[22] + ((size_t)1536 << 20); }
struct EpiIn {
    static constexpr bool PERM = true; static constexpr int ES = 2, SITE_ID = 0;
    bf16_t *Q, *KB, *U, *G;
    __device__ __forceinline__ void operator()(const f32x4 (&acc)[2][2][4][2], const Unit& u, int wr, int wc, int fr, int fq) const {
        const int pn = u.pn; bf16_t* base; int ld, c0, mode;
        if (pn == 0) { base = Q; ld = SBW; c0 = 0; mode = 1; } else if (pn == 1) { base = KB; ld = SBW; c0 = 0; mode = 0; }
        else if (pn < 5) { base = U; ld = PW; c0 = (pn - 2) * BM; mode = 0; } else { base = G; ld = 2 * D; c0 = (pn - 5) * BM; mode = 2; }
        const int row0 = u.pm * BM + wr * 64 + fr, col0 = c0 + wc * 32 + 8 * fq;
#pragma unroll
        EPI_LOOP_ROWS { bf16_t* rowp = base + (size_t)(row0 + ai * HALF + m * 16) * ld + col0;
#pragma unroll
            for (int bj = 0; bj < 2; ++bj) { f32x4 v0 = acc[ai][bj][m][0], v1 = acc[ai][bj][m][1];
                if (mode == 1) { v0 = v0 * 0.125f; v1 = v1 * 0.125f; }
                if (mode == 2) { v0 = pk_sigmoid4(v0); v1 = pk_sigmoid4(v1); }
                *(u32x4*)(rowp + bj * HALF) = pack8(v0, v1); } }
    }
};
struct EpiPlain {
    static constexpr bool PERM = true; static constexpr int ES = 2, SITE_ID = 1;
    bf16_t* O; int ldc, coff; const float* bias; const float* scale;
    __device__ __forceinline__ void operator()(const f32x4 (&acc)[2][2][4][2], const Unit& u, int wr, int wc, int fr, int fq) const {
        const int row0 = u.pm * BM + wr * 64 + fr, col0 = u.pn * BM + wc * 32 + 8 * fq;
        f32x4 bv[2][2], sv[2][2];
#pragma unroll
        for (int bj = 0; bj < 2; ++bj)
#pragma unroll
            for (int n = 0; n < 2; ++n) { bv[bj][n] = bias ? *(const f32x4*)(bias + col0 + bj * HALF + 4 * n) : (f32x4){0.f, 0.f, 0.f, 0.f};
                                          sv[bj][n] = scale ? *(const f32x4*)(scale + col0 + bj * HALF + 4 * n) : (f32x4){1.f, 1.f, 1.f, 1.f}; }
#pragma unroll
        EPI_LOOP_ROWS { bf16_t* rowp = O + (size_t)(row0 + ai * HALF + m * 16) * ldc + coff + col0;
#pragma unroll
            for (int bj = 0; bj < 2; ++bj) *(u32x4*)(rowp + bj * HALF) = pack8((acc[ai][bj][m][0] + bv[bj][0]) * sv[bj][0], (acc[ai][bj][m][1] + bv[bj][1]) * sv[bj][1]); }
    }
};
template <bool ADD> struct EpiBranch {
    static constexpr bool PERM = true; static constexpr int ES = 2, SITE_ID = 2;
    bf16_t* MRG; const bf16_t* G; int goff; bf16_t* MRGout;
    __device__ __forceinline__ void load_q(int q, size_t row0, int col0, u32x4 (&gq)[4], u32x4 (&pq)[4]) const {
#pragma unroll
        for (int t = 0; t < 4; ++t) { const int ai = q >> 1, m = (q & 1) * 2 + (t >> 1), bj = t & 1; const size_t r = row0 + ai * HALF + m * 16; const int c = col0 + bj * HALF;
            gq[t] = *(const u32x4*)(G + r * (2 * D) + goff + c); if (ADD) pq[t] = *(const u32x4*)(MRG + r * D + c); } }
    __device__ __forceinline__ void operator()(const f32x4 (&acc)[2][2][4][2], const Unit& u, int wr, int wc, int fr, int fq) const {
        const size_t row0 = (size_t)(u.pm * BM + wr * 64 + fr); const int col0 = u.pn * BM + wc * 32 + 8 * fq;
        u32x4 gA[4], pA[4], gB[4], pB[4];
        load_q(0, row0, col0, gA, pA);
#pragma unroll
        for (int q = 0; q < 4; ++q) {
            if (q + 1 < 4) { if (q & 1) load_q(q + 1, row0, col0, gA, pA); else load_q(q + 1, row0, col0, gB, pB); }
#pragma unroll
            for (int t = 0; t < 4; ++t) { const int ai = q >> 1, m = (q & 1) * 2 + (t >> 1), bj = t & 1; const size_t r = row0 + ai * HALF + m * 16; const int c = col0 + bj * HALF;
                f32x4 g0, g1; unpack8((q & 1) ? gB[t] : gA[t], g0, g1);
                f32x4 v0 = g0 * acc[ai][bj][m][0], v1 = g1 * acc[ai][bj][m][1];
                if (ADD) { f32x4 p0, p1; unpack8((q & 1) ? pB[t] : pA[t], p0, p1); v0 = v0 + p0; v1 = v1 + p1; }
                *(u32x4*)(MRGout + r * D + c) = pack8(v0, v1); } }
    }
};
struct EpiGU {
    static constexpr bool PERM = true, HAS_PRE = true; static constexpr int ES = 1, SITE_ID = 6;
    unsigned char* ACT8; const float* bgu;
    __device__ __forceinline__ void prefetch(LAS unsigned char* meta, const Unit& u, int wid, int lane) const {
        if (wid == 2 || wid == 3) { const float* src = bgu + (size_t)u.e * (2 * D) + (wid == 3 ? D : 0) + u.pn * HALF + 4 * (lane & 31);
            __builtin_amdgcn_global_load_lds((const unsigned*)src, (LAS unsigned*)(meta + wid * 1024), 16, 0, 0); } }
    __device__ __forceinline__ void epi_lds(const f32x4 (&acc)[2][2][4][2], const Unit& u, int wr, int wc, int fr, int fq, const LAS unsigned char* meta) const {
        const int row0 = u.pm * BM + wr * 64 + fr, col0 = u.pn * HALF + wc * 32 + 8 * fq;
        float w8s = W8_INV; asm volatile("" : "+v"(w8s));
        f32x4 bgv[2], buv[2];
#pragma unroll
        for (int n = 0; n < 2; ++n) { bgv[n] = *(const LAS f32x4*)(meta + 2048 + (wc * 32 + 8 * fq + 4 * n) * 4); buv[n] = *(const LAS f32x4*)(meta + 3072 + (wc * 32 + 8 * fq + 4 * n) * 4); }
#pragma unroll
        EPI_LOOP_ROWS { f32x4 o[2];
#pragma unroll
            for (int n = 0; n < 2; ++n) { const f32x2 w8 = {w8s, w8s};
                o[n] = cat2(swiglu2(pk_fma2(lo2(acc[ai][0][m][n]), w8, lo2(bgv[n])), pk_fma2(lo2(acc[ai][1][m][n]), w8, lo2(buv[n]))),
                            swiglu2(pk_fma2(hi2(acc[ai][0][m][n]), w8, hi2(bgv[n])), pk_fma2(hi2(acc[ai][1][m][n]), w8, hi2(buv[n])))); }
            u32x2 w; w.x = pk4_fp8(o[0][0], o[0][1], o[0][2], o[0][3]); w.y = pk4_fp8(o[1][0], o[1][1], o[1][2], o[1][3]);
            *(u32x2*)(ACT8 + (size_t)(row0 + ai * HALF + m * 16) * D + col0) = w; }
    }
    __device__ __forceinline__ void operator()(const f32x4 (&acc)[2][2][4][2], const Unit& u, int wr, int wc, int fr, int fq) const {
        const int row0 = u.pm * BM + wr * 64 + fr, col0 = u.pn * HALF + wc * 32 + 8 * fq;
        float w8s = W8_INV; asm volatile("" : "+v"(w8s));
        const float* bg = bgu + (size_t)u.e * (2 * D) + col0;
        f32x4 bgv[2], buv[2];
#pragma unroll
        for (int n = 0; n < 2; ++n) { bgv[n] = *(const f32x4*)(bg + 4 * n); buv[n] = *(const f32x4*)(bg + D + 4 * n); }
#pragma unroll
        EPI_LOOP_ROWS { f32x4 o[2];
#pragma unroll
            for (int n = 0; n < 2; ++n) { const f32x2 w8 = {w8s, w8s};
                o[n] = cat2(swiglu2(pk_fma2(lo2(acc[ai][0][m][n]), w8, lo2(bgv[n])), pk_fma2(lo2(acc[ai][1][m][n]), w8, lo2(buv[n]))),
                            swiglu2(pk_fma2(hi2(acc[ai][0][m][n]), w8, hi2(bgv[n])), pk_fma2(hi2(acc[ai][1][m][n]), w8, hi2(buv[n])))); }
            u32x2 w; w.x = pk4_fp8(o[0][0], o[0][1], o[0][2], o[0][3]); w.y = pk4_fp8(o[1][0], o[1][1], o[1][2], o[1][3]);
            *(u32x2*)(ACT8 + (size_t)(row0 + ai * HALF + m * 16) * D + col0) = w; }
    }
};
struct EpiDN {
    static constexpr bool PERM = true, HAS_PRE = true; static constexpr int ES = 1, SITE_ID = 7;
    bf16_t* YR4; const float* bdn; const float* rowgate; const int* rowtk;
    __device__ __forceinline__ void prefetch(LAS unsigned char* meta, const Unit& u, int wid, int lane) const {
        if (wid < 3) { const void* src = wid == 0 ? (const void*)(rowtk + (size_t)u.e * T + u.slot0 + 4 * lane) : wid == 1 ? (const void*)(rowgate + (size_t)u.e * T + u.slot0 + 4 * lane) : (const void*)(bdn + (size_t)u.e * D + u.pn * BM + 4 * lane);
            __builtin_amdgcn_global_load_lds((const unsigned*)src, (LAS unsigned*)(meta + wid * 1024), 16, 0, 0); } }
    __device__ __forceinline__ void epi_lds(const f32x4 (&acc)[2][2][4][2], const Unit& u, int wr, int wc, int fr, int fq, const LAS unsigned char* meta) const {
        const int rl0 = wr * 64 + fr, col0 = u.pn * BM + wc * 32 + 8 * fq;
        float w8s = W8_INV; asm volatile("" : "+v"(w8s));
        f32x4 bv[2][2];
#pragma unroll
        for (int bj = 0; bj < 2; ++bj)
#pragma unroll
            for (int n = 0; n < 2; ++n) bv[bj][n] = *(const LAS f32x4*)(meta + 2048 + (bj * HALF + wc * 32 + 8 * fq + 4 * n) * 4);
#pragma unroll
        EPI_LOOP_ROWS { const int rl = rl0 + ai * HALF + m * 16;
            if (rl < u.nvalid) { const float gt = *(const LAS float*)(meta + 1024 + rl * 4); const int tk = *(const LAS int*)(meta + rl * 4); bf16_t* rowp = YR4 + (size_t)tk * D + col0;
#pragma unroll
                for (int bj = 0; bj < 2; ++bj) *(u32x4*)(rowp + bj * HALF) = pack8((acc[ai][bj][m][0] * w8s + bv[bj][0]) * gt, (acc[ai][bj][m][1] * w8s + bv[bj][1]) * gt); } }
    }
    __device__ __forceinline__ void operator()(const f32x4 (&acc)[2][2][4][2], const Unit& u, int wr, int wc, int fr, int fq) const {
        const int rl0 = wr * 64 + fr, col0 = u.pn * BM + wc * 32 + 8 * fq;
        const float* bp = bdn + (size_t)u.e * D + col0; const float* gp = rowgate + (size_t)u.e * T + u.slot0; const int* tp = rowtk + (size_t)u.e * T + u.slot0;
        float w8s = W8_INV; asm volatile("" : "+v"(w8s));
        f32x4 bv[2][2];
#pragma unroll
        for (int bj = 0; bj < 2; ++bj)
#pragma unroll
            for (int n = 0; n < 2; ++n) bv[bj][n] = *(const f32x4*)(bp + bj * HALF + 4 * n);
        float gtv[2][4]; int tkv[2][4]; const int nv1 = u.nvalid - 1;
#pragma unroll
        EPI_LOOP_ROWS { const int rl = rl0 + ai * HALF + m * 16, rc = rl < nv1 ? rl : nv1; gtv[ai][m] = gp[rc]; tkv[ai][m] = tp[rc]; }
#pragma unroll
        EPI_LOOP_ROWS { const int rl = rl0 + ai * HALF + m * 16;
            if (rl < u.nvalid) { const float gt = gtv[ai][m]; bf16_t* rowp = YR4 + (size_t)tkv[ai][m] * D + col0;
#pragma unroll
                for (int bj = 0; bj < 2; ++bj) *(u32x4*)(rowp + bj * HALF) = pack8((acc[ai][bj][m][0] * w8s + bv[bj][0]) * gt, (acc[ai][bj][m][1] * w8s + bv[bj][1]) * gt); } }
    }
};

template <class E, class = void> struct epi_has_pre { static constexpr bool value = false; };
template <class E> struct epi_has_pre<E, decltype((void)E::HAS_PRE)> { static constexpr bool value = E::HAS_PRE; };
template <class Epi, class Sched>
__device__ __forceinline__ void gemm_simple(int wave, const Gemm g, const Sched& S, const Epi& E) {
    const int wid = launder_s(wave), lane = lane_id_v(), wr = wid >> 2, wc = wid & 3, fr = lane & 15, fq = lane >> 4;
    Unit u; u.e = 0;
    for (int ui = 0; S.next(ui, u); ++ui) {
        f32x4 acc[2][2][4][2];
#pragma unroll
        for (int a = 0; a < 2; ++a)
#pragma unroll
            for (int b = 0; b < 2; ++b)
#pragma unroll
                for (int m = 0; m < 4; ++m)
#pragma unroll
                    for (int n = 0; n < 2; ++n) acc[a][b][m][n] = (f32x4){0.f, 0.f, 0.f, 0.f};
        unsigned ao[2][4], bo[2][2];
#pragma unroll
        for (int ai = 0; ai < 2; ++ai)
#pragma unroll
            for (int m = 0; m < 4; ++m) { const int rl = ai * HALF + wr * 64 + m * 16 + fr;
                if (g.gather) { const int tok = g.gather[(size_t)u.e * T + u.slot0 + (rl < u.nvalid ? rl : u.nvalid - 1)] >> 2; ao[ai][m] = (unsigned)tok * (unsigned)g.lda + fq * 8; }
                else ao[ai][m] = u.aoff + (unsigned)rl * (unsigned)g.lda + fq * 8; }
#pragma unroll
        for (int bj = 0; bj < 2; ++bj)
#pragma unroll
            for (int n = 0; n < 2; ++n) { const int slot = 16 * n + fr, brow = bj * HALF + wc * 32 + (Epi::PERM ? perm32(slot) : slot); bo[bj][n] = u.boff + (unsigned)brow * (unsigned)g.ldb + fq * 8; }
#pragma unroll 1
        for (int k = 0; k < g.K; k += 32) {
            bf16x8 b[2][2];
#pragma unroll
            for (int bj = 0; bj < 2; ++bj)
#pragma unroll
                for (int n = 0; n < 2; ++n) b[bj][n] = *(const bf16x8*)(g.Bt + (size_t)bo[bj][n] + k);
#pragma unroll
            for (int ai = 0; ai < 2; ++ai) {
                bf16x8 a[4];
#pragma unroll
                for (int m = 0; m < 4; ++m) a[m] = *(const bf16x8*)(g.A + (size_t)ao[ai][m] + k);
#pragma unroll
                for (int bj = 0; bj < 2; ++bj)
#pragma unroll
                    for (int m = 0; m < 4; ++m)
#pragma unroll
                        for (int n = 0; n < 2; ++n) acc[ai][bj][m][n] = __builtin_amdgcn_mfma_f32_16x16x32_bf16(b[bj][n], a[m], acc[ai][bj][m][n], 0, 0, 0);
            }
        }
        E(acc, u, wr, wc, fr, fq);
    }
}

typedef int v8i32 __attribute__((ext_vector_type(8)));
typedef int v4i32 __attribute__((ext_vector_type(4)));
template <int ES> struct Frag;
template <> struct Frag<2> { bf16x8 k[2]; };
template <> struct Frag<1> { v8i32 v; };
__device__ __forceinline__ void ld_frag(Frag<2>& f, const LAS unsigned char* p) { f.k[0] = *(const LAS bf16x8*)p; f.k[1] = *(const LAS bf16x8*)(p + 1024); }
__device__ __forceinline__ void ld_frag(Frag<1>& f, const LAS unsigned char* p) { const v4i32 lo = *(const LAS v4i32*)p, hi = *(const LAS v4i32*)(p + 1024); f.v = __builtin_shufflevector(lo, hi, 0, 1, 2, 3, 4, 5, 6, 7); }
__device__ __forceinline__ f32x4 mma_frag(const Frag<2>& b, const Frag<2>& a, f32x4 c) { c = __builtin_amdgcn_mfma_f32_16x16x32_bf16(b.k[0], a.k[0], c, 0, 0, 0); return __builtin_amdgcn_mfma_f32_16x16x32_bf16(b.k[1], a.k[1], c, 0, 0, 0); }
#ifndef FP8_ASM
#define FP8_ASM 1
#endif
#if FP8_ASM
__device__ __forceinline__ f32x4 mma_frag(const Frag<1>& b, const Frag<1>& a, f32x4 c) { asm volatile("v_mfma_f32_16x16x128_f8f6f4 %0, %1, %2, %0" : "+v"(c) : "v"(b.v), "v"(a.v)); return c; }
#else
__device__ __forceinline__ f32x4 mma_frag(const Frag<1>& b, const Frag<1>& a, f32x4 c) { return __builtin_amdgcn_mfma_scale_f32_16x16x128_f8f6f4(b.v, a.v, c, 0, 0, 0, 0, 0, 0); }
#endif
template <class Epi, class Sched, int ES  >
__device__ __forceinline__ void gemm_fast(LAS unsigned char* lds, int wave, const Gemm g, const Sched& S, const Epi& E) {
    const int wid = launder_s(wave), lane = lane_id_v(), tid = wid * 64 + lane, wr = wid >> 2, wc = wid & 3, fr = lane & 15, fq = lane >> 4;
    const int K = launder_s(g.K), nt = K * ES / (BK * 2);
    unsigned voffB[2];
#pragma unroll
    for (int i = 0; i < 2; ++i) { int R, C; stage_rc(tid * 16 + i * 8192, R, C); const int Rb = Epi::PERM ? ((R & ~31) + perm32(R & 31)) : R; voffB[i] = (unsigned)Rb * (unsigned)g.ldb * (unsigned)ES + (unsigned)C * 2u; }
    const size_t kstep = (size_t)(BK * 2);
    const size_t hstepB = (size_t)HALF * g.ldb * ES;
    const unsigned ldsw = (unsigned)wid * 1024u;
    const int aoff = lds_byte(wr * 64 + fr, fq * 8), boff = lds_byte(wc * 32 + fr, fq * 8);
    const char* const Abase = (const char*)g.A; const char* const Bbase = (const char*)g.Bt;
#define PG8_SA(b, h) (((b) * 2 + (h)) * HTB)
#define PG8_SB(b, h) ((4 + (b) * 2 + (h)) * HTB)
#define PG8_STAGE_A(bufoff, ao, kb) do { _Pragma("unroll") for (int _i = 0; _i < 2; ++_i) \
        __builtin_amdgcn_global_load_lds((const unsigned*)(Abase + (size_t)(ao)[_i] + (size_t)(kb)), (LAS unsigned*)(lds + (bufoff) + ldsw + _i * 8192), 16, 0, 0); } while (0)
#define PG8_STAGE_B(bufoff, gbase) do { _Pragma("unroll") for (int _i = 0; _i < 2; ++_i) \
        __builtin_amdgcn_global_load_lds((const unsigned*)((const char*)(gbase) + voffB[_i]), (LAS unsigned*)(lds + (bufoff) + ldsw + _i * 8192), 16, 0, 0); } while (0)
#define PG8_LDA(dst, b, h) do { _Pragma("unroll") for (int m = 0; m < 4; ++m) ld_frag(dst[m], lds + PG8_SA(b, h) + aoff + m * 2048); } while (0)
#define PG8_LDB(dst, b, h) do { _Pragma("unroll") for (int n = 0; n < 2; ++n) ld_frag(dst[n], lds + PG8_SB(b, h) + boff + n * 2048); } while (0)
#define PG8_MMA(ai, bj, At, Bt) do { __builtin_amdgcn_s_setprio(1); _Pragma("unroll") for (int m = 0; m < 4; ++m) _Pragma("unroll") for (int n = 0; n < 2; ++n) acc[ai][bj][m][n] = mma_frag(Bt[n], At[m], acc[ai][bj][m][n]); \
        __builtin_amdgcn_s_setprio(0); } while (0)
#define PG8_WAIT_V(n) asm volatile("s_waitcnt vmcnt(" #n ")" ::: "memory")
#define PG8_WAIT_L(n) asm volatile("s_waitcnt lgkmcnt(" #n ")" ::: "memory")
#define PG8_BAR __builtin_amdgcn_s_barrier()
#define PG8_SCHED __builtin_amdgcn_sched_barrier(0)
#define PG8_AOFFS(u, ao) do { if (g.gather) { const int* _gp = g.gather + (size_t)(u).e * T + (u).slot0; const int _nv1 = (u).nvalid - 1; int _tk[2][2]; \
            _Pragma("unroll") for (int _h = 0; _h < 2; ++_h) _Pragma("unroll") for (int _i = 0; _i < 2; ++_i) { int _R, _C; stage_rc(tid * 16 + _i * 8192, _R, _C); const int _rl = _h * HALF + _R; _tk[_h][_i] = _gp[_rl < _nv1 ? _rl : _nv1]; } \
            _Pragma("unroll") for (int _h = 0; _h < 2; ++_h) _Pragma("unroll") for (int _i = 0; _i < 2; ++_i) { int _R, _C; stage_rc(tid * 16 + _i * 8192, _R, _C); ao[_h][_i] = (unsigned)(_tk[_h][_i] >> 2) * (unsigned)g.lda * (unsigned)ES + (unsigned)_C * 2u; } } \
        else { _Pragma("unroll") for (int _h = 0; _h < 2; ++_h) _Pragma("unroll") for (int _i = 0; _i < 2; ++_i) { int _R, _C; stage_rc(tid * 16 + _i * 8192, _R, _C); ao[_h][_i] = ((u).aoff + (unsigned)(_h * HALF + _R) * (unsigned)g.lda) * (unsigned)ES + (unsigned)_C * 2u; } } } while (0)
    Unit cur, nxt; int ui = 0; cur.e = 0;
    if (!S.next(0, cur)) return;
    constexpr bool PROF = (PROF_REGION != 0) && ((PROF_SITES >> Epi::SITE_ID) & 1);
    unsigned long long prof_acc = 0, prof_t0 = (PROF && PROF_REGION == 1) ? __builtin_amdgcn_s_memrealtime() : 0ull;
#define PG8_PROF(r, begin) do { if (PROF && PROF_REGION == (r) && wid == 0) { const unsigned long long _t = __builtin_amdgcn_s_memrealtime(); if (begin) prof_t0 = _t; else prof_acc += _t - prof_t0; } } while (0)
    f32x4 acc[2][2][4][2];
#pragma unroll
    for (int a = 0; a < 2; ++a)
#pragma unroll
        for (int b = 0; b < 2; ++b)
#pragma unroll
            for (int m = 0; m < 4; ++m)
#pragma unroll
                for (int n = 0; n < 2; ++n) acc[a][b][m][n] = (f32x4){0.f, 0.f, 0.f, 0.f};
    Frag<ES> At[4], B0[2], B1[2];
    unsigned aC[2][2], aN[2][2];
    PG8_AOFFS(cur, aC);
    if constexpr (epi_has_pre<Epi>::value) E.prefetch(lds + META_OFF, cur, wid, lane);
    const char* cB = Bbase + (size_t)cur.boff * ES;
    PG8_STAGE_B(PG8_SB(0, 0), cB); PG8_STAGE_B(PG8_SB(0, 1), cB + hstepB); PG8_STAGE_A(PG8_SA(0, 0), aC[0], 0); PG8_STAGE_A(PG8_SA(0, 1), aC[1], 0);
    if (wr == 1) PG8_BAR;
    PG8_WAIT_V(2); PG8_BAR;
    PG8_STAGE_B(PG8_SB(1, 0), cB + kstep); PG8_STAGE_A(PG8_SA(1, 0), aC[0], kstep); PG8_STAGE_B(PG8_SB(1, 1), cB + hstepB + kstep);
    PG8_WAIT_V(6); PG8_BAR;
    for (;;) {
        nxt.e = cur.e;
        const bool has_next = S.next(ui + 1, nxt);
        if (has_next) { PG8_AOFFS(nxt, aN); } else {
#pragma unroll
            for (int h = 0; h < 2; ++h)
#pragma unroll
                for (int i = 0; i < 2; ++i) aN[h][i] = aC[h][i]; }
        const char* nB = has_next ? Bbase + (size_t)nxt.boff * ES : cB;
        PG8_PROF(1, false); PG8_PROF(2, true);
#pragma unroll 1
        for (int t = 0; t < nt; t += 2) {
            const bool last = (t == nt - 2);
            const size_t k1 = (size_t)(t + 1) * kstep, k2 = last ? 0 : (size_t)(t + 2) * kstep, k3 = k2 + kstep;
            unsigned a2[2][2];
#pragma unroll
            for (int h = 0; h < 2; ++h)
#pragma unroll
                for (int i = 0; i < 2; ++i) a2[h][i] = last ? aN[h][i] : aC[h][i];
            const char* b2 = last ? nB : cB + (size_t)(t + 2) * kstep; const char* b3 = b2 + kstep;
            PG8_LDB(B0, 0, 0); PG8_LDB(B1, 0, 1); PG8_SCHED; PG8_LDA(At, 0, 0); PG8_STAGE_A(PG8_SA(1, 1), aC[1], k1);
            PG8_WAIT_V(8); PG8_WAIT_L(0); PG8_BAR; PG8_MMA(0, 0, At, B0); PG8_MMA(0, 1, At, B1); PG8_BAR; PG8_SCHED;
            PG8_LDA(At, 0, 1); PG8_STAGE_B(PG8_SB(0, 0), b2); PG8_STAGE_B(PG8_SB(0, 1), b2 + hstepB); PG8_STAGE_A(PG8_SA(0, 0), a2[0], k2);
            PG8_WAIT_V(8); PG8_WAIT_L(0); PG8_BAR; PG8_MMA(1, 0, At, B0); PG8_MMA(1, 1, At, B1); PG8_BAR; PG8_SCHED;
            PG8_LDB(B0, 1, 0); PG8_LDB(B1, 1, 1); PG8_SCHED; PG8_LDA(At, 1, 0); PG8_STAGE_A(PG8_SA(0, 1), a2[1], k2);
            PG8_WAIT_V(8); PG8_WAIT_L(0); PG8_BAR; PG8_MMA(0, 0, At, B0); PG8_MMA(0, 1, At, B1); PG8_BAR; PG8_SCHED;
            PG8_LDA(At, 1, 1); PG8_STAGE_B(PG8_SB(1, 0), b3); PG8_STAGE_B(PG8_SB(1, 1), b3 + hstepB); PG8_STAGE_A(PG8_SA(1, 0), a2[0], k3);
            PG8_WAIT_V(8); PG8_WAIT_L(0); PG8_BAR; PG8_MMA(1, 0, At, B0); PG8_MMA(1, 1, At, B1); PG8_BAR; PG8_SCHED;
        }
        PG8_PROF(2, false); PG8_PROF(1, true);
        if constexpr (ES == 1 && FP8_ASM) asm volatile("s_nop 15\n\ts_nop 15\n\ts_nop 15" ::: "memory");
        if (wr == 0) PG8_BAR;
        if constexpr (epi_has_pre<Epi>::value) E.epi_lds(acc, cur, wr, wc, fr, fq, lds + META_OFF + (ui & 1) * META_BYTES); else E(acc, cur, wr, wc, fr, fq);
        if (!has_next) break;
#pragma unroll
        for (int a = 0; a < 2; ++a)
#pragma unroll
            for (int b = 0; b < 2; ++b)
#pragma unroll
                for (int m = 0; m < 4; ++m)
#pragma unroll
                    for (int n = 0; n < 2; ++n) acc[a][b][m][n] = (f32x4){0.f, 0.f, 0.f, 0.f};
        cur = nxt; cB = nB; ++ui;
        if constexpr (epi_has_pre<Epi>::value) E.prefetch(lds + META_OFF + (ui & 1) * META_BYTES, cur, wid, lane);
#pragma unroll
        for (int h = 0; h < 2; ++h)
#pragma unroll
            for (int i = 0; i < 2; ++i) aC[h][i] = aN[h][i];
        if (wr == 1) PG8_BAR;
    }
    PG8_WAIT_V(0);
    if (PROF && wid == 0) { PG8_PROF(1, false); if (lane == 0) { volatile LAS unsigned* pw = (volatile LAS unsigned*)(lds + LDSCTL_OFF) + MISC_PROF; *pw = *pw + (unsigned)prof_acc; } }
    PG8_BAR;
#undef PG8_SA
#undef PG8_SB
#undef PG8_STAGE_A
#undef PG8_STAGE_B
#undef PG8_LDA
#undef PG8_LDB
#undef PG8_MMA
#undef PG8_WAIT_V
#undef PG8_WAIT_L
#undef PG8_BAR
#undef PG8_SCHED
#undef PG8_AOFFS
#undef PG8_PROF
}

template <class Epi, class Sched, int SITE>
__device__ __forceinline__ void gemm_phase(LAS unsigned char* lds, int wave, const Gemm g, const Sched& S, const Epi& E) {
    if constexpr (Epi::ES == 1) gemm_fast<Epi, Sched, 1>(lds, wave, g, S, E);
    else if constexpr ((FAST_MASK >> SITE) & 1) gemm_fast<Epi, Sched, 2>(lds, wave, g, S, E); else gemm_simple<Epi, Sched>(wave, g, S, E);
}
}

struct Frame {
    LAS unsigned char* lds;
    volatile LAS unsigned* MISC;
    unsigned* ctl;
    int tid, lane, wave, vcu, G;
};
struct Args { const float* in[21]; float* out; unsigned char* ws; int ph_lo, ph_hi; };
static_assert(sizeof(Args) == 21 * 8 + 8 + 8 + 8, "Args has no padding");

__device__ __forceinline__ void mods_phase(Frame& F, const float* c, const float* ada_w, const float* ada_b, float* MOD) {
    LAS float* cact = (LAS float*)F.lds;
    LAS float* part = (LAS float*)(F.lds + 8192);
    for (int i = F.tid; i < BATCH * D; i += NTHREADS) { const float v = c[i]; cact[i] = v * fast_sigmoid(v); }
    __syncthreads();
    constexpr int NTASK = DEPTH * (6 * D / 64);
    for (int task = F.vcu; task < NTASK; task += F.G) {
        const int l = task / (6 * D / 64), j0 = (task % (6 * D / 64)) * 64;
        const float* w = ada_w + (size_t)l * D * (6 * D) + j0 + F.lane;
        const int k0 = F.wave * 128;
        float a0 = 0.f, a1 = 0.f;
#pragma unroll 16
        for (int k = 0; k < 128; ++k) { const float wv = w[(size_t)(k0 + k) * (6 * D)]; a0 += cact[k0 + k] * wv; a1 += cact[D + k0 + k] * wv; }
        part[(F.wave * 2 + 0) * 64 + F.lane] = a0; part[(F.wave * 2 + 1) * 64 + F.lane] = a1;
        __syncthreads();
        if (F.tid < 128) { const int b = F.tid >> 6, j = F.tid & 63; float s = 0.f;
#pragma unroll
            for (int w8 = 0; w8 < 8; ++w8) s += part[(w8 * 2 + b) * 64 + j];
            MOD[((size_t)l * BATCH + b) * (6 * D) + j0 + j] = s + ada_b[(size_t)l * (6 * D) + j0 + j]; }
        __syncthreads();
    }
}
__device__ __forceinline__ void tr_item(const float* W, int ldw, bf16_t* WT, int ldt, int k0, int n0, int drow0, int dcol0, LAS float* scr, int lane) {
#pragma unroll 8
    for (int i = 0; i < 32; ++i) { const int kk = 2 * i + (lane >> 5); scr[kk * 33 + (lane & 31)] = W[(size_t)(k0 + kk) * ldw + n0 + (lane & 31)]; }
    LDS_WAIT(); asm volatile("" ::: "memory");
    const int c = lane & 7;
#pragma unroll
    for (int j = 0; j < 4; ++j) { const int n = (lane >> 3) + 8 * j; const LAS float* s = scr + (8 * c) * 33 + n;
        u32x4 o; o.x = pk2(s[0 * 33], s[1 * 33]); o.y = pk2(s[2 * 33], s[3 * 33]); o.z = pk2(s[4 * 33], s[5 * 33]); o.w = pk2(s[6 * 33], s[7 * 33]);
        *(u32x4*)(WT + (size_t)(drow0 + n) * ldt + dcol0 + k0 + 8 * c) = o; }
    LDS_WAIT(); asm volatile("" ::: "memory");
}
__device__ __forceinline__ void tr_item8(const float* W, int ldw, unsigned char* WT, int ldt, int k0, int n0, int drow0, float scale, LAS float* scr, int lane) {
#pragma unroll 8
    for (int i = 0; i < 32; ++i) { const int kk = 2 * i + (lane >> 5); scr[kk * 33 + (lane & 31)] = W[(size_t)(k0 + kk) * ldw + n0 + (lane & 31)]; }
    LDS_WAIT(); asm volatile("" ::: "memory");
    const int c = lane & 3;
#pragma unroll
    for (int j = 0; j < 2; ++j) { const int n = (lane >> 2) + 16 * j; const LAS float* sp = scr + (16 * c) * 33 + n;
        u32x4 o; o.x = pk4_fp8(sp[0 * 33] * scale, sp[1 * 33] * scale, sp[2 * 33] * scale, sp[3 * 33] * scale); o.y = pk4_fp8(sp[4 * 33] * scale, sp[5 * 33] * scale, sp[6 * 33] * scale, sp[7 * 33] * scale);
        o.z = pk4_fp8(sp[8 * 33] * scale, sp[9 * 33] * scale, sp[10 * 33] * scale, sp[11 * 33] * scale); o.w = pk4_fp8(sp[12 * 33] * scale, sp[13 * 33] * scale, sp[14 * 33] * scale, sp[15 * 33] * scale);
        *(u32x4*)(WT + (size_t)(drow0 + n) * ldt + k0 + 16 * c) = o; }
    LDS_WAIT(); asm volatile("" ::: "memory");
}
__device__ __forceinline__ int win_drow(int n0) {
    if (n0 < 512) return n0; if (n0 < 768) return 3328 + (n0 - 512); if (n0 < 1536) return 512 + (n0 - 768); return 1280 + (n0 - 1536);
}
typedef const volatile __attribute__((address_space(4))) Args* KArgs;
__device__ __forceinline__ void convert_phase(Frame& F, KArgs ka) {
    unsigned char* wsb = (unsigned char*)ka->ws; const float *in8 = (const float*)ka->in[8], *in9 = (const float*)ka->in[9], *in12 = (const float*)ka->in[12], *in13 = (const float*)ka->in[13], *in14 = (const float*)ka->in[14], *in15 = (const float*)ka->in[15], *in17 = (const float*)ka->in[17], *in19 = (const float*)ka->in[19];
    LAS float* scr = (LAS float*)(F.lds + F.wave * 16384);
    const int gw = F.vcu * NWAVES + F.wave, NGW = F.G * NWAVES;
    constexpr int I_IN = 16 * 112, I_BRA = 4 * 32, I_BRP = 12 * 32, I_OUT = 16 * 32, I_RT = 16, I_PL = 4 * 3 * 6, I_GU = NE * 16 * 64, I_DN = NE * 16 * 32;
    constexpr int I_LAYER = I_IN + I_BRA + I_BRP + I_OUT + I_RT + I_PL + I_GU + I_DN;
    for (int it = gw; it < DEPTH * I_LAYER; it += NGW) {
        const int l = it / I_LAYER; int r = it % I_LAYER;
        unsigned char* wl = wsb + WS_W + (size_t)l * WL_STRIDE;
        if (r < I_GU) { const int e = r / (16 * 64), q = r % (16 * 64), kb = q / 64, nb = q % 64, n0 = nb * 32, half = n0 / D, cc = n0 % D;
            tr_item8(in17 + ((size_t)l * NE + e) * D * (2 * D), 2 * D, (unsigned char*)(wl + WO_GU) + (size_t)e * (2 * D) * D, D, kb * 64, n0, (cc / 128) * 256 + half * 128 + (cc % 128), W8_SCALE, scr, F.lane); continue; } r -= I_GU;
        if (r < I_DN) { const int e = r / (16 * 32), q = r % (16 * 32), kb = q / 32, nb = q % 32;
            tr_item8(in19 + ((size_t)l * NE + e) * D * D, D, (unsigned char*)(wl + WO_DN) + (size_t)e * D * D, D, kb * 64, nb * 32, nb * 32, W8_SCALE, scr, F.lane); continue; } r -= I_DN;
        if (r < I_IN) { const int kb = r / 112, nb = r % 112;
            tr_item(in8 + (size_t)l * D * INW, INW, (bf16_t*)(wl + WO_WIN), D, kb * 64, nb * 32, win_drow(nb * 32), 0, scr, F.lane); continue; } r -= I_IN;
        if (r < I_BRA) { const int kb = r / 32, nb = r % 32;
            tr_item(in12 + (size_t)l * SBW * D, D, (bf16_t*)(wl + WO_BRA), SBW, kb * 64, nb * 32, nb * 32, 0, scr, F.lane); continue; } r -= I_BRA;
        if (r < I_BRP) { const int kb = r / 32, nb = r % 32;
            tr_item(in13 + (size_t)l * PW * D, D, (bf16_t*)(wl + WO_BRP), PW, kb * 64, nb * 32, nb * 32, 0, scr, F.lane); continue; } r -= I_BRP;
        if (r < I_OUT) { const int kb = r / 32, nb = r % 32;
            tr_item(in14 + (size_t)l * D * D, D, (bf16_t*)(wl + WO_OUT), D, kb * 64, nb * 32, nb * 32, 0, scr, F.lane); continue; } r -= I_OUT;
        if (r < I_RT) { tr_item(in15 + (size_t)l * D * NE, NE, (bf16_t*)(wl + WO_ROUTER), D, r * 64, 0, 0, 0, scr, F.lane); continue; } r -= I_RT;
        { const int gidx = r / 18, q = r % 18, kb = q / 6, nb = q % 6;
            tr_item(in9 + ((size_t)l * 4 + gidx) * PGD * PGD, PGD, (bf16_t*)(wl + WO_POOL), PW, kb * 64, nb * 32, gidx * PGD + nb * 32, gidx * PGD, scr, F.lane); }
    }
    for (int it = gw; it < DEPTH * PW; it += NGW) { const int l = it / PW, n = it % PW, gidx = n / PGD;
        bf16_t* rowp = (bf16_t*)(wsb + WS_W + (size_t)l * WL_STRIDE + WO_POOL) + (size_t)n * PW;
        for (int ch = F.lane; ch < PW / 8; ch += 64) if (ch / (PGD / 8) != gidx) *(u32x4*)(rowp + ch * 8) = (u32x4){0u, 0u, 0u, 0u}; }
}

struct Row16 { f32x4 a[4]; };
__device__ __forceinline__ void ld_row_f32(const float* p, int lane, Row16& v) {
#pragma unroll
    for (int j = 0; j < 2; ++j) { v.a[2 * j] = *(const f32x4*)(p + 8 * lane + 512 * j); v.a[2 * j + 1] = *(const f32x4*)(p + 8 * lane + 512 * j + 4); } }
__device__ __forceinline__ void st_row_f32(float* p, int lane, const Row16& v) {
#pragma unroll
    for (int j = 0; j < 2; ++j) { *(f32x4*)(p + 8 * lane + 512 * j) = v.a[2 * j]; *(f32x4*)(p + 8 * lane + 512 * j + 4) = v.a[2 * j + 1]; } }
__device__ __forceinline__ void ld_row_bf16(const bf16_t* p, int lane, u32x4 (&w)[2]) {
#pragma unroll
    for (int j = 0; j < 2; ++j) w[j] = *(const u32x4*)(p + 8 * lane + 512 * j); }
__device__ __forceinline__ void acc_row_bf16(const u32x4 (&w)[2], Row16& y) {
#pragma unroll
    for (int j = 0; j < 2; ++j) { f32x4 lo, hi; pg8::unpack8(w[j], lo, hi); y.a[2 * j] = y.a[2 * j] + lo; y.a[2 * j + 1] = y.a[2 * j + 1] + hi; } }
__device__ __forceinline__ void ld_row_x(const void* base, bool is_bf16, size_t row, int lane, Row16& v) {
    if (is_bf16) { u32x4 w[2]; ld_row_bf16((const bf16_t*)base + row * D, lane, w);
#pragma unroll
        for (int i = 0; i < 4; ++i) v.a[i] = (f32x4){0.f, 0.f, 0.f, 0.f};
        acc_row_bf16(w, v); }
    else ld_row_f32((const float*)base + row * D, lane, v); }
__device__ __forceinline__ void st_row_x(void* base, bool is_bf16, size_t row, int lane, const Row16& v) {
    if (is_bf16) {
#pragma unroll
        for (int j = 0; j < 2; ++j) { u32x4 w; w.x = pk2(v.a[2 * j].x, v.a[2 * j].y); w.y = pk2(v.a[2 * j].z, v.a[2 * j].w); w.z = pk2(v.a[2 * j + 1].x, v.a[2 * j + 1].y); w.w = pk2(v.a[2 * j + 1].z, v.a[2 * j + 1].w);
            *(u32x4*)((bf16_t*)base + row * D + 8 * lane + 512 * j) = w; } }
    else st_row_f32((float*)base + row * D, lane, v); }
__device__ __forceinline__ float row_sumsq(const Row16& v) { float ss = 0.f;
#pragma unroll
    for (int q = 0; q < 4; ++q) ss += (v.a[q].x * v.a[q].x + v.a[q].y * v.a[q].y) + (v.a[q].z * v.a[q].z + v.a[q].w * v.a[q].w);
    return ss; }
__device__ __forceinline__ void norm_mod_store(const Row16& v, float ss_wave, const Row16& gg, const Row16& s1, const Row16& s0, bf16_t* hrow, int lane, unsigned char* h8row = nullptr) {
    const float r = 1.0f / sqrtf(ss_wave * (1.0f / D) + NORM_EPS);
#pragma unroll
    for (int j = 0; j < 2; ++j) { const f32x4 o0 = v.a[2 * j] * r * gg.a[2 * j] * (s1.a[2 * j] + 1.0f) + s0.a[2 * j], o1 = v.a[2 * j + 1] * r * gg.a[2 * j + 1] * (s1.a[2 * j + 1] + 1.0f) + s0.a[2 * j + 1];
        u32x4 w; w.x = pk2(o0.x, o0.y); w.y = pk2(o0.z, o0.w); w.z = pk2(o1.x, o1.y); w.w = pk2(o1.z, o1.w); *(u32x4*)(hrow + 8 * lane + 512 * j) = w;
        if (h8row) { u32x2 q; q.x = pk4_fp8(o0.x, o0.y, o0.z, o0.w); q.y = pk4_fp8(o1.x, o1.y, o1.z, o1.w); *(u32x2*)(h8row + 8 * lane + 512 * j) = q; } }
}
constexpr int RP = 2;
__device__ __forceinline__ void rowpass_pre(Frame& F, const float* x, const float* g, const float* MODl, bf16_t* H) {
    const int gw = F.vcu * NWAVES + F.wave, NGW = F.G * NWAVES;
    Row16 gg; ld_row_f32(g, F.lane, gg);
    for (int row0 = gw * RP; row0 < T; row0 += NGW * RP) { const int b = row0 / SEQ; const float* mod = MODl + (size_t)b * 6 * D;
        Row16 v[RP], s1, s0; float ss[RP];
#pragma unroll
        for (int q = 0; q < RP; ++q) ld_row_f32(x + (size_t)(row0 + q) * D, F.lane, v[q]);
        ld_row_f32(mod + 1 * D, F.lane, s1); ld_row_f32(mod + 0 * D, F.lane, s0);
#pragma unroll
        for (int q = 0; q < RP; ++q) ss[q] = row_sumsq(v[q]);
#pragma unroll
        for (int o = 1; o < 64; o <<= 1) {
#pragma unroll
            for (int q = 0; q < RP; ++q) ss[q] += __shfl_xor(ss[q], o); }
#pragma unroll
        for (int q = 0; q < RP; ++q) norm_mod_store(v[q], ss[q], gg, s1, s0, H + (size_t)(row0 + q) * D, F.lane); }
}
__device__ __forceinline__ void rowpass_mid(Frame& F, int row_begin, int row_end, int row_step, const void* xin, bool xin_bf16, bf16_t* xout, const bf16_t* Y, const float* post_g, const float* pre2_g, const float* MODl, bf16_t* H, unsigned char* H8) {
    for (int row0 = row_begin; row0 < row_end; row0 += row_step) { const int b = row0 / SEQ; const float* mod = MODl + (size_t)b * 6 * D;
        Row16 v[RP], y[RP]; float ss[RP];
#pragma unroll
        for (int q = 0; q < RP; ++q) { ld_row_x(xin, xin_bf16, (size_t)(row0 + q), F.lane, v[q]); u32x4 w[2]; ld_row_bf16(Y + (size_t)(row0 + q) * D, F.lane, w);
#pragma unroll
            for (int i = 0; i < 4; ++i) y[q].a[i] = (f32x4){0.f, 0.f, 0.f, 0.f};
            acc_row_bf16(w, y[q]); }
        { Row16 pg, g1; ld_row_f32(post_g, F.lane, pg); ld_row_f32(mod + 2 * D, F.lane, g1);
#pragma unroll
            for (int q = 0; q < RP; ++q) ss[q] = row_sumsq(y[q]);
#pragma unroll
            for (int o = 1; o < 64; o <<= 1) {
#pragma unroll
                for (int q = 0; q < RP; ++q) ss[q] += __shfl_xor(ss[q], o); }
#pragma unroll
            for (int q = 0; q < RP; ++q) { const float r = 1.0f / sqrtf(ss[q] * (1.0f / D) + NORM_EPS);
#pragma unroll
                for (int i = 0; i < 4; ++i) v[q].a[i] = v[q].a[i] + g1.a[i] * (y[q].a[i] * r * pg.a[i]);
                st_row_x(xout, true, (size_t)(row0 + q), F.lane, v[q]); } }
        { Row16 gg, s1, s0; ld_row_f32(pre2_g, F.lane, gg); ld_row_f32(mod + 4 * D, F.lane, s1); ld_row_f32(mod + 3 * D, F.lane, s0);
#pragma unroll
            for (int q = 0; q < RP; ++q) ss[q] = row_sumsq(v[q]);
#pragma unroll
            for (int o = 1; o < 64; o <<= 1) {
#pragma unroll
                for (int q = 0; q < RP; ++q) ss[q] += __shfl_xor(ss[q], o); }
#pragma unroll
            for (int q = 0; q < RP; ++q) norm_mod_store(v[q], ss[q], gg, s1, s0, H + (size_t)(row0 + q) * D, F.lane, H8 + (size_t)(row0 + q) * D); } }
}
__device__ __forceinline__ void rowpass_comb(Frame& F, const bf16_t* x, void* xout, bool xout_bf16, const bf16_t* YR4, const float* post_g, const float* MODl,
                                             bool has_next, const float* pre1_g_next, const float* MODn, bf16_t* H) {
    const int gw = F.vcu * NWAVES + F.wave, NGW = F.G * NWAVES;
    for (int row0 = gw * RP; row0 < T; row0 += NGW * RP) { const int b = row0 / SEQ; const float* mod = MODl + (size_t)b * 6 * D;
        Row16 v[RP], y[RP]; float ss[RP]; u32x4 w[RP][TOPK][2];
#pragma unroll
        for (int q = 0; q < RP; ++q) { ld_row_x(x, true, (size_t)(row0 + q), F.lane, v[q]);
#pragma unroll
            for (int k = 0; k < TOPK; ++k) ld_row_bf16(YR4 + ((size_t)(row0 + q) * TOPK + k) * D, F.lane, w[q][k]); }
#pragma unroll
        for (int q = 0; q < RP; ++q) {
#pragma unroll
            for (int i = 0; i < 4; ++i) y[q].a[i] = (f32x4){0.f, 0.f, 0.f, 0.f};
#pragma unroll
            for (int k = 0; k < TOPK; ++k) acc_row_bf16(w[q][k], y[q]); }
        { Row16 pg, g2; ld_row_f32(post_g, F.lane, pg); ld_row_f32(mod + 5 * D, F.lane, g2);
#pragma unroll
            for (int q = 0; q < RP; ++q) ss[q] = row_sumsq(y[q]);
#pragma unroll
            for (int o = 1; o < 64; o <<= 1) {
#pragma unroll
                for (int q = 0; q < RP; ++q) ss[q] += __shfl_xor(ss[q], o); }
#pragma unroll
            for (int q = 0; q < RP; ++q) { const float r = 1.0f / sqrtf(ss[q] * (1.0f / D) + NORM_EPS);
#pragma unroll
                for (int i = 0; i < 4; ++i) v[q].a[i] = v[q].a[i] + g2.a[i] * (y[q].a[i] * r * pg.a[i]);
                st_row_x(xout, xout_bf16, (size_t)(row0 + q), F.lane, v[q]); } }
        if (has_next) { const float* modn = MODn + (size_t)b * 6 * D; Row16 gg, s1, s0; ld_row_f32(pre1_g_next, F.lane, gg); ld_row_f32(modn + 1 * D, F.lane, s1); ld_row_f32(modn + 0 * D, F.lane, s0);
#pragma unroll
            for (int q = 0; q < RP; ++q) ss[q] = row_sumsq(v[q]);
#pragma unroll
            for (int o = 1; o < 64; o <<= 1) {
#pragma unroll
                for (int q = 0; q < RP; ++q) ss[q] += __shfl_xor(ss[q], o); }
#pragma unroll
            for (int q = 0; q < RP; ++q) norm_mod_store(v[q], ss[q], gg, s1, s0, H + (size_t)(row0 + q) * D, F.lane); } }
}

__device__ __forceinline__ void attn_phase(Frame& F, const bf16_t* Q, const bf16_t* KB, const bf16_t* VT, bf16_t* AP) {
    const int gw = F.vcu * NWAVES + F.wave, NGW = F.G * NWAVES;
    const int r = F.lane & 31, hh = F.lane >> 5;
    constexpr int NQT = SEQ / 32, NTASK = BATCH * NH * NQT;
    for (int task = gw; task < NTASK; task += NGW) {
        const int qt = task % NQT, h = (task / NQT) % NH, b = task / (NQT * NH), q0 = qt * 32;
        const size_t trow0 = (size_t)b * SEQ;
        bf16x8 qf[4];
#pragma unroll
        for (int ks = 0; ks < 4; ++ks) qf[ks] = *(const bf16x8*)(Q + (trow0 + q0 + r) * SBW + h * HD + ks * 16 + hh * 8);
        f32x16 o0, o1;
#pragma unroll
        for (int i = 0; i < 16; ++i) { o0[i] = 0.f; o1[i] = 0.f; }
        float C = 0.f;
        bf16x8 kf[4], kn[4]; s16x4 vlo[2][2], vhi[2][2], nlo[2][2], nhi[2][2];
#define ATT_LOAD(KF, VLO, VHI, kb_) do { const bf16_t* kp_ = KB + (trow0 + (kb_) + r) * SBW + h * HD + hh * 8; \
            _Pragma("unroll") for (int ks = 0; ks < 4; ++ks) KF[ks] = *(const bf16x8*)(kp_ + ks * 16); \
            _Pragma("unroll") for (int st = 0; st < 2; ++st) _Pragma("unroll") for (int dt = 0; dt < 2; ++dt) { const bf16_t* vp_ = VT + (size_t)(h * HD + dt * 32 + r) * VTP + trow0 + (kb_) + 16 * st + 4 * hh; VLO[st][dt] = *(const s16x4*)vp_; VHI[st][dt] = *(const s16x4*)(vp_ + 8); } } while (0)
        ATT_LOAD(kf, vlo, vhi, q0);
        for (int kb = q0; kb >= 0; kb -= 32) {
            const bool diag = (kb == q0);
            { const int nkb = kb >= 32 ? kb - 32 : 0; ATT_LOAD(kn, nlo, nhi, nkb); }
            f32x16 s;
#pragma unroll
            for (int i = 0; i < 16; ++i) s[i] = 0.f;
#pragma unroll
            for (int ks = 0; ks < 4; ++ks) s = __builtin_amdgcn_mfma_f32_32x32x16_bf16(kf[ks], qf[ks], s, 0, 0, 0);
            float lk[16];
#pragma unroll
            for (int i = 0; i < 16; ++i) { const int kc = 8 * (i >> 2) + 4 * hh + (i & 3); const bool valid = !diag || (kc < r); lk[i] = valid ? -softplus_f(s[i]) : 0.f; }
            float rt[4], pt[4], both[4];
#pragma unroll
            for (int gq = 0; gq < 4; ++gq) { lk[4 * gq + 2] += lk[4 * gq + 3]; lk[4 * gq + 1] += lk[4 * gq + 2]; lk[4 * gq + 0] += lk[4 * gq + 1]; rt[gq] = lk[4 * gq]; }
#pragma unroll
            for (int gq = 0; gq < 4; ++gq) { pt[gq] = __shfl_xor(rt[gq], 32); both[gq] = rt[gq] + pt[gq]; }
            float after[4]; after[3] = 0.f; after[2] = both[3]; after[1] = both[3] + both[2]; after[0] = after[1] + both[1];
            f32x16 a;
#pragma unroll
            for (int gq = 0; gq < 4; ++gq) { const float off = after[gq] + (hh == 0 ? pt[gq] : 0.f) + C;
#pragma unroll
                for (int j = 0; j < 4; ++j) { const int i = 4 * gq + j, kc = 8 * gq + 4 * hh + j; const bool valid = !diag || (kc < r);
                    a[i] = valid ? fast_exp(s[i] + lk[i] + off) : 0.f; } }
            C += both[0] + after[0];
#pragma unroll
            for (int st = 0; st < 2; ++st) {
                u32x4 pw; pw.x = pk2(a[8 * st + 0], a[8 * st + 1]); pw.y = pk2(a[8 * st + 2], a[8 * st + 3]); pw.z = pk2(a[8 * st + 4], a[8 * st + 5]); pw.w = pk2(a[8 * st + 6], a[8 * st + 7]);
                const bf16x8 pb = __builtin_bit_cast(bf16x8, pw);
                const bf16x8 va0 = __builtin_shufflevector(vlo[st][0], vhi[st][0], 0, 1, 2, 3, 4, 5, 6, 7), va1 = __builtin_shufflevector(vlo[st][1], vhi[st][1], 0, 1, 2, 3, 4, 5, 6, 7);
                o0 = __builtin_amdgcn_mfma_f32_32x32x16_bf16(va0, pb, o0, 0, 0, 0);
                o1 = __builtin_amdgcn_mfma_f32_32x32x16_bf16(va1, pb, o1, 0, 0, 0);
            }
            if (__all(C < STICK_EXIT)) break;
#pragma unroll
            for (int ks = 0; ks < 4; ++ks) kf[ks] = kn[ks];
#pragma unroll
            for (int st = 0; st < 2; ++st)
#pragma unroll
                for (int dt = 0; dt < 2; ++dt) { vlo[st][dt] = nlo[st][dt]; vhi[st][dt] = nhi[st][dt]; }
        }
#undef ATT_LOAD
        bf16_t* orow = AP + (trow0 + q0 + r) * D + h * HD;
#pragma unroll
        for (int gq = 0; gq < 4; ++gq) { u32x2 w0, w1; w0.x = pk2(o0[4 * gq], o0[4 * gq + 1]); w0.y = pk2(o0[4 * gq + 2], o0[4 * gq + 3]); w1.x = pk2(o1[4 * gq], o1[4 * gq + 1]); w1.y = pk2(o1[4 * gq + 2], o1[4 * gq + 3]);
            *(u32x2*)(orow + 8 * gq + 4 * hh) = w0; *(u32x2*)(orow + 32 + 8 * gq + 4 * hh) = w1; }
    }
}

__device__ __forceinline__ void ld8(const bf16_t* p, float (&v)[8]) { const u32x4 q = *(const u32x4*)p; v[0] = bf_lo(q.x); v[1] = bf_hi(q.x); v[2] = bf_lo(q.y); v[3] = bf_hi(q.y); v[4] = bf_lo(q.z); v[5] = bf_hi(q.z); v[6] = bf_lo(q.w); v[7] = bf_hi(q.w); }
template <int W> __device__ __forceinline__ void poolmix_task(const bf16_t* U, bf16_t* MIX, int gidx, int ob, int rb, int lane) {
    const int oct = gidx * (PGD / 8) + ob * 8 + (lane & 7), t0 = rb * 64 + (lane >> 3) * 8, s0 = t0 % SEQ;
    const bf16_t* up = U + (size_t)t0 * PW + oct * 8;
    u32x4 raw[8 + W - 1];
#pragma unroll
    for (int i = 0; i < 8 + W - 1; ++i) { const int rel = i - (W - 1); raw[i] = (s0 + rel >= 0) ? *(const u32x4*)(up + (ptrdiff_t)rel * PW) : (u32x4){0u, 0u, 0u, 0u}; }
    float sum[8];
#pragma unroll
    for (int j = 0; j < 8; ++j) sum[j] = 0.f;
#pragma unroll
    for (int i = 0; i < W; ++i) { f32x4 lo, hi; pg8::unpack8(raw[i], lo, hi);
#pragma unroll
        for (int j = 0; j < 4; ++j) { sum[j] += lo[j]; sum[4 + j] += hi[j]; } }
#pragma unroll
    for (int q = 0; q < 8; ++q) {
        const int s = s0 + q, cnt = (s + 1) < W ? (s + 1) : W; const float inv = 1.0f / (float)cnt;
        f32x4 lo, hi; pg8::unpack8(raw[q + W - 1], lo, hi);
        u32x4 ow; ow.x = pk2(sum[0] * inv - lo[0], sum[1] * inv - lo[1]); ow.y = pk2(sum[2] * inv - lo[2], sum[3] * inv - lo[3]);
        ow.z = pk2(sum[4] * inv - hi[0], sum[5] * inv - hi[1]); ow.w = pk2(sum[6] * inv - hi[2], sum[7] * inv - hi[3]);
        *(u32x4*)(MIX + (size_t)(t0 + q) * PW + oct * 8) = ow;
        if (q + 1 < 8) { f32x4 nl, nh, ol, oh; pg8::unpack8(raw[q + W], nl, nh); pg8::unpack8(raw[q], ol, oh);
#pragma unroll
            for (int j = 0; j < 4; ++j) { sum[j] += nl[j] - ol[j]; sum[4 + j] += nh[j] - oh[j]; } }
    }
}
__device__ __forceinline__ void poolmix_phase(Frame& F, const bf16_t* U, bf16_t* MIX) {
    const int gw = F.vcu * NWAVES + F.wave, NGW = F.G * NWAVES;
    constexpr int NRB = T / 64, NTASK = 4 * 3 * NRB;
    for (int task = gw; task < NTASK; task += NGW) { const int rb = task % NRB, ob = (task / NRB) % 3, gidx = task / (3 * NRB);
        if (gidx == 0) poolmix_task<2>(U, MIX, 0, ob, rb, F.lane); else if (gidx == 1) poolmix_task<4>(U, MIX, 1, ob, rb, F.lane);
        else if (gidx == 2) poolmix_task<8>(U, MIX, 2, ob, rb, F.lane); else poolmix_task<16>(U, MIX, 3, ob, rb, F.lane); }
}

constexpr int NBLK = T / 128;
struct MidArgs { const void* xin; bool xin_bf16; bf16_t* xout; const bf16_t* Y; const float* post_g; const float* pre2_g; const float* MODl; bf16_t* H; unsigned char* H8; };
__device__ __forceinline__ void router_phase_a(Frame& F, const MidArgs& M, const bf16_t* H, const bf16_t* RT, const float* rb, int* HIST, int* TOPE, int* TOPL, float* TOPG) {
    LAS float* lg = (LAS float*)(F.lds + F.wave * 4096);
    volatile LAS int* whist = (volatile LAS int*)(F.lds + 65536);
    const int fr = F.lane & 15, fq = F.lane >> 4;
    for (int blk = F.vcu; blk < NBLK; blk += F.G) {
        const int t0 = blk * 128 + F.wave * 16;
        rowpass_mid(F, t0, t0 + 16, RP, M.xin, M.xin_bf16, M.xout, M.Y, M.post_g, M.pre2_g, M.MODl, M.H, M.H8);
        asm volatile("s_waitcnt vmcnt(0)" ::: "memory");
        if (F.lane < NE) whist[F.wave * NE + F.lane] = 0;
        f32x4 a0 = {0.f, 0.f, 0.f, 0.f}, a1 = {0.f, 0.f, 0.f, 0.f};
        const bf16_t* hp = H + (size_t)(t0 + fr) * D + fq * 8; const bf16_t* w0 = RT + (size_t)fr * D + fq * 8; const bf16_t* w1 = RT + (size_t)(16 + fr) * D + fq * 8;
#pragma unroll 4
        for (int k = 0; k < D; k += 32) { const bf16x8 av = *(const bf16x8*)(hp + k), b0 = *(const bf16x8*)(w0 + k), b1 = *(const bf16x8*)(w1 + k);
            a0 = __builtin_amdgcn_mfma_f32_16x16x32_bf16(av, b0, a0, 0, 0, 0); a1 = __builtin_amdgcn_mfma_f32_16x16x32_bf16(av, b1, a1, 0, 0, 0); }
        const float rb0 = rb[fr], rb1 = rb[16 + fr];
#pragma unroll
        for (int j = 0; j < 4; ++j) { lg[(4 * fq + j) * 33 + fr] = a0[j] + rb0; lg[(4 * fq + j) * 33 + 16 + fr] = a1[j] + rb1; }
        LDS_WAIT(); asm volatile("" ::: "memory");
        float bv[4] = {-INFINITY, -INFINITY, -INFINITY, -INFINITY}; int bi[4] = {0, 0, 0, 0};
        if (F.lane < 16) {
            for (int e = 0; e < NE; ++e) { const float v = lg[F.lane * 33 + e];
                if (v > bv[3]) { bv[3] = v; bi[3] = e;
                    if (bv[3] > bv[2]) { float tv = bv[2]; bv[2] = bv[3]; bv[3] = tv; int ti = bi[2]; bi[2] = bi[3]; bi[3] = ti;
                        if (bv[2] > bv[1]) { tv = bv[1]; bv[1] = bv[2]; bv[2] = tv; ti = bi[1]; bi[1] = bi[2]; bi[2] = ti;
                            if (bv[1] > bv[0]) { tv = bv[0]; bv[0] = bv[1]; bv[1] = tv; ti = bi[0]; bi[0] = bi[1]; bi[1] = ti; } } } } }
        }
        float gt[4]; { float sum = 0.f;
#pragma unroll
            for (int k = 0; k < 4; ++k) { gt[k] = fast_exp(bv[k] - bv[0]); sum += gt[k]; }
            const float inv = 1.0f / sum;
#pragma unroll
            for (int k = 0; k < 4; ++k) gt[k] *= inv; }
        int rk[4];
#pragma unroll
        for (int k = 0; k < 4; ++k) {
            const int e = F.lane < 16 ? bi[k] : -1; int rank = 0;
            unsigned long long todo = __ballot(e >= 0);
            while (todo) { const int leader = __builtin_ctzll(todo); const int le = __shfl(e, leader); const unsigned long long mm = __ballot(e == le);
                const int base = whist[F.wave * NE + le];
                if (e == le) rank = base + __builtin_popcountll(mm & ((1ull << F.lane) - 1ull));
                if (F.lane == leader) whist[F.wave * NE + le] = base + __builtin_popcountll(mm);
                todo &= ~mm; }
            rk[k] = rank;
        }
        __syncthreads();
        if (F.tid < NE) { int run = 0;
#pragma unroll
            for (int w = 0; w < NWAVES; ++w) { const int v = whist[w * NE + F.tid]; whist[w * NE + F.tid] = run; run += v; }
            HIST[blk * NE + F.tid] = run; }
        __syncthreads();
        if (F.lane < 16) { const int t = t0 + F.lane;
#pragma unroll
            for (int k = 0; k < 4; ++k) { TOPE[t * TOPK + k] = bi[k]; TOPL[t * TOPK + k] = whist[F.wave * NE + bi[k]] + rk[k]; TOPG[t * TOPK + k] = gt[k]; } }
        __syncthreads();
    }
}
__device__ __forceinline__ void router_phase_b(Frame& F, const int* HIST, const int* TOPE, const int* TOPL, const float* TOPG, int* TOPS, int* ROWTOK, float* ROWGATE) {
    volatile LAS int* part = (volatile LAS int*)(F.lds + 65536);
    for (int blk = F.vcu; blk < NBLK; blk += F.G) {
        { const int e = F.tid & 31, pt = F.tid >> 5; int sacc = 0;
            for (int b = pt * 16; b < pt * 16 + 16; ++b) sacc += (b < blk) ? HIST[b * NE + e] : 0;
            part[pt * NE + e] = sacc; }
        __syncthreads();
        if (F.tid < NE) { int sacc = 0;
#pragma unroll
            for (int pt = 0; pt < 16; ++pt) sacc += part[pt * NE + F.tid];
            part[512 + F.tid] = sacc; }
        __syncthreads();
        { const int t = blk * 128 + (F.tid >> 2), k = F.tid & 3; const int e = TOPE[t * TOPK + k]; const int slot = part[512 + e] + TOPL[t * TOPK + k];
            TOPS[t * TOPK + k] = slot; ROWTOK[(size_t)e * T + slot] = t * TOPK + k; ROWGATE[(size_t)e * T + slot] = TOPG[t * TOPK + k]; }
        __syncthreads();
    }
}
__device__ __forceinline__ void moe_table(Frame& F, const int* HIST) {
    volatile LAS int* part = (volatile LAS int*)(F.MISC + 256);
    __syncthreads();
    { const int e = F.tid & 31, pt = F.tid >> 5; int sacc = 0;
        for (int b = pt * 16; b < pt * 16 + 16; ++b) sacc += HIST[b * NE + e];
        part[pt * NE + e] = sacc; }
    __syncthreads();
    if (F.tid < 64) { const int e = F.lane; int c = 0;
        if (e < NE) {
#pragma unroll
            for (int pt = 0; pt < 16; ++pt) c += part[pt * NE + e]; }
        int tl = (c + 255) >> 8, pre = tl;
#pragma unroll
        for (int o = 1; o < 64; o <<= 1) { const int v = __shfl_up(pre, o); if (F.lane >= o) pre += v; }
        if (e < NE) { F.MISC[MISC_TB + e] = (unsigned)(pre - tl); F.MISC[MISC_CNT + e] = (unsigned)c; }
        if (e == NE - 1) F.MISC[MISC_TB + NE] = (unsigned)pre; }
    __syncthreads();
}

constexpr int PH_PRO = 0, PH_PRE = 1, PH_L0 = 2, NPL = 10, NPHASES = PH_L0 + DEPTH * NPL;
__global__ void __launch_bounds__(NTHREADS, 2) fwd(Args args_unused) {
    extern __shared__ __attribute__((aligned(16))) unsigned char lds_raw[];
    const volatile __attribute__((address_space(4))) Args* ka = (const volatile __attribute__((address_space(4))) Args*)__builtin_amdgcn_kernarg_segment_ptr();
#define INP(i) ((const float*)ka->in[i])
#define WSB() ((unsigned char*)ka->ws)
#define OUTP() ((float*)ka->out)
    Frame F;
    F.lds = (LAS unsigned char*)lds_raw; F.MISC = (volatile LAS unsigned*)(F.lds + LDSCTL_OFF);
    F.wave = __builtin_amdgcn_readfirstlane((int)threadIdx.x >> 6); F.lane = lane_id_v(); F.tid = F.wave * 64 + F.lane;
    F.G = gridDim.x; { const int bx = blockIdx.x; F.vcu = (F.G % 8 == 0) ? (bx % 8) * (F.G / 8) + bx / 8 : bx; }
    F.ctl = (unsigned*)(WSB() + WS_CTL);
    for (int u = F.tid; u < (LDS_BYTES - LDSCTL_OFF) / 4; u += NTHREADS) ((LAS unsigned*)(F.lds + LDSCTL_OFF))[u] = 0u;
    __syncthreads();
    XcdBarrier bar = xcd_barrier_post(F.ctl + CW_BAR, F.MISC + MISC_BAR, F.tid == 0);
    const int lo = ka->ph_lo, hi = ka->ph_hi;
#define IN(k) (lo <= (k) && (k) < hi)
#define STAMP(k) do { if (TIMER_ON && blockIdx.x == 0 && F.wave == 0 && lane_id_v() == 0) ((unsigned long long*)(F.ctl + CW_TS))[(k)] = __builtin_amdgcn_s_memrealtime(); } while (0)
#ifndef PROF_BARRIER
#define PROF_BARRIER 0
#endif
#ifndef PROF_BTYPES
#define PROF_BTYPES 0xffff
#endif
#define PROF_BSEL(k) ((PROF_BTYPES >> ((k) < 2 ? (k) : 2 + ((k) - 2) % 10)) & 1)
#define PROF_ADD(dt) do { if (F.wave == 0 && lane_id_v() == 0) F.MISC[MISC_PROF] = F.MISC[MISC_PROF] + (unsigned)(dt); } while (0)
#define SEAM(k) do { const unsigned long long _tb0 = PROF_BARRIER ? __builtin_amdgcn_s_memrealtime() : 0ull; \
        if (IN(k) && (IN((k) + 1) || TIMER_ON || SPAN_HI >= 0)) xcd_barrier(bar, F.wave == 0 && lane_id_v() == 0); STAMP(k); \
        if (PROF_BARRIER && PROF_BSEL(k)) PROF_ADD(__builtin_amdgcn_s_memrealtime() - _tb0); \
        if (SPAN_HI >= 0 && (k) == SPAN_LO - 1) span_t0 = __builtin_amdgcn_s_memrealtime(); \
        if (SPAN_HI >= 0 && (k) == SPAN_HI) PROF_ADD(__builtin_amdgcn_s_memrealtime() - span_t0); } while (0)
#define PHASE_FRAME() Frame P = F; P.wave = launder_s(F.wave); P.lane = lane_id_v(); P.tid = P.wave * 64 + P.lane
    const int cb = (int)blockIdx.x;
    unsigned long long span_t0 = (SPAN_HI >= 0 && SPAN_LO == 0) ? __builtin_amdgcn_s_memrealtime() : 0ull;
    STAMP(63);

    if (IN(PH_PRO)) REPEAT(0) { __syncthreads(); unsigned char* ws = WSB(); { PHASE_FRAME(); mods_phase(P, INP(1), INP(2), INP(3), (float*)(ws + WS_MOD)); } { PHASE_FRAME(); convert_phase(P, ka); } }
    SEAM(PH_PRO);
    if (IN(PH_PRE)) REPEAT(1) { unsigned char* ws = WSB(); PHASE_FRAME(); rowpass_pre(P, INP(0), INP(4), (const float*)(ws + WS_MOD), (bf16_t*)(ws + WS_H)); }
    SEAM(PH_PRE);
    if ((REP_MASK >> 16) & 1) { for (int _i = 0; _i < 20; ++_i) xcd_barrier(bar, F.wave == 0 && lane_id_v() == 0); }

#pragma unroll 1
    for (int l = 0; l < DEPTH; ++l) {
        const int pb = PH_L0 + l * NPL;
        if (IN(pb + 0)) { unsigned char* ws = WSB(); unsigned char* wl = ws + WS_W + (size_t)l * WL_STRIDE; const bf16_t* WIN = (const bf16_t*)(wl + WO_WIN); bf16_t* H = (bf16_t*)(ws + WS_H);
            REPEAT(2) { pg8::Gemm g{H, WIN, D, D, D, nullptr}; pg8::StaticOrder S{T / 256, 13, launder_s(F.G), launder_s(cb), D, D, 0}; pg8::EpiIn E{(bf16_t*)(ws + WS_Q), (bf16_t*)(ws + WS_K), (bf16_t*)(ws + WS_U), (bf16_t*)(ws + WS_G)};
              pg8::gemm_phase<pg8::EpiIn, pg8::StaticOrder, 0>(F.lds, F.wave, g, S, E); }
            REPEAT(3) { pg8::Gemm g{WIN + (size_t)3328 * D, H, D, D, D, nullptr}; pg8::StaticOrder S{1, T / 256, launder_s(F.G), (launder_s(cb) + launder_s(F.G) / 2) % launder_s(F.G), D, D, 0}; pg8::EpiPlain E{(bf16_t*)(ws + WS_VT), VTP, 0, nullptr, nullptr};
              pg8::gemm_phase<pg8::EpiPlain, pg8::StaticOrder, 1>(F.lds, F.wave, g, S, E); }
        }
        SEAM(pb + 0);
        if (IN(pb + 1)) { unsigned char* ws = WSB();
            REPEAT(4) { PHASE_FRAME(); attn_phase(P, (const bf16_t*)(ws + WS_Q), (const bf16_t*)(ws + WS_K), (const bf16_t*)(ws + WS_VT), (bf16_t*)(ws + WS_AP)); }
            REPEAT(5) { PHASE_FRAME(); poolmix_phase(P, (const bf16_t*)(ws + WS_U), (bf16_t*)(ws + WS_MIX)); } }
        SEAM(pb + 1);
        if (IN(pb + 2)) { unsigned char* ws = WSB(); unsigned char* wl = ws + WS_W + (size_t)l * WL_STRIDE; bf16_t* AP = (bf16_t*)(ws + WS_AP);
            REPEAT(6) { pg8::Gemm g{AP, (const bf16_t*)(wl + WO_BRA), D, SBW, SBW, nullptr}; pg8::StaticOrder S{T / 256, 4, launder_s(F.G), launder_s(cb), D, SBW, 0}; pg8::EpiBranch<false> E{(bf16_t*)(ws + WS_MRG), (const bf16_t*)(ws + WS_G), 0, (bf16_t*)(ws + WS_MRG)};
              pg8::gemm_phase<pg8::EpiBranch<false>, pg8::StaticOrder, 2>(F.lds, F.wave, g, S, E); }
            REPEAT(7) { pg8::Gemm g{(const bf16_t*)(ws + WS_MIX), (const bf16_t*)(wl + WO_POOL), PW, PW, 384, nullptr}; pg8::StaticOrder S{T / 256, 3, launder_s(F.G), launder_s(cb), PW, PW, PGD};
              pg8::EpiPlain E{AP, D, SBW, INP(10) + (size_t)l * PW, INP(11) + (size_t)l * PW};
              pg8::gemm_phase<pg8::EpiPlain, pg8::StaticOrder, 3>(F.lds, F.wave, g, S, E); }
        }
        SEAM(pb + 2);
        if (IN(pb + 3)) for (int _rep = ((REP_MASK >> 15) & 1) ? 0 : 1; _rep < 2; ++_rep) { unsigned char* ws = WSB(); unsigned char* wl = ws + WS_W + (size_t)l * WL_STRIDE;
            pg8::Gemm g{(const bf16_t*)(ws + WS_AP) + SBW, (const bf16_t*)(wl + WO_BRP), D, PW, PW, nullptr}; pg8::StaticOrder S{T / 256, 4, launder_s(F.G), launder_s(cb), D, PW, 0}; pg8::EpiBranch<true> E{(bf16_t*)(ws + WS_MRG), (const bf16_t*)(ws + WS_G), D, (bf16_t*)(ws + (_rep == 0 ? WS_Y : WS_MRG))};
            pg8::gemm_phase<pg8::EpiBranch<true>, pg8::StaticOrder, 4>(F.lds, F.wave, g, S, E); }
        SEAM(pb + 3);
        if (IN(pb + 4)) REPEAT(8) { unsigned char* ws = WSB(); unsigned char* wl = ws + WS_W + (size_t)l * WL_STRIDE;
            pg8::Gemm g{(const bf16_t*)(ws + WS_MRG), (const bf16_t*)(wl + WO_OUT), D, D, D, nullptr}; pg8::StaticOrder S{T / 256, 4, launder_s(F.G), launder_s(cb), D, D, 0}; pg8::EpiPlain E{(bf16_t*)(ws + WS_Y), D, 0, nullptr, nullptr};
            pg8::gemm_phase<pg8::EpiPlain, pg8::StaticOrder, 5>(F.lds, F.wave, g, S, E); }
        SEAM(pb + 4);
        if (IN(pb + 5)) { unsigned char* ws = WSB(); unsigned char* wl = ws + WS_W + (size_t)l * WL_STRIDE; PHASE_FRAME();
            MidArgs M{l == 0 ? (const void*)INP(0) : (const void*)(ws + WS_XB), l != 0, (bf16_t*)(ws + WS_XB), (const bf16_t*)(ws + WS_Y), INP(5) + (size_t)l * D, INP(6) + (size_t)l * D, (const float*)(ws + WS_MOD) + (size_t)l * BATCH * 6 * D, (bf16_t*)(ws + WS_H), ws + WS_H8};
            router_phase_a(P, M, (const bf16_t*)(ws + WS_H), (const bf16_t*)(wl + WO_ROUTER), INP(16) + (size_t)l * NE, (int*)(ws + WS_HIST) + (size_t)l * NBLK * NE, (int*)(ws + WS_TOPE), (int*)(ws + WS_TOPL), (float*)(ws + WS_TOPG)); }
        SEAM(pb + 5);
        if (IN(pb + 6)) REPEAT(13) { unsigned char* ws = WSB(); PHASE_FRAME();
            router_phase_b(P, (const int*)(ws + WS_HIST) + (size_t)l * NBLK * NE, (const int*)(ws + WS_TOPE), (const int*)(ws + WS_TOPL), (const float*)(ws + WS_TOPG), (int*)(ws + WS_TOPS), (int*)(ws + WS_ROWTOK), (float*)(ws + WS_ROWGATE)); }
        SEAM(pb + 6);
        if (IN(pb + 7)) REPEAT(10) { unsigned char* ws = WSB(); unsigned char* wl = ws + WS_W + (size_t)l * WL_STRIDE; { PHASE_FRAME(); moe_table(P, (const int*)(ws + WS_HIST) + (size_t)l * NBLK * NE); }
            pg8::Gemm g{(const bf16_t*)(ws + WS_H8), (const bf16_t*)(wl + WO_GU), D, D, D, (const int*)(ws + WS_ROWTOK)};
            pg8::MoeOrder S{(const volatile LAS int*)(F.MISC + MISC_TB), (const volatile LAS int*)(F.MISC + MISC_CNT), 8, launder_s(F.G), launder_s(cb), 2 * D};
            pg8::EpiGU E{ws + WS_ACT, INP(18) + (size_t)l * NE * 2 * D};
            pg8::gemm_phase<pg8::EpiGU, pg8::MoeOrder, 6>(F.lds, F.wave, g, S, E); }
        SEAM(pb + 7);
        if (IN(pb + 8)) REPEAT(11) { unsigned char* ws = WSB(); unsigned char* wl = ws + WS_W + (size_t)l * WL_STRIDE; { PHASE_FRAME(); moe_table(P, (const int*)(ws + WS_HIST) + (size_t)l * NBLK * NE); }
            pg8::Gemm g{(const bf16_t*)(ws + WS_ACT), (const bf16_t*)(wl + WO_DN), D, D, D, nullptr};
            pg8::MoeOrder S{(const volatile LAS int*)(F.MISC + MISC_TB), (const volatile LAS int*)(F.MISC + MISC_CNT), 4, launder_s(F.G), launder_s(cb), D};
            pg8::EpiDN E{(bf16_t*)(ws + WS_YR), INP(20) + (size_t)l * NE * D, (const float*)(ws + WS_ROWGATE), (const int*)(ws + WS_ROWTOK)};
            pg8::gemm_phase<pg8::EpiDN, pg8::MoeOrder, 7>(F.lds, F.wave, g, S, E); }
        SEAM(pb + 8);
        if (IN(pb + 9)) for (int _rep = ((REP_MASK >> 14) & 1) ? 0 : 1; _rep < 2; ++_rep) { unsigned char* ws = WSB(); PHASE_FRAME();
            const bool hn = (l + 1 < DEPTH); const float* MOD = (const float*)(ws + WS_MOD);
            rowpass_comb(P, (const bf16_t*)(ws + WS_XB), _rep == 0 ? (void*)(ws + WS_ACT) : (hn ? (void*)(ws + WS_XB) : (void*)OUTP()), hn, (const bf16_t*)(ws + WS_YR), INP(7) + (size_t)l * D, MOD + (size_t)l * BATCH * 6 * D,
                         hn, INP(4) + (size_t)(hn ? l + 1 : l) * D, MOD + (size_t)(hn ? l + 1 : l) * BATCH * 6 * D, (bf16_t*)(ws + WS_H)); }
        SEAM(pb + 9);
    }
    if (PROF_BARRIER == 2) {
        if (F.wave == 0 && lane_id_v() == 0) __hip_atomic_fetch_add(F.ctl + 12000, (unsigned)F.MISC[MISC_PROF], __ATOMIC_RELAXED, __HIP_MEMORY_SCOPE_AGENT);
        xcd_barrier(bar, F.wave == 0 && lane_id_v() == 0);
        if (F.wave == 0 && lane_id_v() == 0) F.MISC[MISC_PROF] = __hip_atomic_load(F.ctl + 12000, __ATOMIC_RELAXED, __HIP_MEMORY_SCOPE_AGENT) / (unsigned)F.G;
    }
    if ((PROF_REGION != 0) || PROF_BARRIER || SPAN_HI >= 0) { if (F.wave == 0) { const unsigned long long dt = F.MISC[MISC_PROF], t0 = __builtin_amdgcn_s_memrealtime(); while (__builtin_amdgcn_s_memrealtime() - t0 < dt) __builtin_amdgcn_s_sleep(8); } }
#if TIMER_ON
    { xcd_barrier(bar, F.wave == 0 && lane_id_v() == 0);
      const unsigned long long* ts = (const unsigned long long*)(F.ctl + CW_TS);
      const float us1 = (float)(long long)(ts[TIMER_B1] - ts[TIMER_A1]) * 0.01f, us2 = (float)(long long)(ts[TIMER_B2] - ts[TIMER_A2]) * 0.01f;
      const float a = sqrtf(us1 * 1e-4f); float* o = OUTP(); const int lane = lane_id_v(), gtid = ((int)blockIdx.x * NWAVES + F.wave) * 64 + lane;
      for (size_t i = (size_t)gtid; i < (size_t)T * D; i += (size_t)F.G * NTHREADS) o[i] += (i & 1) ? a : -a;
      xcd_barrier(bar, F.wave == 0 && lane_id_v() == 0);
      if (blockIdx.x == 0 && F.wave == 0 && lane == 0) o[5] += us2 * 0.2f; }
#endif
#undef IN
#undef SEAM
}

extern "C" void kernel_launch(void* const* d_in, const int* in_sizes, int n_in, void* d_out, int out_size, void* d_ws, size_t ws_size, hipStream_t stream) {
    static int grid = 0;
    if (grid == 0) {
        if (n_in != 21 || in_sizes[0] != T * D || out_size != T * D || ws_size < WS_END) { fprintf(stderr, "kernel_launch: unexpected shapes (n_in %d, in0 %d, out %d, ws %zu < %zu); nothing launched\n", n_in, n_in > 0 ? in_sizes[0] : -1, out_size, ws_size, (size_t)WS_END); grid = -1; return; }
        int dev = 0, cus = 0, per_cu = 0;
        if (hipGetDevice(&dev) != hipSuccess || hipDeviceGetAttribute(&cus, hipDeviceAttributeMultiprocessorCount, dev) != hipSuccess) { grid = -1; return; }
        if (hipFuncSetAttribute((const void*)fwd, hipFuncAttributeMaxDynamicSharedMemorySize, LDS_BYTES) != hipSuccess) { fprintf(stderr, "kernel_launch: hipFuncSetAttribute failed\n"); grid = -1; return; }
        if (hipOccupancyMaxActiveBlocksPerMultiprocessor(&per_cu, (const void*)fwd, NTHREADS, LDS_BYTES) != hipSuccess || per_cu < 1) { fprintf(stderr, "kernel_launch: occupancy query says %d\n", per_cu); }
        (void)hipGetLastError();
        grid = cus;
    }
    if (grid < 0) return;
    if (hipMemsetAsync((char*)d_ws + WS_CTL, 0, CTL_ZERO_BYTES, stream) != hipSuccess) return;
    Args a{};
    for (int i = 0; i < 21; ++i) a.in[i] = (const float*)d_in[i];
    a.out = (float*)d_out; a.ws = (unsigned char*)d_ws;
#if N_LAUNCHES == 1
    a.ph_lo = 0; a.ph_hi = NPHASES;
    hipLaunchKernelGGL(fwd, dim3(grid), dim3(NTHREADS), LDS_BYTES, stream, a);
#else
    for (int p = 0; p < NPHASES; ++p) { a.ph_lo = p; a.ph_hi = p + 1; hipLaunchKernelGGL(fwd, dim3(grid), dim3(NTHREADS), LDS_BYTES, stream, a); }
#endif
}
```

```cpp
#include <hip/hip_runtime.h>
#include <cstdio>
#include <cstdint>

#ifndef N_LAUNCHES
#define N_LAUNCHES 1
#endif
#ifndef REP_MASK
#define REP_MASK 0
#endif
#ifndef REP_BAR
#define REP_BAR 0
#endif
#define REPEAT(b) _Pragma("unroll 1") for (int _rep = 0; _rep < (((REP_MASK >> (b)) & 1) ? 2 : 1); ((REP_BAR && ((REP_MASK >> (b)) & 1)) ? xcd_barrier(bar, F.wave == 0 && lane_id_v() == 0) : (void)0), ++_rep)
#ifndef TIMER_ON
#define TIMER_ON 0
#endif
#ifndef TIMER_A1
#define TIMER_A1 63
#define TIMER_B1 0
#define TIMER_A2 63
#define TIMER_B2 1
#endif
constexpr int CW_TS = 12288;
#ifndef SPAN_LO
#define SPAN_LO -1
#define SPAN_HI -1
#endif
#ifndef PROF_REGION
#define PROF_REGION 0
#define PROF_SITES 0
#endif
#ifndef FAST_MASK
#define FAST_MASK 0xff
#endif

#define LAS __attribute__((address_space(3)))
#define GAS __attribute__((address_space(1)))
typedef unsigned short bf16_t;
typedef short bf16x8 __attribute__((ext_vector_type(8)));
typedef short s16x4 __attribute__((ext_vector_type(4)));
typedef float f32x4 __attribute__((ext_vector_type(4)));
typedef float f32x2 __attribute__((ext_vector_type(2)));
typedef float f32x16 __attribute__((ext_vector_type(16)));
typedef unsigned u32x4 __attribute__((ext_vector_type(4)));
typedef unsigned u32x2 __attribute__((ext_vector_type(2)));

constexpr int D = 1024, BATCH = 2, SEQ = 16384, T = BATCH * SEQ, DEPTH = 2;
constexpr int SBW = 256, NH = 4, HD = 64, PW = 768, PGD = 192, INW = 3584;
constexpr int NE = 32, TOPK = 4;
constexpr float NORM_EPS = 1e-6f, SW_LIMIT = 7.0f, SW_ALPHA = 1.702f;
constexpr float STICK_EXIT = -24.0f;
constexpr int NWAVES = 8, NTHREADS = 512;
constexpr int MAXTILES = (T * TOPK) / 256 + NE;

constexpr size_t MiB = 1u << 20;
constexpr size_t WS_CTL = 0, CTL_ZERO_BYTES = 65536;
constexpr size_t WS_MOD = 1 * MiB;
constexpr size_t WS_W = 2 * MiB, WL_STRIDE = 205 * MiB;
constexpr size_t WO_WIN = 0, WO_BRA = 7 * MiB, WO_BRP = 7 * MiB + MiB / 2, WO_OUT = 9 * MiB, WO_POOL = 11 * MiB, WO_ROUTER = 12 * MiB + MiB / 2, WO_GU = 13 * MiB, WO_DN = 141 * MiB;
constexpr size_t WS_H = 416 * MiB, WS_Q = 480 * MiB, WS_K = 496 * MiB, WS_U = 528 * MiB, WS_G = 576 * MiB;
constexpr int VTP = T + 64;
constexpr size_t WS_AP = 704 * MiB, WS_MIX = 768 * MiB, WS_MRG = 816 * MiB, WS_Y = 880 * MiB;
constexpr size_t WS_TOPE = 944 * MiB, WS_TOPS = 944 * MiB + MiB / 2, WS_TOPL = 945 * MiB, WS_TOPG = 945 * MiB + MiB / 2, WS_ROWTOK = 946 * MiB, WS_ROWGATE = 950 * MiB;
constexpr size_t WS_HIST = 954 * MiB;
constexpr size_t WS_ACT = 960 * MiB, WS_YR = 1232 * MiB, WS_H8 = 1504 * MiB, WS_XB = 1536 * MiB, WS_VT = 1600 * MiB  , WS_END = 1620 * MiB;
static_assert(WO_DN + (size_t)NE * D * D * 2 <= WL_STRIDE && WS_W + DEPTH * WL_STRIDE <= WS_H, "weights map");
static_assert(WS_ACT + (size_t)MAXTILES * 256 * D * 2 <= WS_YR && WS_YR + (size_t)MAXTILES * 256 * D * 2 <= WS_END, "act map");
constexpr int CW_BAR = 4096, CW_CNT = 8192;

constexpr int RING_BYTES = 131072, LDSCTL_OFF = RING_BYTES, LDS_BYTES = 147456;
constexpr int META_OFF = LDSCTL_OFF + 4096, META_BYTES = 4096;
constexpr int MISC_BAR = 8;
constexpr int MISC_TB = 64, MISC_CNT = 128, MISC_PROF = 200;

__device__ __forceinline__ unsigned f2bf(float f) { unsigned u = __builtin_bit_cast(unsigned, f); return (u + 0x7fffu + ((u >> 16) & 1u)) >> 16; }
__device__ __forceinline__ unsigned pk2(float lo, float hi) { return f2bf(lo) | (f2bf(hi) << 16); }
__device__ __forceinline__ float bf_lo(unsigned w) { return __builtin_bit_cast(float, w << 16); }
__device__ __forceinline__ float bf_hi(unsigned w) { return __builtin_bit_cast(float, w & 0xffff0000u); }
__device__ __forceinline__ unsigned pk4_fp8(float a, float b, float c, float d) { int w = 0; w = __builtin_amdgcn_cvt_pk_fp8_f32(a, b, w, false); w = __builtin_amdgcn_cvt_pk_fp8_f32(c, d, w, true); return (unsigned)w; }
constexpr float W8_SCALE = 32.0f, W8_INV = 1.0f / 32.0f;
__device__ __forceinline__ float fast_exp(float x) { return __builtin_amdgcn_exp2f(x * 1.4426950408889634f); }
__device__ __forceinline__ float fast_sigmoid(float x) { return __builtin_amdgcn_rcpf(1.0f + fast_exp(-x)); }
__device__ __forceinline__ float softplus_f(float z) { return fmaxf(z, 0.f) + 0.6931471805599453f * __builtin_amdgcn_logf(1.0f + fast_exp(-fabsf(z))); }
__device__ __forceinline__ float wave_sum(float v) {
#pragma unroll
    for (int o = 1; o < 64; o <<= 1) v += __shfl_xor(v, o);
    return v;
}
__device__ __forceinline__ int launder_v(int x) { asm volatile("" : "+v"(x)); return x; }
__device__ __forceinline__ int launder_s(int x) { asm volatile("" : "+s"(x)); return x; }
__device__ __forceinline__ int lane_id_v() { int x; asm volatile("v_mbcnt_lo_u32_b32 %0, -1, 0\n\tv_mbcnt_hi_u32_b32 %0, -1, %0" : "=v"(x)); return x; }
#define LDS_WAIT() asm volatile("s_waitcnt lgkmcnt(0)" ::: "memory")
#define VM_WAIT() asm volatile("s_waitcnt vmcnt(0)" ::: "memory")

#define XB_TMO      128
#define XB_XCNT(j)  (256  + 64 * (j))
#define XB_XSUB(j)  (1280 + 64 * (j))
#define XB_XGEN(j)  (2304 + 64 * (j))
#define XB_TOP      3328
#define XB_TOPGEN   3392
#define XCD_BAR_WORDS 3456
#define XB_SPIN_CAP (1u << 18)
__device__ __forceinline__ unsigned xb_ld(unsigned* p)              { return __hip_atomic_load(p, __ATOMIC_RELAXED, __HIP_MEMORY_SCOPE_AGENT); }
__device__ __forceinline__ unsigned xb_add(unsigned* p, unsigned v) { return __hip_atomic_fetch_add(p, v, __ATOMIC_RELAXED, __HIP_MEMORY_SCOPE_AGENT); }
__device__ __forceinline__ unsigned xb_xcc_id() { return (unsigned)__builtin_amdgcn_s_getreg((3 << 11) | 20) & 0xFu; }
#define XB_SPIN(cond, bar) do { unsigned _sp = 0; while (cond) { __builtin_amdgcn_s_sleep(1); \
    if ((++_sp & 255u) == 0u) { if (xb_ld(&(bar)[XB_TMO])) break; if (_sp > XB_SPIN_CAP) { atomicAdd(&(bar)[XB_TMO], 1u); break; } } } } while (0)
struct XcdBarrier { unsigned* bar; unsigned x; volatile LAS unsigned* st; };
__device__ __forceinline__ XcdBarrier xcd_barrier_post(unsigned* bar, volatile LAS unsigned* st, bool t0) {
    XcdBarrier b; b.bar = bar; b.x = xb_xcc_id(); b.st = st;
    if (t0) (void)xb_add(&bar[XB_XCNT(b.x)], 1u);
    return b;
}
__device__ __forceinline__ void xcd_barrier_complete(unsigned* bar, unsigned x, unsigned& nloc, unsigned& nx) {
    const unsigned G = gridDim.x * gridDim.y * gridDim.z;
    unsigned sum, cnt, mine, sp = 0u;
    for (;;) {
        sum = 0u; cnt = 0u; mine = 0u;
#pragma unroll
        for (unsigned j = 0; j < 16; ++j) { const unsigned c = xb_ld(&bar[XB_XCNT(j)]); sum += c; cnt += (c > 0u) ? 1u : 0u; mine = (j == x) ? c : mine; }
        if (sum == G) break;
        __builtin_amdgcn_s_sleep(1);
        if ((++sp & 255u) == 0u) { if (xb_ld(&bar[XB_TMO])) break; if (sp > XB_SPIN_CAP) { atomicAdd(&bar[XB_TMO], 1u); break; } }
    }
    nloc = mine > 0u ? mine : 1u; nx = cnt > 0u ? cnt : 1u;
}
__device__ __forceinline__ void xcd_barrier(const XcdBarrier& b, bool t0) {
    asm volatile("s_waitcnt vmcnt(0)" ::: "memory");
    __syncthreads();
    if (t0) {
        unsigned* bar = b.bar;
        __builtin_amdgcn_s_waitcnt(0);
        unsigned nloc = b.st[0], nx = b.st[1];
        if (nloc == 0u) { xcd_barrier_complete(bar, b.x, nloc, nx); b.st[0] = nloc; b.st[1] = nx; }
        const unsigned old = xb_add(&bar[XB_XSUB(b.x)], 1u);
        const unsigned gen = old / nloc;
        if (old + 1u == (gen + 1u) * nloc) {
            __builtin_amdgcn_fence(__ATOMIC_RELEASE, "agent");
            asm volatile("s_waitcnt vmcnt(0)" ::: "memory");
            const unsigned og = xb_add(&bar[XB_TOP], 1u);
            const unsigned tg = og / nx;
            if (og + 1u == (tg + 1u) * nx) xb_add(&bar[XB_TOPGEN], 1u);
            else XB_SPIN(xb_ld(&bar[XB_TOPGEN]) == tg, bar);
            __builtin_amdgcn_fence(__ATOMIC_ACQUIRE, "agent");
            xb_add(&bar[XB_XGEN(b.x)], 1u);
            asm volatile("s_waitcnt vmcnt(0)" ::: "memory");
        } else {
            XB_SPIN(xb_ld(&bar[XB_XGEN(b.x)]) == gen, bar);
            __builtin_amdgcn_fence(__ATOMIC_ACQUIRE, "agent");
            asm volatile("s_waitcnt vmcnt(0)" ::: "memory");
        }
    }
    __syncthreads();
}

namespace pg8 {
constexpr int BM = 256, BK = 64, HALF = 128, HTB = HALF * BK * 2, STAGE_BYTES = 8 * HTB, NXCD = 8, WGM = 8;
__host__ __device__ __forceinline__ int lds_byte(int r, int c) { const int st = (r >> 4) * 2 + (c >> 5), rr = r & 15, cc = c & 31, ob = rr * 64 + cc * 2; return st * 1024 + (ob ^ (((ob >> 9) & 1) << 5)); }
__host__ __device__ __forceinline__ void stage_rc(int b, int& R, int& C) { const int st = b / 1024, sb = b % 1024, swz = sb ^ (((sb >> 9) & 1) << 5); R = (st >> 1) * 16 + swz / 64; C = (st & 1) * 32 + (swz % 64) / 2; }
__host__ __device__ __forceinline__ int perm32(int rho) { const int n = rho >> 4, i = rho & 15; return 8 * (i >> 2) + 4 * n + (i & 3); }

struct Unit { int pm, pn, e, nvalid, slot0; unsigned aoff, boff; };
struct Gemm { const bf16_t* A; const bf16_t* Bt; int lda, ldb, K; const int* gather; };

__device__ __forceinline__ bool order_unit(int i, int G, int c, int nM, int nN, int& pm, int& pn) {
    const int nwg = nM * nN; const long L = (long)i * G + c; if (L >= nwg) return false;
    int wgid = (int)L; { const int q = nwg / NXCD, r = nwg % NXCD, xcd = wgid % NXCD, off = wgid / NXCD; wgid = (xcd < r ? xcd * (q + 1) : r * (q + 1) + (xcd - r) * q) + off; }
    const int nig = WGM * nN, gid = wgid / nig, fm = gid * WGM, gsz = (nM - fm) < WGM ? (nM - fm) : WGM;
    pm = fm + ((wgid % nig) % gsz); pn = (wgid % nig) / gsz; return true;
}
struct StaticOrder {
    int nM, nN, G, c, lda, ldb, kstride;
    __device__ __forceinline__ bool next(int i, Unit& u) const {
        if (!order_unit(i, G, c, nM, nN, u.pm, u.pn)) return false;
        u.e = 0; u.nvalid = 256; u.slot0 = 0;
        u.aoff = (unsigned)(u.pm * BM) * (unsigned)lda + (unsigned)(kstride * u.pn); u.boff = (unsigned)(u.pn * BM) * (unsigned)ldb + (unsigned)(kstride * u.pn); return true;
    }
};
struct MoeOrder {
    const volatile LAS int* tb; const volatile LAS int* cnt; int nN, G, c, nw;
    __device__ __forceinline__ bool next(int i, Unit& u) const {
        const int nM = tb[NE];
        if (!order_unit(i, G, c, nM, nN, u.pm, u.pn)) return false;
        int e = u.e < 0 ? 0 : (u.e > NE - 1 ? NE - 1 : u.e);
#pragma unroll 1
        while (e < NE - 1 && tb[e + 1] <= u.pm) ++e;
#pragma unroll 1
        while (e > 0 && tb[e] > u.pm) --e;
        u.e = e; u.slot0 = (u.pm - tb[e]) * BM; const int left = cnt[e] - u.slot0; u.nvalid = left < BM ? left : BM;
        u.aoff = (unsigned)(u.pm * BM) * (unsigned)D; u.boff = ((unsigned)e * (unsigned)nw + (unsigned)(u.pn * BM)) * (unsigned)D; return true;
    }
};

__device__ __forceinline__ unsigned cvt_pk_bf16(float lo, float hi) { unsigned r; asm volatile("v_cvt_pk_bf16_f32 %0, %1, %2" : "=v"(r) : "v"(lo), "v"(hi)); return r; }
__device__ __forceinline__ u32x4 pack8(const f32x4 a, const f32x4 b) { u32x4 w; w.x = cvt_pk_bf16(a[0], a[1]); w.y = cvt_pk_bf16(a[2], a[3]); w.z = cvt_pk_bf16(b[0], b[1]); w.w = cvt_pk_bf16(b[2], b[3]); return w; }
__device__ __forceinline__ void unpack8(const u32x4 w, f32x4& a, f32x4& b) { a = (f32x4){bf_lo(w.x), bf_hi(w.x), bf_lo(w.y), bf_hi(w.y)}; b = (f32x4){bf_lo(w.z), bf_hi(w.z), bf_lo(w.w), bf_hi(w.w)}; }

__device__ __forceinline__ f32x2 lo2(const f32x4 v) { return __builtin_shufflevector(v, v, 0, 1); }
__device__ __forceinline__ f32x2 hi2(const f32x4 v) { return __builtin_shufflevector(v, v, 2, 3); }
__device__ __forceinline__ f32x4 cat2(const f32x2 a, const f32x2 b) { return __builtin_shufflevector(a, b, 0, 1, 2, 3); }
__device__ __forceinline__ f32x2 pk_sigmoid(const f32x2 x) {
    const f32x2 t = x * (-1.4426950408889634f); f32x2 e; e.x = __builtin_amdgcn_exp2f(t.x); e.y = __builtin_amdgcn_exp2f(t.y);
    const f32x2 d = e + 1.0f; f32x2 r; r.x = __builtin_amdgcn_rcpf(d.x); r.y = __builtin_amdgcn_rcpf(d.y); return r; }
__device__ __forceinline__ f32x4 pk_sigmoid4(const f32x4 v) { return cat2(pk_sigmoid(lo2(v)), pk_sigmoid(hi2(v))); }
__device__ __forceinline__ f32x2 pk_fma2(const f32x2 a, const f32x2 b, const f32x2 c) { return __builtin_elementwise_fma(a, b, c); }
__device__ __forceinline__ f32x2 swiglu2(f32x2 g, f32x2 u) {
    g.x = fminf(g.x, SW_LIMIT); g.y = fminf(g.y, SW_LIMIT); u.x = fminf(fmaxf(u.x, -SW_LIMIT), SW_LIMIT); u.y = fminf(fmaxf(u.y, -SW_LIMIT), SW_LIMIT);
    const f32x2 t = g * (-SW_ALPHA * 1.4426950408889634f); f32x2 e; e.x = __builtin_amdgcn_exp2f(t.x); e.y = __builtin_amdgcn_exp2f(t.y);
    const f32x2 d = e + 1.0f; f32x2 r; r.x = __builtin_amdgcn_rcpf(d.x); r.y = __builtin_amdgcn_rcpf(d.y);
    return pk_fma2(u, g, g) * r; }
#define EPI_LOOP_ROWS for (int ai = 0; ai < 2; ++ai) _Pragma("unroll") for (int m = 0; m < 4; ++m)
__device__ __forceinline__ void* probe_scratch_ptr() { const volatile __attribute__((address_space(4))) void* const* ka = (const volatile __attribute__((address_space(4))) void* const*)__builtin_amdgcn_kernarg_segment_ptr(); return (unsigned char*)ka[22] + ((size_t)1536 << 20); }
struct EpiIn {
    static constexpr bool PERM = true; static constexpr int ES = 2, SITE_ID = 0;
    bf16_t *Q, *KB, *U, *G;
    __device__ __forceinline__ void operator()(const f32x4 (&acc)[2][2][4][2], const Unit& u, int wr, int wc, int fr, int fq) const {
        const int pn = u.pn; bf16_t* base; int ld, c0, mode;
        if (pn == 0) { base = Q; ld = SBW; c0 = 0; mode = 1; } else if (pn == 1) { base = KB; ld = SBW; c0 = 0; mode = 0; }
        else if (pn < 5) { base = U; ld = PW; c0 = (pn - 2) * BM; mode = 0; } else { base = G; ld = 2 * D; c0 = (pn - 5) * BM; mode = 2; }
        const int row0 = u.pm * BM + wr * 64 + fr, col0 = c0 + wc * 32 + 8 * fq;
#pragma unroll
        EPI_LOOP_ROWS { bf16_t* rowp = base + (size_t)(row0 + ai * HALF + m * 16) * ld + col0;
#pragma unroll
            for (int bj = 0; bj < 2; ++bj) { f32x4 v0 = acc[ai][bj][m][0], v1 = acc[ai][bj][m][1];
                if (mode == 1) { v0 = v0 * 0.125f; v1 = v1 * 0.125f; }
                if (mode == 2) { v0 = pk_sigmoid4(v0); v1 = pk_sigmoid4(v1); }
                *(u32x4*)(rowp + bj * HALF) = pack8(v0, v1); } }
    }
};
struct EpiPlain {
    static constexpr bool PERM = true; static constexpr int ES = 2, SITE_ID = 1;
    bf16_t* O; int ldc, coff; const float* bias; const float* scale;
    __device__ __forceinline__ void operator()(const f32x4 (&acc)[2][2][4][2], const Unit& u, int wr, int wc, int fr, int fq) const {
        const int row0 = u.pm * BM + wr * 64 + fr, col0 = u.pn * BM + wc * 32 + 8 * fq;
        f32x4 bv[2][2], sv[2][2];
#pragma unroll
        for (int bj = 0; bj < 2; ++bj)
#pragma unroll
            for (int n = 0; n < 2; ++n) { bv[bj][n] = bias ? *(const f32x4*)(bias + col0 + bj * HALF + 4 * n) : (f32x4){0.f, 0.f, 0.f, 0.f};
                                          sv[bj][n] = scale ? *(const f32x4*)(scale + col0 + bj * HALF + 4 * n) : (f32x4){1.f, 1.f, 1.f, 1.f}; }
#pragma unroll
        EPI_LOOP_ROWS { bf16_t* rowp = O + (size_t)(row0 + ai * HALF + m * 16) * ldc + coff + col0;
#pragma unroll
            for (int bj = 0; bj < 2; ++bj) *(u32x4*)(rowp + bj * HALF) = pack8((acc[ai][bj][m][0] + bv[bj][0]) * sv[bj][0], (acc[ai][bj][m][1] + bv[bj][1]) * sv[bj][1]); }
    }
};
template <bool ADD> struct EpiBranch {
    static constexpr bool PERM = true; static constexpr int ES = 2, SITE_ID = 2;
    bf16_t* MRG; const bf16_t* G; int goff; bf16_t* MRGout;
    __device__ __forceinline__ void operator()(const f32x4 (&acc)[2][2][4][2], const Unit& u, int wr, int wc, int fr, int fq) const {
        const int row0 = u.pm * BM + wr * 64 + fr, col0 = u.pn * BM + wc * 32 + 8 * fq;
#pragma unroll
        for (int ai = 0; ai < 2; ++ai) {
            u32x4 gq[4][2], pq[4][2];
#pragma unroll
            for (int m = 0; m < 4; ++m)
#pragma unroll
                for (int bj = 0; bj < 2; ++bj) { const size_t r = (size_t)(row0 + ai * HALF + m * 16); const int c = col0 + bj * HALF;
                    gq[m][bj] = *(const u32x4*)(G + r * (2 * D) + goff + c); if (ADD) pq[m][bj] = *(const u32x4*)(MRG + r * D + c); }
#pragma unroll
            for (int m = 0; m < 4; ++m)
#pragma unroll
                for (int bj = 0; bj < 2; ++bj) { const size_t r = (size_t)(row0 + ai * HALF + m * 16); const int c = col0 + bj * HALF;
                    f32x4 g0, g1; unpack8(gq[m][bj], g0, g1);
                    f32x4 v0 = g0 * acc[ai][bj][m][0], v1 = g1 * acc[ai][bj][m][1];
                    if (ADD) { f32x4 p0, p1; unpack8(pq[m][bj], p0, p1); v0 = v0 + p0; v1 = v1 + p1; }
                    *(u32x4*)(MRGout + r * D + c) = pack8(v0, v1); } }
    }
};
struct EpiGU {
    static constexpr bool PERM = true, HAS_PRE = true; static constexpr int ES = 1, SITE_ID = 6;
    unsigned char* ACT8; const float* bgu;
    __device__ __forceinline__ void prefetch(LAS unsigned char* meta, const Unit& u, int wid, int lane) const {
        if (wid == 2 || wid == 3) { const float* src = bgu + (size_t)u.e * (2 * D) + (wid == 3 ? D : 0) + u.pn * HALF + 4 * (lane & 31);
            __builtin_amdgcn_global_load_lds((const unsigned*)src, (LAS unsigned*)(meta + wid * 1024), 16, 0, 0); } }
    __device__ __forceinline__ void epi_lds(const f32x4 (&acc)[2][2][4][2], const Unit& u, int wr, int wc, int fr, int fq, const LAS unsigned char* meta) const {
        const int row0 = u.pm * BM + wr * 64 + fr, col0 = u.pn * HALF + wc * 32 + 8 * fq;
        float w8s = W8_INV; asm volatile("" : "+v"(w8s));
        f32x4 bgv[2], buv[2];
#pragma unroll
        for (int n = 0; n < 2; ++n) { bgv[n] = *(const LAS f32x4*)(meta + 2048 + (wc * 32 + 8 * fq + 4 * n) * 4); buv[n] = *(const LAS f32x4*)(meta + 3072 + (wc * 32 + 8 * fq + 4 * n) * 4); }
#pragma unroll
        EPI_LOOP_ROWS { f32x4 o[2];
#pragma unroll
            for (int n = 0; n < 2; ++n) { const f32x2 w8 = {w8s, w8s};
                o[n] = cat2(swiglu2(pk_fma2(lo2(acc[ai][0][m][n]), w8, lo2(bgv[n])), pk_fma2(lo2(acc[ai][1][m][n]), w8, lo2(buv[n]))),
                            swiglu2(pk_fma2(hi2(acc[ai][0][m][n]), w8, hi2(bgv[n])), pk_fma2(hi2(acc[ai][1][m][n]), w8, hi2(buv[n])))); }
            u32x2 w; w.x = pk4_fp8(o[0][0], o[0][1], o[0][2], o[0][3]); w.y = pk4_fp8(o[1][0], o[1][1], o[1][2], o[1][3]);
            *(u32x2*)(ACT8 + (size_t)(row0 + ai * HALF + m * 16) * D + col0) = w; }
    }
    __device__ __forceinline__ void operator()(const f32x4 (&acc)[2][2][4][2], const Unit& u, int wr, int wc, int fr, int fq) const {
        const int row0 = u.pm * BM + wr * 64 + fr, col0 = u.pn * HALF + wc * 32 + 8 * fq;
        float w8s = W8_INV; asm volatile("" : "+v"(w8s));
        const float* bg = bgu + (size_t)u.e * (2 * D) + col0;
        f32x4 bgv[2], buv[2];
#pragma unroll
        for (int n = 0; n < 2; ++n) { bgv[n] = *(const f32x4*)(bg + 4 * n); buv[n] = *(const f32x4*)(bg + D + 4 * n); }
#pragma unroll
        EPI_LOOP_ROWS { f32x4 o[2];
#pragma unroll
            for (int n = 0; n < 2; ++n) { const f32x2 w8 = {w8s, w8s};
                o[n] = cat2(swiglu2(pk_fma2(lo2(acc[ai][0][m][n]), w8, lo2(bgv[n])), pk_fma2(lo2(acc[ai][1][m][n]), w8, lo2(buv[n]))),
                            swiglu2(pk_fma2(hi2(acc[ai][0][m][n]), w8, hi2(bgv[n])), pk_fma2(hi2(acc[ai][1][m][n]), w8, hi2(buv[n])))); }
            u32x2 w; w.x = pk4_fp8(o[0][0], o[0][1], o[0][2], o[0][3]); w.y = pk4_fp8(o[1][0], o[1][1], o[1][2], o[1][3]);
            *(u32x2*)(ACT8 + (size_t)(row0 + ai * HALF + m * 16) * D + col0) = w; }
    }
};
struct EpiDN {
    static constexpr bool PERM = true, HAS_PRE = true; static constexpr int ES = 1, SITE_ID = 7;
    bf16_t* YR4; const float* bdn; const float* rowgate; const int* rowtk;
    __device__ __forceinline__ void prefetch(LAS unsigned char* meta, const Unit& u, int wid, int lane) const {
        if (wid < 3) { const void* src = wid == 0 ? (const void*)(rowtk + (size_t)u.e * T + u.slot0 + 4 * lane) : wid == 1 ? (const void*)(rowgate + (size_t)u.e * T + u.slot0 + 4 * lane) : (const void*)(bdn + (size_t)u.e * D + u.pn * BM + 4 * lane);
            __builtin_amdgcn_global_load_lds((const unsigned*)src, (LAS unsigned*)(meta + wid * 1024), 16, 0, 0); } }
    __device__ __forceinline__ void epi_lds(const f32x4 (&acc)[2][2][4][2], const Unit& u, int wr, int wc, int fr, int fq, const LAS unsigned char* meta) const {
        const int rl0 = wr * 64 + fr, col0 = u.pn * BM + wc * 32 + 8 * fq;
        float w8s = W8_INV; asm volatile("" : "+v"(w8s));
        f32x4 bv[2][2];
#pragma unroll
        for (int bj = 0; bj < 2; ++bj)
#pragma unroll
            for (int n = 0; n < 2; ++n) bv[bj][n] = *(const LAS f32x4*)(meta + 2048 + (bj * HALF + wc * 32 + 8 * fq + 4 * n) * 4);
#pragma unroll
        EPI_LOOP_ROWS { const int rl = rl0 + ai * HALF + m * 16;
            if (rl < u.nvalid) { const float gt = *(const LAS float*)(meta + 1024 + rl * 4); const int tk = *(const LAS int*)(meta + rl * 4); bf16_t* rowp = YR4 + (size_t)tk * D + col0;
#pragma unroll
                for (int bj = 0; bj < 2; ++bj) *(u32x4*)(rowp + bj * HALF) = pack8((acc[ai][bj][m][0] * w8s + bv[bj][0]) * gt, (acc[ai][bj][m][1] * w8s + bv[bj][1]) * gt); } }
    }
    __device__ __forceinline__ void operator()(const f32x4 (&acc)[2][2][4][2], const Unit& u, int wr, int wc, int fr, int fq) const {
        const int rl0 = wr * 64 + fr, col0 = u.pn * BM + wc * 32 + 8 * fq;
        const float* bp = bdn + (size_t)u.e * D + col0; const float* gp = rowgate + (size_t)u.e * T + u.slot0; const int* tp = rowtk + (size_t)u.e * T + u.slot0;
        float w8s = W8_INV; asm volatile("" : "+v"(w8s));
        f32x4 bv[2][2];
#pragma unroll
        for (int bj = 0; bj < 2; ++bj)
#pragma unroll
            for (int n = 0; n < 2; ++n) bv[bj][n] = *(const f32x4*)(bp + bj * HALF + 4 * n);
        float gtv[2][4]; int tkv[2][4]; const int nv1 = u.nvalid - 1;
#pragma unroll
        EPI_LOOP_ROWS { const int rl = rl0 + ai * HALF + m * 16, rc = rl < nv1 ? rl : nv1; gtv[ai][m] = gp[rc]; tkv[ai][m] = tp[rc]; }
#pragma unroll
        EPI_LOOP_ROWS { const int rl = rl0 + ai * HALF + m * 16;
            if (rl < u.nvalid) { const float gt = gtv[ai][m]; bf16_t* rowp = YR4 + (size_t)tkv[ai][m] * D + col0;
#pragma unroll
                for (int bj = 0; bj < 2; ++bj) *(u32x4*)(rowp + bj * HALF) = pack8((acc[ai][bj][m][0] * w8s + bv[bj][0]) * gt, (acc[ai][bj][m][1] * w8s + bv[bj][1]) * gt); } }
    }
};

template <class E, class = void> struct epi_has_pre { static constexpr bool value = false; };
template <class E> struct epi_has_pre<E, decltype((void)E::HAS_PRE)> { static constexpr bool value = E::HAS_PRE; };
template <class Epi, class Sched>
__device__ __forceinline__ void gemm_simple(int wave, const Gemm g, const Sched& S, const Epi& E) {
    const int wid = launder_s(wave), lane = lane_id_v(), wr = wid >> 2, wc = wid & 3, fr = lane & 15, fq = lane >> 4;
    Unit u; u.e = 0;
    for (int ui = 0; S.next(ui, u); ++ui) {
        f32x4 acc[2][2][4][2];
#pragma unroll
        for (int a = 0; a < 2; ++a)
#pragma unroll
            for (int b = 0; b < 2; ++b)
#pragma unroll
                for (int m = 0; m < 4; ++m)
#pragma unroll
                    for (int n = 0; n < 2; ++n) acc[a][b][m][n] = (f32x4){0.f, 0.f, 0.f, 0.f};
        unsigned ao[2][4], bo[2][2];
#pragma unroll
        for (int ai = 0; ai < 2; ++ai)
#pragma unroll
            for (int m = 0; m < 4; ++m) { const int rl = ai * HALF + wr * 64 + m * 16 + fr;
                if (g.gather) { const int tok = g.gather[(size_t)u.e * T + u.slot0 + (rl < u.nvalid ? rl : u.nvalid - 1)] >> 2; ao[ai][m] = (unsigned)tok * (unsigned)g.lda + fq * 8; }
                else ao[ai][m] = u.aoff + (unsigned)rl * (unsigned)g.lda + fq * 8; }
#pragma unroll
        for (int bj = 0; bj < 2; ++bj)
#pragma unroll
            for (int n = 0; n < 2; ++n) { const int slot = 16 * n + fr, brow = bj * HALF + wc * 32 + (Epi::PERM ? perm32(slot) : slot); bo[bj][n] = u.boff + (unsigned)brow * (unsigned)g.ldb + fq * 8; }
#pragma unroll 1
        for (int k = 0; k < g.K; k += 32) {
            bf16x8 b[2][2];
#pragma unroll
            for (int bj = 0; bj < 2; ++bj)
#pragma unroll
                for (int n = 0; n < 2; ++n) b[bj][n] = *(const bf16x8*)(g.Bt + (size_t)bo[bj][n] + k);
#pragma unroll
            for (int ai = 0; ai < 2; ++ai) {
                bf16x8 a[4];
#pragma unroll
                for (int m = 0; m < 4; ++m) a[m] = *(const bf16x8*)(g.A + (size_t)ao[ai][m] + k);
#pragma unroll
                for (int bj = 0; bj < 2; ++bj)
#pragma unroll
                    for (int m = 0; m < 4; ++m)
#pragma unroll
                        for (int n = 0; n < 2; ++n) acc[ai][bj][m][n] = __builtin_amdgcn_mfma_f32_16x16x32_bf16(b[bj][n], a[m], acc[ai][bj][m][n], 0, 0, 0);
            }
        }
        E(acc, u, wr, wc, fr, fq);
    }
}

typedef int v8i32 __attribute__((ext_vector_type(8)));
typedef int v4i32 __attribute__((ext_vector_type(4)));
template <int ES> struct Frag;
template <> struct Frag<2> { bf16x8 k[2]; };
template <> struct Frag<1> { v8i32 v; };
__device__ __forceinline__ void ld_frag(Frag<2>& f, const LAS unsigned char* p) { f.k[0] = *(const LAS bf16x8*)p; f.k[1] = *(const LAS bf16x8*)(p + 1024); }
__device__ __forceinline__ void ld_frag(Frag<1>& f, const LAS unsigned char* p) { const v4i32 lo = *(const LAS v4i32*)p, hi = *(const LAS v4i32*)(p + 1024); f.v = __builtin_shufflevector(lo, hi, 0, 1, 2, 3, 4, 5, 6, 7); }
__device__ __forceinline__ f32x4 mma_frag(const Frag<2>& b, const Frag<2>& a, f32x4 c) { c = __builtin_amdgcn_mfma_f32_16x16x32_bf16(b.k[0], a.k[0], c, 0, 0, 0); return __builtin_amdgcn_mfma_f32_16x16x32_bf16(b.k[1], a.k[1], c, 0, 0, 0); }
#ifndef FP8_ASM
#define FP8_ASM 1
#endif
#if FP8_ASM
__device__ __forceinline__ f32x4 mma_frag(const Frag<1>& b, const Frag<1>& a, f32x4 c) { asm volatile("v_mfma_f32_16x16x128_f8f6f4 %0, %1, %2, %0" : "+v"(c) : "v"(b.v), "v"(a.v)); return c; }
#else
__device__ __forceinline__ f32x4 mma_frag(const Frag<1>& b, const Frag<1>& a, f32x4 c) { return __builtin_amdgcn_mfma_scale_f32_16x16x128_f8f6f4(b.v, a.v, c, 0, 0, 0, 0, 0, 0); }
#endif
template <class Epi, class Sched, int ES  >
__device__ __forceinline__ void gemm_fast(LAS unsigned char* lds, int wave, const Gemm g, const Sched& S, const Epi& E) {
    const int wid = launder_s(wave), lane = lane_id_v(), tid = wid * 64 + lane, wr = wid >> 2, wc = wid & 3, fr = lane & 15, fq = lane >> 4;
    const int K = launder_s(g.K), nt = K * ES / (BK * 2);
    unsigned voffB[2];
#pragma unroll
    for (int i = 0; i < 2; ++i) { int R, C; stage_rc(tid * 16 + i * 8192, R, C); const int Rb = Epi::PERM ? ((R & ~31) + perm32(R & 31)) : R; voffB[i] = (unsigned)Rb * (unsigned)g.ldb * (unsigned)ES + (unsigned)C * 2u; }
    const size_t kstep = (size_t)(BK * 2);
    const size_t hstepB = (size_t)HALF * g.ldb * ES;
    const unsigned ldsw = (unsigned)wid * 1024u;
    const int aoff = lds_byte(wr * 64 + fr, fq * 8), boff = lds_byte(wc * 32 + fr, fq * 8);
    const char* const Abase = (const char*)g.A; const char* const Bbase = (const char*)g.Bt;
#define PG8_SA(b, h) (((b) * 2 + (h)) * HTB)
#define PG8_SB(b, h) ((4 + (b) * 2 + (h)) * HTB)
#define PG8_STAGE_A(bufoff, ao, kb) do { _Pragma("unroll") for (int _i = 0; _i < 2; ++_i) \
        __builtin_amdgcn_global_load_lds((const unsigned*)(Abase + (size_t)(ao)[_i] + (size_t)(kb)), (LAS unsigned*)(lds + (bufoff) + ldsw + _i * 8192), 16, 0, 0); } while (0)
#define PG8_STAGE_B(bufoff, gbase) do { _Pragma("unroll") for (int _i = 0; _i < 2; ++_i) \
        __builtin_amdgcn_global_load_lds((const unsigned*)((const char*)(gbase) + voffB[_i]), (LAS unsigned*)(lds + (bufoff) + ldsw + _i * 8192), 16, 0, 0); } while (0)
#define PG8_LDA(dst, b, h) do { _Pragma("unroll") for (int m = 0; m < 4; ++m) ld_frag(dst[m], lds + PG8_SA(b, h) + aoff + m * 2048); } while (0)
#define PG8_LDB(dst, b, h) do { _Pragma("unroll") for (int n = 0; n < 2; ++n) ld_frag(dst[n], lds + PG8_SB(b, h) + boff + n * 2048); } while (0)
#define PG8_MMA(ai, bj, At, Bt) do { __builtin_amdgcn_s_setprio(1); _Pragma("unroll") for (int m = 0; m < 4; ++m) _Pragma("unroll") for (int n = 0; n < 2; ++n) acc[ai][bj][m][n] = mma_frag(Bt[n], At[m], acc[ai][bj][m][n]); \
        __builtin_amdgcn_s_setprio(0); } while (0)
#define PG8_WAIT_V(n) asm volatile("s_waitcnt vmcnt(" #n ")" ::: "memory")
#define PG8_WAIT_L(n) asm volatile("s_waitcnt lgkmcnt(" #n ")" ::: "memory")
#define PG8_BAR __builtin_amdgcn_s_barrier()
#define PG8_SCHED __builtin_amdgcn_sched_barrier(0)
#define PG8_AOFFS(u, ao) do { if (g.gather) { const int* _gp = g.gather + (size_t)(u).e * T + (u).slot0; const int _nv1 = (u).nvalid - 1; int _tk[2][2]; \
            _Pragma("unroll") for (int _h = 0; _h < 2; ++_h) _Pragma("unroll") for (int _i = 0; _i < 2; ++_i) { int _R, _C; stage_rc(tid * 16 + _i * 8192, _R, _C); const int _rl = _h * HALF + _R; _tk[_h][_i] = _gp[_rl < _nv1 ? _rl : _nv1]; } \
            _Pragma("unroll") for (int _h = 0; _h < 2; ++_h) _Pragma("unroll") for (int _i = 0; _i < 2; ++_i) { int _R, _C; stage_rc(tid * 16 + _i * 8192, _R, _C); ao[_h][_i] = (unsigned)(_tk[_h][_i] >> 2) * (unsigned)g.lda * (unsigned)ES + (unsigned)_C * 2u; } } \
        else { _Pragma("unroll") for (int _h = 0; _h < 2; ++_h) _Pragma("unroll") for (int _i = 0; _i < 2; ++_i) { int _R, _C; stage_rc(tid * 16 + _i * 8192, _R, _C); ao[_h][_i] = ((u).aoff + (unsigned)(_h * HALF + _R) * (unsigned)g.lda) * (unsigned)ES + (unsigned)_C * 2u; } } } while (0)
    Unit cur, nxt; int ui = 0; cur.e = 0;
    if (!S.next(0, cur)) return;
    constexpr bool PROF = (PROF_REGION != 0) && ((PROF_SITES >> Epi::SITE_ID) & 1);
    unsigned long long prof_acc = 0, prof_t0 = (PROF && PROF_REGION == 1) ? __builtin_amdgcn_s_memrealtime() : 0ull;
#define PG8_PROF(r, begin) do { if (PROF && PROF_REGION == (r) && wid == 0) { const unsigned long long _t = __builtin_amdgcn_s_memrealtime(); if (begin) prof_t0 = _t; else prof_acc += _t - prof_t0; } } while (0)
    f32x4 acc[2][2][4][2];
#pragma unroll
    for (int a = 0; a < 2; ++a)
#pragma unroll
        for (int b = 0; b < 2; ++b)
#pragma unroll
            for (int m = 0; m < 4; ++m)
#pragma unroll
                for (int n = 0; n < 2; ++n) acc[a][b][m][n] = (f32x4){0.f, 0.f, 0.f, 0.f};
    Frag<ES> At[4], B0[2], B1[2];
    unsigned aC[2][2], aN[2][2];
    PG8_AOFFS(cur, aC);
    if constexpr (epi_has_pre<Epi>::value) E.prefetch(lds + META_OFF, cur, wid, lane);
    const char* cB = Bbase + (size_t)cur.boff * ES;
    PG8_STAGE_B(PG8_SB(0, 0), cB); PG8_STAGE_B(PG8_SB(0, 1), cB + hstepB); PG8_STAGE_A(PG8_SA(0, 0), aC[0], 0); PG8_STAGE_A(PG8_SA(0, 1), aC[1], 0);
    if (wr == 1) PG8_BAR;
    PG8_WAIT_V(2); PG8_BAR;
    PG8_STAGE_B(PG8_SB(1, 0), cB + kstep); PG8_STAGE_A(PG8_SA(1, 0), aC[0], kstep); PG8_STAGE_B(PG8_SB(1, 1), cB + hstepB + kstep);
    PG8_WAIT_V(6); PG8_BAR;
    for (;;) {
        nxt.e = cur.e;
        const bool has_next = S.next(ui + 1, nxt);
        if (has_next) { PG8_AOFFS(nxt, aN); } else {
#pragma unroll
            for (int h = 0; h < 2; ++h)
#pragma unroll
                for (int i = 0; i < 2; ++i) aN[h][i] = aC[h][i]; }
        const char* nB = has_next ? Bbase + (size_t)nxt.boff * ES : cB;
        PG8_PROF(1, false); PG8_PROF(2, true);
#pragma unroll 1
        for (int t = 0; t < nt; t += 2) {
            const bool last = (t == nt - 2);
            const size_t k1 = (size_t)(t + 1) * kstep, k2 = last ? 0 : (size_t)(t + 2) * kstep, k3 = k2 + kstep;
            unsigned a2[2][2];
#pragma unroll
            for (int h = 0; h < 2; ++h)
#pragma unroll
                for (int i = 0; i < 2; ++i) a2[h][i] = last ? aN[h][i] : aC[h][i];
            const char* b2 = last ? nB : cB + (size_t)(t + 2) * kstep; const char* b3 = b2 + kstep;
            PG8_LDB(B0, 0, 0); PG8_LDB(B1, 0, 1); PG8_SCHED; PG8_LDA(At, 0, 0); PG8_STAGE_A(PG8_SA(1, 1), aC[1], k1);
            PG8_WAIT_V(8); PG8_WAIT_L(0); PG8_BAR; PG8_MMA(0, 0, At, B0); PG8_MMA(0, 1, At, B1); PG8_BAR; PG8_SCHED;
            PG8_LDA(At, 0, 1); PG8_STAGE_B(PG8_SB(0, 0), b2); PG8_STAGE_B(PG8_SB(0, 1), b2 + hstepB); PG8_STAGE_A(PG8_SA(0, 0), a2[0], k2);
            PG8_WAIT_V(8); PG8_WAIT_L(0); PG8_BAR; PG8_MMA(1, 0, At, B0); PG8_MMA(1, 1, At, B1); PG8_BAR; PG8_SCHED;
            PG8_LDB(B0, 1, 0); PG8_LDB(B1, 1, 1); PG8_SCHED; PG8_LDA(At, 1, 0); PG8_STAGE_A(PG8_SA(0, 1), a2[1], k2);
            PG8_WAIT_V(8); PG8_WAIT_L(0); PG8_BAR; PG8_MMA(0, 0, At, B0); PG8_MMA(0, 1, At, B1); PG8_BAR; PG8_SCHED;
            PG8_LDA(At, 1, 1); PG8_STAGE_B(PG8_SB(1, 0), b3); PG8_STAGE_B(PG8_SB(1, 1), b3 + hstepB); PG8_STAGE_A(PG8_SA(1, 0), a2[0], k3);
            PG8_WAIT_V(8); PG8_WAIT_L(0); PG8_BAR; PG8_MMA(1, 0, At, B0); PG8_MMA(1, 1, At, B1); PG8_BAR; PG8_SCHED;
        }
        PG8_PROF(2, false); PG8_PROF(1, true);
        if constexpr (ES == 1 && FP8_ASM) asm volatile("s_nop 15\n\ts_nop 15\n\ts_nop 15" ::: "memory");
        if (wr == 0) PG8_BAR;
        if constexpr (epi_has_pre<Epi>::value) E.epi_lds(acc, cur, wr, wc, fr, fq, lds + META_OFF + (ui & 1) * META_BYTES); else E(acc, cur, wr, wc, fr, fq);
        if (!has_next) break;
#pragma unroll
        for (int a = 0; a < 2; ++a)
#pragma unroll
            for (int b = 0; b < 2; ++b)
#pragma unroll
                for (int m = 0; m < 4; ++m)
#pragma unroll
                    for (int n = 0; n < 2; ++n) acc[a][b][m][n] = (f32x4){0.f, 0.f, 0.f, 0.f};
        cur = nxt; cB = nB; ++ui;
        if constexpr (epi_has_pre<Epi>::value) E.prefetch(lds + META_OFF + (ui & 1) * META_BYTES, cur, wid, lane);
#pragma unroll
        for (int h = 0; h < 2; ++h)
#pragma unroll
            for (int i = 0; i < 2; ++i) aC[h][i] = aN[h][i];
        if (wr == 1) PG8_BAR;
    }
    PG8_WAIT_V(0);
    if (PROF && wid == 0) { PG8_PROF(1, false); if (lane == 0) { volatile LAS unsigned* pw = (volatile LAS unsigned*)(lds + LDSCTL_OFF) + MISC_PROF; *pw = *pw + (unsigned)prof_acc; } }
    PG8_BAR;
#undef PG8_SA
#undef PG8_SB
#undef PG8_STAGE_A
#undef PG8_STAGE_B
#undef PG8_LDA
#undef PG8_LDB
#undef PG8_MMA
#undef PG8_WAIT_V
#undef PG8_WAIT_L
#undef PG8_BAR
#undef PG8_SCHED
#undef PG8_AOFFS
#undef PG8_PROF
}

template <class Epi, class Sched, int SITE>
__device__ __forceinline__ void gemm_phase(LAS unsigned char* lds, int wave, const Gemm g, const Sched& S, const Epi& E) {
    if constexpr (Epi::ES == 1) gemm_fast<Epi, Sched, 1>(lds, wave, g, S, E);
    else if constexpr ((FAST_MASK >> SITE) & 1) gemm_fast<Epi, Sched, 2>(lds, wave, g, S, E); else gemm_simple<Epi, Sched>(wave, g, S, E);
}
}

struct Frame {
    LAS unsigned char* lds;
    volatile LAS unsigned* MISC;
    unsigned* ctl;
    int tid, lane, wave, vcu, G;
};
struct Args { const float* in[21]; float* out; unsigned char* ws; int ph_lo, ph_hi; };
static_assert(sizeof(Args) == 21 * 8 + 8 + 8 + 8, "Args has no padding");

__device__ __forceinline__ void mods_phase(Frame& F, const float* c, const float* ada_w, const float* ada_b, float* MOD) {
    LAS float* cact = (LAS float*)F.lds;
    LAS float* part = (LAS float*)(F.lds + 8192);
    for (int i = F.tid; i < BATCH * D; i += NTHREADS) { const float v = c[i]; cact[i] = v * fast_sigmoid(v); }
    __syncthreads();
    constexpr int NTASK = DEPTH * (6 * D / 64);
    for (int task = F.vcu; task < NTASK; task += F.G) {
        const int l = task / (6 * D / 64), j0 = (task % (6 * D / 64)) * 64;
        const float* w = ada_w + (size_t)l * D * (6 * D) + j0 + F.lane;
        const int k0 = F.wave * 128;
        float a0 = 0.f, a1 = 0.f;
#pragma unroll 16
        for (int k = 0; k < 128; ++k) { const float wv = w[(size_t)(k0 + k) * (6 * D)]; a0 += cact[k0 + k] * wv; a1 += cact[D + k0 + k] * wv; }
        part[(F.wave * 2 + 0) * 64 + F.lane] = a0; part[(F.wave * 2 + 1) * 64 + F.lane] = a1;
        __syncthreads();
        if (F.tid < 128) { const int b = F.tid >> 6, j = F.tid & 63; float s = 0.f;
#pragma unroll
            for (int w8 = 0; w8 < 8; ++w8) s += part[(w8 * 2 + b) * 64 + j];
            MOD[((size_t)l * BATCH + b) * (6 * D) + j0 + j] = s + ada_b[(size_t)l * (6 * D) + j0 + j]; }
        __syncthreads();
    }
}
__device__ __forceinline__ void tr_item(const float* W, int ldw, bf16_t* WT, int ldt, int k0, int n0, int drow0, int dcol0, LAS float* scr, int lane) {
#pragma unroll 8
    for (int i = 0; i < 32; ++i) { const int kk = 2 * i + (lane >> 5); scr[kk * 33 + (lane & 31)] = W[(size_t)(k0 + kk) * ldw + n0 + (lane & 31)]; }
    LDS_WAIT(); asm volatile("" ::: "memory");
    const int c = lane & 7;
#pragma unroll
    for (int j = 0; j < 4; ++j) { const int n = (lane >> 3) + 8 * j; const LAS float* s = scr + (8 * c) * 33 + n;
        u32x4 o; o.x = pk2(s[0 * 33], s[1 * 33]); o.y = pk2(s[2 * 33], s[3 * 33]); o.z = pk2(s[4 * 33], s[5 * 33]); o.w = pk2(s[6 * 33], s[7 * 33]);
        *(u32x4*)(WT + (size_t)(drow0 + n) * ldt + dcol0 + k0 + 8 * c) = o; }
    LDS_WAIT(); asm volatile("" ::: "memory");
}
__device__ __forceinline__ void tr_item8(const float* W, int ldw, unsigned char* WT, int ldt, int k0, int n0, int drow0, float scale, LAS float* scr, int lane) {
#pragma unroll 8
    for (int i = 0; i < 32; ++i) { const int kk = 2 * i + (lane >> 5); scr[kk * 33 + (lane & 31)] = W[(size_t)(k0 + kk) * ldw + n0 + (lane & 31)]; }
    LDS_WAIT(); asm volatile("" ::: "memory");
    const int c = lane & 3;
#pragma unroll
    for (int j = 0; j < 2; ++j) { const int n = (lane >> 2) + 16 * j; const LAS float* sp = scr + (16 * c) * 33 + n;
        u32x4 o; o.x = pk4_fp8(sp[0 * 33] * scale, sp[1 * 33] * scale, sp[2 * 33] * scale, sp[3 * 33] * scale); o.y = pk4_fp8(sp[4 * 33] * scale, sp[5 * 33] * scale, sp[6 * 33] * scale, sp[7 * 33] * scale);
        o.z = pk4_fp8(sp[8 * 33] * scale, sp[9 * 33] * scale, sp[10 * 33] * scale, sp[11 * 33] * scale); o.w = pk4_fp8(sp[12 * 33] * scale, sp[13 * 33] * scale, sp[14 * 33] * scale, sp[15 * 33] * scale);
        *(u32x4*)(WT + (size_t)(drow0 + n) * ldt + k0 + 16 * c) = o; }
    LDS_WAIT(); asm volatile("" ::: "memory");
}
__device__ __forceinline__ int win_drow(int n0) {
    if (n0 < 512) return n0; if (n0 < 768) return 3328 + (n0 - 512); if (n0 < 1536) return 512 + (n0 - 768); return 1280 + (n0 - 1536);
}
typedef const volatile __attribute__((address_space(4))) Args* KArgs;
__device__ __forceinline__ void convert_phase(Frame& F, KArgs ka) {
    unsigned char* wsb = (unsigned char*)ka->ws; const float *in8 = (const float*)ka->in[8], *in9 = (const float*)ka->in[9], *in12 = (const float*)ka->in[12], *in13 = (const float*)ka->in[13], *in14 = (const float*)ka->in[14], *in15 = (const float*)ka->in[15], *in17 = (const float*)ka->in[17], *in19 = (const float*)ka->in[19];
    LAS float* scr = (LAS float*)(F.lds + F.wave * 16384);
    const int gw = F.vcu * NWAVES + F.wave, NGW = F.G * NWAVES;
    constexpr int I_IN = 16 * 112, I_BRA = 4 * 32, I_BRP = 12 * 32, I_OUT = 16 * 32, I_RT = 16, I_PL = 4 * 3 * 6, I_GU = NE * 16 * 64, I_DN = NE * 16 * 32;
    constexpr int I_LAYER = I_IN + I_BRA + I_BRP + I_OUT + I_RT + I_PL + I_GU + I_DN;
    for (int it = gw; it < DEPTH * I_LAYER; it += NGW) {
        const int l = it / I_LAYER; int r = it % I_LAYER;
        unsigned char* wl = wsb + WS_W + (size_t)l * WL_STRIDE;
        if (r < I_GU) { const int e = r / (16 * 64), q = r % (16 * 64), kb = q / 64, nb = q % 64, n0 = nb * 32, half = n0 / D, cc = n0 % D;
            tr_item8(in17 + ((size_t)l * NE + e) * D * (2 * D), 2 * D, (unsigned char*)(wl + WO_GU) + (size_t)e * (2 * D) * D, D, kb * 64, n0, (cc / 128) * 256 + half * 128 + (cc % 128), W8_SCALE, scr, F.lane); continue; } r -= I_GU;
        if (r < I_DN) { const int e = r / (16 * 32), q = r % (16 * 32), kb = q / 32, nb = q % 32;
            tr_item8(in19 + ((size_t)l * NE + e) * D * D, D, (unsigned char*)(wl + WO_DN) + (size_t)e * D * D, D, kb * 64, nb * 32, nb * 32, W8_SCALE, scr, F.lane); continue; } r -= I_DN;
        if (r < I_IN) { const int kb = r / 112, nb = r % 112;
            tr_item(in8 + (size_t)l * D * INW, INW, (bf16_t*)(wl + WO_WIN), D, kb * 64, nb * 32, win_drow(nb * 32), 0, scr, F.lane); continue; } r -= I_IN;
        if (r < I_BRA) { const int kb = r / 32, nb = r % 32;
            tr_item(in12 + (size_t)l * SBW * D, D, (bf16_t*)(wl + WO_BRA), SBW, kb * 64, nb * 32, nb * 32, 0, scr, F.lane); continue; } r -= I_BRA;
        if (r < I_BRP) { const int kb = r / 32, nb = r % 32;
            tr_item(in13 + (size_t)l * PW * D, D, (bf16_t*)(wl + WO_BRP), PW, kb * 64, nb * 32, nb * 32, 0, scr, F.lane); continue; } r -= I_BRP;
        if (r < I_OUT) { const int kb = r / 32, nb = r % 32;
            tr_item(in14 + (size_t)l * D * D, D, (bf16_t*)(wl + WO_OUT), D, kb * 64, nb * 32, nb * 32, 0, scr, F.lane); continue; } r -= I_OUT;
        if (r < I_RT) { tr_item(in15 + (size_t)l * D * NE, NE, (bf16_t*)(wl + WO_ROUTER), D, r * 64, 0, 0, 0, scr, F.lane); continue; } r -= I_RT;
        { const int gidx = r / 18, q = r % 18, kb = q / 6, nb = q % 6;
            tr_item(in9 + ((size_t)l * 4 + gidx) * PGD * PGD, PGD, (bf16_t*)(wl + WO_POOL), PW, kb * 64, nb * 32, gidx * PGD + nb * 32, gidx * PGD, scr, F.lane); }
    }
    for (int it = gw; it < DEPTH * PW; it += NGW) { const int l = it / PW, n = it % PW, gidx = n / PGD;
        bf16_t* rowp = (bf16_t*)(wsb + WS_W + (size_t)l * WL_STRIDE + WO_POOL) + (size_t)n * PW;
        for (int ch = F.lane; ch < PW / 8; ch += 64) if (ch / (PGD / 8) != gidx) *(u32x4*)(rowp + ch * 8) = (u32x4){0u, 0u, 0u, 0u}; }
}

struct Row16 { f32x4 a[4]; };
__device__ __forceinline__ void ld_row_f32(const float* p, int lane, Row16& v) {
#pragma unroll
    for (int j = 0; j < 2; ++j) { v.a[2 * j] = *(const f32x4*)(p + 8 * lane + 512 * j); v.a[2 * j + 1] = *(const f32x4*)(p + 8 * lane + 512 * j + 4); } }
__device__ __forceinline__ void st_row_f32(float* p, int lane, const Row16& v) {
#pragma unroll
    for (int j = 0; j < 2; ++j) { *(f32x4*)(p + 8 * lane + 512 * j) = v.a[2 * j]; *(f32x4*)(p + 8 * lane + 512 * j + 4) = v.a[2 * j + 1]; } }
__device__ __forceinline__ void ld_row_bf16(const bf16_t* p, int lane, u32x4 (&w)[2]) {
#pragma unroll
    for (int j = 0; j < 2; ++j) w[j] = *(const u32x4*)(p + 8 * lane + 512 * j); }
__device__ __forceinline__ void acc_row_bf16(const u32x4 (&w)[2], Row16& y) {
#pragma unroll
    for (int j = 0; j < 2; ++j) { f32x4 lo, hi; pg8::unpack8(w[j], lo, hi); y.a[2 * j] = y.a[2 * j] + lo; y.a[2 * j + 1] = y.a[2 * j + 1] + hi; } }
__device__ __forceinline__ void ld_row_x(const void* base, bool is_bf16, size_t row, int lane, Row16& v) {
    if (is_bf16) { u32x4 w[2]; ld_row_bf16((const bf16_t*)base + row * D, lane, w);
#pragma unroll
        for (int i = 0; i < 4; ++i) v.a[i] = (f32x4){0.f, 0.f, 0.f, 0.f};
        acc_row_bf16(w, v); }
    else ld_row_f32((const float*)base + row * D, lane, v); }
__device__ __forceinline__ void st_row_x(void* base, bool is_bf16, size_t row, int lane, const Row16& v) {
    if (is_bf16) {
#pragma unroll
        for (int j = 0; j < 2; ++j) { u32x4 w; w.x = pk2(v.a[2 * j].x, v.a[2 * j].y); w.y = pk2(v.a[2 * j].z, v.a[2 * j].w); w.z = pk2(v.a[2 * j + 1].x, v.a[2 * j + 1].y); w.w = pk2(v.a[2 * j + 1].z, v.a[2 * j + 1].w);
            *(u32x4*)((bf16_t*)base + row * D + 8 * lane + 512 * j) = w; } }
    else st_row_f32((float*)base + row * D, lane, v); }
__device__ __forceinline__ float row_sumsq(const Row16& v) { float ss = 0.f;
#pragma unroll
    for (int q = 0; q < 4; ++q) ss += (v.a[q].x * v.a[q].x + v.a[q].y * v.a[q].y) + (v.a[q].z * v.a[q].z + v.a[q].w * v.a[q].w);
    return ss; }
__device__ __forceinline__ void norm_mod_store(const Row16& v, float ss_wave, const Row16& gg, const Row16& s1, const Row16& s0, bf16_t* hrow, int lane, unsigned char* h8row = nullptr) {
    const float r = 1.0f / sqrtf(ss_wave * (1.0f / D) + NORM_EPS);
#pragma unroll
    for (int j = 0; j < 2; ++j) { const f32x4 o0 = v.a[2 * j] * r * gg.a[2 * j] * (s1.a[2 * j] + 1.0f) + s0.a[2 * j], o1 = v.a[2 * j + 1] * r * gg.a[2 * j + 1] * (s1.a[2 * j + 1] + 1.0f) + s0.a[2 * j + 1];
        u32x4 w; w.x = pk2(o0.x, o0.y); w.y = pk2(o0.z, o0.w); w.z = pk2(o1.x, o1.y); w.w = pk2(o1.z, o1.w); *(u32x4*)(hrow + 8 * lane + 512 * j) = w;
        if (h8row) { u32x2 q; q.x = pk4_fp8(o0.x, o0.y, o0.z, o0.w); q.y = pk4_fp8(o1.x, o1.y, o1.z, o1.w); *(u32x2*)(h8row + 8 * lane + 512 * j) = q; } }
}
constexpr int RP = 2;
__device__ __forceinline__ void rowpass_pre(Frame& F, const float* x, const float* g, const float* MODl, bf16_t* H) {
    const int gw = F.vcu * NWAVES + F.wave, NGW = F.G * NWAVES;
    Row16 gg; ld_row_f32(g, F.lane, gg);
    for (int row0 = gw * RP; row0 < T; row0 += NGW * RP) { const int b = row0 / SEQ; const float* mod = MODl + (size_t)b * 6 * D;
        Row16 v[RP], s1, s0; float ss[RP];
#pragma unroll
        for (int q = 0; q < RP; ++q) ld_row_f32(x + (size_t)(row0 + q) * D, F.lane, v[q]);
        ld_row_f32(mod + 1 * D, F.lane, s1); ld_row_f32(mod + 0 * D, F.lane, s0);
#pragma unroll
        for (int q = 0; q < RP; ++q) ss[q] = row_sumsq(v[q]);
#pragma unroll
        for (int o = 1; o < 64; o <<= 1) {
#pragma unroll
            for (int q = 0; q < RP; ++q) ss[q] += __shfl_xor(ss[q], o); }
#pragma unroll
        for (int q = 0; q < RP; ++q) norm_mod_store(v[q], ss[q], gg, s1, s0, H + (size_t)(row0 + q) * D, F.lane); }
}
__device__ __forceinline__ void rowpass_mid(Frame& F, int row_begin, int row_end, int row_step, const void* xin, bool xin_bf16, bf16_t* xout, const bf16_t* Y, const float* post_g, const float* pre2_g, const float* MODl, bf16_t* H, unsigned char* H8) {
    for (int row0 = row_begin; row0 < row_end; row0 += row_step) { const int b = row0 / SEQ; const float* mod = MODl + (size_t)b * 6 * D;
        Row16 v[RP], y[RP]; float ss[RP];
#pragma unroll
        for (int q = 0; q < RP; ++q) { ld_row_x(xin, xin_bf16, (size_t)(row0 + q), F.lane, v[q]); u32x4 w[2]; ld_row_bf16(Y + (size_t)(row0 + q) * D, F.lane, w);
#pragma unroll
            for (int i = 0; i < 4; ++i) y[q].a[i] = (f32x4){0.f, 0.f, 0.f, 0.f};
            acc_row_bf16(w, y[q]); }
        { Row16 pg, g1; ld_row_f32(post_g, F.lane, pg); ld_row_f32(mod + 2 * D, F.lane, g1);
#pragma unroll
            for (int q = 0; q < RP; ++q) ss[q] = row_sumsq(y[q]);
#pragma unroll
            for (int o = 1; o < 64; o <<= 1) {
#pragma unroll
                for (int q = 0; q < RP; ++q) ss[q] += __shfl_xor(ss[q], o); }
#pragma unroll
            for (int q = 0; q < RP; ++q) { const float r = 1.0f / sqrtf(ss[q] * (1.0f / D) + NORM_EPS);
#pragma unroll
                for (int i = 0; i < 4; ++i) v[q].a[i] = v[q].a[i] + g1.a[i] * (y[q].a[i] * r * pg.a[i]);
                st_row_x(xout, true, (size_t)(row0 + q), F.lane, v[q]); } }
        { Row16 gg, s1, s0; ld_row_f32(pre2_g, F.lane, gg); ld_row_f32(mod + 4 * D, F.lane, s1); ld_row_f32(mod + 3 * D, F.lane, s0);
#pragma unroll
            for (int q = 0; q < RP; ++q) ss[q] = row_sumsq(v[q]);
#pragma unroll
            for (int o = 1; o < 64; o <<= 1) {
#pragma unroll
                for (int q = 0; q < RP; ++q) ss[q] += __shfl_xor(ss[q], o); }
#pragma unroll
            for (int q = 0; q < RP; ++q) norm_mod_store(v[q], ss[q], gg, s1, s0, H + (size_t)(row0 + q) * D, F.lane, H8 + (size_t)(row0 + q) * D); } }
}
__device__ __forceinline__ void rowpass_comb(Frame& F, const bf16_t* x, void* xout, bool xout_bf16, const bf16_t* YR4, const float* post_g, const float* MODl,
                                             bool has_next, const float* pre1_g_next, const float* MODn, bf16_t* H) {
    const int gw = F.vcu * NWAVES + F.wave, NGW = F.G * NWAVES;
    for (int row0 = gw * RP; row0 < T; row0 += NGW * RP) { const int b = row0 / SEQ; const float* mod = MODl + (size_t)b * 6 * D;
        Row16 v[RP], y[RP]; float ss[RP]; u32x4 w[RP][TOPK][2];
#pragma unroll
        for (int q = 0; q < RP; ++q) { ld_row_x(x, true, (size_t)(row0 + q), F.lane, v[q]);
#pragma unroll
            for (int k = 0; k < TOPK; ++k) ld_row_bf16(YR4 + ((size_t)(row0 + q) * TOPK + k) * D, F.lane, w[q][k]); }
#pragma unroll
        for (int q = 0; q < RP; ++q) {
#pragma unroll
            for (int i = 0; i < 4; ++i) y[q].a[i] = (f32x4){0.f, 0.f, 0.f, 0.f};
#pragma unroll
            for (int k = 0; k < TOPK; ++k) acc_row_bf16(w[q][k], y[q]); }
        { Row16 pg, g2; ld_row_f32(post_g, F.lane, pg); ld_row_f32(mod + 5 * D, F.lane, g2);
#pragma unroll
            for (int q = 0; q < RP; ++q) ss[q] = row_sumsq(y[q]);
#pragma unroll
            for (int o = 1; o < 64; o <<= 1) {
#pragma unroll
                for (int q = 0; q < RP; ++q) ss[q] += __shfl_xor(ss[q], o); }
#pragma unroll
            for (int q = 0; q < RP; ++q) { const float r = 1.0f / sqrtf(ss[q] * (1.0f / D) + NORM_EPS);
#pragma unroll
                for (int i = 0; i < 4; ++i) v[q].a[i] = v[q].a[i] + g2.a[i] * (y[q].a[i] * r * pg.a[i]);
                st_row_x(xout, xout_bf16, (size_t)(row0 + q), F.lane, v[q]); } }
        if (has_next) { const float* modn = MODn + (size_t)b * 6 * D; Row16 gg, s1, s0; ld_row_f32(pre1_g_next, F.lane, gg); ld_row_f32(modn + 1 * D, F.lane, s1); ld_row_f32(modn + 0 * D, F.lane, s0);
#pragma unroll
            for (int q = 0; q < RP; ++q) ss[q] = row_sumsq(v[q]);
#pragma unroll
            for (int o = 1; o < 64; o <<= 1) {
#pragma unroll
                for (int q = 0; q < RP; ++q) ss[q] += __shfl_xor(ss[q], o); }
#pragma unroll
            for (int q = 0; q < RP; ++q) norm_mod_store(v[q], ss[q], gg, s1, s0, H + (size_t)(row0 + q) * D, F.lane); } }
}

__device__ __forceinline__ void attn_phase(Frame& F, const bf16_t* Q, const bf16_t* KB, const bf16_t* VT, bf16_t* AP) {
    const int gw = F.vcu * NWAVES + F.wave, NGW = F.G * NWAVES;
    const int r = F.lane & 31, hh = F.lane >> 5;
    constexpr int NQT = SEQ / 32, NTASK = BATCH * NH * NQT;
    for (int task = gw; task < NTASK; task += NGW) {
        const int qt = task % NQT, h = (task / NQT) % NH, b = task / (NQT * NH), q0 = qt * 32;
        const size_t trow0 = (size_t)b * SEQ;
        bf16x8 qf[4];
#pragma unroll
        for (int ks = 0; ks < 4; ++ks) qf[ks] = *(const bf16x8*)(Q + (trow0 + q0 + r) * SBW + h * HD + ks * 16 + hh * 8);
        f32x16 o0, o1;
#pragma unroll
        for (int i = 0; i < 16; ++i) { o0[i] = 0.f; o1[i] = 0.f; }
        float C = 0.f;
        bf16x8 kf[4], kn[4]; s16x4 vlo[2][2], vhi[2][2], nlo[2][2], nhi[2][2];
#define ATT_LOAD(KF, VLO, VHI, kb_) do { const bf16_t* kp_ = KB + (trow0 + (kb_) + r) * SBW + h * HD + hh * 8; \
            _Pragma("unroll") for (int ks = 0; ks < 4; ++ks) KF[ks] = *(const bf16x8*)(kp_ + ks * 16); \
            _Pragma("unroll") for (int st = 0; st < 2; ++st) _Pragma("unroll") for (int dt = 0; dt < 2; ++dt) { const bf16_t* vp_ = VT + (size_t)(h * HD + dt * 32 + r) * VTP + trow0 + (kb_) + 16 * st + 4 * hh; VLO[st][dt] = *(const s16x4*)vp_; VHI[st][dt] = *(const s16x4*)(vp_ + 8); } } while (0)
        ATT_LOAD(kf, vlo, vhi, q0);
        for (int kb = q0; kb >= 0; kb -= 32) {
            const bool diag = (kb == q0);
            { const int nkb = kb >= 32 ? kb - 32 : 0; ATT_LOAD(kn, nlo, nhi, nkb); }
            f32x16 s;
#pragma unroll
            for (int i = 0; i < 16; ++i) s[i] = 0.f;
#pragma unroll
            for (int ks = 0; ks < 4; ++ks) s = __builtin_amdgcn_mfma_f32_32x32x16_bf16(kf[ks], qf[ks], s, 0, 0, 0);
            float lk[16];
#pragma unroll
            for (int i = 0; i < 16; ++i) { const int kc = 8 * (i >> 2) + 4 * hh + (i & 3); const bool valid = !diag || (kc < r); lk[i] = valid ? -softplus_f(s[i]) : 0.f; }
            float rt[4], pt[4], both[4];
#pragma unroll
            for (int gq = 0; gq < 4; ++gq) { lk[4 * gq + 2] += lk[4 * gq + 3]; lk[4 * gq + 1] += lk[4 * gq + 2]; lk[4 * gq + 0] += lk[4 * gq + 1]; rt[gq] = lk[4 * gq]; }
#pragma unroll
            for (int gq = 0; gq < 4; ++gq) { pt[gq] = __shfl_xor(rt[gq], 32); both[gq] = rt[gq] + pt[gq]; }
            float after[4]; after[3] = 0.f; after[2] = both[3]; after[1] = both[3] + both[2]; after[0] = after[1] + both[1];
            f32x16 a;
#pragma unroll
            for (int gq = 0; gq < 4; ++gq) { const float off = after[gq] + (hh == 0 ? pt[gq] : 0.f) + C;
#pragma unroll
                for (int j = 0; j < 4; ++j) { const int i = 4 * gq + j, kc = 8 * gq + 4 * hh + j; const bool valid = !diag || (kc < r);
                    a[i] = valid ? fast_exp(s[i] + lk[i] + off) : 0.f; } }
            C += both[0] + after[0];
#pragma unroll
            for (int st = 0; st < 2; ++st) {
                u32x4 pw; pw.x = pk2(a[8 * st + 0], a[8 * st + 1]); pw.y = pk2(a[8 * st + 2], a[8 * st + 3]); pw.z = pk2(a[8 * st + 4], a[8 * st + 5]); pw.w = pk2(a[8 * st + 6], a[8 * st + 7]);
                const bf16x8 pb = __builtin_bit_cast(bf16x8, pw);
                const bf16x8 va0 = __builtin_shufflevector(vlo[st][0], vhi[st][0], 0, 1, 2, 3, 4, 5, 6, 7), va1 = __builtin_shufflevector(vlo[st][1], vhi[st][1], 0, 1, 2, 3, 4, 5, 6, 7);
                o0 = __builtin_amdgcn_mfma_f32_32x32x16_bf16(va0, pb, o0, 0, 0, 0);
                o1 = __builtin_amdgcn_mfma_f32_32x32x16_bf16(va1, pb, o1, 0, 0, 0);
            }
            if (__all(C < STICK_EXIT)) break;
#pragma unroll
            for (int ks = 0; ks < 4; ++ks) kf[ks] = kn[ks];
#pragma unroll
            for (int st = 0; st < 2; ++st)
#pragma unroll
                for (int dt = 0; dt < 2; ++dt) { vlo[st][dt] = nlo[st][dt]; vhi[st][dt] = nhi[st][dt]; }
        }
#undef ATT_LOAD
        bf16_t* orow = AP + (trow0 + q0 + r) * D + h * HD;
#pragma unroll
        for (int gq = 0; gq < 4; ++gq) { u32x2 w0, w1; w0.x = pk2(o0[4 * gq], o0[4 * gq + 1]); w0.y = pk2(o0[4 * gq + 2], o0[4 * gq + 3]); w1.x = pk2(o1[4 * gq], o1[4 * gq + 1]); w1.y = pk2(o1[4 * gq + 2], o1[4 * gq + 3]);
            *(u32x2*)(orow + 8 * gq + 4 * hh) = w0; *(u32x2*)(orow + 32 + 8 * gq + 4 * hh) = w1; }
    }
}

__device__ __forceinline__ void ld8(const bf16_t* p, float (&v)[8]) { const u32x4 q = *(const u32x4*)p; v[0] = bf_lo(q.x); v[1] = bf_hi(q.x); v[2] = bf_lo(q.y); v[3] = bf_hi(q.y); v[4] = bf_lo(q.z); v[5] = bf_hi(q.z); v[6] = bf_lo(q.w); v[7] = bf_hi(q.w); }
template <int W> __device__ __forceinline__ void poolmix_task(const bf16_t* U, bf16_t* MIX, int gidx, int ob, int rb, int lane) {
    const int oct = gidx * (PGD / 8) + ob * 8 + (lane & 7), t0 = rb * 64 + (lane >> 3) * 8, s0 = t0 % SEQ;
    const bf16_t* up = U + (size_t)t0 * PW + oct * 8;
    u32x4 raw[8 + W - 1];
#pragma unroll
    for (int i = 0; i < 8 + W - 1; ++i) { const int rel = i - (W - 1); raw[i] = (s0 + rel >= 0) ? *(const u32x4*)(up + (ptrdiff_t)rel * PW) : (u32x4){0u, 0u, 0u, 0u}; }
    float sum[8];
#pragma unroll
    for (int j = 0; j < 8; ++j) sum[j] = 0.f;
#pragma unroll
    for (int i = 0; i < W; ++i) { f32x4 lo, hi; pg8::unpack8(raw[i], lo, hi);
#pragma unroll
        for (int j = 0; j < 4; ++j) { sum[j] += lo[j]; sum[4 + j] += hi[j]; } }
#pragma unroll
    for (int q = 0; q < 8; ++q) {
        const int s = s0 + q, cnt = (s + 1) < W ? (s + 1) : W; const float inv = 1.0f / (float)cnt;
        f32x4 lo, hi; pg8::unpack8(raw[q + W - 1], lo, hi);
        u32x4 ow; ow.x = pk2(sum[0] * inv - lo[0], sum[1] * inv - lo[1]); ow.y = pk2(sum[2] * inv - lo[2], sum[3] * inv - lo[3]);
        ow.z = pk2(sum[4] * inv - hi[0], sum[5] * inv - hi[1]); ow.w = pk2(sum[6] * inv - hi[2], sum[7] * inv - hi[3]);
        *(u32x4*)(MIX + (size_t)(t0 + q) * PW + oct * 8) = ow;
        if (q + 1 < 8) { f32x4 nl, nh, ol, oh; pg8::unpack8(raw[q + W], nl, nh); pg8::unpack8(raw[q], ol, oh);
#pragma unroll
            for (int j = 0; j < 4; ++j) { sum[j] += nl[j] - ol[j]; sum[4 + j] += nh[j] - oh[j]; } }
    }
}
__device__ __forceinline__ void poolmix_phase(Frame& F, const bf16_t* U, bf16_t* MIX) {
    const int gw = F.vcu * NWAVES + F.wave, NGW = F.G * NWAVES;
    constexpr int NRB = T / 64, NTASK = 4 * 3 * NRB;
    for (int task = gw; task < NTASK; task += NGW) { const int rb = task % NRB, ob = (task / NRB) % 3, gidx = task / (3 * NRB);
        if (gidx == 0) poolmix_task<2>(U, MIX, 0, ob, rb, F.lane); else if (gidx == 1) poolmix_task<4>(U, MIX, 1, ob, rb, F.lane);
        else if (gidx == 2) poolmix_task<8>(U, MIX, 2, ob, rb, F.lane); else poolmix_task<16>(U, MIX, 3, ob, rb, F.lane); }
}

constexpr int NBLK = T / 128;
struct MidArgs { const void* xin; bool xin_bf16; bf16_t* xout; const bf16_t* Y; const float* post_g; const float* pre2_g; const float* MODl; bf16_t* H; unsigned char* H8; };
__device__ __forceinline__ void router_phase_a(Frame& F, const MidArgs& M, const bf16_t* H, const bf16_t* RT, const float* rb, int* HIST, int* TOPE, int* TOPL, float* TOPG) {
    LAS float* lg = (LAS float*)(F.lds + F.wave * 4096);
    volatile LAS int* whist = (volatile LAS int*)(F.lds + 65536);
    const int fr = F.lane & 15, fq = F.lane >> 4;
    for (int blk = F.vcu; blk < NBLK; blk += F.G) {
        const int t0 = blk * 128 + F.wave * 16;
        rowpass_mid(F, t0, t0 + 16, RP, M.xin, M.xin_bf16, M.xout, M.Y, M.post_g, M.pre2_g, M.MODl, M.H, M.H8);
        asm volatile("s_waitcnt vmcnt(0)" ::: "memory");
        if (F.lane < NE) whist[F.wave * NE + F.lane] = 0;
        f32x4 a0 = {0.f, 0.f, 0.f, 0.f}, a1 = {0.f, 0.f, 0.f, 0.f};
        const bf16_t* hp = H + (size_t)(t0 + fr) * D + fq * 8; const bf16_t* w0 = RT + (size_t)fr * D + fq * 8; const bf16_t* w1 = RT + (size_t)(16 + fr) * D + fq * 8;
#pragma unroll 4
        for (int k = 0; k < D; k += 32) { const bf16x8 av = *(const bf16x8*)(hp + k), b0 = *(const bf16x8*)(w0 + k), b1 = *(const bf16x8*)(w1 + k);
            a0 = __builtin_amdgcn_mfma_f32_16x16x32_bf16(av, b0, a0, 0, 0, 0); a1 = __builtin_amdgcn_mfma_f32_16x16x32_bf16(av, b1, a1, 0, 0, 0); }
        const float rb0 = rb[fr], rb1 = rb[16 + fr];
#pragma unroll
        for (int j = 0; j < 4; ++j) { lg[(4 * fq + j) * 33 + fr] = a0[j] + rb0; lg[(4 * fq + j) * 33 + 16 + fr] = a1[j] + rb1; }
        LDS_WAIT(); asm volatile("" ::: "memory");
        float bv[4] = {-INFINITY, -INFINITY, -INFINITY, -INFINITY}; int bi[4] = {0, 0, 0, 0};
        if (F.lane < 16) {
            for (int e = 0; e < NE; ++e) { const float v = lg[F.lane * 33 + e];
                if (v > bv[3]) { bv[3] = v; bi[3] = e;
                    if (bv[3] > bv[2]) { float tv = bv[2]; bv[2] = bv[3]; bv[3] = tv; int ti = bi[2]; bi[2] = bi[3]; bi[3] = ti;
                        if (bv[2] > bv[1]) { tv = bv[1]; bv[1] = bv[2]; bv[2] = tv; ti = bi[1]; bi[1] = bi[2]; bi[2] = ti;
                            if (bv[1] > bv[0]) { tv = bv[0]; bv[0] = bv[1]; bv[1] = tv; ti = bi[0]; bi[0] = bi[1]; bi[1] = ti; } } } } }
        }
        float gt[4]; { float sum = 0.f;
#pragma unroll
            for (int k = 0; k < 4; ++k) { gt[k] = fast_exp(bv[k] - bv[0]); sum += gt[k]; }
            const float inv = 1.0f / sum;
#pragma unroll
            for (int k = 0; k < 4; ++k) gt[k] *= inv; }
        int rk[4];
#pragma unroll
        for (int k = 0; k < 4; ++k) {
            const int e = F.lane < 16 ? bi[k] : -1; int rank = 0;
            unsigned long long todo = __ballot(e >= 0);
            while (todo) { const int leader = __builtin_ctzll(todo); const int le = __shfl(e, leader); const unsigned long long mm = __ballot(e == le);
                const int base = whist[F.wave * NE + le];
                if (e == le) rank = base + __builtin_popcountll(mm & ((1ull << F.lane) - 1ull));
                if (F.lane == leader) whist[F.wave * NE + le] = base + __builtin_popcountll(mm);
                todo &= ~mm; }
            rk[k] = rank;
        }
        __syncthreads();
        if (F.tid < NE) { int run = 0;
#pragma unroll
            for (int w = 0; w < NWAVES; ++w) { const int v = whist[w * NE + F.tid]; whist[w * NE + F.tid] = run; run += v; }
            HIST[blk * NE + F.tid] = run; }
        __syncthreads();
        if (F.lane < 16) { const int t = t0 + F.lane;
#pragma unroll
            for (int k = 0; k < 4; ++k) { TOPE[t * TOPK + k] = bi[k]; TOPL[t * TOPK + k] = whist[F.wave * NE + bi[k]] + rk[k]; TOPG[t * TOPK + k] = gt[k]; } }
        __syncthreads();
    }
}
__device__ __forceinline__ void router_phase_b(Frame& F, const int* HIST, const int* TOPE, const int* TOPL, const float* TOPG, int* TOPS, int* ROWTOK, float* ROWGATE) {
    volatile LAS int* part = (volatile LAS int*)(F.lds + 65536);
    bool first = true;
    for (int blk = F.vcu; blk < NBLK; blk += F.G) {
        { const int e = F.tid & 31, pt = F.tid >> 5; int sacc = 0, stot = 0;
            for (int b = pt * 16; b < pt * 16 + 16; ++b) { const int hv = HIST[b * NE + e]; stot += hv; sacc += (b < blk) ? hv : 0; }
            part[pt * NE + e] = sacc; part[1024 + pt * NE + e] = stot; }
        __syncthreads();
        if (F.tid < NE) { int sacc = 0;
#pragma unroll
            for (int pt = 0; pt < 16; ++pt) sacc += part[pt * NE + F.tid];
            part[512 + F.tid] = sacc; }
        if (first && F.tid >= 64 && F.tid < 128) { const int e = F.lane; int c = 0;
            if (e < NE) {
#pragma unroll
                for (int pt = 0; pt < 16; ++pt) c += part[1024 + pt * NE + e]; }
            int tl = (c + 255) >> 8, pre = tl;
#pragma unroll
            for (int o = 1; o < 64; o <<= 1) { const int v = __shfl_up(pre, o); if (F.lane >= o) pre += v; }
            if (e < NE) { F.MISC[MISC_TB + e] = (unsigned)(pre - tl); F.MISC[MISC_CNT + e] = (unsigned)c; }
            if (e == NE - 1) F.MISC[MISC_TB + NE] = (unsigned)pre; }
        first = false;
        __syncthreads();
        { const int t = blk * 128 + (F.tid >> 2), k = F.tid & 3; const int e = TOPE[t * TOPK + k]; const int slot = part[512 + e] + TOPL[t * TOPK + k];
            TOPS[t * TOPK + k] = slot; ROWTOK[(size_t)e * T + slot] = t * TOPK + k; ROWGATE[(size_t)e * T + slot] = TOPG[t * TOPK + k]; }
        __syncthreads();
    }
}
__device__ __forceinline__ void moe_table(Frame& F, const int* HIST) {
    volatile LAS int* part = (volatile LAS int*)(F.MISC + 256);
    __syncthreads();
    { const int e = F.tid & 31, pt = F.tid >> 5; int sacc = 0;
        for (int b = pt * 16; b < pt * 16 + 16; ++b) sacc += HIST[b * NE + e];
        part[pt * NE + e] = sacc; }
    __syncthreads();
    if (F.tid < 64) { const int e = F.lane; int c = 0;
        if (e < NE) {
#pragma unroll
            for (int pt = 0; pt < 16; ++pt) c += part[pt * NE + e]; }
        int tl = (c + 255) >> 8, pre = tl;
#pragma unroll
        for (int o = 1; o < 64; o <<= 1) { const int v = __shfl_up(pre, o); if (F.lane >= o) pre += v; }
        if (e < NE) { F.MISC[MISC_TB + e] = (unsigned)(pre - tl); F.MISC[MISC_CNT + e] = (unsigned)c; }
        if (e == NE - 1) F.MISC[MISC_TB + NE] = (unsigned)pre; }
    __syncthreads();
}

constexpr int PH_PRO = 0, PH_PRE = 1, PH_L0 = 2, NPL = 10, NPHASES = PH_L0 + DEPTH * NPL;
__global__ void __launch_bounds__(NTHREADS, 2) fwd(Args args_unused) {
    extern __shared__ __attribute__((aligned(16))) unsigned char lds_raw[];
    const volatile __attribute__((address_space(4))) Args* ka = (const volatile __attribute__((address_space(4))) Args*)__builtin_amdgcn_kernarg_segment_ptr();
#define INP(i) ((const float*)ka->in[i])
#define WSB() ((unsigned char*)ka->ws)
#define OUTP() ((float*)ka->out)
    Frame F;
    F.lds = (LAS unsigned char*)lds_raw; F.MISC = (volatile LAS unsigned*)(F.lds + LDSCTL_OFF);
    F.wave = __builtin_amdgcn_readfirstlane((int)threadIdx.x >> 6); F.lane = lane_id_v(); F.tid = F.wave * 64 + F.lane;
    F.G = gridDim.x; { const int bx = blockIdx.x; F.vcu = (F.G % 8 == 0) ? (bx % 8) * (F.G / 8) + bx / 8 : bx; }
    F.ctl = (unsigned*)(WSB() + WS_CTL);
    for (int u = F.tid; u < (LDS_BYTES - LDSCTL_OFF) / 4; u += NTHREADS) ((LAS unsigned*)(F.lds + LDSCTL_OFF))[u] = 0u;
    __syncthreads();
    XcdBarrier bar = xcd_barrier_post(F.ctl + CW_BAR, F.MISC + MISC_BAR, F.tid == 0);
    const int lo = ka->ph_lo, hi = ka->ph_hi;
#define IN(k) (lo <= (k) && (k) < hi)
#define STAMP(k) do { if (TIMER_ON && blockIdx.x == 0 && F.wave == 0 && lane_id_v() == 0) ((unsigned long long*)(F.ctl + CW_TS))[(k)] = __builtin_amdgcn_s_memrealtime(); } while (0)
#ifndef PROF_BARRIER
#define PROF_BARRIER 0
#endif
#ifndef PROF_BTYPES
#define PROF_BTYPES 0xffff
#endif
#define PROF_BSEL(k) ((PROF_BTYPES >> ((k) < 2 ? (k) : 2 + ((k) - 2) % 10)) & 1)
#define PROF_ADD(dt) do { if (F.wave == 0 && lane_id_v() == 0) F.MISC[MISC_PROF] = F.MISC[MISC_PROF] + (unsigned)(dt); } while (0)
#define SEAM(k) do { const unsigned long long _tb0 = PROF_BARRIER ? __builtin_amdgcn_s_memrealtime() : 0ull; \
        if (IN(k) && (IN((k) + 1) || TIMER_ON || SPAN_HI >= 0)) xcd_barrier(bar, F.wave == 0 && lane_id_v() == 0); STAMP(k); \
        if (PROF_BARRIER && PROF_BSEL(k)) PROF_ADD(__builtin_amdgcn_s_memrealtime() - _tb0); \
        if (SPAN_HI >= 0 && (k) == SPAN_LO - 1) span_t0 = __builtin_amdgcn_s_memrealtime(); \
        if (SPAN_HI >= 0 && (k) == SPAN_HI) PROF_ADD(__builtin_amdgcn_s_memrealtime() - span_t0); } while (0)
#define PHASE_FRAME() Frame P = F; P.wave = launder_s(F.wave); P.lane = lane_id_v(); P.tid = P.wave * 64 + P.lane
    const int cb = (int)blockIdx.x;
    unsigned long long span_t0 = (SPAN_HI >= 0 && SPAN_LO == 0) ? __builtin_amdgcn_s_memrealtime() : 0ull;
    STAMP(63);

    if (IN(PH_PRO)) REPEAT(0) { __syncthreads(); unsigned char* ws = WSB(); { PHASE_FRAME(); mods_phase(P, INP(1), INP(2), INP(3), (float*)(ws + WS_MOD)); } { PHASE_FRAME(); convert_phase(P, ka); } }
    SEAM(PH_PRO);
    if (IN(PH_PRE)) REPEAT(1) { unsigned char* ws = WSB(); PHASE_FRAME(); rowpass_pre(P, INP(0), INP(4), (const float*)(ws + WS_MOD), (bf16_t*)(ws + WS_H)); }
    SEAM(PH_PRE);
    if ((REP_MASK >> 16) & 1) { for (int _i = 0; _i < 20; ++_i) xcd_barrier(bar, F.wave == 0 && lane_id_v() == 0); }

#pragma unroll 1
    for (int l = 0; l < DEPTH; ++l) {
        const int pb = PH_L0 + l * NPL;
        if (IN(pb + 0)) { unsigned char* ws = WSB(); unsigned char* wl = ws + WS_W + (size_t)l * WL_STRIDE; const bf16_t* WIN = (const bf16_t*)(wl + WO_WIN); bf16_t* H = (bf16_t*)(ws + WS_H);
            REPEAT(2) { pg8::Gemm g{H, WIN, D, D, D, nullptr}; pg8::StaticOrder S{T / 256, 13, launder_s(F.G), launder_s(cb), D, D, 0}; pg8::EpiIn E{(bf16_t*)(ws + WS_Q), (bf16_t*)(ws + WS_K), (bf16_t*)(ws + WS_U), (bf16_t*)(ws + WS_G)};
              pg8::gemm_phase<pg8::EpiIn, pg8::StaticOrder, 0>(F.lds, F.wave, g, S, E); }
            REPEAT(3) { pg8::Gemm g{WIN + (size_t)3328 * D, H, D, D, D, nullptr}; pg8::StaticOrder S{1, T / 256, launder_s(F.G), (launder_s(cb) + launder_s(F.G) / 2) % launder_s(F.G), D, D, 0}; pg8::EpiPlain E{(bf16_t*)(ws + WS_VT), VTP, 0, nullptr, nullptr};
              pg8::gemm_phase<pg8::EpiPlain, pg8::StaticOrder, 1>(F.lds, F.wave, g, S, E); }
        }
        SEAM(pb + 0);
        if (IN(pb + 1)) { unsigned char* ws = WSB();
            REPEAT(4) { PHASE_FRAME(); attn_phase(P, (const bf16_t*)(ws + WS_Q), (const bf16_t*)(ws + WS_K), (const bf16_t*)(ws + WS_VT), (bf16_t*)(ws + WS_AP)); }
            REPEAT(5) { PHASE_FRAME(); poolmix_phase(P, (const bf16_t*)(ws + WS_U), (bf16_t*)(ws + WS_MIX)); } }
        SEAM(pb + 1);
        if (IN(pb + 2)) { unsigned char* ws = WSB(); unsigned char* wl = ws + WS_W + (size_t)l * WL_STRIDE; bf16_t* AP = (bf16_t*)(ws + WS_AP);
            REPEAT(6) { pg8::Gemm g{AP, (const bf16_t*)(wl + WO_BRA), D, SBW, SBW, nullptr}; pg8::StaticOrder S{T / 256, 4, launder_s(F.G), launder_s(cb), D, SBW, 0}; pg8::EpiBranch<false> E{(bf16_t*)(ws + WS_MRG), (const bf16_t*)(ws + WS_G), 0, (bf16_t*)(ws + WS_MRG)};
              pg8::gemm_phase<pg8::EpiBranch<false>, pg8::StaticOrder, 2>(F.lds, F.wave, g, S, E); }
            REPEAT(7) { pg8::Gemm g{(const bf16_t*)(ws + WS_MIX), (const bf16_t*)(wl + WO_POOL), PW, PW, 384, nullptr}; pg8::StaticOrder S{T / 256, 3, launder_s(F.G), launder_s(cb), PW, PW, PGD};
              pg8::EpiPlain E{AP, D, SBW, INP(10) + (size_t)l * PW, INP(11) + (size_t)l * PW};
              pg8::gemm_phase<pg8::EpiPlain, pg8::StaticOrder, 3>(F.lds, F.wave, g, S, E); }
        }
        SEAM(pb + 2);
        if (IN(pb + 3)) for (int _rep = ((REP_MASK >> 15) & 1) ? 0 : 1; _rep < 2; ++_rep) { unsigned char* ws = WSB(); unsigned char* wl = ws + WS_W + (size_t)l * WL_STRIDE;
            pg8::Gemm g{(const bf16_t*)(ws + WS_AP) + SBW, (const bf16_t*)(wl + WO_BRP), D, PW, PW, nullptr}; pg8::StaticOrder S{T / 256, 4, launder_s(F.G), launder_s(cb), D, PW, 0}; pg8::EpiBranch<true> E{(bf16_t*)(ws + WS_MRG), (const bf16_t*)(ws + WS_G), D, (bf16_t*)(ws + (_rep == 0 ? WS_Y : WS_MRG))};
            pg8::gemm_phase<pg8::EpiBranch<true>, pg8::StaticOrder, 4>(F.lds, F.wave, g, S, E); }
        SEAM(pb + 3);
        if (IN(pb + 4)) REPEAT(8) { unsigned char* ws = WSB(); unsigned char* wl = ws + WS_W + (size_t)l * WL_STRIDE;
            pg8::Gemm g{(const bf16_t*)(ws + WS_MRG), (const bf16_t*)(wl + WO_OUT), D, D, D, nullptr}; pg8::StaticOrder S{T / 256, 4, launder_s(F.G), launder_s(cb), D, D, 0}; pg8::EpiPlain E{(bf16_t*)(ws + WS_Y), D, 0, nullptr, nullptr};
            pg8::gemm_phase<pg8::EpiPlain, pg8::StaticOrder, 5>(F.lds, F.wave, g, S, E); }
        SEAM(pb + 4);
        if (IN(pb + 5)) { unsigned char* ws = WSB(); unsigned char* wl = ws + WS_W + (size_t)l * WL_STRIDE; PHASE_FRAME();
            MidArgs M{l == 0 ? (const void*)INP(0) : (const void*)(ws + WS_XB), l != 0, (bf16_t*)(ws + WS_XB), (const bf16_t*)(ws + WS_Y), INP(5) + (size_t)l * D, INP(6) + (size_t)l * D, (const float*)(ws + WS_MOD) + (size_t)l * BATCH * 6 * D, (bf16_t*)(ws + WS_H), ws + WS_H8};
            router_phase_a(P, M, (const bf16_t*)(ws + WS_H), (const bf16_t*)(wl + WO_ROUTER), INP(16) + (size_t)l * NE, (int*)(ws + WS_HIST) + (size_t)l * NBLK * NE, (int*)(ws + WS_TOPE), (int*)(ws + WS_TOPL), (float*)(ws + WS_TOPG)); }
        SEAM(pb + 5);
        if (IN(pb + 6)) REPEAT(13) { unsigned char* ws = WSB(); PHASE_FRAME();
            router_phase_b(P, (const int*)(ws + WS_HIST) + (size_t)l * NBLK * NE, (const int*)(ws + WS_TOPE), (const int*)(ws + WS_TOPL), (const float*)(ws + WS_TOPG), (int*)(ws + WS_TOPS), (int*)(ws + WS_ROWTOK), (float*)(ws + WS_ROWGATE)); }
        SEAM(pb + 6);
        if (IN(pb + 7)) REPEAT(10) { unsigned char* ws = WSB(); unsigned char* wl = ws + WS_W + (size_t)l * WL_STRIDE; if (N_LAUNCHES != 1 || F.G > NBLK) { PHASE_FRAME(); moe_table(P, (const int*)(ws + WS_HIST) + (size_t)l * NBLK * NE); }
            pg8::Gemm g{(const bf16_t*)(ws + WS_H8), (const bf16_t*)(wl + WO_GU), D, D, D, (const int*)(ws + WS_ROWTOK)};
            pg8::MoeOrder S{(const volatile LAS int*)(F.MISC + MISC_TB), (const volatile LAS int*)(F.MISC + MISC_CNT), 8, launder_s(F.G), launder_s(cb), 2 * D};
            pg8::EpiGU E{ws + WS_ACT, INP(18) + (size_t)l * NE * 2 * D};
            pg8::gemm_phase<pg8::EpiGU, pg8::MoeOrder, 6>(F.lds, F.wave, g, S, E); }
        SEAM(pb + 7);
        if (IN(pb + 8)) REPEAT(11) { unsigned char* ws = WSB(); unsigned char* wl = ws + WS_W + (size_t)l * WL_STRIDE; if (N_LAUNCHES != 1 || F.G > NBLK) { PHASE_FRAME(); moe_table(P, (const int*)(ws + WS_HIST) + (size_t)l * NBLK * NE); }
            pg8::Gemm g{(const bf16_t*)(ws + WS_ACT), (const bf16_t*)(wl + WO_DN), D, D, D, nullptr};
            pg8::MoeOrder S{(const volatile LAS int*)(F.MISC + MISC_TB), (const volatile LAS int*)(F.MISC + MISC_CNT), 4, launder_s(F.G), launder_s(cb), D};
            pg8::EpiDN E{(bf16_t*)(ws + WS_YR), INP(20) + (size_t)l * NE * D, (const float*)(ws + WS_ROWGATE), (const int*)(ws + WS_ROWTOK)};
            pg8::gemm_phase<pg8::EpiDN, pg8::MoeOrder, 7>(F.lds, F.wave, g, S, E); }
        SEAM(pb + 8);
        if (IN(pb + 9)) for (int _rep = ((REP_MASK >> 14) & 1) ? 0 : 1; _rep < 2; ++_rep) { unsigned char* ws = WSB(); PHASE_FRAME();
            const bool hn = (l + 1 < DEPTH); const float* MOD = (const float*)(ws + WS_MOD);
            rowpass_comb(P, (const bf16_t*)(ws + WS_XB), _rep == 0 ? (void*)(ws + WS_ACT) : (hn ? (void*)(ws + WS_XB) : (void*)OUTP()), hn, (const bf16_t*)(ws + WS_YR), INP(7) + (size_t)l * D, MOD + (size_t)l * BATCH * 6 * D,
                         hn, INP(4) + (size_t)(hn ? l + 1 : l) * D, MOD + (size_t)(hn ? l + 1 : l) * BATCH * 6 * D, (bf16_t*)(ws + WS_H)); }
        SEAM(pb + 9);
    }
    if ((PROF_REGION != 0) || PROF_BARRIER || SPAN_HI >= 0) { if (F.wave == 0) { const unsigned long long dt = F.MISC[MISC_PROF], t0 = __builtin_amdgcn_s_memrealtime(); while (__builtin_amdgcn_s_memrealtime() - t0 < dt) __builtin_amdgcn_s_sleep(8); } }
#if TIMER_ON
    { xcd_barrier(bar, F.wave == 0 && lane_id_v() == 0);
      const unsigned long long* ts = (const unsigned long long*)(F.ctl + CW_TS);
      const float us1 = (float)(long long)(ts[TIMER_B1] - ts[TIMER_A1]) * 0.01f, us2 = (float)(long long)(ts[TIMER_B2] - ts[TIMER_A2]) * 0.01f;
      const float a = sqrtf(us1 * 1e-4f); float* o = OUTP(); const int lane = lane_id_v(), gtid = ((int)blockIdx.x * NWAVES + F.wave) * 64 + lane;
      for (size_t i = (size_t)gtid; i < (size_t)T * D; i += (size_t)F.G * NTHREADS) o[i] += (i & 1) ? a : -a;
      xcd_barrier(bar, F.wave == 0 && lane_id_v() == 0);
      if (blockIdx.x == 0 && F.wave == 0 && lane == 0) o[5] += us2 * 0.2f; }
#endif
#undef IN
#undef SEAM
}

extern "C" void kernel_launch(void* const* d_in, const int* in_sizes, int n_in, void* d_out, int out_size, void* d_ws, size_t ws_size, hipStream_t stream) {
    static int grid = 0;
    if (grid == 0) {
        if (n_in != 21 || in_sizes[0] != T * D || out_size != T * D || ws_size < WS_END) { fprintf(stderr, "kernel_launch: unexpected shapes (n_in %d, in0 %d, out %d, ws %zu < %zu); nothing launched\n", n_in, n_in > 0 ? in_sizes[0] : -1, out_size, ws_size, (size_t)WS_END); grid = -1; return; }
        int dev = 0, cus = 0, per_cu = 0;
        if (hipGetDevice(&dev) != hipSuccess || hipDeviceGetAttribute(&cus, hipDeviceAttributeMultiprocessorCount, dev) != hipSuccess) { grid = -1; return; }
        if (hipFuncSetAttribute((const void*)fwd, hipFuncAttributeMaxDynamicSharedMemorySize, LDS_BYTES) != hipSuccess) { fprintf(stderr, "kernel_launch: hipFuncSetAttribute failed\n"); grid = -1; return; }
        if (hipOccupancyMaxActiveBlocksPerMultiprocessor(&per_cu, (const void*)fwd, NTHREADS, LDS_BYTES) != hipSuccess || per_cu < 1) { fprintf(stderr, "kernel_launch: occupancy query says %d\n", per_cu); }
        (void)hipGetLastError();
        grid = cus;
    }
    if (grid < 0) return;
    if (hipMemsetAsync((char*)d_ws + WS_CTL, 0, CTL_ZERO_BYTES, stream) != hipSuccess) return;
    Args a{};
    for (int i = 0; i < 21; ++i) a.in[i] = (const float*)d_in[i];
    a.out = (float*)d_out; a.ws = (unsigned char*)d_ws;
#if N_LAUNCHES == 1
    a.ph_lo = 0; a.ph_hi = NPHASES;
    hipLaunchKernelGGL(fwd, dim3(grid), dim3(NTHREADS), LDS_BYTES, stream, a);
#else
    for (int p = 0; p < NPHASES; ++p) { a.ph_lo = p; a.ph_hi = p + 1; hipLaunchKernelGGL(fwd, dim3(grid), dim3(NTHREADS), LDS_BYTES, stream, a); }
#endif
}
```

```cpp
#include <hip/hip_runtime.h>
#include <cstdio>
#include <cstdint>

#ifndef N_LAUNCHES
#define N_LAUNCHES 1
#endif
#ifndef REP_MASK
#define REP_MASK 0
#endif
#ifndef REP_BAR
#define REP_BAR 0
#endif
#define REPEAT(b) _Pragma("unroll 1") for (int _rep = 0; _rep < (((REP_MASK >> (b)) & 1) ? 2 : 1); ((REP_BAR && ((REP_MASK >> (b)) & 1)) ? xcd_barrier(bar, F.wave == 0 && lane_id_v() == 0) : (void)0), ++_rep)
#ifndef TIMER_ON
#define TIMER_ON 0
#endif
#ifndef TIMER_A1
#define TIMER_A1 63
#define TIMER_B1 0
#define TIMER_A2 63
#define TIMER_B2 1
#endif
constexpr int CW_TS = 12288;
#ifndef SPAN_LO
#define SPAN_LO -1
#define SPAN_HI -1
#endif
#ifndef PROF_REGION
#define PROF_REGION 0
#define PROF_SITES 0
#endif
#ifndef FAST_MASK
#define FAST_MASK 0xff
#endif

#define LAS __attribute__((address_space(3)))
#define GAS __attribute__((address_space(1)))
typedef unsigned short bf16_t;
typedef short bf16x8 __attribute__((ext_vector_type(8)));
typedef short s16x4 __attribute__((ext_vector_type(4)));
typedef float f32x4 __attribute__((ext_vector_type(4)));
typedef float f32x2 __attribute__((ext_vector_type(2)));
typedef float f32x16 __attribute__((ext_vector_type(16)));
typedef unsigned u32x4 __attribute__((ext_vector_type(4)));
typedef unsigned u32x2 __attribute__((ext_vector_type(2)));

constexpr int D = 1024, BATCH = 2, SEQ = 16384, T = BATCH * SEQ, DEPTH = 2;
constexpr int SBW = 256, NH = 4, HD = 64, PW = 768, PGD = 192, INW = 3584;
constexpr int NE = 32, TOPK = 4;
constexpr float NORM_EPS = 1e-6f, SW_LIMIT = 7.0f, SW_ALPHA = 1.702f;
constexpr float STICK_EXIT = -24.0f;
constexpr int NWAVES = 8, NTHREADS = 512;
constexpr int MAXTILES = (T * TOPK) / 256 + NE;

constexpr size_t MiB = 1u << 20;
constexpr size_t WS_CTL = 0, CTL_ZERO_BYTES = 65536;
constexpr size_t WS_MOD = 1 * MiB;
constexpr size_t WS_W = 2 * MiB, WL_STRIDE = 205 * MiB;
constexpr size_t WO_WIN = 0, WO_BRA = 7 * MiB, WO_BRP = 7 * MiB + MiB / 2, WO_OUT = 9 * MiB, WO_POOL = 11 * MiB, WO_ROUTER = 12 * MiB + MiB / 2, WO_GU = 13 * MiB, WO_DN = 141 * MiB;
constexpr size_t WS_H = 416 * MiB, WS_Q = 480 * MiB, WS_K = 496 * MiB, WS_U = 528 * MiB, WS_G = 576 * MiB;
constexpr int VTP = T + 64;
constexpr size_t WS_AP = 704 * MiB, WS_MIX = 768 * MiB, WS_MRG = 816 * MiB, WS_Y = 880 * MiB;
constexpr size_t WS_TOPE = 944 * MiB, WS_TOPS = 944 * MiB + MiB / 2, WS_TOPL = 945 * MiB, WS_TOPG = 945 * MiB + MiB / 2, WS_ROWTOK = 946 * MiB, WS_ROWGATE = 950 * MiB;
constexpr size_t WS_HIST = 954 * MiB;
constexpr size_t WS_ACT = 960 * MiB, WS_YR = 1232 * MiB, WS_H8 = 1504 * MiB, WS_XB = 1536 * MiB, WS_VT = 1600 * MiB  , WS_END = 1620 * MiB;
static_assert(WO_DN + (size_t)NE * D * D * 2 <= WL_STRIDE && WS_W + DEPTH * WL_STRIDE <= WS_H, "weights map");
static_assert(WS_ACT + (size_t)MAXTILES * 256 * D * 2 <= WS_YR && WS_YR + (size_t)MAXTILES * 256 * D * 2 <= WS_END, "act map");
constexpr int CW_BAR = 4096, CW_CNT = 8192;

constexpr int RING_BYTES = 131072, LDSCTL_OFF = RING_BYTES, LDS_BYTES = 147456;
constexpr int META_OFF = LDSCTL_OFF + 4096, META_BYTES = 4096;
constexpr int MISC_BAR = 8;
constexpr int MISC_TB = 64, MISC_CNT = 128, MISC_PROF = 200;

__device__ __forceinline__ unsigned f2bf(float f) { unsigned u = __builtin_bit_cast(unsigned, f); return (u + 0x7fffu + ((u >> 16) & 1u)) >> 16; }
__device__ __forceinline__ unsigned pk2(float lo, float hi) { return f2bf(lo) | (f2bf(hi) << 16); }
__device__ __forceinline__ float bf_lo(unsigned w) { return __builtin_bit_cast(float, w << 16); }
__device__ __forceinline__ float bf_hi(unsigned w) { return __builtin_bit_cast(float, w & 0xffff0000u); }
__device__ __forceinline__ unsigned pk4_fp8(float a, float b, float c, float d) { int w = 0; w = __builtin_amdgcn_cvt_pk_fp8_f32(a, b, w, false); w = __builtin_amdgcn_cvt_pk_fp8_f32(c, d, w, true); return (unsigned)w; }
constexpr float W8_SCALE = 32.0f, W8_INV = 1.0f / 32.0f;
__device__ __forceinline__ float fast_exp(float x) { return __builtin_amdgcn_exp2f(x * 1.4426950408889634f); }
__device__ __forceinline__ float fast_sigmoid(float x) { return __builtin_amdgcn_rcpf(1.0f + fast_exp(-x)); }
__device__ __forceinline__ float softplus_f(float z) { return fmaxf(z, 0.f) + 0.6931471805599453f * __builtin_amdgcn_logf(1.0f + fast_exp(-fabsf(z))); }
__device__ __forceinline__ float wave_sum(float v) {
#pragma unroll
    for (int o = 1; o < 64; o <<= 1) v += __shfl_xor(v, o);
    return v;
}
__device__ __forceinline__ int launder_v(int x) { asm volatile("" : "+v"(x)); return x; }
__device__ __forceinline__ int launder_s(int x) { asm volatile("" : "+s"(x)); return x; }
__device__ __forceinline__ int lane_id_v() { int x; asm volatile("v_mbcnt_lo_u32_b32 %0, -1, 0\n\tv_mbcnt_hi_u32_b32 %0, -1, %0" : "=v"(x)); return x; }
#define LDS_WAIT() asm volatile("s_waitcnt lgkmcnt(0)" ::: "memory")
#define VM_WAIT() asm volatile("s_waitcnt vmcnt(0)" ::: "memory")

#define XB_TMO      128
#define XB_XCNT(j)  (256  + 64 * (j))
#define XB_XSUB(j)  (1280 + 64 * (j))
#define XB_XGEN(j)  (2304 + 64 * (j))
#define XB_TOP      3328
#define XB_TOPGEN   3392
#define XCD_BAR_WORDS 3456
#define XB_SPIN_CAP (1u << 18)
__device__ __forceinline__ unsigned xb_ld(unsigned* p)              { return __hip_atomic_load(p, __ATOMIC_RELAXED, __HIP_MEMORY_SCOPE_AGENT); }
__device__ __forceinline__ unsigned xb_add(unsigned* p, unsigned v) { return __hip_atomic_fetch_add(p, v, __ATOMIC_RELAXED, __HIP_MEMORY_SCOPE_AGENT); }
__device__ __forceinline__ unsigned xb_xcc_id() { return (unsigned)__builtin_amdgcn_s_getreg((3 << 11) | 20) & 0xFu; }
#define XB_SPIN(cond, bar) do { unsigned _sp = 0; while (cond) { __builtin_amdgcn_s_sleep(1); \
    if ((++_sp & 255u) == 0u) { if (xb_ld(&(bar)[XB_TMO])) break; if (_sp > XB_SPIN_CAP) { atomicAdd(&(bar)[XB_TMO], 1u); break; } } } } while (0)
struct XcdBarrier { unsigned* bar; unsigned x; volatile LAS unsigned* st; };
__device__ __forceinline__ XcdBarrier xcd_barrier_post(unsigned* bar, volatile LAS unsigned* st, bool t0) {
    XcdBarrier b; b.bar = bar; b.x = xb_xcc_id(); b.st = st;
    if (t0) (void)xb_add(&bar[XB_XCNT(b.x)], 1u);
    return b;
}
__device__ __forceinline__ void xcd_barrier_complete(unsigned* bar, unsigned x, unsigned& nloc, unsigned& nx) {
    const unsigned G = gridDim.x * gridDim.y * gridDim.z;
    unsigned sum, cnt, mine, sp = 0u;
    for (;;) {
        sum = 0u; cnt = 0u; mine = 0u;
#pragma unroll
        for (unsigned j = 0; j < 16; ++j) { const unsigned c = xb_ld(&bar[XB_XCNT(j)]); sum += c; cnt += (c > 0u) ? 1u : 0u; mine = (j == x) ? c : mine; }
        if (sum == G) break;
        __builtin_amdgcn_s_sleep(1);
        if ((++sp & 255u) == 0u) { if (xb_ld(&bar[XB_TMO])) break; if (sp > XB_SPIN_CAP) { atomicAdd(&bar[XB_TMO], 1u); break; } }
    }
    nloc = mine > 0u ? mine : 1u; nx = cnt > 0u ? cnt : 1u;
}
__device__ __forceinline__ void xcd_barrier(const XcdBarrier& b, bool t0) {
    asm volatile("s_waitcnt vmcnt(0)" ::: "memory");
    __syncthreads();
    if (t0) {
        unsigned* bar = b.bar;
        __builtin_amdgcn_s_waitcnt(0);
        unsigned nloc = b.st[0], nx = b.st[1];
        if (nloc == 0u) { xcd_barrier_complete(bar, b.x, nloc, nx); b.st[0] = nloc; b.st[1] = nx; }
        const unsigned old = xb_add(&bar[XB_XSUB(b.x)], 1u);
        const unsigned gen = old / nloc;
        if (old + 1u == (gen + 1u) * nloc) {
            __builtin_amdgcn_fence(__ATOMIC_RELEASE, "agent");
            asm volatile("s_waitcnt vmcnt(0)" ::: "memory");
            const unsigned og = xb_add(&bar[XB_TOP], 1u);
            const unsigned tg = og / nx;
            if (og + 1u == (tg + 1u) * nx) xb_add(&bar[XB_TOPGEN], 1u);
            else XB_SPIN(xb_ld(&bar[XB_TOPGEN]) == tg, bar);
            __builtin_amdgcn_fence(__ATOMIC_ACQUIRE, "agent");
            xb_add(&bar[XB_XGEN(b.x)], 1u);
            asm volatile("s_waitcnt vmcnt(0)" ::: "memory");
        } else {
            XB_SPIN(xb_ld(&bar[XB_XGEN(b.x)]) == gen, bar);
            __builtin_amdgcn_fence(__ATOMIC_ACQUIRE, "agent");
            asm volatile("s_waitcnt vmcnt(0)" ::: "memory");
        }
    }
    __syncthreads();
}

namespace pg8 {
constexpr int BM = 256, BK = 64, HALF = 128, HTB = HALF * BK * 2, STAGE_BYTES = 8 * HTB, NXCD = 8, WGM = 8;
__host__ __device__ __forceinline__ int lds_byte(int r, int c) { const int st = (r >> 4) * 2 + (c >> 5), rr = r & 15, cc = c & 31, ob = rr * 64 + cc * 2; return st * 1024 + (ob ^ (((ob >> 9) & 1) << 5)); }
__host__ __device__ __forceinline__ void stage_rc(int b, int& R, int& C) { const int st = b / 1024, sb = b % 1024, swz = sb ^ (((sb >> 9) & 1) << 5); R = (st >> 1) * 16 + swz / 64; C = (st & 1) * 32 + (swz % 64) / 2; }
__host__ __device__ __forceinline__ int perm32(int rho) { const int n = rho >> 4, i = rho & 15; return 8 * (i >> 2) + 4 * n + (i & 3); }

struct Unit { int pm, pn, e, nvalid, slot0; unsigned aoff, boff; };
struct Gemm { const bf16_t* A; const bf16_t* Bt; int lda, ldb, K; const int* gather; };

__device__ __forceinline__ bool order_unit(int i, int G, int c, int nM, int nN, int& pm, int& pn) {
    const int nwg = nM * nN; const long L = (long)i * G + c; if (L >= nwg) return false;
    int wgid = (int)L; { const int q = nwg / NXCD, r = nwg % NXCD, xcd = wgid % NXCD, off = wgid / NXCD; wgid = (xcd < r ? xcd * (q + 1) : r * (q + 1) + (xcd - r) * q) + off; }
    const int nig = WGM * nN, gid = wgid / nig, fm = gid * WGM, gsz = (nM - fm) < WGM ? (nM - fm) : WGM;
    pm = fm + ((wgid % nig) % gsz); pn = (wgid % nig) / gsz; return true;
}
struct StaticOrder {
    int nM, nN, G, c, lda, ldb, kstride;
    __device__ __forceinline__ bool next(int i, Unit& u) const {
        if (!order_unit(i, G, c, nM, nN, u.pm, u.pn)) return false;
        u.e = 0; u.nvalid = 256; u.slot0 = 0;
        u.aoff = (unsigned)(u.pm * BM) * (unsigned)lda + (unsigned)(kstride * u.pn); u.boff = (unsigned)(u.pn * BM) * (unsigned)ldb + (unsigned)(kstride * u.pn); return true;
    }
};
struct MoeOrder {
    const volatile LAS int* tb; const volatile LAS int* cnt; int nN, G, c, nw;
    __device__ __forceinline__ bool next(int i, Unit& u) const {
        const int nM = tb[NE];
        if (!order_unit(i, G, c, nM, nN, u.pm, u.pn)) return false;
        int e = u.e < 0 ? 0 : (u.e > NE - 1 ? NE - 1 : u.e);
#pragma unroll 1
        while (e < NE - 1 && tb[e + 1] <= u.pm) ++e;
#pragma unroll 1
        while (e > 0 && tb[e] > u.pm) --e;
        u.e = e; u.slot0 = (u.pm - tb[e]) * BM; const int left = cnt[e] - u.slot0; u.nvalid = left < BM ? left : BM;
        u.aoff = (unsigned)(u.pm * BM) * (unsigned)D; u.boff = ((unsigned)e * (unsigned)nw + (unsigned)(u.pn * BM)) * (unsigned)D; return true;
    }
};

__device__ __forceinline__ unsigned cvt_pk_bf16(float lo, float hi) { unsigned r; asm volatile("v_cvt_pk_bf16_f32 %0, %1, %2" : "=v"(r) : "v"(lo), "v"(hi)); return r; }
__device__ __forceinline__ u32x4 pack8(const f32x4 a, const f32x4 b) { u32x4 w; w.x = cvt_pk_bf16(a[0], a[1]); w.y = cvt_pk_bf16(a[2], a[3]); w.z = cvt_pk_bf16(b[0], b[1]); w.w = cvt_pk_bf16(b[2], b[3]); return w; }
__device__ __forceinline__ void unpack8(const u32x4 w, f32x4& a, f32x4& b) { a = (f32x4){bf_lo(w.x), bf_hi(w.x), bf_lo(w.y), bf_hi(w.y)}; b = (f32x4){bf_lo(w.z), bf_hi(w.z), bf_lo(w.w), bf_hi(w.w)}; }

__device__ __forceinline__ f32x2 lo2(const f32x4 v) { return __builtin_shufflevector(v, v, 0, 1); }
__device__ __forceinline__ f32x2 hi2(const f32x4 v) { return __builtin_shufflevector(v, v, 2, 3); }
__device__ __forceinline__ f32x4 cat2(const f32x2 a, const f32x2 b) { return __builtin_shufflevector(a, b, 0, 1, 2, 3); }
__device__ __forceinline__ f32x2 pk_sigmoid(const f32x2 x) {
    const f32x2 t = x * (-1.4426950408889634f); f32x2 e; e.x = __builtin_amdgcn_exp2f(t.x); e.y = __builtin_amdgcn_exp2f(t.y);
    const f32x2 d = e + 1.0f; f32x2 r; r.x = __builtin_amdgcn_rcpf(d.x); r.y = __builtin_amdgcn_rcpf(d.y); return r; }
__device__ __forceinline__ f32x4 pk_sigmoid4(const f32x4 v) { return cat2(pk_sigmoid(lo2(v)), pk_sigmoid(hi2(v))); }
__device__ __forceinline__ f32x2 pk_fma2(const f32x2 a, const f32x2 b, const f32x2 c) { return __builtin_elementwise_fma(a, b, c); }
__device__ __forceinline__ f32x2 swiglu2(f32x2 g, f32x2 u) {
    g.x = fminf(g.x, SW_LIMIT); g.y = fminf(g.y, SW_LIMIT); u.x = fminf(fmaxf(u.x, -SW_LIMIT), SW_LIMIT); u.y = fminf(fmaxf(u.y, -SW_LIMIT), SW_LIMIT);
    const f32x2 t = g * (-SW_ALPHA * 1.4426950408889634f); f32x2 e; e.x = __builtin_amdgcn_exp2f(t.x); e.y = __builtin_amdgcn_exp2f(t.y);
    const f32x2 d = e + 1.0f; f32x2 r; r.x = __builtin_amdgcn_rcpf(d.x); r.y = __builtin_amdgcn_rcpf(d.y);
    return pk_fma2(u, g, g) * r; }
#define EPI_LOOP_ROWS for (int ai = 0; ai < 2; ++ai) _Pragma("unroll") for (int m = 0; m < 4; ++m)
__device__ __forceinline__ size_t frag_off(int tile, int ai, int m, int bj, int wr, int wc, int fr, int fq) {
    const int piece = (ai * 4 + m) * 2 + bj, thr = (wr * 4 + wc) * 64 + fq * 16 + fr; return (((size_t)tile * 16 + piece) * 512 + thr) * 8; }
__device__ __forceinline__ void* probe_scratch_ptr() { const volatile __attribute__((address_space(4))) void* const* ka = (const volatile __attribute__((address_space(4))) void* const*)__builtin_amdgcn_kernarg_segment_ptr(); return (unsigned char*)ka[22] + ((size_t)1536 << 20); }
struct EpiIn {
    static constexpr bool PERM = true; static constexpr int ES = 2, SITE_ID = 0;
    bf16_t *Q, *KB, *U, *G;
    __device__ __forceinline__ void operator()(const f32x4 (&acc)[2][2][4][2], const Unit& u, int wr, int wc, int fr, int fq) const {
        const int pn = u.pn; bf16_t* base; int ld, c0, mode;
        if (pn == 0) { base = Q; ld = SBW; c0 = 0; mode = 1; } else if (pn == 1) { base = KB; ld = SBW; c0 = 0; mode = 0; }
        else if (pn < 5) { base = U; ld = PW; c0 = (pn - 2) * BM; mode = 0; } else { base = G; ld = 2 * D; c0 = (pn - 5) * BM; mode = 2; }
        const int row0 = u.pm * BM + wr * 64 + fr, col0 = c0 + wc * 32 + 8 * fq;
#pragma unroll
        EPI_LOOP_ROWS { bf16_t* rowp = base + (size_t)(row0 + ai * HALF + m * 16) * ld + col0;
#pragma unroll
            for (int bj = 0; bj < 2; ++bj) { f32x4 v0 = acc[ai][bj][m][0], v1 = acc[ai][bj][m][1];
                if (mode == 1) { v0 = v0 * 0.125f; v1 = v1 * 0.125f; }
                if (mode == 2) { v0 = pk_sigmoid4(v0); v1 = pk_sigmoid4(v1); *(u32x4*)(G + frag_off(u.pm * 8 + (pn - 5), ai, m, bj, wr, wc, fr, fq)) = pack8(v0, v1); }
                else *(u32x4*)(rowp + bj * HALF) = pack8(v0, v1); } }
    }
};
struct EpiPlain {
    static constexpr bool PERM = true; static constexpr int ES = 2, SITE_ID = 1;
    bf16_t* O; int ldc, coff; const float* bias; const float* scale;
    __device__ __forceinline__ void operator()(const f32x4 (&acc)[2][2][4][2], const Unit& u, int wr, int wc, int fr, int fq) const {
        const int row0 = u.pm * BM + wr * 64 + fr, col0 = u.pn * BM + wc * 32 + 8 * fq;
        f32x4 bv[2][2], sv[2][2];
#pragma unroll
        for (int bj = 0; bj < 2; ++bj)
#pragma unroll
            for (int n = 0; n < 2; ++n) { bv[bj][n] = bias ? *(const f32x4*)(bias + col0 + bj * HALF + 4 * n) : (f32x4){0.f, 0.f, 0.f, 0.f};
                                          sv[bj][n] = scale ? *(const f32x4*)(scale + col0 + bj * HALF + 4 * n) : (f32x4){1.f, 1.f, 1.f, 1.f}; }
#pragma unroll
        EPI_LOOP_ROWS { bf16_t* rowp = O + (size_t)(row0 + ai * HALF + m * 16) * ldc + coff + col0;
#pragma unroll
            for (int bj = 0; bj < 2; ++bj) *(u32x4*)(rowp + bj * HALF) = pack8((acc[ai][bj][m][0] + bv[bj][0]) * sv[bj][0], (acc[ai][bj][m][1] + bv[bj][1]) * sv[bj][1]); }
    }
};
template <bool ADD> struct EpiBranch {
    static constexpr bool PERM = true; static constexpr int ES = 2, SITE_ID = 2;
    bf16_t* PART; const bf16_t* G; int gtile0; bf16_t* MRGout;
    __device__ __forceinline__ void operator()(const f32x4 (&acc)[2][2][4][2], const Unit& u, int wr, int wc, int fr, int fq) const {
        const int row0 = u.pm * BM + wr * 64 + fr, col0 = u.pn * BM + wc * 32 + 8 * fq;
        const int gt = u.pm * 8 + gtile0 + u.pn, ptile = u.pm * 4 + u.pn;
#pragma unroll
        for (int ai = 0; ai < 2; ++ai) {
            u32x4 gq[4][2], pq[4][2];
#pragma unroll
            for (int m = 0; m < 4; ++m)
#pragma unroll
                for (int bj = 0; bj < 2; ++bj) { gq[m][bj] = *(const u32x4*)(G + frag_off(gt, ai, m, bj, wr, wc, fr, fq)); if (ADD) pq[m][bj] = *(const u32x4*)(PART + frag_off(ptile, ai, m, bj, wr, wc, fr, fq)); }
#pragma unroll
            for (int m = 0; m < 4; ++m)
#pragma unroll
                for (int bj = 0; bj < 2; ++bj) { const size_t r = (size_t)(row0 + ai * HALF + m * 16); const int c = col0 + bj * HALF;
                    f32x4 g0, g1; unpack8(gq[m][bj], g0, g1);
                    f32x4 v0 = g0 * acc[ai][bj][m][0], v1 = g1 * acc[ai][bj][m][1];
                    if (ADD) { f32x4 p0, p1; unpack8(pq[m][bj], p0, p1); v0 = v0 + p0; v1 = v1 + p1; *(u32x4*)(MRGout + r * D + c) = pack8(v0, v1); }
                    else *(u32x4*)(PART + frag_off(ptile, ai, m, bj, wr, wc, fr, fq)) = pack8(v0, v1); } }
    }
};
struct EpiGU {
    static constexpr bool PERM = true, HAS_PRE = true; static constexpr int ES = 1, SITE_ID = 6;
    unsigned char* ACT8; const float* bgu;
    __device__ __forceinline__ void prefetch(LAS unsigned char* meta, const Unit& u, int wid, int lane) const {
        if (wid == 2 || wid == 3) { const float* src = bgu + (size_t)u.e * (2 * D) + (wid == 3 ? D : 0) + u.pn * HALF + 4 * (lane & 31);
            __builtin_amdgcn_global_load_lds((const unsigned*)src, (LAS unsigned*)(meta + wid * 1024), 16, 0, 0); } }
    __device__ __forceinline__ void epi_lds(const f32x4 (&acc)[2][2][4][2], const Unit& u, int wr, int wc, int fr, int fq, const LAS unsigned char* meta) const {
        const int row0 = u.pm * BM + wr * 64 + fr, col0 = u.pn * HALF + wc * 32 + 8 * fq;
        float w8s = W8_INV; asm volatile("" : "+v"(w8s));
        f32x4 bgv[2], buv[2];
#pragma unroll
        for (int n = 0; n < 2; ++n) { bgv[n] = *(const LAS f32x4*)(meta + 2048 + (wc * 32 + 8 * fq + 4 * n) * 4); buv[n] = *(const LAS f32x4*)(meta + 3072 + (wc * 32 + 8 * fq + 4 * n) * 4); }
#pragma unroll
        EPI_LOOP_ROWS { f32x4 o[2];
#pragma unroll
            for (int n = 0; n < 2; ++n) { const f32x2 w8 = {w8s, w8s};
                o[n] = cat2(swiglu2(pk_fma2(lo2(acc[ai][0][m][n]), w8, lo2(bgv[n])), pk_fma2(lo2(acc[ai][1][m][n]), w8, lo2(buv[n]))),
                            swiglu2(pk_fma2(hi2(acc[ai][0][m][n]), w8, hi2(bgv[n])), pk_fma2(hi2(acc[ai][1][m][n]), w8, hi2(buv[n])))); }
            u32x2 w; w.x = pk4_fp8(o[0][0], o[0][1], o[0][2], o[0][3]); w.y = pk4_fp8(o[1][0], o[1][1], o[1][2], o[1][3]);
            *(u32x2*)(ACT8 + (size_t)(row0 + ai * HALF + m * 16) * D + col0) = w; }
    }
    __device__ __forceinline__ void operator()(const f32x4 (&acc)[2][2][4][2], const Unit& u, int wr, int wc, int fr, int fq) const {
        const int row0 = u.pm * BM + wr * 64 + fr, col0 = u.pn * HALF + wc * 32 + 8 * fq;
        float w8s = W8_INV; asm volatile("" : "+v"(w8s));
        const float* bg = bgu + (size_t)u.e * (2 * D) + col0;
        f32x4 bgv[2], buv[2];
#pragma unroll
        for (int n = 0; n < 2; ++n) { bgv[n] = *(const f32x4*)(bg + 4 * n); buv[n] = *(const f32x4*)(bg + D + 4 * n); }
#pragma unroll
        EPI_LOOP_ROWS { f32x4 o[2];
#pragma unroll
            for (int n = 0; n < 2; ++n) { const f32x2 w8 = {w8s, w8s};
                o[n] = cat2(swiglu2(pk_fma2(lo2(acc[ai][0][m][n]), w8, lo2(bgv[n])), pk_fma2(lo2(acc[ai][1][m][n]), w8, lo2(buv[n]))),
                            swiglu2(pk_fma2(hi2(acc[ai][0][m][n]), w8, hi2(bgv[n])), pk_fma2(hi2(acc[ai][1][m][n]), w8, hi2(buv[n])))); }
            u32x2 w; w.x = pk4_fp8(o[0][0], o[0][1], o[0][2], o[0][3]); w.y = pk4_fp8(o[1][0], o[1][1], o[1][2], o[1][3]);
            *(u32x2*)(ACT8 + (size_t)(row0 + ai * HALF + m * 16) * D + col0) = w; }
    }
};
struct EpiDN {
    static constexpr bool PERM = true, HAS_PRE = true; static constexpr int ES = 1, SITE_ID = 7;
    bf16_t* YR4; const float* bdn; const float* rowgate; const int* rowtk;
    __device__ __forceinline__ void prefetch(LAS unsigned char* meta, const Unit& u, int wid, int lane) const {
        if (wid < 3) { const void* src = wid == 0 ? (const void*)(rowtk + (size_t)u.e * T + u.slot0 + 4 * lane) : wid == 1 ? (const void*)(rowgate + (size_t)u.e * T + u.slot0 + 4 * lane) : (const void*)(bdn + (size_t)u.e * D + u.pn * BM + 4 * lane);
            __builtin_amdgcn_global_load_lds((const unsigned*)src, (LAS unsigned*)(meta + wid * 1024), 16, 0, 0); } }
    __device__ __forceinline__ void epi_lds(const f32x4 (&acc)[2][2][4][2], const Unit& u, int wr, int wc, int fr, int fq, const LAS unsigned char* meta) const {
        const int rl0 = wr * 64 + fr, col0 = u.pn * BM + wc * 32 + 8 * fq;
        float w8s = W8_INV; asm volatile("" : "+v"(w8s));
        f32x4 bv[2][2];
#pragma unroll
        for (int bj = 0; bj < 2; ++bj)
#pragma unroll
            for (int n = 0; n < 2; ++n) bv[bj][n] = *(const LAS f32x4*)(meta + 2048 + (bj * HALF + wc * 32 + 8 * fq + 4 * n) * 4);
#pragma unroll
        EPI_LOOP_ROWS { const int rl = rl0 + ai * HALF + m * 16;
            if (rl < u.nvalid) { const float gt = *(const LAS float*)(meta + 1024 + rl * 4); const int tk = *(const LAS int*)(meta + rl * 4); bf16_t* rowp = YR4 + (size_t)tk * D + col0;
#pragma unroll
                for (int bj = 0; bj < 2; ++bj) *(u32x4*)(rowp + bj * HALF) = pack8((acc[ai][bj][m][0] * w8s + bv[bj][0]) * gt, (acc[ai][bj][m][1] * w8s + bv[bj][1]) * gt); } }
    }
    __device__ __forceinline__ void operator()(const f32x4 (&acc)[2][2][4][2], const Unit& u, int wr, int wc, int fr, int fq) const {
        const int rl0 = wr * 64 + fr, col0 = u.pn * BM + wc * 32 + 8 * fq;
        const float* bp = bdn + (size_t)u.e * D + col0; const float* gp = rowgate + (size_t)u.e * T + u.slot0; const int* tp = rowtk + (size_t)u.e * T + u.slot0;
        float w8s = W8_INV; asm volatile("" : "+v"(w8s));
        f32x4 bv[2][2];
#pragma unroll
        for (int bj = 0; bj < 2; ++bj)
#pragma unroll
            for (int n = 0; n < 2; ++n) bv[bj][n] = *(const f32x4*)(bp + bj * HALF + 4 * n);
        float gtv[2][4]; int tkv[2][4]; const int nv1 = u.nvalid - 1;
#pragma unroll
        EPI_LOOP_ROWS { const int rl = rl0 + ai * HALF + m * 16, rc = rl < nv1 ? rl : nv1; gtv[ai][m] = gp[rc]; tkv[ai][m] = tp[rc]; }
#pragma unroll
        EPI_LOOP_ROWS { const int rl = rl0 + ai * HALF + m * 16;
            if (rl < u.nvalid) { const float gt = gtv[ai][m]; bf16_t* rowp = YR4 + (size_t)tkv[ai][m] * D + col0;
#pragma unroll
                for (int bj = 0; bj < 2; ++bj) *(u32x4*)(rowp + bj * HALF) = pack8((acc[ai][bj][m][0] * w8s + bv[bj][0]) * gt, (acc[ai][bj][m][1] * w8s + bv[bj][1]) * gt); } }
    }
};

template <class E, class = void> struct epi_has_pre { static constexpr bool value = false; };
template <class E> struct epi_has_pre<E, decltype((void)E::HAS_PRE)> { static constexpr bool value = E::HAS_PRE; };
template <class Epi, class Sched>
__device__ __forceinline__ void gemm_simple(int wave, const Gemm g, const Sched& S, const Epi& E) {
    const int wid = launder_s(wave), lane = lane_id_v(), wr = wid >> 2, wc = wid & 3, fr = lane & 15, fq = lane >> 4;
    Unit u; u.e = 0;
    for (int ui = 0; S.next(ui, u); ++ui) {
        f32x4 acc[2][2][4][2];
#pragma unroll
        for (int a = 0; a < 2; ++a)
#pragma unroll
            for (int b = 0; b < 2; ++b)
#pragma unroll
                for (int m = 0; m < 4; ++m)
#pragma unroll
                    for (int n = 0; n < 2; ++n) acc[a][b][m][n] = (f32x4){0.f, 0.f, 0.f, 0.f};
        unsigned ao[2][4], bo[2][2];
#pragma unroll
        for (int ai = 0; ai < 2; ++ai)
#pragma unroll
            for (int m = 0; m < 4; ++m) { const int rl = ai * HALF + wr * 64 + m * 16 + fr;
                if (g.gather) { const int tok = g.gather[(size_t)u.e * T + u.slot0 + (rl < u.nvalid ? rl : u.nvalid - 1)] >> 2; ao[ai][m] = (unsigned)tok * (unsigned)g.lda + fq * 8; }
                else ao[ai][m] = u.aoff + (unsigned)rl * (unsigned)g.lda + fq * 8; }
#pragma unroll
        for (int bj = 0; bj < 2; ++bj)
#pragma unroll
            for (int n = 0; n < 2; ++n) { const int slot = 16 * n + fr, brow = bj * HALF + wc * 32 + (Epi::PERM ? perm32(slot) : slot); bo[bj][n] = u.boff + (unsigned)brow * (unsigned)g.ldb + fq * 8; }
#pragma unroll 1
        for (int k = 0; k < g.K; k += 32) {
            bf16x8 b[2][2];
#pragma unroll
            for (int bj = 0; bj < 2; ++bj)
#pragma unroll
                for (int n = 0; n < 2; ++n) b[bj][n] = *(const bf16x8*)(g.Bt + (size_t)bo[bj][n] + k);
#pragma unroll
            for (int ai = 0; ai < 2; ++ai) {
                bf16x8 a[4];
#pragma unroll
                for (int m = 0; m < 4; ++m) a[m] = *(const bf16x8*)(g.A + (size_t)ao[ai][m] + k);
#pragma unroll
                for (int bj = 0; bj < 2; ++bj)
#pragma unroll
                    for (int m = 0; m < 4; ++m)
#pragma unroll
                        for (int n = 0; n < 2; ++n) acc[ai][bj][m][n] = __builtin_amdgcn_mfma_f32_16x16x32_bf16(b[bj][n], a[m], acc[ai][bj][m][n], 0, 0, 0);
            }
        }
        E(acc, u, wr, wc, fr, fq);
    }
}

typedef int v8i32 __attribute__((ext_vector_type(8)));
typedef int v4i32 __attribute__((ext_vector_type(4)));
template <int ES> struct Frag;
template <> struct Frag<2> { bf16x8 k[2]; };
template <> struct Frag<1> { v8i32 v; };
__device__ __forceinline__ void ld_frag(Frag<2>& f, const LAS unsigned char* p) { f.k[0] = *(const LAS bf16x8*)p; f.k[1] = *(const LAS bf16x8*)(p + 1024); }
__device__ __forceinline__ void ld_frag(Frag<1>& f, const LAS unsigned char* p) { const v4i32 lo = *(const LAS v4i32*)p, hi = *(const LAS v4i32*)(p + 1024); f.v = __builtin_shufflevector(lo, hi, 0, 1, 2, 3, 4, 5, 6, 7); }
__device__ __forceinline__ f32x4 mma_frag(const Frag<2>& b, const Frag<2>& a, f32x4 c) { c = __builtin_amdgcn_mfma_f32_16x16x32_bf16(b.k[0], a.k[0], c, 0, 0, 0); return __builtin_amdgcn_mfma_f32_16x16x32_bf16(b.k[1], a.k[1], c, 0, 0, 0); }
#ifndef FP8_ASM
#define FP8_ASM 1
#endif
#if FP8_ASM
__device__ __forceinline__ f32x4 mma_frag(const Frag<1>& b, const Frag<1>& a, f32x4 c) { asm volatile("v_mfma_f32_16x16x128_f8f6f4 %0, %1, %2, %0" : "+v"(c) : "v"(b.v), "v"(a.v)); return c; }
#else
__device__ __forceinline__ f32x4 mma_frag(const Frag<1>& b, const Frag<1>& a, f32x4 c) { return __builtin_amdgcn_mfma_scale_f32_16x16x128_f8f6f4(b.v, a.v, c, 0, 0, 0, 0, 0, 0); }
#endif
template <class Epi, class Sched, int ES  >
__device__ __forceinline__ void gemm_fast(LAS unsigned char* lds, int wave, const Gemm g, const Sched& S, const Epi& E) {
    const int wid = launder_s(wave), lane = lane_id_v(), tid = wid * 64 + lane, wr = wid >> 2, wc = wid & 3, fr = lane & 15, fq = lane >> 4;
    const int K = launder_s(g.K), nt = K * ES / (BK * 2);
    unsigned voffB[2];
#pragma unroll
    for (int i = 0; i < 2; ++i) { int R, C; stage_rc(tid * 16 + i * 8192, R, C); const int Rb = Epi::PERM ? ((R & ~31) + perm32(R & 31)) : R; voffB[i] = (unsigned)Rb * (unsigned)g.ldb * (unsigned)ES + (unsigned)C * 2u; }
    const size_t kstep = (size_t)(BK * 2);
    const size_t hstepB = (size_t)HALF * g.ldb * ES;
    const unsigned ldsw = (unsigned)wid * 1024u;
    const int aoff = lds_byte(wr * 64 + fr, fq * 8), boff = lds_byte(wc * 32 + fr, fq * 8);
    const char* const Abase = (const char*)g.A; const char* const Bbase = (const char*)g.Bt;
#define PG8_SA(b, h) (((b) * 2 + (h)) * HTB)
#define PG8_SB(b, h) ((4 + (b) * 2 + (h)) * HTB)
#define PG8_STAGE_A(bufoff, ao, kb) do { _Pragma("unroll") for (int _i = 0; _i < 2; ++_i) \
        __builtin_amdgcn_global_load_lds((const unsigned*)(Abase + (size_t)(ao)[_i] + (size_t)(kb)), (LAS unsigned*)(lds + (bufoff) + ldsw + _i * 8192), 16, 0, 0); } while (0)
#define PG8_STAGE_B(bufoff, gbase) do { _Pragma("unroll") for (int _i = 0; _i < 2; ++_i) \
        __builtin_amdgcn_global_load_lds((const unsigned*)((const char*)(gbase) + voffB[_i]), (LAS unsigned*)(lds + (bufoff) + ldsw + _i * 8192), 16, 0, 0); } while (0)
#define PG8_LDA(dst, b, h) do { _Pragma("unroll") for (int m = 0; m < 4; ++m) ld_frag(dst[m], lds + PG8_SA(b, h) + aoff + m * 2048); } while (0)
#define PG8_LDB(dst, b, h) do { _Pragma("unroll") for (int n = 0; n < 2; ++n) ld_frag(dst[n], lds + PG8_SB(b, h) + boff + n * 2048); } while (0)
#define PG8_MMA(ai, bj, At, Bt) do { __builtin_amdgcn_s_setprio(1); _Pragma("unroll") for (int m = 0; m < 4; ++m) _Pragma("unroll") for (int n = 0; n < 2; ++n) acc[ai][bj][m][n] = mma_frag(Bt[n], At[m], acc[ai][bj][m][n]); \
        __builtin_amdgcn_s_setprio(0); } while (0)
#define PG8_WAIT_V(n) asm volatile("s_waitcnt vmcnt(" #n ")" ::: "memory")
#define PG8_WAIT_L(n) asm volatile("s_waitcnt lgkmcnt(" #n ")" ::: "memory")
#define PG8_BAR __builtin_amdgcn_s_barrier()
#define PG8_SCHED __builtin_amdgcn_sched_barrier(0)
#define PG8_AOFFS(u, ao) do { if (g.gather) { const int* _gp = g.gather + (size_t)(u).e * T + (u).slot0; const int _nv1 = (u).nvalid - 1; int _tk[2][2]; \
            _Pragma("unroll") for (int _h = 0; _h < 2; ++_h) _Pragma("unroll") for (int _i = 0; _i < 2; ++_i) { int _R, _C; stage_rc(tid * 16 + _i * 8192, _R, _C); const int _rl = _h * HALF + _R; _tk[_h][_i] = _gp[_rl < _nv1 ? _rl : _nv1]; } \
            _Pragma("unroll") for (int _h = 0; _h < 2; ++_h) _Pragma("unroll") for (int _i = 0; _i < 2; ++_i) { int _R, _C; stage_rc(tid * 16 + _i * 8192, _R, _C); ao[_h][_i] = (unsigned)(_tk[_h][_i] >> 2) * (unsigned)g.lda * (unsigned)ES + (unsigned)_C * 2u; } } \
        else { _Pragma("unroll") for (int _h = 0; _h < 2; ++_h) _Pragma("unroll") for (int _i = 0; _i < 2; ++_i) { int _R, _C; stage_rc(tid * 16 + _i * 8192, _R, _C); ao[_h][_i] = ((u).aoff + (unsigned)(_h * HALF + _R) * (unsigned)g.lda) * (unsigned)ES + (unsigned)_C * 2u; } } } while (0)
    Unit cur, nxt; int ui = 0; cur.e = 0;
    if (!S.next(0, cur)) return;
    constexpr bool PROF = (PROF_REGION != 0) && ((PROF_SITES >> Epi::SITE_ID) & 1);
    unsigned long long prof_acc = 0, prof_t0 = (PROF && PROF_REGION == 1) ? __builtin_amdgcn_s_memrealtime() : 0ull;
#define PG8_PROF(r, begin) do { if (PROF && PROF_REGION == (r) && wid == 0) { const unsigned long long _t = __builtin_amdgcn_s_memrealtime(); if (begin) prof_t0 = _t; else prof_acc += _t - prof_t0; } } while (0)
    f32x4 acc[2][2][4][2];
#pragma unroll
    for (int a = 0; a < 2; ++a)
#pragma unroll
        for (int b = 0; b < 2; ++b)
#pragma unroll
            for (int m = 0; m < 4; ++m)
#pragma unroll
                for (int n = 0; n < 2; ++n) acc[a][b][m][n] = (f32x4){0.f, 0.f, 0.f, 0.f};
    Frag<ES> At[4], B0[2], B1[2];
    unsigned aC[2][2], aN[2][2];
    PG8_AOFFS(cur, aC);
    if constexpr (epi_has_pre<Epi>::value) E.prefetch(lds + META_OFF, cur, wid, lane);
    const char* cB = Bbase + (size_t)cur.boff * ES;
    PG8_STAGE_B(PG8_SB(0, 0), cB); PG8_STAGE_B(PG8_SB(0, 1), cB + hstepB); PG8_STAGE_A(PG8_SA(0, 0), aC[0], 0); PG8_STAGE_A(PG8_SA(0, 1), aC[1], 0);
    if (wr == 1) PG8_BAR;
    PG8_WAIT_V(2); PG8_BAR;
    PG8_STAGE_B(PG8_SB(1, 0), cB + kstep); PG8_STAGE_A(PG8_SA(1, 0), aC[0], kstep); PG8_STAGE_B(PG8_SB(1, 1), cB + hstepB + kstep);
    PG8_WAIT_V(6); PG8_BAR;
    for (;;) {
        nxt.e = cur.e;
        const bool has_next = S.next(ui + 1, nxt);
        if (has_next) { PG8_AOFFS(nxt, aN); } else {
#pragma unroll
            for (int h = 0; h < 2; ++h)
#pragma unroll
                for (int i = 0; i < 2; ++i) aN[h][i] = aC[h][i]; }
        const char* nB = has_next ? Bbase + (size_t)nxt.boff * ES : cB;
        PG8_PROF(1, false); PG8_PROF(2, true);
#pragma unroll 1
        for (int t = 0; t < nt; t += 2) {
            const bool last = (t == nt - 2);
            const size_t k1 = (size_t)(t + 1) * kstep, k2 = last ? 0 : (size_t)(t + 2) * kstep, k3 = k2 + kstep;
            unsigned a2[2][2];
#pragma unroll
            for (int h = 0; h < 2; ++h)
#pragma unroll
                for (int i = 0; i < 2; ++i) a2[h][i] = last ? aN[h][i] : aC[h][i];
            const char* b2 = last ? nB : cB + (size_t)(t + 2) * kstep; const char* b3 = b2 + kstep;
            PG8_LDB(B0, 0, 0); PG8_LDB(B1, 0, 1); PG8_SCHED; PG8_LDA(At, 0, 0); PG8_STAGE_A(PG8_SA(1, 1), aC[1], k1);
            PG8_WAIT_V(8); PG8_WAIT_L(0); PG8_BAR; PG8_MMA(0, 0, At, B0); PG8_MMA(0, 1, At, B1); PG8_BAR; PG8_SCHED;
            PG8_LDA(At, 0, 1); PG8_STAGE_B(PG8_SB(0, 0), b2); PG8_STAGE_B(PG8_SB(0, 1), b2 + hstepB); PG8_STAGE_A(PG8_SA(0, 0), a2[0], k2);
            PG8_WAIT_V(8); PG8_WAIT_L(0); PG8_BAR; PG8_MMA(1, 0, At, B0); PG8_MMA(1, 1, At, B1); PG8_BAR; PG8_SCHED;
            PG8_LDB(B0, 1, 0); PG8_LDB(B1, 1, 1); PG8_SCHED; PG8_LDA(At, 1, 0); PG8_STAGE_A(PG8_SA(0, 1), a2[1], k2);
            PG8_WAIT_V(8); PG8_WAIT_L(0); PG8_BAR; PG8_MMA(0, 0, At, B0); PG8_MMA(0, 1, At, B1); PG8_BAR; PG8_SCHED;
            PG8_LDA(At, 1, 1); PG8_STAGE_B(PG8_SB(1, 0), b3); PG8_STAGE_B(PG8_SB(1, 1), b3 + hstepB); PG8_STAGE_A(PG8_SA(1, 0), a2[0], k3);
            PG8_WAIT_V(8); PG8_WAIT_L(0); PG8_BAR; PG8_MMA(1, 0, At, B0); PG8_MMA(1, 1, At, B1); PG8_BAR; PG8_SCHED;
        }
        PG8_PROF(2, false); PG8_PROF(1, true);
        if constexpr (ES == 1 && FP8_ASM) asm volatile("s_nop 15\n\ts_nop 15\n\ts_nop 15" ::: "memory");
        if (wr == 0) PG8_BAR;
        if constexpr (epi_has_pre<Epi>::value) E.epi_lds(acc, cur, wr, wc, fr, fq, lds + META_OFF + (ui & 1) * META_BYTES); else E(acc, cur, wr, wc, fr, fq);
        if (!has_next) break;
#pragma unroll
        for (int a = 0; a < 2; ++a)
#pragma unroll
            for (int b = 0; b < 2; ++b)
#pragma unroll
                for (int m = 0; m < 4; ++m)
#pragma unroll
                    for (int n = 0; n < 2; ++n) acc[a][b][m][n] = (f32x4){0.f, 0.f, 0.f, 0.f};
        cur = nxt; cB = nB; ++ui;
        if constexpr (epi_has_pre<Epi>::value) E.prefetch(lds + META_OFF + (ui & 1) * META_BYTES, cur, wid, lane);
#pragma unroll
        for (int h = 0; h < 2; ++h)
#pragma unroll
            for (int i = 0; i < 2; ++i) aC[h][i] = aN[h][i];
        if (wr == 1) PG8_BAR;
    }
    PG8_WAIT_V(0);
    if (PROF && wid == 0) { PG8_PROF(1, false); if (lane == 0) { volatile LAS unsigned* pw = (volatile LAS unsigned*)(lds + LDSCTL_OFF) + MISC_PROF; *pw = *pw + (unsigned)prof_acc; } }
    PG8_BAR;
#undef PG8_SA
#undef PG8_SB
#undef PG8_STAGE_A
#undef PG8_STAGE_B
#undef PG8_LDA
#undef PG8_LDB
#undef PG8_MMA
#undef PG8_WAIT_V
#undef PG8_WAIT_L
#undef PG8_BAR
#undef PG8_SCHED
#undef PG8_AOFFS
#undef PG8_PROF
}

template <class Epi, class Sched, int SITE>
__device__ __forceinline__ void gemm_phase(LAS unsigned char* lds, int wave, const Gemm g, const Sched& S, const Epi& E) {
    if constexpr (Epi::ES == 1) gemm_fast<Epi, Sched, 1>(lds, wave, g, S, E);
    else if constexpr ((FAST_MASK >> SITE) & 1) gemm_fast<Epi, Sched, 2>(lds, wave, g, S, E); else gemm_simple<Epi, Sched>(wave, g, S, E);
}
}

struct Frame {
    LAS unsigned char* lds;
    volatile LAS unsigned* MISC;
    unsigned* ctl;
    int tid, lane, wave, vcu, G;
};
struct Args { const float* in[21]; float* out; unsigned char* ws; int ph_lo, ph_hi; };
static_assert(sizeof(Args) == 21 * 8 + 8 + 8 + 8, "Args has no padding");

__device__ __forceinline__ void mods_phase(Frame& F, const float* c, const float* ada_w, const float* ada_b, float* MOD) {
    LAS float* cact = (LAS float*)F.lds;
    LAS float* part = (LAS float*)(F.lds + 8192);
    for (int i = F.tid; i < BATCH * D; i += NTHREADS) { const float v = c[i]; cact[i] = v * fast_sigmoid(v); }
    __syncthreads();
    constexpr int NTASK = DEPTH * (6 * D / 64);
    for (int task = F.vcu; task < NTASK; task += F.G) {
        const int l = task / (6 * D / 64), j0 = (task % (6 * D / 64)) * 64;
        const float* w = ada_w + (size_t)l * D * (6 * D) + j0 + F.lane;
        const int k0 = F.wave * 128;
        float a0 = 0.f, a1 = 0.f;
#pragma unroll 16
        for (int k = 0; k < 128; ++k) { const float wv = w[(size_t)(k0 + k) * (6 * D)]; a0 += cact[k0 + k] * wv; a1 += cact[D + k0 + k] * wv; }
        part[(F.wave * 2 + 0) * 64 + F.lane] = a0; part[(F.wave * 2 + 1) * 64 + F.lane] = a1;
        __syncthreads();
        if (F.tid < 128) { const int b = F.tid >> 6, j = F.tid & 63; float s = 0.f;
#pragma unroll
            for (int w8 = 0; w8 < 8; ++w8) s += part[(w8 * 2 + b) * 64 + j];
            MOD[((size_t)l * BATCH + b) * (6 * D) + j0 + j] = s + ada_b[(size_t)l * (6 * D) + j0 + j]; }
        __syncthreads();
    }
}
__device__ __forceinline__ void tr_item(const float* W, int ldw, bf16_t* WT, int ldt, int k0, int n0, int drow0, int dcol0, LAS float* scr, int lane) {
#pragma unroll 8
    for (int i = 0; i < 32; ++i) { const int kk = 2 * i + (lane >> 5); scr[kk * 33 + (lane & 31)] = W[(size_t)(k0 + kk) * ldw + n0 + (lane & 31)]; }
    LDS_WAIT(); asm volatile("" ::: "memory");
    const int c = lane & 7;
#pragma unroll
    for (int j = 0; j < 4; ++j) { const int n = (lane >> 3) + 8 * j; const LAS float* s = scr + (8 * c) * 33 + n;
        u32x4 o; o.x = pk2(s[0 * 33], s[1 * 33]); o.y = pk2(s[2 * 33], s[3 * 33]); o.z = pk2(s[4 * 33], s[5 * 33]); o.w = pk2(s[6 * 33], s[7 * 33]);
        *(u32x4*)(WT + (size_t)(drow0 + n) * ldt + dcol0 + k0 + 8 * c) = o; }
    LDS_WAIT(); asm volatile("" ::: "memory");
}
__device__ __forceinline__ void tr_item8(const float* W, int ldw, unsigned char* WT, int ldt, int k0, int n0, int drow0, float scale, LAS float* scr, int lane) {
#pragma unroll 8
    for (int i = 0; i < 32; ++i) { const int kk = 2 * i + (lane >> 5); scr[kk * 33 + (lane & 31)] = W[(size_t)(k0 + kk) * ldw + n0 + (lane & 31)]; }
    LDS_WAIT(); asm volatile("" ::: "memory");
    const int c = lane & 3;
#pragma unroll
    for (int j = 0; j < 2; ++j) { const int n = (lane >> 2) + 16 * j; const LAS float* sp = scr + (16 * c) * 33 + n;
        u32x4 o; o.x = pk4_fp8(sp[0 * 33] * scale, sp[1 * 33] * scale, sp[2 * 33] * scale, sp[3 * 33] * scale); o.y = pk4_fp8(sp[4 * 33] * scale, sp[5 * 33] * scale, sp[6 * 33] * scale, sp[7 * 33] * scale);
        o.z = pk4_fp8(sp[8 * 33] * scale, sp[9 * 33] * scale, sp[10 * 33] * scale, sp[11 * 33] * scale); o.w = pk4_fp8(sp[12 * 33] * scale, sp[13 * 33] * scale, sp[14 * 33] * scale, sp[15 * 33] * scale);
        *(u32x4*)(WT + (size_t)(drow0 + n) * ldt + k0 + 16 * c) = o; }
    LDS_WAIT(); asm volatile("" ::: "memory");
}
__device__ __forceinline__ int win_drow(int n0) {
    if (n0 < 512) return n0; if (n0 < 768) return 3328 + (n0 - 512); if (n0 < 1536) return 512 + (n0 - 768); return 1280 + (n0 - 1536);
}
typedef const volatile __attribute__((address_space(4))) Args* KArgs;
__device__ __forceinline__ void convert_phase(Frame& F, KArgs ka) {
    unsigned char* wsb = (unsigned char*)ka->ws; const float *in8 = (const float*)ka->in[8], *in9 = (const float*)ka->in[9], *in12 = (const float*)ka->in[12], *in13 = (const float*)ka->in[13], *in14 = (const float*)ka->in[14], *in15 = (const float*)ka->in[15], *in17 = (const float*)ka->in[17], *in19 = (const float*)ka->in[19];
    LAS float* scr = (LAS float*)(F.lds + F.wave * 16384);
    const int gw = F.vcu * NWAVES + F.wave, NGW = F.G * NWAVES;
    constexpr int I_IN = 16 * 112, I_BRA = 4 * 32, I_BRP = 12 * 32, I_OUT = 16 * 32, I_RT = 16, I_PL = 4 * 3 * 6, I_GU = NE * 16 * 64, I_DN = NE * 16 * 32;
    constexpr int I_LAYER = I_IN + I_BRA + I_BRP + I_OUT + I_RT + I_PL + I_GU + I_DN;
    for (int it = gw; it < DEPTH * I_LAYER; it += NGW) {
        const int l = it / I_LAYER; int r = it % I_LAYER;
        unsigned char* wl = wsb + WS_W + (size_t)l * WL_STRIDE;
        if (r < I_GU) { const int e = r / (16 * 64), q = r % (16 * 64), kb = q / 64, nb = q % 64, n0 = nb * 32, half = n0 / D, cc = n0 % D;
            tr_item8(in17 + ((size_t)l * NE + e) * D * (2 * D), 2 * D, (unsigned char*)(wl + WO_GU) + (size_t)e * (2 * D) * D, D, kb * 64, n0, (cc / 128) * 256 + half * 128 + (cc % 128), W8_SCALE, scr, F.lane); continue; } r -= I_GU;
        if (r < I_DN) { const int e = r / (16 * 32), q = r % (16 * 32), kb = q / 32, nb = q % 32;
            tr_item8(in19 + ((size_t)l * NE + e) * D * D, D, (unsigned char*)(wl + WO_DN) + (size_t)e * D * D, D, kb * 64, nb * 32, nb * 32, W8_SCALE, scr, F.lane); continue; } r -= I_DN;
        if (r < I_IN) { const int kb = r / 112, nb = r % 112;
            tr_item(in8 + (size_t)l * D * INW, INW, (bf16_t*)(wl + WO_WIN), D, kb * 64, nb * 32, win_drow(nb * 32), 0, scr, F.lane); continue; } r -= I_IN;
        if (r < I_BRA) { const int kb = r / 32, nb = r % 32;
            tr_item(in12 + (size_t)l * SBW * D, D, (bf16_t*)(wl + WO_BRA), SBW, kb * 64, nb * 32, nb * 32, 0, scr, F.lane); continue; } r -= I_BRA;
        if (r < I_BRP) { const int kb = r / 32, nb = r % 32;
            tr_item(in13 + (size_t)l * PW * D, D, (bf16_t*)(wl + WO_BRP), PW, kb * 64, nb * 32, nb * 32, 0, scr, F.lane); continue; } r -= I_BRP;
        if (r < I_OUT) { const int kb = r / 32, nb = r % 32;
            tr_item(in14 + (size_t)l * D * D, D, (bf16_t*)(wl + WO_OUT), D, kb * 64, nb * 32, nb * 32, 0, scr, F.lane); continue; } r -= I_OUT;
        if (r < I_RT) { tr_item(in15 + (size_t)l * D * NE, NE, (bf16_t*)(wl + WO_ROUTER), D, r * 64, 0, 0, 0, scr, F.lane); continue; } r -= I_RT;
        { const int gidx = r / 18, q = r % 18, kb = q / 6, nb = q % 6;
            tr_item(in9 + ((size_t)l * 4 + gidx) * PGD * PGD, PGD, (bf16_t*)(wl + WO_POOL), PW, kb * 64, nb * 32, gidx * PGD + nb * 32, gidx * PGD, scr, F.lane); }
    }
    for (int it = gw; it < DEPTH * PW; it += NGW) { const int l = it / PW, n = it % PW, gidx = n / PGD;
        bf16_t* rowp = (bf16_t*)(wsb + WS_W + (size_t)l * WL_STRIDE + WO_POOL) + (size_t)n * PW;
        for (int ch = F.lane; ch < PW / 8; ch += 64) if (ch / (PGD / 8) != gidx) *(u32x4*)(rowp + ch * 8) = (u32x4){0u, 0u, 0u, 0u}; }
}

struct Row16 { f32x4 a[4]; };
__device__ __forceinline__ void ld_row_f32(const float* p, int lane, Row16& v) {
#pragma unroll
    for (int j = 0; j < 2; ++j) { v.a[2 * j] = *(const f32x4*)(p + 8 * lane + 512 * j); v.a[2 * j + 1] = *(const f32x4*)(p + 8 * lane + 512 * j + 4); } }
__device__ __forceinline__ void st_row_f32(float* p, int lane, const Row16& v) {
#pragma unroll
    for (int j = 0; j < 2; ++j) { *(f32x4*)(p + 8 * lane + 512 * j) = v.a[2 * j]; *(f32x4*)(p + 8 * lane + 512 * j + 4) = v.a[2 * j + 1]; } }
__device__ __forceinline__ void ld_row_bf16(const bf16_t* p, int lane, u32x4 (&w)[2]) {
#pragma unroll
    for (int j = 0; j < 2; ++j) w[j] = *(const u32x4*)(p + 8 * lane + 512 * j); }
__device__ __forceinline__ void acc_row_bf16(const u32x4 (&w)[2], Row16& y) {
#pragma unroll
    for (int j = 0; j < 2; ++j) { f32x4 lo, hi; pg8::unpack8(w[j], lo, hi); y.a[2 * j] = y.a[2 * j] + lo; y.a[2 * j + 1] = y.a[2 * j + 1] + hi; } }
__device__ __forceinline__ void ld_row_x(const void* base, bool is_bf16, size_t row, int lane, Row16& v) {
    if (is_bf16) { u32x4 w[2]; ld_row_bf16((const bf16_t*)base + row * D, lane, w);
#pragma unroll
        for (int i = 0; i < 4; ++i) v.a[i] = (f32x4){0.f, 0.f, 0.f, 0.f};
        acc_row_bf16(w, v); }
    else ld_row_f32((const float*)base + row * D, lane, v); }
__device__ __forceinline__ void st_row_x(void* base, bool is_bf16, size_t row, int lane, const Row16& v) {
    if (is_bf16) {
#pragma unroll
        for (int j = 0; j < 2; ++j) { u32x4 w; w.x = pk2(v.a[2 * j].x, v.a[2 * j].y); w.y = pk2(v.a[2 * j].z, v.a[2 * j].w); w.z = pk2(v.a[2 * j + 1].x, v.a[2 * j + 1].y); w.w = pk2(v.a[2 * j + 1].z, v.a[2 * j + 1].w);
            *(u32x4*)((bf16_t*)base + row * D + 8 * lane + 512 * j) = w; } }
    else st_row_f32((float*)base + row * D, lane, v); }
__device__ __forceinline__ float row_sumsq(const Row16& v) { float ss = 0.f;
#pragma unroll
    for (int q = 0; q < 4; ++q) ss += (v.a[q].x * v.a[q].x + v.a[q].y * v.a[q].y) + (v.a[q].z * v.a[q].z + v.a[q].w * v.a[q].w);
    return ss; }
__device__ __forceinline__ void norm_mod_store(const Row16& v, float ss_wave, const Row16& gg, const Row16& s1, const Row16& s0, bf16_t* hrow, int lane, unsigned char* h8row = nullptr) {
    const float r = 1.0f / sqrtf(ss_wave * (1.0f / D) + NORM_EPS);
#pragma unroll
    for (int j = 0; j < 2; ++j) { const f32x4 o0 = v.a[2 * j] * r * gg.a[2 * j] * (s1.a[2 * j] + 1.0f) + s0.a[2 * j], o1 = v.a[2 * j + 1] * r * gg.a[2 * j + 1] * (s1.a[2 * j + 1] + 1.0f) + s0.a[2 * j + 1];
        u32x4 w; w.x = pk2(o0.x, o0.y); w.y = pk2(o0.z, o0.w); w.z = pk2(o1.x, o1.y); w.w = pk2(o1.z, o1.w); *(u32x4*)(hrow + 8 * lane + 512 * j) = w;
        if (h8row) { u32x2 q; q.x = pk4_fp8(o0.x, o0.y, o0.z, o0.w); q.y = pk4_fp8(o1.x, o1.y, o1.z, o1.w); *(u32x2*)(h8row + 8 * lane + 512 * j) = q; } }
}
constexpr int RP = 2;
__device__ __forceinline__ void rowpass_pre(Frame& F, const float* x, const float* g, const float* MODl, bf16_t* H) {
    const int gw = F.vcu * NWAVES + F.wave, NGW = F.G * NWAVES;
    Row16 gg; ld_row_f32(g, F.lane, gg);
    for (int row0 = gw * RP; row0 < T; row0 += NGW * RP) { const int b = row0 / SEQ; const float* mod = MODl + (size_t)b * 6 * D;
        Row16 v[RP], s1, s0; float ss[RP];
#pragma unroll
        for (int q = 0; q < RP; ++q) ld_row_f32(x + (size_t)(row0 + q) * D, F.lane, v[q]);
        ld_row_f32(mod + 1 * D, F.lane, s1); ld_row_f32(mod + 0 * D, F.lane, s0);
#pragma unroll
        for (int q = 0; q < RP; ++q) ss[q] = row_sumsq(v[q]);
#pragma unroll
        for (int o = 1; o < 64; o <<= 1) {
#pragma unroll
            for (int q = 0; q < RP; ++q) ss[q] += __shfl_xor(ss[q], o); }
#pragma unroll
        for (int q = 0; q < RP; ++q) norm_mod_store(v[q], ss[q], gg, s1, s0, H + (size_t)(row0 + q) * D, F.lane); }
}
__device__ __forceinline__ void rowpass_mid(Frame& F, int row_begin, int row_end, int row_step, const void* xin, bool xin_bf16, bf16_t* xout, const bf16_t* Y, const float* post_g, const float* pre2_g, const float* MODl, bf16_t* H, unsigned char* H8) {
    for (int row0 = row_begin; row0 < row_end; row0 += row_step) { const int b = row0 / SEQ; const float* mod = MODl + (size_t)b * 6 * D;
        Row16 v[RP], y[RP]; float ss[RP];
#pragma unroll
        for (int q = 0; q < RP; ++q) { ld_row_x(xin, xin_bf16, (size_t)(row0 + q), F.lane, v[q]); u32x4 w[2]; ld_row_bf16(Y + (size_t)(row0 + q) * D, F.lane, w);
#pragma unroll
            for (int i = 0; i < 4; ++i) y[q].a[i] = (f32x4){0.f, 0.f, 0.f, 0.f};
            acc_row_bf16(w, y[q]); }
        { Row16 pg, g1; ld_row_f32(post_g, F.lane, pg); ld_row_f32(mod + 2 * D, F.lane, g1);
#pragma unroll
            for (int q = 0; q < RP; ++q) ss[q] = row_sumsq(y[q]);
#pragma unroll
            for (int o = 1; o < 64; o <<= 1) {
#pragma unroll
                for (int q = 0; q < RP; ++q) ss[q] += __shfl_xor(ss[q], o); }
#pragma unroll
            for (int q = 0; q < RP; ++q) { const float r = 1.0f / sqrtf(ss[q] * (1.0f / D) + NORM_EPS);
#pragma unroll
                for (int i = 0; i < 4; ++i) v[q].a[i] = v[q].a[i] + g1.a[i] * (y[q].a[i] * r * pg.a[i]);
                st_row_x(xout, true, (size_t)(row0 + q), F.lane, v[q]); } }
        { Row16 gg, s1, s0; ld_row_f32(pre2_g, F.lane, gg); ld_row_f32(mod + 4 * D, F.lane, s1); ld_row_f32(mod + 3 * D, F.lane, s0);
#pragma unroll
            for (int q = 0; q < RP; ++q) ss[q] = row_sumsq(v[q]);
#pragma unroll
            for (int o = 1; o < 64; o <<= 1) {
#pragma unroll
                for (int q = 0; q < RP; ++q) ss[q] += __shfl_xor(ss[q], o); }
#pragma unroll
            for (int q = 0; q < RP; ++q) norm_mod_store(v[q], ss[q], gg, s1, s0, H + (size_t)(row0 + q) * D, F.lane, H8 + (size_t)(row0 + q) * D); } }
}
__device__ __forceinline__ void rowpass_comb(Frame& F, const bf16_t* x, void* xout, bool xout_bf16, const bf16_t* YR4, const float* post_g, const float* MODl,
                                             bool has_next, const float* pre1_g_next, const float* MODn, bf16_t* H) {
    const int gw = F.vcu * NWAVES + F.wave, NGW = F.G * NWAVES;
    for (int row0 = gw * RP; row0 < T; row0 += NGW * RP) { const int b = row0 / SEQ; const float* mod = MODl + (size_t)b * 6 * D;
        Row16 v[RP], y[RP]; float ss[RP]; u32x4 w[RP][TOPK][2];
#pragma unroll
        for (int q = 0; q < RP; ++q) { ld_row_x(x, true, (size_t)(row0 + q), F.lane, v[q]);
#pragma unroll
            for (int k = 0; k < TOPK; ++k) ld_row_bf16(YR4 + ((size_t)(row0 + q) * TOPK + k) * D, F.lane, w[q][k]); }
#pragma unroll
        for (int q = 0; q < RP; ++q) {
#pragma unroll
            for (int i = 0; i < 4; ++i) y[q].a[i] = (f32x4){0.f, 0.f, 0.f, 0.f};
#pragma unroll
            for (int k = 0; k < TOPK; ++k) acc_row_bf16(w[q][k], y[q]); }
        { Row16 pg, g2; ld_row_f32(post_g, F.lane, pg); ld_row_f32(mod + 5 * D, F.lane, g2);
#pragma unroll
            for (int q = 0; q < RP; ++q) ss[q] = row_sumsq(y[q]);
#pragma unroll
            for (int o = 1; o < 64; o <<= 1) {
#pragma unroll
                for (int q = 0; q < RP; ++q) ss[q] += __shfl_xor(ss[q], o); }
#pragma unroll
            for (int q = 0; q < RP; ++q) { const float r = 1.0f / sqrtf(ss[q] * (1.0f / D) + NORM_EPS);
#pragma unroll
                for (int i = 0; i < 4; ++i) v[q].a[i] = v[q].a[i] + g2.a[i] * (y[q].a[i] * r * pg.a[i]);
                st_row_x(xout, xout_bf16, (size_t)(row0 + q), F.lane, v[q]); } }
        if (has_next) { const float* modn = MODn + (size_t)b * 6 * D; Row16 gg, s1, s0; ld_row_f32(pre1_g_next, F.lane, gg); ld_row_f32(modn + 1 * D, F.lane, s1); ld_row_f32(modn + 0 * D, F.lane, s0);
#pragma unroll
            for (int q = 0; q < RP; ++q) ss[q] = row_sumsq(v[q]);
#pragma unroll
            for (int o = 1; o < 64; o <<= 1) {
#pragma unroll
                for (int q = 0; q < RP; ++q) ss[q] += __shfl_xor(ss[q], o); }
#pragma unroll
            for (int q = 0; q < RP; ++q) norm_mod_store(v[q], ss[q], gg, s1, s0, H + (size_t)(row0 + q) * D, F.lane); } }
}

__device__ __forceinline__ void attn_phase(Frame& F, const bf16_t* Q, const bf16_t* KB, const bf16_t* VT, bf16_t* AP) {
    const int gw = F.vcu * NWAVES + F.wave, NGW = F.G * NWAVES;
    const int r = F.lane & 31, hh = F.lane >> 5;
    constexpr int NQT = SEQ / 32, NTASK = BATCH * NH * NQT;
    for (int task = gw; task < NTASK; task += NGW) {
        const int qt = task % NQT, h = (task / NQT) % NH, b = task / (NQT * NH), q0 = qt * 32;
        const size_t trow0 = (size_t)b * SEQ;
        bf16x8 qf[4];
#pragma unroll
        for (int ks = 0; ks < 4; ++ks) qf[ks] = *(const bf16x8*)(Q + (trow0 + q0 + r) * SBW + h * HD + ks * 16 + hh * 8);
        f32x16 o0, o1;
#pragma unroll
        for (int i = 0; i < 16; ++i) { o0[i] = 0.f; o1[i] = 0.f; }
        float C = 0.f;
        bf16x8 kf[4], kn[4]; s16x4 vlo[2][2], vhi[2][2], nlo[2][2], nhi[2][2];
#define ATT_LOAD(KF, VLO, VHI, kb_) do { const bf16_t* kp_ = KB + (trow0 + (kb_) + r) * SBW + h * HD + hh * 8; \
            _Pragma("unroll") for (int ks = 0; ks < 4; ++ks) KF[ks] = *(const bf16x8*)(kp_ + ks * 16); \
            _Pragma("unroll") for (int st = 0; st < 2; ++st) _Pragma("unroll") for (int dt = 0; dt < 2; ++dt) { const bf16_t* vp_ = VT + (size_t)(h * HD + dt * 32 + r) * VTP + trow0 + (kb_) + 16 * st + 4 * hh; VLO[st][dt] = *(const s16x4*)vp_; VHI[st][dt] = *(const s16x4*)(vp_ + 8); } } while (0)
        ATT_LOAD(kf, vlo, vhi, q0);
        for (int kb = q0; kb >= 0; kb -= 32) {
            const bool diag = (kb == q0);
            { const int nkb = kb >= 32 ? kb - 32 : 0; ATT_LOAD(kn, nlo, nhi, nkb); }
            f32x16 s;
#pragma unroll
            for (int i = 0; i < 16; ++i) s[i] = 0.f;
#pragma unroll
            for (int ks = 0; ks < 4; ++ks) s = __builtin_amdgcn_mfma_f32_32x32x16_bf16(kf[ks], qf[ks], s, 0, 0, 0);
            float lk[16];
#pragma unroll
            for (int i = 0; i < 16; ++i) { const int kc = 8 * (i >> 2) + 4 * hh + (i & 3); const bool valid = !diag || (kc < r); lk[i] = valid ? -softplus_f(s[i]) : 0.f; }
            float rt[4], pt[4], both[4];
#pragma unroll
            for (int gq = 0; gq < 4; ++gq) { lk[4 * gq + 2] += lk[4 * gq + 3]; lk[4 * gq + 1] += lk[4 * gq + 2]; lk[4 * gq + 0] += lk[4 * gq + 1]; rt[gq] = lk[4 * gq]; }
#pragma unroll
            for (int gq = 0; gq < 4; ++gq) { pt[gq] = __shfl_xor(rt[gq], 32); both[gq] = rt[gq] + pt[gq]; }
            float after[4]; after[3] = 0.f; after[2] = both[3]; after[1] = both[3] + both[2]; after[0] = after[1] + both[1];
            f32x16 a;
#pragma unroll
            for (int gq = 0; gq < 4; ++gq) { const float off = after[gq] + (hh == 0 ? pt[gq] : 0.f) + C;
#pragma unroll
                for (int j = 0; j < 4; ++j) { const int i = 4 * gq + j, kc = 8 * gq + 4 * hh + j; const bool valid = !diag || (kc < r);
                    a[i] = valid ? fast_exp(s[i] + lk[i] + off) : 0.f; } }
            C += both[0] + after[0];
#pragma unroll
            for (int st = 0; st < 2; ++st) {
                u32x4 pw; pw.x = pk2(a[8 * st + 0], a[8 * st + 1]); pw.y = pk2(a[8 * st + 2], a[8 * st + 3]); pw.z = pk2(a[8 * st + 4], a[8 * st + 5]); pw.w = pk2(a[8 * st + 6], a[8 * st + 7]);
                const bf16x8 pb = __builtin_bit_cast(bf16x8, pw);
                const bf16x8 va0 = __builtin_shufflevector(vlo[st][0], vhi[st][0], 0, 1, 2, 3, 4, 5, 6, 7), va1 = __builtin_shufflevector(vlo[st][1], vhi[st][1], 0, 1, 2, 3, 4, 5, 6, 7);
                o0 = __builtin_amdgcn_mfma_f32_32x32x16_bf16(va0, pb, o0, 0, 0, 0);
                o1 = __builtin_amdgcn_mfma_f32_32x32x16_bf16(va1, pb, o1, 0, 0, 0);
            }
            if (__all(C < STICK_EXIT)) break;
#pragma unroll
            for (int ks = 0; ks < 4; ++ks) kf[ks] = kn[ks];
#pragma unroll
            for (int st = 0; st < 2; ++st)
#pragma unroll
                for (int dt = 0; dt < 2; ++dt) { vlo[st][dt] = nlo[st][dt]; vhi[st][dt] = nhi[st][dt]; }
        }
#undef ATT_LOAD
        bf16_t* orow = AP + (trow0 + q0 + r) * D + h * HD;
#pragma unroll
        for (int gq = 0; gq < 4; ++gq) { u32x2 w0, w1; w0.x = pk2(o0[4 * gq], o0[4 * gq + 1]); w0.y = pk2(o0[4 * gq + 2], o0[4 * gq + 3]); w1.x = pk2(o1[4 * gq], o1[4 * gq + 1]); w1.y = pk2(o1[4 * gq + 2], o1[4 * gq + 3]);
            *(u32x2*)(orow + 8 * gq + 4 * hh) = w0; *(u32x2*)(orow + 32 + 8 * gq + 4 * hh) = w1; }
    }
}

__device__ __forceinline__ void ld8(const bf16_t* p, float (&v)[8]) { const u32x4 q = *(const u32x4*)p; v[0] = bf_lo(q.x); v[1] = bf_hi(q.x); v[2] = bf_lo(q.y); v[3] = bf_hi(q.y); v[4] = bf_lo(q.z); v[5] = bf_hi(q.z); v[6] = bf_lo(q.w); v[7] = bf_hi(q.w); }
template <int W> __device__ __forceinline__ void poolmix_task(const bf16_t* U, bf16_t* MIX, int gidx, int ob, int rb, int lane) {
    const int oct = gidx * (PGD / 8) + ob * 8 + (lane & 7), t0 = rb * 64 + (lane >> 3) * 8, s0 = t0 % SEQ;
    const bf16_t* up = U + (size_t)t0 * PW + oct * 8;
    u32x4 raw[8 + W - 1];
#pragma unroll
    for (int i = 0; i < 8 + W - 1; ++i) { const int rel = i - (W - 1); raw[i] = (s0 + rel >= 0) ? *(const u32x4*)(up + (ptrdiff_t)rel * PW) : (u32x4){0u, 0u, 0u, 0u}; }
    float sum[8];
#pragma unroll
    for (int j = 0; j < 8; ++j) sum[j] = 0.f;
#pragma unroll
    for (int i = 0; i < W; ++i) { f32x4 lo, hi; pg8::unpack8(raw[i], lo, hi);
#pragma unroll
        for (int j = 0; j < 4; ++j) { sum[j] += lo[j]; sum[4 + j] += hi[j]; } }
#pragma unroll
    for (int q = 0; q < 8; ++q) {
        const int s = s0 + q, cnt = (s + 1) < W ? (s + 1) : W; const float inv = 1.0f / (float)cnt;
        f32x4 lo, hi; pg8::unpack8(raw[q + W - 1], lo, hi);
        u32x4 ow; ow.x = pk2(sum[0] * inv - lo[0], sum[1] * inv - lo[1]); ow.y = pk2(sum[2] * inv - lo[2], sum[3] * inv - lo[3]);
        ow.z = pk2(sum[4] * inv - hi[0], sum[5] * inv - hi[1]); ow.w = pk2(sum[6] * inv - hi[2], sum[7] * inv - hi[3]);
        *(u32x4*)(MIX + (size_t)(t0 + q) * PW + oct * 8) = ow;
        if (q + 1 < 8) { f32x4 nl, nh, ol, oh; pg8::unpack8(raw[q + W], nl, nh); pg8::unpack8(raw[q], ol, oh);
#pragma unroll
            for (int j = 0; j < 4; ++j) { sum[j] += nl[j] - ol[j]; sum[4 + j] += nh[j] - oh[j]; } }
    }
}
__device__ __forceinline__ void poolmix_phase(Frame& F, const bf16_t* U, bf16_t* MIX) {
    const int gw = F.vcu * NWAVES + F.wave, NGW = F.G * NWAVES;
    constexpr int NRB = T / 64, NTASK = 4 * 3 * NRB;
    for (int task = gw; task < NTASK; task += NGW) { const int rb = task % NRB, ob = (task / NRB) % 3, gidx = task / (3 * NRB);
        if (gidx == 0) poolmix_task<2>(U, MIX, 0, ob, rb, F.lane); else if (gidx == 1) poolmix_task<4>(U, MIX, 1, ob, rb, F.lane);
        else if (gidx == 2) poolmix_task<8>(U, MIX, 2, ob, rb, F.lane); else poolmix_task<16>(U, MIX, 3, ob, rb, F.lane); }
}

constexpr int NBLK = T / 128;
struct MidArgs { const void* xin; bool xin_bf16; bf16_t* xout; const bf16_t* Y; const float* post_g; const float* pre2_g; const float* MODl; bf16_t* H; unsigned char* H8; };
__device__ __forceinline__ void router_phase_a(Frame& F, const MidArgs& M, const bf16_t* H, const bf16_t* RT, const float* rb, int* HIST, int* TOPE, int* TOPL, float* TOPG) {
    LAS float* lg = (LAS float*)(F.lds + F.wave * 4096);
    volatile LAS int* whist = (volatile LAS int*)(F.lds + 65536);
    const int fr = F.lane & 15, fq = F.lane >> 4;
    for (int blk = F.vcu; blk < NBLK; blk += F.G) {
        const int t0 = blk * 128 + F.wave * 16;
        rowpass_mid(F, t0, t0 + 16, RP, M.xin, M.xin_bf16, M.xout, M.Y, M.post_g, M.pre2_g, M.MODl, M.H, M.H8);
        asm volatile("s_waitcnt vmcnt(0)" ::: "memory");
        if (F.lane < NE) whist[F.wave * NE + F.lane] = 0;
        f32x4 a0 = {0.f, 0.f, 0.f, 0.f}, a1 = {0.f, 0.f, 0.f, 0.f};
        const bf16_t* hp = H + (size_t)(t0 + fr) * D + fq * 8; const bf16_t* w0 = RT + (size_t)fr * D + fq * 8; const bf16_t* w1 = RT + (size_t)(16 + fr) * D + fq * 8;
#pragma unroll 4
        for (int k = 0; k < D; k += 32) { const bf16x8 av = *(const bf16x8*)(hp + k), b0 = *(const bf16x8*)(w0 + k), b1 = *(const bf16x8*)(w1 + k);
            a0 = __builtin_amdgcn_mfma_f32_16x16x32_bf16(av, b0, a0, 0, 0, 0); a1 = __builtin_amdgcn_mfma_f32_16x16x32_bf16(av, b1, a1, 0, 0, 0); }
        const float rb0 = rb[fr], rb1 = rb[16 + fr];
#pragma unroll
        for (int j = 0; j < 4; ++j) { lg[(4 * fq + j) * 33 + fr] = a0[j] + rb0; lg[(4 * fq + j) * 33 + 16 + fr] = a1[j] + rb1; }
        LDS_WAIT(); asm volatile("" ::: "memory");
        float bv[4] = {-INFINITY, -INFINITY, -INFINITY, -INFINITY}; int bi[4] = {0, 0, 0, 0};
        if (F.lane < 16) {
            for (int e = 0; e < NE; ++e) { const float v = lg[F.lane * 33 + e];
                if (v > bv[3]) { bv[3] = v; bi[3] = e;
                    if (bv[3] > bv[2]) { float tv = bv[2]; bv[2] = bv[3]; bv[3] = tv; int ti = bi[2]; bi[2] = bi[3]; bi[3] = ti;
                        if (bv[2] > bv[1]) { tv = bv[1]; bv[1] = bv[2]; bv[2] = tv; ti = bi[1]; bi[1] = bi[2]; bi[2] = ti;
                            if (bv[1] > bv[0]) { tv = bv[0]; bv[0] = bv[1]; bv[1] = tv; ti = bi[0]; bi[0] = bi[1]; bi[1] = ti; } } } } }
        }
        float gt[4]; { float sum = 0.f;
#pragma unroll
            for (int k = 0; k < 4; ++k) { gt[k] = fast_exp(bv[k] - bv[0]); sum += gt[k]; }
            const float inv = 1.0f / sum;
#pragma unroll
            for (int k = 0; k < 4; ++k) gt[k] *= inv; }
        int rk[4];
#pragma unroll
        for (int k = 0; k < 4; ++k) {
            const int e = F.lane < 16 ? bi[k] : -1; int rank = 0;
            unsigned long long todo = __ballot(e >= 0);
            while (todo) { const int leader = __builtin_ctzll(todo); const int le = __shfl(e, leader); const unsigned long long mm = __ballot(e == le);
                const int base = whist[F.wave * NE + le];
                if (e == le) rank = base + __builtin_popcountll(mm & ((1ull << F.lane) - 1ull));
                if (F.lane == leader) whist[F.wave * NE + le] = base + __builtin_popcountll(mm);
                todo &= ~mm; }
            rk[k] = rank;
        }
        __syncthreads();
        if (F.tid < NE) { int run = 0;
#pragma unroll
            for (int w = 0; w < NWAVES; ++w) { const int v = whist[w * NE + F.tid]; whist[w * NE + F.tid] = run; run += v; }
            HIST[blk * NE + F.tid] = run; }
        __syncthreads();
        if (F.lane < 16) { const int t = t0 + F.lane;
#pragma unroll
            for (int k = 0; k < 4; ++k) { TOPE[t * TOPK + k] = bi[k]; TOPL[t * TOPK + k] = whist[F.wave * NE + bi[k]] + rk[k]; TOPG[t * TOPK + k] = gt[k]; } }
        __syncthreads();
    }
}
__device__ __forceinline__ void router_phase_b(Frame& F, const int* HIST, const int* TOPE, const int* TOPL, const float* TOPG, int* TOPS, int* ROWTOK, float* ROWGATE) {
    volatile LAS int* part = (volatile LAS int*)(F.lds + 65536);
    bool first = true;
    for (int blk = F.vcu; blk < NBLK; blk += F.G) {
        { const int e = F.tid & 31, pt = F.tid >> 5; int sacc = 0, stot = 0;
            for (int b = pt * 16; b < pt * 16 + 16; ++b) { const int hv = HIST[b * NE + e]; stot += hv; sacc += (b < blk) ? hv : 0; }
            part[pt * NE + e] = sacc; part[1024 + pt * NE + e] = stot; }
        __syncthreads();
        if (F.tid < NE) { int sacc = 0;
#pragma unroll
            for (int pt = 0; pt < 16; ++pt) sacc += part[pt * NE + F.tid];
            part[512 + F.tid] = sacc; }
        if (first && F.tid >= 64 && F.tid < 128) { const int e = F.lane; int c = 0;
            if (e < NE) {
#pragma unroll
                for (int pt = 0; pt < 16; ++pt) c += part[1024 + pt * NE + e]; }
            int tl = (c + 255) >> 8, pre = tl;
#pragma unroll
            for (int o = 1; o < 64; o <<= 1) { const int v = __shfl_up(pre, o); if (F.lane >= o) pre += v; }
            if (e < NE) { F.MISC[MISC_TB + e] = (unsigned)(pre - tl); F.MISC[MISC_CNT + e] = (unsigned)c; }
            if (e == NE - 1) F.MISC[MISC_TB + NE] = (unsigned)pre; }
        first = false;
        __syncthreads();
        { const int t = blk * 128 + (F.tid >> 2), k = F.tid & 3; const int e = TOPE[t * TOPK + k]; const int slot = part[512 + e] + TOPL[t * TOPK + k];
            TOPS[t * TOPK + k] = slot; ROWTOK[(size_t)e * T + slot] = t * TOPK + k; ROWGATE[(size_t)e * T + slot] = TOPG[t * TOPK + k]; }
        __syncthreads();
    }
}
__device__ __forceinline__ void moe_table(Frame& F, const int* HIST) {
    volatile LAS int* part = (volatile LAS int*)(F.MISC + 256);
    __syncthreads();
    { const int e = F.tid & 31, pt = F.tid >> 5; int sacc = 0;
        for (int b = pt * 16; b < pt * 16 + 16; ++b) sacc += HIST[b * NE + e];
        part[pt * NE + e] = sacc; }
    __syncthreads();
    if (F.tid < 64) { const int e = F.lane; int c = 0;
        if (e < NE) {
#pragma unroll
            for (int pt = 0; pt < 16; ++pt) c += part[pt * NE + e]; }
        int tl = (c + 255) >> 8, pre = tl;
#pragma unroll
        for (int o = 1; o < 64; o <<= 1) { const int v = __shfl_up(pre, o); if (F.lane >= o) pre += v; }
        if (e < NE) { F.MISC[MISC_TB + e] = (unsigned)(pre - tl); F.MISC[MISC_CNT + e] = (unsigned)c; }
        if (e == NE - 1) F.MISC[MISC_TB + NE] = (unsigned)pre; }
    __syncthreads();
}

constexpr int PH_PRO = 0, PH_PRE = 1, PH_L0 = 2, NPL = 10, NPHASES = PH_L0 + DEPTH * NPL;
__global__ void __launch_bounds__(NTHREADS, 2) fwd(Args args_unused) {
    extern __shared__ __attribute__((aligned(16))) unsigned char lds_raw[];
    const volatile __attribute__((address_space(4))) Args* ka = (const volatile __attribute__((address_space(4))) Args*)__builtin_amdgcn_kernarg_segment_ptr();
#define INP(i) ((const float*)ka->in[i])
#define WSB() ((unsigned char*)ka->ws)
#define OUTP() ((float*)ka->out)
    Frame F;
    F.lds = (LAS unsigned char*)lds_raw; F.MISC = (volatile LAS unsigned*)(F.lds + LDSCTL_OFF);
    F.wave = __builtin_amdgcn_readfirstlane((int)threadIdx.x >> 6); F.lane = lane_id_v(); F.tid = F.wave * 64 + F.lane;
    F.G = gridDim.x; { const int bx = blockIdx.x; F.vcu = (F.G % 8 == 0) ? (bx % 8) * (F.G / 8) + bx / 8 : bx; }
    F.ctl = (unsigned*)(WSB() + WS_CTL);
    for (int u = F.tid; u < (LDS_BYTES - LDSCTL_OFF) / 4; u += NTHREADS) ((LAS unsigned*)(F.lds + LDSCTL_OFF))[u] = 0u;
    __syncthreads();
    XcdBarrier bar = xcd_barrier_post(F.ctl + CW_BAR, F.MISC + MISC_BAR, F.tid == 0);
    const int lo = ka->ph_lo, hi = ka->ph_hi;
#define IN(k) (lo <= (k) && (k) < hi)
#define STAMP(k) do { if (TIMER_ON && blockIdx.x == 0 && F.wave == 0 && lane_id_v() == 0) ((unsigned long long*)(F.ctl + CW_TS))[(k)] = __builtin_amdgcn_s_memrealtime(); } while (0)
#ifndef PROF_BARRIER
#define PROF_BARRIER 0
#endif
#ifndef PROF_BTYPES
#define PROF_BTYPES 0xffff
#endif
#define PROF_BSEL(k) ((PROF_BTYPES >> ((k) < 2 ? (k) : 2 + ((k) - 2) % 10)) & 1)
#define PROF_ADD(dt) do { if (F.wave == 0 && lane_id_v() == 0) F.MISC[MISC_PROF] = F.MISC[MISC_PROF] + (unsigned)(dt); } while (0)
#define SEAM(k) do { const unsigned long long _tb0 = PROF_BARRIER ? __builtin_amdgcn_s_memrealtime() : 0ull; \
        if (IN(k) && (IN((k) + 1) || TIMER_ON || SPAN_HI >= 0)) xcd_barrier(bar, F.wave == 0 && lane_id_v() == 0); STAMP(k); \
        if (PROF_BARRIER && PROF_BSEL(k)) PROF_ADD(__builtin_amdgcn_s_memrealtime() - _tb0); \
        if (SPAN_HI >= 0 && (k) == SPAN_LO - 1) span_t0 = __builtin_amdgcn_s_memrealtime(); \
        if (SPAN_HI >= 0 && (k) == SPAN_HI) PROF_ADD(__builtin_amdgcn_s_memrealtime() - span_t0); } while (0)
#define PHASE_FRAME() Frame P = F; P.wave = launder_s(F.wave); P.lane = lane_id_v(); P.tid = P.wave * 64 + P.lane
    const int cb = (int)blockIdx.x;
    unsigned long long span_t0 = (SPAN_HI >= 0 && SPAN_LO == 0) ? __builtin_amdgcn_s_memrealtime() : 0ull;
    STAMP(63);

    if (IN(PH_PRO)) REPEAT(0) { __syncthreads(); unsigned char* ws = WSB(); { PHASE_FRAME(); mods_phase(P, INP(1), INP(2), INP(3), (float*)(ws + WS_MOD)); } { PHASE_FRAME(); convert_phase(P, ka); } }
    SEAM(PH_PRO);
    if (IN(PH_PRE)) REPEAT(1) { unsigned char* ws = WSB(); PHASE_FRAME(); rowpass_pre(P, INP(0), INP(4), (const float*)(ws + WS_MOD), (bf16_t*)(ws + WS_H)); }
    SEAM(PH_PRE);
    if ((REP_MASK >> 16) & 1) { for (int _i = 0; _i < 20; ++_i) xcd_barrier(bar, F.wave == 0 && lane_id_v() == 0); }

#pragma unroll 1
    for (int l = 0; l < DEPTH; ++l) {
        const int pb = PH_L0 + l * NPL;
        if (IN(pb + 0)) { unsigned char* ws = WSB(); unsigned char* wl = ws + WS_W + (size_t)l * WL_STRIDE; const bf16_t* WIN = (const bf16_t*)(wl + WO_WIN); bf16_t* H = (bf16_t*)(ws + WS_H);
            REPEAT(2) { pg8::Gemm g{H, WIN, D, D, D, nullptr}; pg8::StaticOrder S{T / 256, 13, launder_s(F.G), launder_s(cb), D, D, 0}; pg8::EpiIn E{(bf16_t*)(ws + WS_Q), (bf16_t*)(ws + WS_K), (bf16_t*)(ws + WS_U), (bf16_t*)(ws + WS_G)};
              pg8::gemm_phase<pg8::EpiIn, pg8::StaticOrder, 0>(F.lds, F.wave, g, S, E); }
            REPEAT(3) { pg8::Gemm g{WIN + (size_t)3328 * D, H, D, D, D, nullptr}; pg8::StaticOrder S{1, T / 256, launder_s(F.G), (launder_s(cb) + launder_s(F.G) / 2) % launder_s(F.G), D, D, 0}; pg8::EpiPlain E{(bf16_t*)(ws + WS_VT), VTP, 0, nullptr, nullptr};
              pg8::gemm_phase<pg8::EpiPlain, pg8::StaticOrder, 1>(F.lds, F.wave, g, S, E); }
        }
        SEAM(pb + 0);
        if (IN(pb + 1)) { unsigned char* ws = WSB();
            REPEAT(4) { PHASE_FRAME(); attn_phase(P, (const bf16_t*)(ws + WS_Q), (const bf16_t*)(ws + WS_K), (const bf16_t*)(ws + WS_VT), (bf16_t*)(ws + WS_AP)); }
            REPEAT(5) { PHASE_FRAME(); poolmix_phase(P, (const bf16_t*)(ws + WS_U), (bf16_t*)(ws + WS_MIX)); } }
        SEAM(pb + 1);
        if (IN(pb + 2)) { unsigned char* ws = WSB(); unsigned char* wl = ws + WS_W + (size_t)l * WL_STRIDE; bf16_t* AP = (bf16_t*)(ws + WS_AP);
            REPEAT(6) { pg8::Gemm g{AP, (const bf16_t*)(wl + WO_BRA), D, SBW, SBW, nullptr}; pg8::StaticOrder S{T / 256, 4, launder_s(F.G), launder_s(cb), D, SBW, 0}; pg8::EpiBranch<false> E{(bf16_t*)(ws + WS_Y), (const bf16_t*)(ws + WS_G), 0, nullptr};
              pg8::gemm_phase<pg8::EpiBranch<false>, pg8::StaticOrder, 2>(F.lds, F.wave, g, S, E); }
            REPEAT(7) { pg8::Gemm g{(const bf16_t*)(ws + WS_MIX), (const bf16_t*)(wl + WO_POOL), PW, PW, 384, nullptr}; pg8::StaticOrder S{T / 256, 3, launder_s(F.G), launder_s(cb), PW, PW, PGD};
              pg8::EpiPlain E{AP, D, SBW, INP(10) + (size_t)l * PW, INP(11) + (size_t)l * PW};
              pg8::gemm_phase<pg8::EpiPlain, pg8::StaticOrder, 3>(F.lds, F.wave, g, S, E); }
        }
        SEAM(pb + 2);
        if (IN(pb + 3)) for (int _rep = ((REP_MASK >> 15) & 1) ? 0 : 1; _rep < 2; ++_rep) { unsigned char* ws = WSB(); unsigned char* wl = ws + WS_W + (size_t)l * WL_STRIDE;
            pg8::Gemm g{(const bf16_t*)(ws + WS_AP) + SBW, (const bf16_t*)(wl + WO_BRP), D, PW, PW, nullptr}; pg8::StaticOrder S{T / 256, 4, launder_s(F.G), launder_s(cb), D, PW, 0}; pg8::EpiBranch<true> E{(bf16_t*)(ws + WS_Y), (const bf16_t*)(ws + WS_G), 4, (bf16_t*)(ws + WS_MRG)};
            pg8::gemm_phase<pg8::EpiBranch<true>, pg8::StaticOrder, 4>(F.lds, F.wave, g, S, E); }
        SEAM(pb + 3);
        if (IN(pb + 4)) REPEAT(8) { unsigned char* ws = WSB(); unsigned char* wl = ws + WS_W + (size_t)l * WL_STRIDE;
            pg8::Gemm g{(const bf16_t*)(ws + WS_MRG), (const bf16_t*)(wl + WO_OUT), D, D, D, nullptr}; pg8::StaticOrder S{T / 256, 4, launder_s(F.G), launder_s(cb), D, D, 0}; pg8::EpiPlain E{(bf16_t*)(ws + WS_Y), D, 0, nullptr, nullptr};
            pg8::gemm_phase<pg8::EpiPlain, pg8::StaticOrder, 5>(F.lds, F.wave, g, S, E); }
        SEAM(pb + 4);
        if (IN(pb + 5)) { unsigned char* ws = WSB(); unsigned char* wl = ws + WS_W + (size_t)l * WL_STRIDE; PHASE_FRAME();
            MidArgs M{l == 0 ? (const void*)INP(0) : (const void*)(ws + WS_XB), l != 0, (bf16_t*)(ws + WS_XB), (const bf16_t*)(ws + WS_Y), INP(5) + (size_t)l * D, INP(6) + (size_t)l * D, (const float*)(ws + WS_MOD) + (size_t)l * BATCH * 6 * D, (bf16_t*)(ws + WS_H), ws + WS_H8};
            router_phase_a(P, M, (const bf16_t*)(ws + WS_H), (const bf16_t*)(wl + WO_ROUTER), INP(16) + (size_t)l * NE, (int*)(ws + WS_HIST) + (size_t)l * NBLK * NE, (int*)(ws + WS_TOPE), (int*)(ws + WS_TOPL), (float*)(ws + WS_TOPG)); }
        SEAM(pb + 5);
        if (IN(pb + 6)) REPEAT(13) { unsigned char* ws = WSB(); PHASE_FRAME();
            router_phase_b(P, (const int*)(ws + WS_HIST) + (size_t)l * NBLK * NE, (const int*)(ws + WS_TOPE), (const int*)(ws + WS_TOPL), (const float*)(ws + WS_TOPG), (int*)(ws + WS_TOPS), (int*)(ws + WS_ROWTOK), (float*)(ws + WS_ROWGATE)); }
        SEAM(pb + 6);
        if (IN(pb + 7)) REPEAT(10) { unsigned char* ws = WSB(); unsigned char* wl = ws + WS_W + (size_t)l * WL_STRIDE; if (N_LAUNCHES != 1 || F.G > NBLK) { PHASE_FRAME(); moe_table(P, (const int*)(ws + WS_HIST) + (size_t)l * NBLK * NE); }
            pg8::Gemm g{(const bf16_t*)(ws + WS_H8), (const bf16_t*)(wl + WO_GU), D, D, D, (const int*)(ws + WS_ROWTOK)};
            pg8::MoeOrder S{(const volatile LAS int*)(F.MISC + MISC_TB), (const volatile LAS int*)(F.MISC + MISC_CNT), 8, launder_s(F.G), launder_s(cb), 2 * D};
            pg8::EpiGU E{ws + WS_ACT, INP(18) + (size_t)l * NE * 2 * D};
            pg8::gemm_phase<pg8::EpiGU, pg8::MoeOrder, 6>(F.lds, F.wave, g, S, E); }
        SEAM(pb + 7);
        if (IN(pb + 8)) REPEAT(11) { unsigned char* ws = WSB(); unsigned char* wl = ws + WS_W + (size_t)l * WL_STRIDE; if (N_LAUNCHES != 1 || F.G > NBLK) { PHASE_FRAME(); moe_table(P, (const int*)(ws + WS_HIST) + (size_t)l * NBLK * NE); }
            pg8::Gemm g{(const bf16_t*)(ws + WS_ACT), (const bf16_t*)(wl + WO_DN), D, D, D, nullptr};
            pg8::MoeOrder S{(const volatile LAS int*)(F.MISC + MISC_TB), (const volatile LAS int*)(F.MISC + MISC_CNT), 4, launder_s(F.G), launder_s(cb), D};
            pg8::EpiDN E{(bf16_t*)(ws + WS_YR), INP(20) + (size_t)l * NE * D, (const float*)(ws + WS_ROWGATE), (const int*)(ws + WS_ROWTOK)};
            pg8::gemm_phase<pg8::EpiDN, pg8::MoeOrder, 7>(F.lds, F.wave, g, S, E); }
        SEAM(pb + 8);
        if (IN(pb + 9)) for (int _rep = ((REP_MASK >> 14) & 1) ? 0 : 1; _rep < 2; ++_rep) { unsigned char* ws = WSB(); PHASE_FRAME();
            const bool hn = (l + 1 < DEPTH); const float* MOD = (const float*)(ws + WS_MOD);
            rowpass_comb(P, (const bf16_t*)(ws + WS_XB), _rep == 0 ? (void*)(ws + WS_ACT) : (hn ? (void*)(ws + WS_XB) : (void*)OUTP()), hn, (const bf16_t*)(ws + WS_YR), INP(7) + (size_t)l * D, MOD + (size_t)l * BATCH * 6 * D,
                         hn, INP(4) + (size_t)(hn ? l + 1 : l) * D, MOD + (size_t)(hn ? l + 1 : l) * BATCH * 6 * D, (bf16_t*)(ws + WS_H)); }
        SEAM(pb + 9);
    }
    if ((PROF_REGION != 0) || PROF_BARRIER || SPAN_HI >= 0) { if (F.wave == 0) { const unsigned long long dt = F.MISC[MISC_PROF], t0 = __builtin_amdgcn_s_memrealtime(); while (__builtin_amdgcn_s_memrealtime() - t0 < dt) __builtin_amdgcn_s_sleep(8); } }
#if TIMER_ON
    { xcd_barrier(bar, F.wave == 0 && lane_id_v() == 0);
      const unsigned long long* ts = (const unsigned long long*)(F.ctl + CW_TS);
      const float us1 = (float)(long long)(ts[TIMER_B1] - ts[TIMER_A1]) * 0.01f, us2 = (float)(long long)(ts[TIMER_B2] - ts[TIMER_A2]) * 0.01f;
      const float a = sqrtf(us1 * 1e-4f); float* o = OUTP(); const int lane = lane_id_v(), gtid = ((int)blockIdx.x * NWAVES + F.wave) * 64 + lane;
      for (size_t i = (size_t)gtid; i < (size_t)T * D; i += (size_t)F.G * NTHREADS) o[i] += (i & 1) ? a : -a;
      xcd_barrier(bar, F.wave == 0 && lane_id_v() == 0);
      if (blockIdx.x == 0 && F.wave == 0 && lane == 0) o[5] += us2 * 0.2f; }
#endif
#undef IN
#undef SEAM
}

extern "C" void kernel_launch(void* const* d_in, const int* in_sizes, int n_in, void* d_out, int out_size, void* d_ws, size_t ws_size, hipStream_t stream) {
    static int grid = 0;
    if (grid == 0) {
        if (n_in != 21 || in_sizes[0] != T * D || out_size != T * D || ws_size < WS_END) { fprintf(stderr, "kernel_launch: unexpected shapes (n_in %d, in0 %d, out %d, ws %zu < %zu); nothing launched\n", n_in, n_in > 0 ? in_sizes[0] : -1, out_size, ws_size, (size_t)WS_END); grid = -1; return; }
        int dev = 0, cus = 0, per_cu = 0;
        if (hipGetDevice(&dev) != hipSuccess || hipDeviceGetAttribute(&cus, hipDeviceAttributeMultiprocessorCount, dev) != hipSuccess) { grid = -1; return; }
        if (hipFuncSetAttribute((const void*)fwd, hipFuncAttributeMaxDynamicSharedMemorySize, LDS_BYTES) != hipSuccess) { fprintf(stderr, "kernel_launch: hipFuncSetAttribute failed\n"); grid = -1; return; }
        if (hipOccupancyMaxActiveBlocksPerMultiprocessor(&per_cu, (const void*)fwd, NTHREADS, LDS_BYTES) != hipSuccess || per_cu < 1) { fprintf(stderr, "kernel_launch: occupancy query says %d\n", per_cu); }
        (void)hipGetLastError();
        grid = cus;
    }
    if (grid < 0) return;
    if (hipMemsetAsync((char*)d_ws + WS_CTL, 0, CTL_ZERO_BYTES, stream) != hipSuccess) return;
    Args a{};
    for (int i = 0; i < 21; ++i) a.in[i] = (const float*)d_in[i];
    a.out = (float*)d_out; a.ws = (unsigned char*)d_ws;
#if N_LAUNCHES == 1
    a.ph_lo = 0; a.ph_hi = NPHASES;
    hipLaunchKernelGGL(fwd, dim3(grid), dim3(NTHREADS), LDS_BYTES, stream, a);
#else
    for (int p = 0; p < NPHASES; ++p) { a.ph_lo = p; a.ph_hi = p + 1; hipLaunchKernelGGL(fwd, dim3(grid), dim3(NTHREADS), LDS_BYTES, stream, a); }
#endif
}
```

```cpp
#include <hip/hip_runtime.h>
#include <cstdio>
#include <cstdint>

#ifndef N_LAUNCHES
#define N_LAUNCHES 1
#endif
#ifndef REP_MASK
#define REP_MASK 0
#endif
#ifndef REP_BAR
#define REP_BAR 0
#endif
#define REPEAT(b) _Pragma("unroll 1") for (int _rep = 0; _rep < (((REP_MASK >> (b)) & 1) ? 2 : 1); ((REP_BAR && ((REP_MASK >> (b)) & 1)) ? xcd_barrier(bar, F.wave == 0 && lane_id_v() == 0) : (void)0), ++_rep)
#ifndef TIMER_ON
#define TIMER_ON 0
#endif
#ifndef TIMER_A1
#define TIMER_A1 63
#define TIMER_B1 0
#define TIMER_A2 63
#define TIMER_B2 1
#endif
constexpr int CW_TS = 12288;
#ifndef SPAN_LO
#define SPAN_LO -1
#define SPAN_HI -1
#endif
#ifndef PROF_REGION
#define PROF_REGION 0
#define PROF_SITES 0
#endif
#ifndef FAST_MASK
#define FAST_MASK 0xff
#endif

#define LAS __attribute__((address_space(3)))
#define GAS __attribute__((address_space(1)))
typedef unsigned short bf16_t;
typedef short bf16x8 __attribute__((ext_vector_type(8)));
typedef short s16x4 __attribute__((ext_vector_type(4)));
typedef float f32x4 __attribute__((ext_vector_type(4)));
typedef float f32x2 __attribute__((ext_vector_type(2)));
typedef float f32x16 __attribute__((ext_vector_type(16)));
typedef unsigned u32x4 __attribute__((ext_vector_type(4)));
typedef unsigned u32x2 __attribute__((ext_vector_type(2)));

constexpr int D = 1024, BATCH = 2, SEQ = 16384, T = BATCH * SEQ, DEPTH = 2;
constexpr int SBW = 256, NH = 4, HD = 64, PW = 768, PGD = 192, INW = 3584;
constexpr int NE = 32, TOPK = 4;
constexpr float NORM_EPS = 1e-6f, SW_LIMIT = 7.0f, SW_ALPHA = 1.702f;
constexpr float STICK_EXIT = -24.0f;
constexpr int NWAVES = 8, NTHREADS = 512;
constexpr int MAXTILES = (T * TOPK) / 256 + NE;

constexpr size_t MiB = 1u << 20;
constexpr size_t WS_CTL = 0, CTL_ZERO_BYTES = 65536;
constexpr size_t WS_MOD = 1 * MiB;
constexpr size_t WS_W = 2 * MiB, WL_STRIDE = 205 * MiB;
constexpr size_t WO_WIN = 0, WO_BRA = 7 * MiB, WO_BRP = 7 * MiB + MiB / 2, WO_OUT = 9 * MiB, WO_POOL = 11 * MiB, WO_ROUTER = 12 * MiB + MiB / 2, WO_GU = 13 * MiB, WO_DN = 141 * MiB;
constexpr size_t WS_H = 416 * MiB, WS_Q = 480 * MiB, WS_K = 496 * MiB, WS_U = 528 * MiB, WS_G = 576 * MiB;
constexpr int VTP = T + 64;
constexpr size_t WS_AP = 704 * MiB, WS_MIX = 768 * MiB, WS_MRG = 816 * MiB, WS_Y = 880 * MiB;
constexpr size_t WS_TOPE = 944 * MiB, WS_TOPS = 944 * MiB + MiB / 2, WS_TOPL = 945 * MiB, WS_TOPG = 945 * MiB + MiB / 2, WS_ROWTOK = 946 * MiB, WS_ROWGATE = 950 * MiB;
constexpr size_t WS_HIST = 954 * MiB;
constexpr size_t WS_ACT = 960 * MiB, WS_YR = 1232 * MiB, WS_H8 = 1504 * MiB, WS_XB = 1536 * MiB, WS_VT = 1600 * MiB  , WS_END = 1620 * MiB;
static_assert(WO_DN + (size_t)NE * D * D * 2 <= WL_STRIDE && WS_W + DEPTH * WL_STRIDE <= WS_H, "weights map");
static_assert(WS_ACT + (size_t)MAXTILES * 256 * D * 2 <= WS_YR && WS_YR + (size_t)MAXTILES * 256 * D * 2 <= WS_END, "act map");
constexpr int CW_BAR = 4096, CW_CNT = 8192;

constexpr int RING_BYTES = 131072, LDSCTL_OFF = RING_BYTES, LDS_BYTES = 147456;
constexpr int META_OFF = LDSCTL_OFF + 4096, META_BYTES = 4096;
constexpr int MISC_BAR = 8;
constexpr int MISC_TB = 64, MISC_CNT = 128, MISC_PROF = 200;

__device__ __forceinline__ unsigned f2bf(float f) { unsigned u = __builtin_bit_cast(unsigned, f); return (u + 0x7fffu + ((u >> 16) & 1u)) >> 16; }
__device__ __forceinline__ unsigned pk2(float lo, float hi) { return f2bf(lo) | (f2bf(hi) << 16); }
__device__ __forceinline__ float bf_lo(unsigned w) { return __builtin_bit_cast(float, w << 16); }
__device__ __forceinline__ float bf_hi(unsigned w) { return __builtin_bit_cast(float, w & 0xffff0000u); }
__device__ __forceinline__ unsigned pk4_fp8(float a, float b, float c, float d) { int w = 0; w = __builtin_amdgcn_cvt_pk_fp8_f32(a, b, w, false); w = __builtin_amdgcn_cvt_pk_fp8_f32(c, d, w, true); return (unsigned)w; }
constexpr float W8_SCALE = 32.0f, W8_INV = 1.0f / 32.0f;
__device__ __forceinline__ float fast_exp(float x) { return __builtin_amdgcn_exp2f(x * 1.4426950408889634f); }
__device__ __forceinline__ float fast_sigmoid(float x) { return __builtin_amdgcn_rcpf(1.0f + fast_exp(-x)); }
__device__ __forceinline__ float softplus_f(float z) { return fmaxf(z, 0.f) + 0.6931471805599453f * __builtin_amdgcn_logf(1.0f + fast_exp(-fabsf(z))); }
__device__ __forceinline__ float wave_sum(float v) {
#pragma unroll
    for (int o = 1; o < 64; o <<= 1) v += __shfl_xor(v, o);
    return v;
}
__device__ __forceinline__ int launder_v(int x) { asm volatile("" : "+v"(x)); return x; }
__device__ __forceinline__ int launder_s(int x) { asm volatile("" : "+s"(x)); return x; }
__device__ __forceinline__ int lane_id_v() { int x; asm volatile("v_mbcnt_lo_u32_b32 %0, -1, 0\n\tv_mbcnt_hi_u32_b32 %0, -1, %0" : "=v"(x)); return x; }
#define LDS_WAIT() asm volatile("s_waitcnt lgkmcnt(0)" ::: "memory")
#define VM_WAIT() asm volatile("s_waitcnt vmcnt(0)" ::: "memory")

#define XB_TMO      128
#define XB_XCNT(j)  (256  + 64 * (j))
#define XB_XSUB(j)  (1280 + 64 * (j))
#define XB_XGEN(j)  (2304 + 64 * (j))
#define XB_TOP      3328
#define XB_TOPGEN   3392
#define XCD_BAR_WORDS 3456
#define XB_SPIN_CAP (1u << 18)
__device__ __forceinline__ unsigned xb_ld(unsigned* p)              { return __hip_atomic_load(p, __ATOMIC_RELAXED, __HIP_MEMORY_SCOPE_AGENT); }
__device__ __forceinline__ unsigned xb_add(unsigned* p, unsigned v) { return __hip_atomic_fetch_add(p, v, __ATOMIC_RELAXED, __HIP_MEMORY_SCOPE_AGENT); }
__device__ __forceinline__ unsigned xb_xcc_id() { return (unsigned)__builtin_amdgcn_s_getreg((3 << 11) | 20) & 0xFu; }
#define XB_SPIN(cond, bar) do { unsigned _sp = 0; while (cond) { __builtin_amdgcn_s_sleep(1); \
    if ((++_sp & 255u) == 0u) { if (xb_ld(&(bar)[XB_TMO])) break; if (_sp > XB_SPIN_CAP) { atomicAdd(&(bar)[XB_TMO], 1u); break; } } } } while (0)
struct XcdBarrier { unsigned* bar; unsigned x; volatile LAS unsigned* st; };
__device__ __forceinline__ XcdBarrier xcd_barrier_post(unsigned* bar, volatile LAS unsigned* st, bool t0) {
    XcdBarrier b; b.bar = bar; b.x = xb_xcc_id(); b.st = st;
    if (t0) (void)xb_add(&bar[XB_XCNT(b.x)], 1u);
    return b;
}
__device__ __forceinline__ void xcd_barrier_complete(unsigned* bar, unsigned x, unsigned& nloc, unsigned& nx) {
    const unsigned G = gridDim.x * gridDim.y * gridDim.z;
    unsigned sum, cnt, mine, sp = 0u;
    for (;;) {
        sum = 0u; cnt = 0u; mine = 0u;
#pragma unroll
        for (unsigned j = 0; j < 16; ++j) { const unsigned c = xb_ld(&bar[XB_XCNT(j)]); sum += c; cnt += (c > 0u) ? 1u : 0u; mine = (j == x) ? c : mine; }
        if (sum == G) break;
        __builtin_amdgcn_s_sleep(1);
        if ((++sp & 255u) == 0u) { if (xb_ld(&bar[XB_TMO])) break; if (sp > XB_SPIN_CAP) { atomicAdd(&bar[XB_TMO], 1u); break; } }
    }
    nloc = mine > 0u ? mine : 1u; nx = cnt > 0u ? cnt : 1u;
}
__device__ __forceinline__ void xcd_barrier(const XcdBarrier& b, bool t0) {
    asm volatile("s_waitcnt vmcnt(0)" ::: "memory");
    __syncthreads();
    if (t0) {
        unsigned* bar = b.bar;
        __builtin_amdgcn_s_waitcnt(0);
        unsigned nloc = b.st[0], nx = b.st[1];
        if (nloc == 0u) { xcd_barrier_complete(bar, b.x, nloc, nx); b.st[0] = nloc; b.st[1] = nx; }
        const unsigned old = xb_add(&bar[XB_XSUB(b.x)], 1u);
        const unsigned gen = old / nloc;
        if (old + 1u == (gen + 1u) * nloc) {
            __builtin_amdgcn_fence(__ATOMIC_RELEASE, "agent");
            asm volatile("s_waitcnt vmcnt(0)" ::: "memory");
            const unsigned og = xb_add(&bar[XB_TOP], 1u);
            const unsigned tg = og / nx;
            if (og + 1u == (tg + 1u) * nx) xb_add(&bar[XB_TOPGEN], 1u);
            else XB_SPIN(xb_ld(&bar[XB_TOPGEN]) == tg, bar);
            __builtin_amdgcn_fence(__ATOMIC_ACQUIRE, "agent");
            xb_add(&bar[XB_XGEN(b.x)], 1u);
            asm volatile("s_waitcnt vmcnt(0)" ::: "memory");
        } else {
            XB_SPIN(xb_ld(&bar[XB_XGEN(b.x)]) == gen, bar);
            __builtin_amdgcn_fence(__ATOMIC_ACQUIRE, "agent");
            asm volatile("s_waitcnt vmcnt(0)" ::: "memory");
        }
    }
    __syncthreads();
}

namespace pg8 {
constexpr int BM = 256, BK = 64, HALF = 128, HTB = HALF * BK * 2, STAGE_BYTES = 8 * HTB, NXCD = 8, WGM = 8;
__host__ __device__ __forceinline__ int lds_byte(int r, int c) { const int st = (r >> 4) * 2 + (c >> 5), rr = r & 15, cc = c & 31, ob = rr * 64 + cc * 2; return st * 1024 + (ob ^ (((ob >> 9) & 1) << 5)); }
__host__ __device__ __forceinline__ void stage_rc(int b, int& R, int& C) { const int st = b / 1024, sb = b % 1024, swz = sb ^ (((sb >> 9) & 1) << 5); R = (st >> 1) * 16 + swz / 64; C = (st & 1) * 32 + (swz % 64) / 2; }
__host__ __device__ __forceinline__ int perm32(int rho) { const int n = rho >> 4, i = rho & 15; return 8 * (i >> 2) + 4 * n + (i & 3); }

struct Unit { int pm, pn, e, nvalid, slot0; unsigned aoff, boff; };
struct Gemm { const bf16_t* A; const bf16_t* Bt; int lda, ldb, K; const int* gather; };

__device__ __forceinline__ bool order_unit(int i, int G, int c, int nM, int nN, int& pm, int& pn) {
    const int nwg = nM * nN; const long L = (long)i * G + c; if (L >= nwg) return false;
    int wgid = (int)L; { const int q = nwg / NXCD, r = nwg % NXCD, xcd = wgid % NXCD, off = wgid / NXCD; wgid = (xcd < r ? xcd * (q + 1) : r * (q + 1) + (xcd - r) * q) + off; }
    const int nig = WGM * nN, gid = wgid / nig, fm = gid * WGM, gsz = (nM - fm) < WGM ? (nM - fm) : WGM;
    pm = fm + ((wgid % nig) % gsz); pn = (wgid % nig) / gsz; return true;
}
struct StaticOrder {
    int nM, nN, G, c, lda, ldb, kstride;
    __device__ __forceinline__ bool next(int i, Unit& u) const {
        if (!order_unit(i, G, c, nM, nN, u.pm, u.pn)) return false;
        u.e = 0; u.nvalid = 256; u.slot0 = 0;
        u.aoff = (unsigned)(u.pm * BM) * (unsigned)lda + (unsigned)(kstride * u.pn); u.boff = (unsigned)(u.pn * BM) * (unsigned)ldb + (unsigned)(kstride * u.pn); return true;
    }
};
struct MoeOrder {
    const volatile LAS int* tb; const volatile LAS int* cnt; int nN, G, c, nw;
    __device__ __forceinline__ bool next(int i, Unit& u) const {
        const int nM = tb[NE];
        if (!order_unit(i, G, c, nM, nN, u.pm, u.pn)) return false;
        int e = u.e < 0 ? 0 : (u.e > NE - 1 ? NE - 1 : u.e);
#pragma unroll 1
        while (e < NE - 1 && tb[e + 1] <= u.pm) ++e;
#pragma unroll 1
        while (e > 0 && tb[e] > u.pm) --e;
        u.e = e; u.slot0 = (u.pm - tb[e]) * BM; const int left = cnt[e] - u.slot0; u.nvalid = left < BM ? left : BM;
        u.aoff = (unsigned)(u.pm * BM) * (unsigned)D; u.boff = ((unsigned)e * (unsigned)nw + (unsigned)(u.pn * BM)) * (unsigned)D; return true;
    }
};

__device__ __forceinline__ unsigned cvt_pk_bf16(float lo, float hi) { unsigned r; asm volatile("v_cvt_pk_bf16_f32 %0, %1, %2" : "=v"(r) : "v"(lo), "v"(hi)); return r; }
__device__ __forceinline__ u32x4 pack8(const f32x4 a, const f32x4 b) { u32x4 w; w.x = cvt_pk_bf16(a[0], a[1]); w.y = cvt_pk_bf16(a[2], a[3]); w.z = cvt_pk_bf16(b[0], b[1]); w.w = cvt_pk_bf16(b[2], b[3]); return w; }
__device__ __forceinline__ void unpack8(const u32x4 w, f32x4& a, f32x4& b) { a = (f32x4){bf_lo(w.x), bf_hi(w.x), bf_lo(w.y), bf_hi(w.y)}; b = (f32x4){bf_lo(w.z), bf_hi(w.z), bf_lo(w.w), bf_hi(w.w)}; }

__device__ __forceinline__ f32x2 lo2(const f32x4 v) { return __builtin_shufflevector(v, v, 0, 1); }
__device__ __forceinline__ f32x2 hi2(const f32x4 v) { return __builtin_shufflevector(v, v, 2, 3); }
__device__ __forceinline__ f32x4 cat2(const f32x2 a, const f32x2 b) { return __builtin_shufflevector(a, b, 0, 1, 2, 3); }
__device__ __forceinline__ f32x2 pk_sigmoid(const f32x2 x) {
    const f32x2 t = x * (-1.4426950408889634f); f32x2 e; e.x = __builtin_amdgcn_exp2f(t.x); e.y = __builtin_amdgcn_exp2f(t.y);
    const f32x2 d = e + 1.0f; f32x2 r; r.x = __builtin_amdgcn_rcpf(d.x); r.y = __builtin_amdgcn_rcpf(d.y); return r; }
__device__ __forceinline__ f32x4 pk_sigmoid4(const f32x4 v) { return cat2(pk_sigmoid(lo2(v)), pk_sigmoid(hi2(v))); }
__device__ __forceinline__ f32x2 pk_fma2(const f32x2 a, const f32x2 b, const f32x2 c) { return __builtin_elementwise_fma(a, b, c); }
__device__ __forceinline__ f32x2 swiglu2(f32x2 g, f32x2 u) {
    g.x = fminf(g.x, SW_LIMIT); g.y = fminf(g.y, SW_LIMIT); u.x = fminf(fmaxf(u.x, -SW_LIMIT), SW_LIMIT); u.y = fminf(fmaxf(u.y, -SW_LIMIT), SW_LIMIT);
    const f32x2 t = g * (-SW_ALPHA * 1.4426950408889634f); f32x2 e; e.x = __builtin_amdgcn_exp2f(t.x); e.y = __builtin_amdgcn_exp2f(t.y);
    const f32x2 d = e + 1.0f; f32x2 r; r.x = __builtin_amdgcn_rcpf(d.x); r.y = __builtin_amdgcn_rcpf(d.y);
    return pk_fma2(u, g, g) * r; }
#define EPI_LOOP_ROWS for (int ai = 0; ai < 2; ++ai) _Pragma("unroll") for (int m = 0; m < 4; ++m)
__device__ __forceinline__ size_t frag_off(int tile, int ai, int m, int bj, int wr, int wc, int fr, int fq) {
    const int piece = (ai * 4 + m) * 2 + bj, thr = (wr * 4 + wc) * 64 + fq * 16 + fr; return (((size_t)tile * 16 + piece) * 512 + thr) * 8; }
__device__ __forceinline__ void* probe_scratch_ptr() { const volatile __attribute__((address_space(4))) void* const* ka = (const volatile __attribute__((address_space(4))) void* const*)__builtin_amdgcn_kernarg_segment_ptr(); return (unsigned char*)ka[22] + ((size_t)1536 << 20); }
struct EpiIn {
    static constexpr bool PERM = true; static constexpr int ES = 2, SITE_ID = 0;
    bf16_t *Q, *KB, *U, *G;
    __device__ __forceinline__ void operator()(const f32x4 (&acc)[2][2][4][2], const Unit& u, int wr, int wc, int fr, int fq) const {
        const int pn = u.pn; bf16_t* base; int ld, c0, mode;
        if (pn == 0) { base = Q; ld = SBW; c0 = 0; mode = 1; } else if (pn == 1) { base = KB; ld = SBW; c0 = 0; mode = 0; }
        else if (pn < 5) { base = U; ld = PW; c0 = (pn - 2) * BM; mode = 0; } else { base = G; ld = 2 * D; c0 = (pn - 5) * BM; mode = 2; }
        const int row0 = u.pm * BM + wr * 64 + fr, col0 = c0 + wc * 32 + 8 * fq;
#pragma unroll
        EPI_LOOP_ROWS { bf16_t* rowp = base + (size_t)(row0 + ai * HALF + m * 16) * ld + col0;
#pragma unroll
            for (int bj = 0; bj < 2; ++bj) { f32x4 v0 = acc[ai][bj][m][0], v1 = acc[ai][bj][m][1];
                if (mode == 1) { v0 = v0 * 0.125f; v1 = v1 * 0.125f; }
                if (mode == 2) { v0 = pk_sigmoid4(v0); v1 = pk_sigmoid4(v1); __builtin_nontemporal_store(pack8(v0, v1), (u32x4*)(G + frag_off(u.pm * 8 + (pn - 5), ai, m, bj, wr, wc, fr, fq))); }
                else *(u32x4*)(rowp + bj * HALF) = pack8(v0, v1); } }
    }
};
struct EpiPlain {
    static constexpr bool PERM = true; static constexpr int ES = 2, SITE_ID = 1;
    bf16_t* O; int ldc, coff; const float* bias; const float* scale;
    __device__ __forceinline__ void operator()(const f32x4 (&acc)[2][2][4][2], const Unit& u, int wr, int wc, int fr, int fq) const {
        const int row0 = u.pm * BM + wr * 64 + fr, col0 = u.pn * BM + wc * 32 + 8 * fq;
        f32x4 bv[2][2], sv[2][2];
#pragma unroll
        for (int bj = 0; bj < 2; ++bj)
#pragma unroll
            for (int n = 0; n < 2; ++n) { bv[bj][n] = bias ? *(const f32x4*)(bias + col0 + bj * HALF + 4 * n) : (f32x4){0.f, 0.f, 0.f, 0.f};
                                          sv[bj][n] = scale ? *(const f32x4*)(scale + col0 + bj * HALF + 4 * n) : (f32x4){1.f, 1.f, 1.f, 1.f}; }
#pragma unroll
        EPI_LOOP_ROWS { bf16_t* rowp = O + (size_t)(row0 + ai * HALF + m * 16) * ldc + coff + col0;
#pragma unroll
            for (int bj = 0; bj < 2; ++bj) *(u32x4*)(rowp + bj * HALF) = pack8((acc[ai][bj][m][0] + bv[bj][0]) * sv[bj][0], (acc[ai][bj][m][1] + bv[bj][1]) * sv[bj][1]); }
    }
};
template <bool ADD> struct EpiBranch {
    static constexpr bool PERM = true; static constexpr int ES = 2, SITE_ID = 2;
    bf16_t* PART; const bf16_t* G; int gtile0; bf16_t* MRGout;
    __device__ __forceinline__ void operator()(const f32x4 (&acc)[2][2][4][2], const Unit& u, int wr, int wc, int fr, int fq) const {
        const int row0 = u.pm * BM + wr * 64 + fr, col0 = u.pn * BM + wc * 32 + 8 * fq;
        const int gt = u.pm * 8 + gtile0 + u.pn, ptile = u.pm * 4 + u.pn;
#pragma unroll
        for (int ai = 0; ai < 2; ++ai) {
            u32x4 gq[4][2], pq[4][2];
#pragma unroll
            for (int m = 0; m < 4; ++m)
#pragma unroll
                for (int bj = 0; bj < 2; ++bj) { gq[m][bj] = __builtin_nontemporal_load((const u32x4*)(G + frag_off(gt, ai, m, bj, wr, wc, fr, fq))); if (ADD) pq[m][bj] = __builtin_nontemporal_load((const u32x4*)(PART + frag_off(ptile, ai, m, bj, wr, wc, fr, fq))); }
#pragma unroll
            for (int m = 0; m < 4; ++m)
#pragma unroll
                for (int bj = 0; bj < 2; ++bj) { const size_t r = (size_t)(row0 + ai * HALF + m * 16); const int c = col0 + bj * HALF;
                    f32x4 g0, g1; unpack8(gq[m][bj], g0, g1);
                    f32x4 v0 = g0 * acc[ai][bj][m][0], v1 = g1 * acc[ai][bj][m][1];
                    if (ADD) { f32x4 p0, p1; unpack8(pq[m][bj], p0, p1); v0 = v0 + p0; v1 = v1 + p1; *(u32x4*)(MRGout + r * D + c) = pack8(v0, v1); }
                    else *(u32x4*)(PART + frag_off(ptile, ai, m, bj, wr, wc, fr, fq)) = pack8(v0, v1); } }
    }
};
struct EpiGU {
    static constexpr bool PERM = true, HAS_PRE = true; static constexpr int ES = 1, SITE_ID = 6;
    unsigned char* ACT8; const float* bgu;
    __device__ __forceinline__ void prefetch(LAS unsigned char* meta, const Unit& u, int wid, int lane) const {
        if (wid == 2 || wid == 3) { const float* src = bgu + (size_t)u.e * (2 * D) + (wid == 3 ? D : 0) + u.pn * HALF + 4 * (lane & 31);
            __builtin_amdgcn_global_load_lds((const unsigned*)src, (LAS unsigned*)(meta + wid * 1024), 16, 0, 0); } }
    __device__ __forceinline__ void epi_lds(const f32x4 (&acc)[2][2][4][2], const Unit& u, int wr, int wc, int fr, int fq, const LAS unsigned char* meta) const {
        const int row0 = u.pm * BM + wr * 64 + fr, col0 = u.pn * HALF + wc * 32 + 8 * fq;
        float w8s = W8_INV; asm volatile("" : "+v"(w8s));
        f32x4 bgv[2], buv[2];
#pragma unroll
        for (int n = 0; n < 2; ++n) { bgv[n] = *(const LAS f32x4*)(meta + 2048 + (wc * 32 + 8 * fq + 4 * n) * 4); buv[n] = *(const LAS f32x4*)(meta + 3072 + (wc * 32 + 8 * fq + 4 * n) * 4); }
#pragma unroll
        EPI_LOOP_ROWS { f32x4 o[2];
#pragma unroll
            for (int n = 0; n < 2; ++n) { const f32x2 w8 = {w8s, w8s};
                o[n] = cat2(swiglu2(pk_fma2(lo2(acc[ai][0][m][n]), w8, lo2(bgv[n])), pk_fma2(lo2(acc[ai][1][m][n]), w8, lo2(buv[n]))),
                            swiglu2(pk_fma2(hi2(acc[ai][0][m][n]), w8, hi2(bgv[n])), pk_fma2(hi2(acc[ai][1][m][n]), w8, hi2(buv[n])))); }
            u32x2 w; w.x = pk4_fp8(o[0][0], o[0][1], o[0][2], o[0][3]); w.y = pk4_fp8(o[1][0], o[1][1], o[1][2], o[1][3]);
            *(u32x2*)(ACT8 + (size_t)(row0 + ai * HALF + m * 16) * D + col0) = w; }
    }
    __device__ __forceinline__ void operator()(const f32x4 (&acc)[2][2][4][2], const Unit& u, int wr, int wc, int fr, int fq) const {
        const int row0 = u.pm * BM + wr * 64 + fr, col0 = u.pn * HALF + wc * 32 + 8 * fq;
        float w8s = W8_INV; asm volatile("" : "+v"(w8s));
        const float* bg = bgu + (size_t)u.e * (2 * D) + col0;
        f32x4 bgv[2], buv[2];
#pragma unroll
        for (int n = 0; n < 2; ++n) { bgv[n] = *(const f32x4*)(bg + 4 * n); buv[n] = *(const f32x4*)(bg + D + 4 * n); }
#pragma unroll
        EPI_LOOP_ROWS { f32x4 o[2];
#pragma unroll
            for (int n = 0; n < 2; ++n) { const f32x2 w8 = {w8s, w8s};
                o[n] = cat2(swiglu2(pk_fma2(lo2(acc[ai][0][m][n]), w8, lo2(bgv[n])), pk_fma2(lo2(acc[ai][1][m][n]), w8, lo2(buv[n]))),
                            swiglu2(pk_fma2(hi2(acc[ai][0][m][n]), w8, hi2(bgv[n])), pk_fma2(hi2(acc[ai][1][m][n]), w8, hi2(buv[n])))); }
            u32x2 w; w.x = pk4_fp8(o[0][0], o[0][1], o[0][2], o[0][3]); w.y = pk4_fp8(o[1][0], o[1][1], o[1][2], o[1][3]);
            *(u32x2*)(ACT8 + (size_t)(row0 + ai * HALF + m * 16) * D + col0) = w; }
    }
};
struct EpiDN {
    static constexpr bool PERM = true, HAS_PRE = true; static constexpr int ES = 1, SITE_ID = 7;
    bf16_t* YR4; const float* bdn; const float* rowgate; const int* rowtk;
    __device__ __forceinline__ void prefetch(LAS unsigned char* meta, const Unit& u, int wid, int lane) const {
        if (wid < 3) { const void* src = wid == 0 ? (const void*)(rowtk + (size_t)u.e * T + u.slot0 + 4 * lane) : wid == 1 ? (const void*)(rowgate + (size_t)u.e * T + u.slot0 + 4 * lane) : (const void*)(bdn + (size_t)u.e * D + u.pn * BM + 4 * lane);
            __builtin_amdgcn_global_load_lds((const unsigned*)src, (LAS unsigned*)(meta + wid * 1024), 16, 0, 0); } }
    __device__ __forceinline__ void epi_lds(const f32x4 (&acc)[2][2][4][2], const Unit& u, int wr, int wc, int fr, int fq, const LAS unsigned char* meta) const {
        const int rl0 = wr * 64 + fr, col0 = u.pn * BM + wc * 32 + 8 * fq;
        float w8s = W8_INV; asm volatile("" : "+v"(w8s));
        f32x4 bv[2][2];
#pragma unroll
        for (int bj = 0; bj < 2; ++bj)
#pragma unroll
            for (int n = 0; n < 2; ++n) bv[bj][n] = *(const LAS f32x4*)(meta + 2048 + (bj * HALF + wc * 32 + 8 * fq + 4 * n) * 4);
#pragma unroll
        EPI_LOOP_ROWS { const int rl = rl0 + ai * HALF + m * 16;
            if (rl < u.nvalid) { const float gt = *(const LAS float*)(meta + 1024 + rl * 4); const int tk = *(const LAS int*)(meta + rl * 4); bf16_t* rowp = YR4 + (size_t)tk * D + col0;
#pragma unroll
                for (int bj = 0; bj < 2; ++bj) *(u32x4*)(rowp + bj * HALF) = pack8((acc[ai][bj][m][0] * w8s + bv[bj][0]) * gt, (acc[ai][bj][m][1] * w8s + bv[bj][1]) * gt); } }
    }
    __device__ __forceinline__ void operator()(const f32x4 (&acc)[2][2][4][2], const Unit& u, int wr, int wc, int fr, int fq) const {
        const int rl0 = wr * 64 + fr, col0 = u.pn * BM + wc * 32 + 8 * fq;
        const float* bp = bdn + (size_t)u.e * D + col0; const float* gp = rowgate + (size_t)u.e * T + u.slot0; const int* tp = rowtk + (size_t)u.e * T + u.slot0;
        float w8s = W8_INV; asm volatile("" : "+v"(w8s));
        f32x4 bv[2][2];
#pragma unroll
        for (int bj = 0; bj < 2; ++bj)
#pragma unroll
            for (int n = 0; n < 2; ++n) bv[bj][n] = *(const f32x4*)(bp + bj * HALF + 4 * n);
        float gtv[2][4]; int tkv[2][4]; const int nv1 = u.nvalid - 1;
#pragma unroll
        EPI_LOOP_ROWS { const int rl = rl0 + ai * HALF + m * 16, rc = rl < nv1 ? rl : nv1; gtv[ai][m] = gp[rc]; tkv[ai][m] = tp[rc]; }
#pragma unroll
        EPI_LOOP_ROWS { const int rl = rl0 + ai * HALF + m * 16;
            if (rl < u.nvalid) { const float gt = gtv[ai][m]; bf16_t* rowp = YR4 + (size_t)tkv[ai][m] * D + col0;
#pragma unroll
                for (int bj = 0; bj < 2; ++bj) *(u32x4*)(rowp + bj * HALF) = pack8((acc[ai][bj][m][0] * w8s + bv[bj][0]) * gt, (acc[ai][bj][m][1] * w8s + bv[bj][1]) * gt); } }
    }
};

template <class E, class = void> struct epi_has_pre { static constexpr bool value = false; };
template <class E> struct epi_has_pre<E, decltype((void)E::HAS_PRE)> { static constexpr bool value = E::HAS_PRE; };
template <class Epi, class Sched>
__device__ __forceinline__ void gemm_simple(int wave, const Gemm g, const Sched& S, const Epi& E) {
    const int wid = launder_s(wave), lane = lane_id_v(), wr = wid >> 2, wc = wid & 3, fr = lane & 15, fq = lane >> 4;
    Unit u; u.e = 0;
    for (int ui = 0; S.next(ui, u); ++ui) {
        f32x4 acc[2][2][4][2];
#pragma unroll
        for (int a = 0; a < 2; ++a)
#pragma unroll
            for (int b = 0; b < 2; ++b)
#pragma unroll
                for (int m = 0; m < 4; ++m)
#pragma unroll
                    for (int n = 0; n < 2; ++n) acc[a][b][m][n] = (f32x4){0.f, 0.f, 0.f, 0.f};
        unsigned ao[2][4], bo[2][2];
#pragma unroll
        for (int ai = 0; ai < 2; ++ai)
#pragma unroll
            for (int m = 0; m < 4; ++m) { const int rl = ai * HALF + wr * 64 + m * 16 + fr;
                if (g.gather) { const int tok = g.gather[(size_t)u.e * T + u.slot0 + (rl < u.nvalid ? rl : u.nvalid - 1)] >> 2; ao[ai][m] = (unsigned)tok * (unsigned)g.lda + fq * 8; }
                else ao[ai][m] = u.aoff + (unsigned)rl * (unsigned)g.lda + fq * 8; }
#pragma unroll
        for (int bj = 0; bj < 2; ++bj)
#pragma unroll
            for (int n = 0; n < 2; ++n) { const int slot = 16 * n + fr, brow = bj * HALF + wc * 32 + (Epi::PERM ? perm32(slot) : slot); bo[bj][n] = u.boff + (unsigned)brow * (unsigned)g.ldb + fq * 8; }
#pragma unroll 1
        for (int k = 0; k < g.K; k += 32) {
            bf16x8 b[2][2];
#pragma unroll
            for (int bj = 0; bj < 2; ++bj)
#pragma unroll
                for (int n = 0; n < 2; ++n) b[bj][n] = *(const bf16x8*)(g.Bt + (size_t)bo[bj][n] + k);
#pragma unroll
            for (int ai = 0; ai < 2; ++ai) {
                bf16x8 a[4];
#pragma unroll
                for (int m = 0; m < 4; ++m) a[m] = *(const bf16x8*)(g.A + (size_t)ao[ai][m] + k);
#pragma unroll
                for (int bj = 0; bj < 2; ++bj)
#pragma unroll
                    for (int m = 0; m < 4; ++m)
#pragma unroll
                        for (int n = 0; n < 2; ++n) acc[ai][bj][m][n] = __builtin_amdgcn_mfma_f32_16x16x32_bf16(b[bj][n], a[m], acc[ai][bj][m][n], 0, 0, 0);
            }
        }
        E(acc, u, wr, wc, fr, fq);
    }
}

typedef int v8i32 __attribute__((ext_vector_type(8)));
typedef int v4i32 __attribute__((ext_vector_type(4)));
template <int ES> struct Frag;
template <> struct Frag<2> { bf16x8 k[2]; };
template <> struct Frag<1> { v8i32 v; };
__device__ __forceinline__ void ld_frag(Frag<2>& f, const LAS unsigned char* p) { f.k[0] = *(const LAS bf16x8*)p; f.k[1] = *(const LAS bf16x8*)(p + 1024); }
__device__ __forceinline__ void ld_frag(Frag<1>& f, const LAS unsigned char* p) { const v4i32 lo = *(const LAS v4i32*)p, hi = *(const LAS v4i32*)(p + 1024); f.v = __builtin_shufflevector(lo, hi, 0, 1, 2, 3, 4, 5, 6, 7); }
__device__ __forceinline__ f32x4 mma_frag(const Frag<2>& b, const Frag<2>& a, f32x4 c) { c = __builtin_amdgcn_mfma_f32_16x16x32_bf16(b.k[0], a.k[0], c, 0, 0, 0); return __builtin_amdgcn_mfma_f32_16x16x32_bf16(b.k[1], a.k[1], c, 0, 0, 0); }
#ifndef FP8_ASM
#define FP8_ASM 1
#endif
#if FP8_ASM
__device__ __forceinline__ f32x4 mma_frag(const Frag<1>& b, const Frag<1>& a, f32x4 c) { asm volatile("v_mfma_f32_16x16x128_f8f6f4 %0, %1, %2, %0" : "+v"(c) : "v"(b.v), "v"(a.v)); return c; }
#else
__device__ __forceinline__ f32x4 mma_frag(const Frag<1>& b, const Frag<1>& a, f32x4 c) { return __builtin_amdgcn_mfma_scale_f32_16x16x128_f8f6f4(b.v, a.v, c, 0, 0, 0, 0, 0, 0); }
#endif
template <class Epi, class Sched, int ES  >
__device__ __forceinline__ void gemm_fast(LAS unsigned char* lds, int wave, const Gemm g, const Sched& S, const Epi& E) {
    const int wid = launder_s(wave), lane = lane_id_v(), tid = wid * 64 + lane, wr = wid >> 2, wc = wid & 3, fr = lane & 15, fq = lane >> 4;
    const int K = launder_s(g.K), nt = K * ES / (BK * 2);
    unsigned voffB[2];
#pragma unroll
    for (int i = 0; i < 2; ++i) { int R, C; stage_rc(tid * 16 + i * 8192, R, C); const int Rb = Epi::PERM ? ((R & ~31) + perm32(R & 31)) : R; voffB[i] = (unsigned)Rb * (unsigned)g.ldb * (unsigned)ES + (unsigned)C * 2u; }
    const size_t kstep = (size_t)(BK * 2);
    const size_t hstepB = (size_t)HALF * g.ldb * ES;
    const unsigned ldsw = (unsigned)wid * 1024u;
    const int aoff = lds_byte(wr * 64 + fr, fq * 8), boff = lds_byte(wc * 32 + fr, fq * 8);
    const char* const Abase = (const char*)g.A; const char* const Bbase = (const char*)g.Bt;
#define PG8_SA(b, h) (((b) * 2 + (h)) * HTB)
#define PG8_SB(b, h) ((4 + (b) * 2 + (h)) * HTB)
#define PG8_STAGE_A(bufoff, ao, kb) do { _Pragma("unroll") for (int _i = 0; _i < 2; ++_i) \
        __builtin_amdgcn_global_load_lds((const unsigned*)(Abase + (size_t)(ao)[_i] + (size_t)(kb)), (LAS unsigned*)(lds + (bufoff) + ldsw + _i * 8192), 16, 0, 0); } while (0)
#define PG8_STAGE_B(bufoff, gbase) do { _Pragma("unroll") for (int _i = 0; _i < 2; ++_i) \
        __builtin_amdgcn_global_load_lds((const unsigned*)((const char*)(gbase) + voffB[_i]), (LAS unsigned*)(lds + (bufoff) + ldsw + _i * 8192), 16, 0, 0); } while (0)
#define PG8_LDA(dst, b, h) do { _Pragma("unroll") for (int m = 0; m < 4; ++m) ld_frag(dst[m], lds + PG8_SA(b, h) + aoff + m * 2048); } while (0)
#define PG8_LDB(dst, b, h) do { _Pragma("unroll") for (int n = 0; n < 2; ++n) ld_frag(dst[n], lds + PG8_SB(b, h) + boff + n * 2048); } while (0)
#define PG8_MMA(ai, bj, At, Bt) do { __builtin_amdgcn_s_setprio(1); _Pragma("unroll") for (int m = 0; m < 4; ++m) _Pragma("unroll") for (int n = 0; n < 2; ++n) acc[ai][bj][m][n] = mma_frag(Bt[n], At[m], acc[ai][bj][m][n]); \
        __builtin_amdgcn_s_setprio(0); } while (0)
#define PG8_WAIT_V(n) asm volatile("s_waitcnt vmcnt(" #n ")" ::: "memory")
#define PG8_WAIT_L(n) asm volatile("s_waitcnt lgkmcnt(" #n ")" ::: "memory")
#define PG8_BAR __builtin_amdgcn_s_barrier()
#define PG8_SCHED __builtin_amdgcn_sched_barrier(0)
#define PG8_AOFFS(u, ao) do { if (g.gather) { const int* _gp = g.gather + (size_t)(u).e * T + (u).slot0; const int _nv1 = (u).nvalid - 1; int _tk[2][2]; \
            _Pragma("unroll") for (int _h = 0; _h < 2; ++_h) _Pragma("unroll") for (int _i = 0; _i < 2; ++_i) { int _R, _C; stage_rc(tid * 16 + _i * 8192, _R, _C); const int _rl = _h * HALF + _R; _tk[_h][_i] = _gp[_rl < _nv1 ? _rl : _nv1]; } \
            _Pragma("unroll") for (int _h = 0; _h < 2; ++_h) _Pragma("unroll") for (int _i = 0; _i < 2; ++_i) { int _R, _C; stage_rc(tid * 16 + _i * 8192, _R, _C); ao[_h][_i] = (unsigned)(_tk[_h][_i] >> 2) * (unsigned)g.lda * (unsigned)ES + (unsigned)_C * 2u; } } \
        else { _Pragma("unroll") for (int _h = 0; _h < 2; ++_h) _Pragma("unroll") for (int _i = 0; _i < 2; ++_i) { int _R, _C; stage_rc(tid * 16 + _i * 8192, _R, _C); ao[_h][_i] = ((u).aoff + (unsigned)(_h * HALF + _R) * (unsigned)g.lda) * (unsigned)ES + (unsigned)_C * 2u; } } } while (0)
    Unit cur, nxt; int ui = 0; cur.e = 0;
    if (!S.next(0, cur)) return;
    constexpr bool PROF = (PROF_REGION != 0) && ((PROF_SITES >> Epi::SITE_ID) & 1);
    unsigned long long prof_acc = 0, prof_t0 = (PROF && PROF_REGION == 1) ? __builtin_amdgcn_s_memrealtime() : 0ull;
#define PG8_PROF(r, begin) do { if (PROF && PROF_REGION == (r) && wid == 0) { const unsigned long long _t = __builtin_amdgcn_s_memrealtime(); if (begin) prof_t0 = _t; else prof_acc += _t - prof_t0; } } while (0)
    f32x4 acc[2][2][4][2];
#pragma unroll
    for (int a = 0; a < 2; ++a)
#pragma unroll
        for (int b = 0; b < 2; ++b)
#pragma unroll
            for (int m = 0; m < 4; ++m)
#pragma unroll
                for (int n = 0; n < 2; ++n) acc[a][b][m][n] = (f32x4){0.f, 0.f, 0.f, 0.f};
    Frag<ES> At[4], B0[2], B1[2];
    unsigned aC[2][2], aN[2][2];
    PG8_AOFFS(cur, aC);
    if constexpr (epi_has_pre<Epi>::value) E.prefetch(lds + META_OFF, cur, wid, lane);
    const char* cB = Bbase + (size_t)cur.boff * ES;
    PG8_STAGE_B(PG8_SB(0, 0), cB); PG8_STAGE_B(PG8_SB(0, 1), cB + hstepB); PG8_STAGE_A(PG8_SA(0, 0), aC[0], 0); PG8_STAGE_A(PG8_SA(0, 1), aC[1], 0);
    if (wr == 1) PG8_BAR;
    PG8_WAIT_V(2); PG8_BAR;
    PG8_STAGE_B(PG8_SB(1, 0), cB + kstep); PG8_STAGE_A(PG8_SA(1, 0), aC[0], kstep); PG8_STAGE_B(PG8_SB(1, 1), cB + hstepB + kstep);
    PG8_WAIT_V(6); PG8_BAR;
    for (;;) {
        nxt.e = cur.e;
        const bool has_next = S.next(ui + 1, nxt);
        if (has_next) { PG8_AOFFS(nxt, aN); } else {
#pragma unroll
            for (int h = 0; h < 2; ++h)
#pragma unroll
                for (int i = 0; i < 2; ++i) aN[h][i] = aC[h][i]; }
        const char* nB = has_next ? Bbase + (size_t)nxt.boff * ES : cB;
        PG8_PROF(1, false); PG8_PROF(2, true);
#pragma unroll 1
        for (int t = 0; t < nt; t += 2) {
            const bool last = (t == nt - 2);
            const size_t k1 = (size_t)(t + 1) * kstep, k2 = last ? 0 : (size_t)(t + 2) * kstep, k3 = k2 + kstep;
            unsigned a2[2][2];
#pragma unroll
            for (int h = 0; h < 2; ++h)
#pragma unroll
                for (int i = 0; i < 2; ++i) a2[h][i] = last ? aN[h][i] : aC[h][i];
            const char* b2 = last ? nB : cB + (size_t)(t + 2) * kstep; const char* b3 = b2 + kstep;
            PG8_LDB(B0, 0, 0); PG8_LDB(B1, 0, 1); PG8_SCHED; PG8_LDA(At, 0, 0); PG8_STAGE_A(PG8_SA(1, 1), aC[1], k1);
            PG8_WAIT_V(8); PG8_WAIT_L(0); PG8_BAR; PG8_MMA(0, 0, At, B0); PG8_MMA(0, 1, At, B1); PG8_BAR; PG8_SCHED;
            PG8_LDA(At, 0, 1); PG8_STAGE_B(PG8_SB(0, 0), b2); PG8_STAGE_B(PG8_SB(0, 1), b2 + hstepB); PG8_STAGE_A(PG8_SA(0, 0), a2[0], k2);
            PG8_WAIT_V(8); PG8_WAIT_L(0); PG8_BAR; PG8_MMA(1, 0, At, B0); PG8_MMA(1, 1, At, B1); PG8_BAR; PG8_SCHED;
            PG8_LDB(B0, 1, 0); PG8_LDB(B1, 1, 1); PG8_SCHED; PG8_LDA(At, 1, 0); PG8_STAGE_A(PG8_SA(0, 1), a2[1], k2);
            PG8_WAIT_V(8); PG8_WAIT_L(0); PG8_BAR; PG8_MMA(0, 0, At, B0); PG8_MMA(0, 1, At, B1); PG8_BAR; PG8_SCHED;
            PG8_LDA(At, 1, 1); PG8_STAGE_B(PG8_SB(1, 0), b3); PG8_STAGE_B(PG8_SB(1, 1), b3 + hstepB); PG8_STAGE_A(PG8_SA(1, 0), a2[0], k3);
            PG8_WAIT_V(8); PG8_WAIT_L(0); PG8_BAR; PG8_MMA(1, 0, At, B0); PG8_MMA(1, 1, At, B1); PG8_BAR; PG8_SCHED;
        }
        PG8_PROF(2, false); PG8_PROF(1, true);
        if constexpr (ES == 1 && FP8_ASM) asm volatile("s_nop 15\n\ts_nop 15\n\ts_nop 15" ::: "memory");
        if (wr == 0) PG8_BAR;
        if constexpr (epi_has_pre<Epi>::value) E.epi_lds(acc, cur, wr, wc, fr, fq, lds + META_OFF + (ui & 1) * META_BYTES); else E(acc, cur, wr, wc, fr, fq);
        if (!has_next) break;
#pragma unroll
        for (int a = 0; a < 2; ++a)
#pragma unroll
            for (int b = 0; b < 2; ++b)
#pragma unroll
                for (int m = 0; m < 4; ++m)
#pragma unroll
                    for (int n = 0; n < 2; ++n) acc[a][b][m][n] = (f32x4){0.f, 0.f, 0.f, 0.f};
        cur = nxt; cB = nB; ++ui;
        if constexpr (epi_has_pre<Epi>::value) E.prefetch(lds + META_OFF + (ui & 1) * META_BYTES, cur, wid, lane);
#pragma unroll
        for (int h = 0; h < 2; ++h)
#pragma unroll
            for (int i = 0; i < 2; ++i) aC[h][i] = aN[h][i];
        if (wr == 1) PG8_BAR;
    }
    PG8_WAIT_V(0);
    if (PROF && wid == 0) { PG8_PROF(1, false); if (lane == 0) { volatile LAS unsigned* pw = (volatile LAS unsigned*)(lds + LDSCTL_OFF) + MISC_PROF; *pw = *pw + (unsigned)prof_acc; } }
    PG8_BAR;
#undef PG8_SA
#undef PG8_SB
#undef PG8_STAGE_A
#undef PG8_STAGE_B
#undef PG8_LDA
#undef PG8_LDB
#undef PG8_MMA
#undef PG8_WAIT_V
#undef PG8_WAIT_L
#undef PG8_BAR
#undef PG8_SCHED
#undef PG8_AOFFS
#undef PG8_PROF
}

template <class Epi, class Sched, int SITE>
__device__ __forceinline__ void gemm_phase(LAS unsigned char* lds, int wave, const Gemm g, const Sched& S, const Epi& E) {
    if constexpr (Epi::ES == 1) gemm_fast<Epi, Sched, 1>(lds, wave, g, S, E);
    else if constexpr ((FAST_MASK >> SITE) & 1) gemm_fast<Epi, Sched, 2>(lds, wave, g, S, E); else gemm_simple<Epi, Sched>(wave, g, S, E);
}
}

struct Frame {
    LAS unsigned char* lds;
    volatile LAS unsigned* MISC;
    unsigned* ctl;
    int tid, lane, wave, vcu, G;
};
struct Args { const float* in[21]; float* out; unsigned char* ws; int ph_lo, ph_hi; };
static_assert(sizeof(Args) == 21 * 8 + 8 + 8 + 8, "Args has no padding");

__device__ __forceinline__ void mods_phase(Frame& F, const float* c, const float* ada_w, const float* ada_b, float* MOD) {
    LAS float* cact = (LAS float*)F.lds;
    LAS float* part = (LAS float*)(F.lds + 8192);
    for (int i = F.tid; i < BATCH * D; i += NTHREADS) { const float v = c[i]; cact[i] = v * fast_sigmoid(v); }
    __syncthreads();
    constexpr int NTASK = DEPTH * (6 * D / 64);
    for (int task = F.vcu; task < NTASK; task += F.G) {
        const int l = task / (6 * D / 64), j0 = (task % (6 * D / 64)) * 64;
        const float* w = ada_w + (size_t)l * D * (6 * D) + j0 + F.lane;
        const int k0 = F.wave * 128;
        float a0 = 0.f, a1 = 0.f;
#pragma unroll 16
        for (int k = 0; k < 128; ++k) { const float wv = __builtin_nontemporal_load(w + (size_t)(k0 + k) * (6 * D)); a0 += cact[k0 + k] * wv; a1 += cact[D + k0 + k] * wv; }
        part[(F.wave * 2 + 0) * 64 + F.lane] = a0; part[(F.wave * 2 + 1) * 64 + F.lane] = a1;
        __syncthreads();
        if (F.tid < 128) { const int b = F.tid >> 6, j = F.tid & 63; float s = 0.f;
#pragma unroll
            for (int w8 = 0; w8 < 8; ++w8) s += part[(w8 * 2 + b) * 64 + j];
            MOD[((size_t)l * BATCH + b) * (6 * D) + j0 + j] = s + ada_b[(size_t)l * (6 * D) + j0 + j]; }
        __syncthreads();
    }
}
__device__ __forceinline__ void tr_item(const float* W, int ldw, bf16_t* WT, int ldt, int k0, int n0, int drow0, int dcol0, LAS float* scr, int lane) {
#pragma unroll 8
    for (int i = 0; i < 32; ++i) { const int kk = 2 * i + (lane >> 5); scr[kk * 33 + (lane & 31)] = __builtin_nontemporal_load(W + (size_t)(k0 + kk) * ldw + n0 + (lane & 31)); }
    LDS_WAIT(); asm volatile("" ::: "memory");
    const int c = lane & 7;
#pragma unroll
    for (int j = 0; j < 4; ++j) { const int n = (lane >> 3) + 8 * j; const LAS float* s = scr + (8 * c) * 33 + n;
        u32x4 o; o.x = pk2(s[0 * 33], s[1 * 33]); o.y = pk2(s[2 * 33], s[3 * 33]); o.z = pk2(s[4 * 33], s[5 * 33]); o.w = pk2(s[6 * 33], s[7 * 33]);
        *(u32x4*)(WT + (size_t)(drow0 + n) * ldt + dcol0 + k0 + 8 * c) = o; }
    LDS_WAIT(); asm volatile("" ::: "memory");
}
__device__ __forceinline__ void tr_item8(const float* W, int ldw, unsigned char* WT, int ldt, int k0, int n0, int drow0, float scale, LAS float* scr, int lane, bool nts) {
#pragma unroll 8
    for (int i = 0; i < 32; ++i) { const int kk = 2 * i + (lane >> 5); scr[kk * 33 + (lane & 31)] = __builtin_nontemporal_load(W + (size_t)(k0 + kk) * ldw + n0 + (lane & 31)); }
    LDS_WAIT(); asm volatile("" ::: "memory");
    const int c = lane & 3;
#pragma unroll
    for (int j = 0; j < 2; ++j) { const int n = (lane >> 2) + 16 * j; const LAS float* sp = scr + (16 * c) * 33 + n;
        u32x4 o; o.x = pk4_fp8(sp[0 * 33] * scale, sp[1 * 33] * scale, sp[2 * 33] * scale, sp[3 * 33] * scale); o.y = pk4_fp8(sp[4 * 33] * scale, sp[5 * 33] * scale, sp[6 * 33] * scale, sp[7 * 33] * scale);
        o.z = pk4_fp8(sp[8 * 33] * scale, sp[9 * 33] * scale, sp[10 * 33] * scale, sp[11 * 33] * scale); o.w = pk4_fp8(sp[12 * 33] * scale, sp[13 * 33] * scale, sp[14 * 33] * scale, sp[15 * 33] * scale);
        if (nts) __builtin_nontemporal_store(o, (u32x4*)(WT + (size_t)(drow0 + n) * ldt + k0 + 16 * c)); else *(u32x4*)(WT + (size_t)(drow0 + n) * ldt + k0 + 16 * c) = o; }
    LDS_WAIT(); asm volatile("" ::: "memory");
}
__device__ __forceinline__ int win_drow(int n0) {
    if (n0 < 512) return n0; if (n0 < 768) return 3328 + (n0 - 512); if (n0 < 1536) return 512 + (n0 - 768); return 1280 + (n0 - 1536);
}
typedef const volatile __attribute__((address_space(4))) Args* KArgs;
__device__ __forceinline__ void convert_phase(Frame& F, KArgs ka) {
    unsigned char* wsb = (unsigned char*)ka->ws; const float *in8 = (const float*)ka->in[8], *in9 = (const float*)ka->in[9], *in12 = (const float*)ka->in[12], *in13 = (const float*)ka->in[13], *in14 = (const float*)ka->in[14], *in15 = (const float*)ka->in[15], *in17 = (const float*)ka->in[17], *in19 = (const float*)ka->in[19];
    LAS float* scr = (LAS float*)(F.lds + F.wave * 16384);
    const int gw = F.vcu * NWAVES + F.wave, NGW = F.G * NWAVES;
    constexpr int I_IN = 16 * 112, I_BRA = 4 * 32, I_BRP = 12 * 32, I_OUT = 16 * 32, I_RT = 16, I_PL = 4 * 3 * 6, I_GU = NE * 16 * 64, I_DN = NE * 16 * 32;
    constexpr int I_LAYER = I_IN + I_BRA + I_BRP + I_OUT + I_RT + I_PL + I_GU + I_DN;
    for (int it = gw; it < DEPTH * I_LAYER; it += NGW) {
        const int l = it / I_LAYER; int r = it % I_LAYER;
        unsigned char* wl = wsb + WS_W + (size_t)l * WL_STRIDE;
        if (r < I_GU) { const int e = r / (16 * 64), q = r % (16 * 64), kb = q / 64, nb = q % 64, n0 = nb * 32, half = n0 / D, cc = n0 % D;
            tr_item8(in17 + ((size_t)l * NE + e) * D * (2 * D), 2 * D, (unsigned char*)(wl + WO_GU) + (size_t)e * (2 * D) * D, D, kb * 64, n0, (cc / 128) * 256 + half * 128 + (cc % 128), W8_SCALE, scr, F.lane, true); continue; } r -= I_GU;
        if (r < I_DN) { const int e = r / (16 * 32), q = r % (16 * 32), kb = q / 32, nb = q % 32;
            tr_item8(in19 + ((size_t)l * NE + e) * D * D, D, (unsigned char*)(wl + WO_DN) + (size_t)e * D * D, D, kb * 64, nb * 32, nb * 32, W8_SCALE, scr, F.lane, true); continue; } r -= I_DN;
        if (r < I_IN) { const int kb = r / 112, nb = r % 112;
            tr_item(in8 + (size_t)l * D * INW, INW, (bf16_t*)(wl + WO_WIN), D, kb * 64, nb * 32, win_drow(nb * 32), 0, scr, F.lane); continue; } r -= I_IN;
        if (r < I_BRA) { const int kb = r / 32, nb = r % 32;
            tr_item(in12 + (size_t)l * SBW * D, D, (bf16_t*)(wl + WO_BRA), SBW, kb * 64, nb * 32, nb * 32, 0, scr, F.lane); continue; } r -= I_BRA;
        if (r < I_BRP) { const int kb = r / 32, nb = r % 32;
            tr_item(in13 + (size_t)l * PW * D, D, (bf16_t*)(wl + WO_BRP), PW, kb * 64, nb * 32, nb * 32, 0, scr, F.lane); continue; } r -= I_BRP;
        if (r < I_OUT) { const int kb = r / 32, nb = r % 32;
            tr_item(in14 + (size_t)l * D * D, D, (bf16_t*)(wl + WO_OUT), D, kb * 64, nb * 32, nb * 32, 0, scr, F.lane); continue; } r -= I_OUT;
        if (r < I_RT) { tr_item(in15 + (size_t)l * D * NE, NE, (bf16_t*)(wl + WO_ROUTER), D, r * 64, 0, 0, 0, scr, F.lane); continue; } r -= I_RT;
        { const int gidx = r / 18, q = r % 18, kb = q / 6, nb = q % 6;
            tr_item(in9 + ((size_t)l * 4 + gidx) * PGD * PGD, PGD, (bf16_t*)(wl + WO_POOL), PW, kb * 64, nb * 32, gidx * PGD + nb * 32, gidx * PGD, scr, F.lane); }
    }
    for (int it = gw; it < DEPTH * PW; it += NGW) { const int l = it / PW, n = it % PW, gidx = n / PGD;
        bf16_t* rowp = (bf16_t*)(wsb + WS_W + (size_t)l * WL_STRIDE + WO_POOL) + (size_t)n * PW;
        for (int ch = F.lane; ch < PW / 8; ch += 64) if (ch / (PGD / 8) != gidx) *(u32x4*)(rowp + ch * 8) = (u32x4){0u, 0u, 0u, 0u}; }
}

struct Row16 { f32x4 a[4]; };
__device__ __forceinline__ void ld_row_f32(const float* p, int lane, Row16& v) {
#pragma unroll
    for (int j = 0; j < 2; ++j) { v.a[2 * j] = *(const f32x4*)(p + 8 * lane + 512 * j); v.a[2 * j + 1] = *(const f32x4*)(p + 8 * lane + 512 * j + 4); } }
__device__ __forceinline__ void ld_row_f32_nt(const float* p, int lane, Row16& v) {
#pragma unroll
    for (int j = 0; j < 2; ++j) { v.a[2 * j] = __builtin_nontemporal_load((const f32x4*)(p + 8 * lane + 512 * j)); v.a[2 * j + 1] = __builtin_nontemporal_load((const f32x4*)(p + 8 * lane + 512 * j + 4)); } }
__device__ __forceinline__ void ld_row_bf16_nt(const bf16_t* p, int lane, u32x4 (&w)[2]);
__device__ __forceinline__ void st_row_f32(float* p, int lane, const Row16& v) {
#pragma unroll
    for (int j = 0; j < 2; ++j) { __builtin_nontemporal_store(v.a[2 * j], (f32x4*)(p + 8 * lane + 512 * j)); __builtin_nontemporal_store(v.a[2 * j + 1], (f32x4*)(p + 8 * lane + 512 * j + 4)); } }
__device__ __forceinline__ void ld_row_bf16(const bf16_t* p, int lane, u32x4 (&w)[2]) {
#pragma unroll
    for (int j = 0; j < 2; ++j) w[j] = *(const u32x4*)(p + 8 * lane + 512 * j); }
__device__ __forceinline__ void ld_row_bf16_nt(const bf16_t* p, int lane, u32x4 (&w)[2]) {
#pragma unroll
    for (int j = 0; j < 2; ++j) w[j] = __builtin_nontemporal_load((const u32x4*)(p + 8 * lane + 512 * j)); }
__device__ __forceinline__ void acc_row_bf16(const u32x4 (&w)[2], Row16& y) {
#pragma unroll
    for (int j = 0; j < 2; ++j) { f32x4 lo, hi; pg8::unpack8(w[j], lo, hi); y.a[2 * j] = y.a[2 * j] + lo; y.a[2 * j + 1] = y.a[2 * j + 1] + hi; } }
__device__ __forceinline__ void ld_row_x(const void* base, bool is_bf16, size_t row, int lane, Row16& v) {
    if (is_bf16) { u32x4 w[2]; ld_row_bf16_nt((const bf16_t*)base + row * D, lane, w);
#pragma unroll
        for (int i = 0; i < 4; ++i) v.a[i] = (f32x4){0.f, 0.f, 0.f, 0.f};
        acc_row_bf16(w, v); }
    else ld_row_f32_nt((const float*)base + row * D, lane, v); }
__device__ __forceinline__ void st_row_x(void* base, bool is_bf16, size_t row, int lane, const Row16& v) {
    if (is_bf16) {
#pragma unroll
        for (int j = 0; j < 2; ++j) { u32x4 w; w.x = pk2(v.a[2 * j].x, v.a[2 * j].y); w.y = pk2(v.a[2 * j].z, v.a[2 * j].w); w.z = pk2(v.a[2 * j + 1].x, v.a[2 * j + 1].y); w.w = pk2(v.a[2 * j + 1].z, v.a[2 * j + 1].w);
            __builtin_nontemporal_store(w, (u32x4*)((bf16_t*)base + row * D + 8 * lane + 512 * j)); } }
    else st_row_f32((float*)base + row * D, lane, v); }
__device__ __forceinline__ float row_sumsq(const Row16& v) { float ss = 0.f;
#pragma unroll
    for (int q = 0; q < 4; ++q) ss += (v.a[q].x * v.a[q].x + v.a[q].y * v.a[q].y) + (v.a[q].z * v.a[q].z + v.a[q].w * v.a[q].w);
    return ss; }
__device__ __forceinline__ void norm_mod_store(const Row16& v, float ss_wave, const Row16& gg, const Row16& s1, const Row16& s0, bf16_t* hrow, int lane, unsigned char* h8row = nullptr) {
    const float r = 1.0f / sqrtf(ss_wave * (1.0f / D) + NORM_EPS);
#pragma unroll
    for (int j = 0; j < 2; ++j) { const f32x4 o0 = v.a[2 * j] * r * gg.a[2 * j] * (s1.a[2 * j] + 1.0f) + s0.a[2 * j], o1 = v.a[2 * j + 1] * r * gg.a[2 * j + 1] * (s1.a[2 * j + 1] + 1.0f) + s0.a[2 * j + 1];
        u32x4 w; w.x = pk2(o0.x, o0.y); w.y = pk2(o0.z, o0.w); w.z = pk2(o1.x, o1.y); w.w = pk2(o1.z, o1.w); *(u32x4*)(hrow + 8 * lane + 512 * j) = w;
        if (h8row) { u32x2 q; q.x = pk4_fp8(o0.x, o0.y, o0.z, o0.w); q.y = pk4_fp8(o1.x, o1.y, o1.z, o1.w); *(u32x2*)(h8row + 8 * lane + 512 * j) = q; } }
}
constexpr int RP = 2;
__device__ __forceinline__ void rowpass_pre(Frame& F, const float* x, const float* g, const float* MODl, bf16_t* H) {
    const int gw = F.vcu * NWAVES + F.wave, NGW = F.G * NWAVES;
    Row16 gg; ld_row_f32(g, F.lane, gg);
    for (int row0 = gw * RP; row0 < T; row0 += NGW * RP) { const int b = row0 / SEQ; const float* mod = MODl + (size_t)b * 6 * D;
        Row16 v[RP], s1, s0; float ss[RP];
#pragma unroll
        for (int q = 0; q < RP; ++q) ld_row_f32_nt(x + (size_t)(row0 + q) * D, F.lane, v[q]);
        ld_row_f32(mod + 1 * D, F.lane, s1); ld_row_f32(mod + 0 * D, F.lane, s0);
#pragma unroll
        for (int q = 0; q < RP; ++q) ss[q] = row_sumsq(v[q]);
#pragma unroll
        for (int o = 1; o < 64; o <<= 1) {
#pragma unroll
            for (int q = 0; q < RP; ++q) ss[q] += __shfl_xor(ss[q], o); }
#pragma unroll
        for (int q = 0; q < RP; ++q) norm_mod_store(v[q], ss[q], gg, s1, s0, H + (size_t)(row0 + q) * D, F.lane); }
}
__device__ __forceinline__ void rowpass_mid(Frame& F, int row_begin, int row_end, int row_step, const void* xin, bool xin_bf16, bf16_t* xout, const bf16_t* Y, const float* post_g, const float* pre2_g, const float* MODl, bf16_t* H, unsigned char* H8) {
    for (int row0 = row_begin; row0 < row_end; row0 += row_step) { const int b = row0 / SEQ; const float* mod = MODl + (size_t)b * 6 * D;
        Row16 v[RP], y[RP]; float ss[RP];
#pragma unroll
        for (int q = 0; q < RP; ++q) { ld_row_x(xin, xin_bf16, (size_t)(row0 + q), F.lane, v[q]); u32x4 w[2]; ld_row_bf16_nt(Y + (size_t)(row0 + q) * D, F.lane, w);
#pragma unroll
            for (int i = 0; i < 4; ++i) y[q].a[i] = (f32x4){0.f, 0.f, 0.f, 0.f};
            acc_row_bf16(w, y[q]); }
        { Row16 pg, g1; ld_row_f32(post_g, F.lane, pg); ld_row_f32(mod + 2 * D, F.lane, g1);
#pragma unroll
            for (int q = 0; q < RP; ++q) ss[q] = row_sumsq(y[q]);
#pragma unroll
            for (int o = 1; o < 64; o <<= 1) {
#pragma unroll
                for (int q = 0; q < RP; ++q) ss[q] += __shfl_xor(ss[q], o); }
#pragma unroll
            for (int q = 0; q < RP; ++q) { const float r = 1.0f / sqrtf(ss[q] * (1.0f / D) + NORM_EPS);
#pragma unroll
                for (int i = 0; i < 4; ++i) v[q].a[i] = v[q].a[i] + g1.a[i] * (y[q].a[i] * r * pg.a[i]);
                st_row_x(xout, true, (size_t)(row0 + q), F.lane, v[q]); } }
        { Row16 gg, s1, s0; ld_row_f32(pre2_g, F.lane, gg); ld_row_f32(mod + 4 * D, F.lane, s1); ld_row_f32(mod + 3 * D, F.lane, s0);
#pragma unroll
            for (int q = 0; q < RP; ++q) ss[q] = row_sumsq(v[q]);
#pragma unroll
            for (int o = 1; o < 64; o <<= 1) {
#pragma unroll
                for (int q = 0; q < RP; ++q) ss[q] += __shfl_xor(ss[q], o); }
#pragma unroll
            for (int q = 0; q < RP; ++q) norm_mod_store(v[q], ss[q], gg, s1, s0, H + (size_t)(row0 + q) * D, F.lane, H8 + (size_t)(row0 + q) * D); } }
}
__device__ __forceinline__ void rowpass_comb(Frame& F, const bf16_t* x, void* xout, bool xout_bf16, const bf16_t* YR4, const float* post_g, const float* MODl,
                                             bool has_next, const float* pre1_g_next, const float* MODn, bf16_t* H) {
    const int gw = F.vcu * NWAVES + F.wave, NGW = F.G * NWAVES;
    for (int row0 = gw * RP; row0 < T; row0 += NGW * RP) { const int b = row0 / SEQ; const float* mod = MODl + (size_t)b * 6 * D;
        Row16 v[RP], y[RP]; float ss[RP]; u32x4 w[RP][TOPK][2];
#pragma unroll
        for (int q = 0; q < RP; ++q) { ld_row_x(x, true, (size_t)(row0 + q), F.lane, v[q]);
#pragma unroll
            for (int k = 0; k < TOPK; ++k) ld_row_bf16_nt(YR4 + ((size_t)(row0 + q) * TOPK + k) * D, F.lane, w[q][k]); }
#pragma unroll
        for (int q = 0; q < RP; ++q) {
#pragma unroll
            for (int i = 0; i < 4; ++i) y[q].a[i] = (f32x4){0.f, 0.f, 0.f, 0.f};
#pragma unroll
            for (int k = 0; k < TOPK; ++k) acc_row_bf16(w[q][k], y[q]); }
        { Row16 pg, g2; ld_row_f32(post_g, F.lane, pg); ld_row_f32(mod + 5 * D, F.lane, g2);
#pragma unroll
            for (int q = 0; q < RP; ++q) ss[q] = row_sumsq(y[q]);
#pragma unroll
            for (int o = 1; o < 64; o <<= 1) {
#pragma unroll
                for (int q = 0; q < RP; ++q) ss[q] += __shfl_xor(ss[q], o); }
#pragma unroll
            for (int q = 0; q < RP; ++q) { const float r = 1.0f / sqrtf(ss[q] * (1.0f / D) + NORM_EPS);
#pragma unroll
                for (int i = 0; i < 4; ++i) v[q].a[i] = v[q].a[i] + g2.a[i] * (y[q].a[i] * r * pg.a[i]);
                st_row_x(xout, xout_bf16, (size_t)(row0 + q), F.lane, v[q]); } }
        if (has_next) { const float* modn = MODn + (size_t)b * 6 * D; Row16 gg, s1, s0; ld_row_f32(pre1_g_next, F.lane, gg); ld_row_f32(modn + 1 * D, F.lane, s1); ld_row_f32(modn + 0 * D, F.lane, s0);
#pragma unroll
            for (int q = 0; q < RP; ++q) ss[q] = row_sumsq(v[q]);
#pragma unroll
            for (int o = 1; o < 64; o <<= 1) {
#pragma unroll
                for (int q = 0; q < RP; ++q) ss[q] += __shfl_xor(ss[q], o); }
#pragma unroll
            for (int q = 0; q < RP; ++q) norm_mod_store(v[q], ss[q], gg, s1, s0, H + (size_t)(row0 + q) * D, F.lane); } }
}

__device__ __forceinline__ void attn_phase(Frame& F, const bf16_t* Q, const bf16_t* KB, const bf16_t* VT, bf16_t* AP) {
    const int gw = F.vcu * NWAVES + F.wave, NGW = F.G * NWAVES;
    const int r = F.lane & 31, hh = F.lane >> 5;
    constexpr int NQT = SEQ / 32, NTASK = BATCH * NH * NQT;
    for (int task = gw; task < NTASK; task += NGW) {
        const int qt = task % NQT, h = (task / NQT) % NH, b = task / (NQT * NH), q0 = qt * 32;
        const size_t trow0 = (size_t)b * SEQ;
        bf16x8 qf[4];
#pragma unroll
        for (int ks = 0; ks < 4; ++ks) qf[ks] = *(const bf16x8*)(Q + (trow0 + q0 + r) * SBW + h * HD + ks * 16 + hh * 8);
        f32x16 o0, o1;
#pragma unroll
        for (int i = 0; i < 16; ++i) { o0[i] = 0.f; o1[i] = 0.f; }
        float C = 0.f;
        bf16x8 kf[4], kn[4]; s16x4 vlo[2][2], vhi[2][2], nlo[2][2], nhi[2][2];
#define ATT_LOAD(KF, VLO, VHI, kb_) do { const bf16_t* kp_ = KB + (trow0 + (kb_) + r) * SBW + h * HD + hh * 8; \
            _Pragma("unroll") for (int ks = 0; ks < 4; ++ks) KF[ks] = *(const bf16x8*)(kp_ + ks * 16); \
            _Pragma("unroll") for (int st = 0; st < 2; ++st) _Pragma("unroll") for (int dt = 0; dt < 2; ++dt) { const bf16_t* vp_ = VT + (size_t)(h * HD + dt * 32 + r) * VTP + trow0 + (kb_) + 16 * st + 4 * hh; VLO[st][dt] = *(const s16x4*)vp_; VHI[st][dt] = *(const s16x4*)(vp_ + 8); } } while (0)
        ATT_LOAD(kf, vlo, vhi, q0);
        for (int kb = q0; kb >= 0; kb -= 32) {
            const bool diag = (kb == q0);
            { const int nkb = kb >= 32 ? kb - 32 : 0; ATT_LOAD(kn, nlo, nhi, nkb); }
            f32x16 s;
#pragma unroll
            for (int i = 0; i < 16; ++i) s[i] = 0.f;
#pragma unroll
            for (int ks = 0; ks < 4; ++ks) s = __builtin_amdgcn_mfma_f32_32x32x16_bf16(kf[ks], qf[ks], s, 0, 0, 0);
            float lk[16];
#pragma unroll
            for (int i = 0; i < 16; ++i) { const int kc = 8 * (i >> 2) + 4 * hh + (i & 3); const bool valid = !diag || (kc < r); lk[i] = valid ? -softplus_f(s[i]) : 0.f; }
            float rt[4], pt[4], both[4];
#pragma unroll
            for (int gq = 0; gq < 4; ++gq) { lk[4 * gq + 2] += lk[4 * gq + 3]; lk[4 * gq + 1] += lk[4 * gq + 2]; lk[4 * gq + 0] += lk[4 * gq + 1]; rt[gq] = lk[4 * gq]; }
#pragma unroll
            for (int gq = 0; gq < 4; ++gq) { pt[gq] = __shfl_xor(rt[gq], 32); both[gq] = rt[gq] + pt[gq]; }
            float after[4]; after[3] = 0.f; after[2] = both[3]; after[1] = both[3] + both[2]; after[0] = after[1] + both[1];
            f32x16 a;
#pragma unroll
            for (int gq = 0; gq < 4; ++gq) { const float off = after[gq] + (hh == 0 ? pt[gq] : 0.f) + C;
#pragma unroll
                for (int j = 0; j < 4; ++j) { const int i = 4 * gq + j, kc = 8 * gq + 4 * hh + j; const bool valid = !diag || (kc < r);
                    a[i] = valid ? fast_exp(s[i] + lk[i] + off) : 0.f; } }
            C += both[0] + after[0];
#pragma unroll
            for (int st = 0; st < 2; ++st) {
                u32x4 pw; pw.x = pk2(a[8 * st + 0], a[8 * st + 1]); pw.y = pk2(a[8 * st + 2], a[8 * st + 3]); pw.z = pk2(a[8 * st + 4], a[8 * st + 5]); pw.w = pk2(a[8 * st + 6], a[8 * st + 7]);
                const bf16x8 pb = __builtin_bit_cast(bf16x8, pw);
                const bf16x8 va0 = __builtin_shufflevector(vlo[st][0], vhi[st][0], 0, 1, 2, 3, 4, 5, 6, 7), va1 = __builtin_shufflevector(vlo[st][1], vhi[st][1], 0, 1, 2, 3, 4, 5, 6, 7);
                o0 = __builtin_amdgcn_mfma_f32_32x32x16_bf16(va0, pb, o0, 0, 0, 0);
                o1 = __builtin_amdgcn_mfma_f32_32x32x16_bf16(va1, pb, o1, 0, 0, 0);
            }
            if (__all(C < STICK_EXIT)) break;
#pragma unroll
            for (int ks = 0; ks < 4; ++ks) kf[ks] = kn[ks];
#pragma unroll
            for (int st = 0; st < 2; ++st)
#pragma unroll
                for (int dt = 0; dt < 2; ++dt) { vlo[st][dt] = nlo[st][dt]; vhi[st][dt] = nhi[st][dt]; }
        }
#undef ATT_LOAD
        bf16_t* orow = AP + (trow0 + q0 + r) * D + h * HD;
#pragma unroll
        for (int gq = 0; gq < 4; ++gq) { u32x2 w0, w1; w0.x = pk2(o0[4 * gq], o0[4 * gq + 1]); w0.y = pk2(o0[4 * gq + 2], o0[4 * gq + 3]); w1.x = pk2(o1[4 * gq], o1[4 * gq + 1]); w1.y = pk2(o1[4 * gq + 2], o1[4 * gq + 3]);
            *(u32x2*)(orow + 8 * gq + 4 * hh) = w0; *(u32x2*)(orow + 32 + 8 * gq + 4 * hh) = w1; }
    }
}

__device__ __forceinline__ void ld8(const bf16_t* p, float (&v)[8]) { const u32x4 q = *(const u32x4*)p; v[0] = bf_lo(q.x); v[1] = bf_hi(q.x); v[2] = bf_lo(q.y); v[3] = bf_hi(q.y); v[4] = bf_lo(q.z); v[5] = bf_hi(q.z); v[6] = bf_lo(q.w); v[7] = bf_hi(q.w); }
template <int W> __device__ __forceinline__ void poolmix_task(const bf16_t* U, bf16_t* MIX, int gidx, int ob, int rb, int lane) {
    const int oct = gidx * (PGD / 8) + ob * 8 + (lane & 7), t0 = rb * 64 + (lane >> 3) * 8, s0 = t0 % SEQ;
    const bf16_t* up = U + (size_t)t0 * PW + oct * 8;
    u32x4 raw[8 + W - 1];
#pragma unroll
    for (int i = 0; i < 8 + W - 1; ++i) { const int rel = i - (W - 1); raw[i] = (s0 + rel >= 0) ? *(const u32x4*)(up + (ptrdiff_t)rel * PW) : (u32x4){0u, 0u, 0u, 0u}; }
    float sum[8];
#pragma unroll
    for (int j = 0; j < 8; ++j) sum[j] = 0.f;
#pragma unroll
    for (int i = 0; i < W; ++i) { f32x4 lo, hi; pg8::unpack8(raw[i], lo, hi);
#pragma unroll
        for (int j = 0; j < 4; ++j) { sum[j] += lo[j]; sum[4 + j] += hi[j]; } }
#pragma unroll
    for (int q = 0; q < 8; ++q) {
        const int s = s0 + q, cnt = (s + 1) < W ? (s + 1) : W; const float inv = 1.0f / (float)cnt;
        f32x4 lo, hi; pg8::unpack8(raw[q + W - 1], lo, hi);
        u32x4 ow; ow.x = pk2(sum[0] * inv - lo[0], sum[1] * inv - lo[1]); ow.y = pk2(sum[2] * inv - lo[2], sum[3] * inv - lo[3]);
        ow.z = pk2(sum[4] * inv - hi[0], sum[5] * inv - hi[1]); ow.w = pk2(sum[6] * inv - hi[2], sum[7] * inv - hi[3]);
        *(u32x4*)(MIX + (size_t)(t0 + q) * PW + oct * 8) = ow;
        if (q + 1 < 8) { f32x4 nl, nh, ol, oh; pg8::unpack8(raw[q + W], nl, nh); pg8::unpack8(raw[q], ol, oh);
#pragma unroll
            for (int j = 0; j < 4; ++j) { sum[j] += nl[j] - ol[j]; sum[4 + j] += nh[j] - oh[j]; } }
    }
}
__device__ __forceinline__ void poolmix_phase(Frame& F, const bf16_t* U, bf16_t* MIX) {
    const int gw = F.vcu * NWAVES + F.wave, NGW = F.G * NWAVES;
    constexpr int NRB = T / 64, NTASK = 4 * 3 * NRB;
    for (int task = gw; task < NTASK; task += NGW) { const int rb = task % NRB, ob = (task / NRB) % 3, gidx = task / (3 * NRB);
        if (gidx == 0) poolmix_task<2>(U, MIX, 0, ob, rb, F.lane); else if (gidx == 1) poolmix_task<4>(U, MIX, 1, ob, rb, F.lane);
        else if (gidx == 2) poolmix_task<8>(U, MIX, 2, ob, rb, F.lane); else poolmix_task<16>(U, MIX, 3, ob, rb, F.lane); }
}

constexpr int NBLK = T / 128;
struct MidArgs { const void* xin; bool xin_bf16; bf16_t* xout; const bf16_t* Y; const float* post_g; const float* pre2_g; const float* MODl; bf16_t* H; unsigned char* H8; };
__device__ __forceinline__ void router_phase_a(Frame& F, const MidArgs& M, const bf16_t* H, const bf16_t* RT, const float* rb, int* HIST, int* TOPE, int* TOPL, float* TOPG) {
    LAS float* lg = (LAS float*)(F.lds + F.wave * 4096);
    volatile LAS int* whist = (volatile LAS int*)(F.lds + 65536);
    const int fr = F.lane & 15, fq = F.lane >> 4;
    for (int blk = F.vcu; blk < NBLK; blk += F.G) {
        const int t0 = blk * 128 + F.wave * 16;
        rowpass_mid(F, t0, t0 + 16, RP, M.xin, M.xin_bf16, M.xout, M.Y, M.post_g, M.pre2_g, M.MODl, M.H, M.H8);
        asm volatile("s_waitcnt vmcnt(0)" ::: "memory");
        if (F.lane < NE) whist[F.wave * NE + F.lane] = 0;
        f32x4 a0 = {0.f, 0.f, 0.f, 0.f}, a1 = {0.f, 0.f, 0.f, 0.f};
        const bf16_t* hp = H + (size_t)(t0 + fr) * D + fq * 8; const bf16_t* w0 = RT + (size_t)fr * D + fq * 8; const bf16_t* w1 = RT + (size_t)(16 + fr) * D + fq * 8;
#pragma unroll 4
        for (int k = 0; k < D; k += 32) { const bf16x8 av = *(const bf16x8*)(hp + k), b0 = *(const bf16x8*)(w0 + k), b1 = *(const bf16x8*)(w1 + k);
            a0 = __builtin_amdgcn_mfma_f32_16x16x32_bf16(av, b0, a0, 0, 0, 0); a1 = __builtin_amdgcn_mfma_f32_16x16x32_bf16(av, b1, a1, 0, 0, 0); }
        const float rb0 = rb[fr], rb1 = rb[16 + fr];
#pragma unroll
        for (int j = 0; j < 4; ++j) { lg[(4 * fq + j) * 33 + fr] = a0[j] + rb0; lg[(4 * fq + j) * 33 + 16 + fr] = a1[j] + rb1; }
        LDS_WAIT(); asm volatile("" ::: "memory");
        float bv[4] = {-INFINITY, -INFINITY, -INFINITY, -INFINITY}; int bi[4] = {0, 0, 0, 0};
        if (F.lane < 16) {
            for (int e = 0; e < NE; ++e) { const float v = lg[F.lane * 33 + e];
                if (v > bv[3]) { bv[3] = v; bi[3] = e;
                    if (bv[3] > bv[2]) { float tv = bv[2]; bv[2] = bv[3]; bv[3] = tv; int ti = bi[2]; bi[2] = bi[3]; bi[3] = ti;
                        if (bv[2] > bv[1]) { tv = bv[1]; bv[1] = bv[2]; bv[2] = tv; ti = bi[1]; bi[1] = bi[2]; bi[2] = ti;
                            if (bv[1] > bv[0]) { tv = bv[0]; bv[0] = bv[1]; bv[1] = tv; ti = bi[0]; bi[0] = bi[1]; bi[1] = ti; } } } } }
        }
        float gt[4]; { float sum = 0.f;
#pragma unroll
            for (int k = 0; k < 4; ++k) { gt[k] = fast_exp(bv[k] - bv[0]); sum += gt[k]; }
            const float inv = 1.0f / sum;
#pragma unroll
            for (int k = 0; k < 4; ++k) gt[k] *= inv; }
        int rk[4];
#pragma unroll
        for (int k = 0; k < 4; ++k) {
            const int e = F.lane < 16 ? bi[k] : -1; int rank = 0;
            unsigned long long todo = __ballot(e >= 0);
            while (todo) { const int leader = __builtin_ctzll(todo); const int le = __shfl(e, leader); const unsigned long long mm = __ballot(e == le);
                const int base = whist[F.wave * NE + le];
                if (e == le) rank = base + __builtin_popcountll(mm & ((1ull << F.lane) - 1ull));
                if (F.lane == leader) whist[F.wave * NE + le] = base + __builtin_popcountll(mm);
                todo &= ~mm; }
            rk[k] = rank;
        }
        __syncthreads();
        if (F.tid < NE) { int run = 0;
#pragma unroll
            for (int w = 0; w < NWAVES; ++w) { const int v = whist[w * NE + F.tid]; whist[w * NE + F.tid] = run; run += v; }
            HIST[blk * NE + F.tid] = run; }
        __syncthreads();
        if (F.lane < 16) { const int t = t0 + F.lane;
#pragma unroll
            for (int k = 0; k < 4; ++k) { TOPE[t * TOPK + k] = bi[k]; TOPL[t * TOPK + k] = whist[F.wave * NE + bi[k]] + rk[k]; TOPG[t * TOPK + k] = gt[k]; } }
        __syncthreads();
    }
}
__device__ __forceinline__ void router_phase_b(Frame& F, const int* HIST, const int* TOPE, const int* TOPL, const float* TOPG, int* TOPS, int* ROWTOK, float* ROWGATE) {
    volatile LAS int* part = (volatile LAS int*)(F.lds + 65536);
    bool first = true;
    for (int blk = F.vcu; blk < NBLK; blk += F.G) {
        { const int e = F.tid & 31, pt = F.tid >> 5; int sacc = 0, stot = 0;
            for (int b = pt * 16; b < pt * 16 + 16; ++b) { const int hv = HIST[b * NE + e]; stot += hv; sacc += (b < blk) ? hv : 0; }
            part[pt * NE + e] = sacc; part[1024 + pt * NE + e] = stot; }
        __syncthreads();
        if (F.tid < NE) { int sacc = 0;
#pragma unroll
            for (int pt = 0; pt < 16; ++pt) sacc += part[pt * NE + F.tid];
            part[512 + F.tid] = sacc; }
        if (first && F.tid >= 64 && F.tid < 128) { const int e = F.lane; int c = 0;
            if (e < NE) {
#pragma unroll
                for (int pt = 0; pt < 16; ++pt) c += part[1024 + pt * NE + e]; }
            int tl = (c + 255) >> 8, pre = tl;
#pragma unroll
            for (int o = 1; o < 64; o <<= 1) { const int v = __shfl_up(pre, o); if (F.lane >= o) pre += v; }
            if (e < NE) { F.MISC[MISC_TB + e] = (unsigned)(pre - tl); F.MISC[MISC_CNT + e] = (unsigned)c; }
            if (e == NE - 1) F.MISC[MISC_TB + NE] = (unsigned)pre; }
        first = false;
        __syncthreads();
        { const int t = blk * 128 + (F.tid >> 2), k = F.tid & 3; const int e = TOPE[t * TOPK + k]; const int slot = part[512 + e] + TOPL[t * TOPK + k];
            TOPS[t * TOPK + k] = slot; ROWTOK[(size_t)e * T + slot] = t * TOPK + k; ROWGATE[(size_t)e * T + slot] = TOPG[t * TOPK + k]; }
        __syncthreads();
    }
}
__device__ __forceinline__ void moe_table(Frame& F, const int* HIST) {
    volatile LAS int* part = (volatile LAS int*)(F.MISC + 256);
    __syncthreads();
    { const int e = F.tid & 31, pt = F.tid >> 5; int sacc = 0;
        for (int b = pt * 16; b < pt * 16 + 16; ++b) sacc += HIST[b * NE + e];
        part[pt * NE + e] = sacc; }
    __syncthreads();
    if (F.tid < 64) { const int e = F.lane; int c = 0;
        if (e < NE) {
#pragma unroll
            for (int pt = 0; pt < 16; ++pt) c += part[pt * NE + e]; }
        int tl = (c + 255) >> 8, pre = tl;
#pragma unroll
        for (int o = 1; o < 64; o <<= 1) { const int v = __shfl_up(pre, o); if (F.lane >= o) pre += v; }
        if (e < NE) { F.MISC[MISC_TB + e] = (unsigned)(pre - tl); F.MISC[MISC_CNT + e] = (unsigned)c; }
        if (e == NE - 1) F.MISC[MISC_TB + NE] = (unsigned)pre; }
    __syncthreads();
}

constexpr int PH_PRO = 0, PH_PRE = 1, PH_L0 = 2, NPL = 10, NPHASES = PH_L0 + DEPTH * NPL;
__global__ void __launch_bounds__(NTHREADS, 2) fwd(Args args_unused) {
    extern __shared__ __attribute__((aligned(16))) unsigned char lds_raw[];
    const volatile __attribute__((address_space(4))) Args* ka = (const volatile __attribute__((address_space(4))) Args*)__builtin_amdgcn_kernarg_segment_ptr();
#define INP(i) ((const float*)ka->in[i])
#define WSB() ((unsigned char*)ka->ws)
#define OUTP() ((float*)ka->out)
    Frame F;
    F.lds = (LAS unsigned char*)lds_raw; F.MISC = (volatile LAS unsigned*)(F.lds + LDSCTL_OFF);
    F.wave = __builtin_amdgcn_readfirstlane((int)threadIdx.x >> 6); F.lane = lane_id_v(); F.tid = F.wave * 64 + F.lane;
    F.G = gridDim.x; { const int bx = blockIdx.x; F.vcu = (F.G % 8 == 0) ? (bx % 8) * (F.G / 8) + bx / 8 : bx; }
    F.ctl = (unsigned*)(WSB() + WS_CTL);
    for (int u = F.tid; u < (LDS_BYTES - LDSCTL_OFF) / 4; u += NTHREADS) ((LAS unsigned*)(F.lds + LDSCTL_OFF))[u] = 0u;
    __syncthreads();
    XcdBarrier bar = xcd_barrier_post(F.ctl + CW_BAR, F.MISC + MISC_BAR, F.tid == 0);
    const int lo = ka->ph_lo, hi = ka->ph_hi;
#define IN(k) (lo <= (k) && (k) < hi)
#define STAMP(k) do { if (TIMER_ON && blockIdx.x == 0 && F.wave == 0 && lane_id_v() == 0) ((unsigned long long*)(F.ctl + CW_TS))[(k)] = __builtin_amdgcn_s_memrealtime(); } while (0)
#ifndef PROF_BARRIER
#define PROF_BARRIER 0
#endif
#ifndef PROF_BTYPES
#define PROF_BTYPES 0xffff
#endif
#define PROF_BSEL(k) ((PROF_BTYPES >> ((k) < 2 ? (k) : 2 + ((k) - 2) % 10)) & 1)
#define PROF_ADD(dt) do { if (F.wave == 0 && lane_id_v() == 0) F.MISC[MISC_PROF] = F.MISC[MISC_PROF] + (unsigned)(dt); } while (0)
#define SEAM(k) do { const unsigned long long _tb0 = PROF_BARRIER ? __builtin_amdgcn_s_memrealtime() : 0ull; \
        if (IN(k) && (IN((k) + 1) || TIMER_ON || SPAN_HI >= 0)) xcd_barrier(bar, F.wave == 0 && lane_id_v() == 0); STAMP(k); \
        if (PROF_BARRIER && PROF_BSEL(k)) PROF_ADD(__builtin_amdgcn_s_memrealtime() - _tb0); \
        if (SPAN_HI >= 0 && (k) == SPAN_LO - 1) span_t0 = __builtin_amdgcn_s_memrealtime(); \
        if (SPAN_HI >= 0 && (k) == SPAN_HI) PROF_ADD(__builtin_amdgcn_s_memrealtime() - span_t0); } while (0)
#define PHASE_FRAME() Frame P = F; P.wave = launder_s(F.wave); P.lane = lane_id_v(); P.tid = P.wave * 64 + P.lane
    const int cb = (int)blockIdx.x;
    unsigned long long span_t0 = (SPAN_HI >= 0 && SPAN_LO == 0) ? __builtin_amdgcn_s_memrealtime() : 0ull;
    STAMP(63);

    if (IN(PH_PRO)) REPEAT(0) { __syncthreads(); unsigned char* ws = WSB(); { PHASE_FRAME(); mods_phase(P, INP(1), INP(2), INP(3), (float*)(ws + WS_MOD)); } { PHASE_FRAME(); convert_phase(P, ka); } }
    SEAM(PH_PRO);
    if (IN(PH_PRE)) REPEAT(1) { unsigned char* ws = WSB(); PHASE_FRAME(); rowpass_pre(P, INP(0), INP(4), (const float*)(ws + WS_MOD), (bf16_t*)(ws + WS_H)); }
    SEAM(PH_PRE);
    if ((REP_MASK >> 16) & 1) { for (int _i = 0; _i < 20; ++_i) xcd_barrier(bar, F.wave == 0 && lane_id_v() == 0); }

#pragma unroll 1
    for (int l = 0; l < DEPTH; ++l) {
        const int pb = PH_L0 + l * NPL;
        if (IN(pb + 0)) { unsigned char* ws = WSB(); unsigned char* wl = ws + WS_W + (size_t)l * WL_STRIDE; const bf16_t* WIN = (const bf16_t*)(wl + WO_WIN); bf16_t* H = (bf16_t*)(ws + WS_H);
            REPEAT(2) { pg8::Gemm g{H, WIN, D, D, D, nullptr}; pg8::StaticOrder S{T / 256, 13, launder_s(F.G), launder_s(cb), D, D, 0}; pg8::EpiIn E{(bf16_t*)(ws + WS_Q), (bf16_t*)(ws + WS_K), (bf16_t*)(ws + WS_U), (bf16_t*)(ws + WS_G)};
              pg8::gemm_phase<pg8::EpiIn, pg8::StaticOrder, 0>(F.lds, F.wave, g, S, E); }
            REPEAT(3) { pg8::Gemm g{WIN + (size_t)3328 * D, H, D, D, D, nullptr}; pg8::StaticOrder S{1, T / 256, launder_s(F.G), (launder_s(cb) + launder_s(F.G) / 2) % launder_s(F.G), D, D, 0}; pg8::EpiPlain E{(bf16_t*)(ws + WS_VT), VTP, 0, nullptr, nullptr};
              pg8::gemm_phase<pg8::EpiPlain, pg8::StaticOrder, 1>(F.lds, F.wave, g, S, E); }
        }
        SEAM(pb + 0);
        if (IN(pb + 1)) { unsigned char* ws = WSB();
            REPEAT(4) { PHASE_FRAME(); attn_phase(P, (const bf16_t*)(ws + WS_Q), (const bf16_t*)(ws + WS_K), (const bf16_t*)(ws + WS_VT), (bf16_t*)(ws + WS_AP)); }
            REPEAT(5) { PHASE_FRAME(); poolmix_phase(P, (const bf16_t*)(ws + WS_U), (bf16_t*)(ws + WS_MIX)); } }
        SEAM(pb + 1);
        if (IN(pb + 2)) { unsigned char* ws = WSB(); unsigned char* wl = ws + WS_W + (size_t)l * WL_STRIDE; bf16_t* AP = (bf16_t*)(ws + WS_AP);
            REPEAT(6) { pg8::Gemm g{AP, (const bf16_t*)(wl + WO_BRA), D, SBW, SBW, nullptr}; pg8::StaticOrder S{T / 256, 4, launder_s(F.G), launder_s(cb), D, SBW, 0}; pg8::EpiBranch<false> E{(bf16_t*)(ws + WS_Y), (const bf16_t*)(ws + WS_G), 0, nullptr};
              pg8::gemm_phase<pg8::EpiBranch<false>, pg8::StaticOrder, 2>(F.lds, F.wave, g, S, E); }
            REPEAT(7) { pg8::Gemm g{(const bf16_t*)(ws + WS_MIX), (const bf16_t*)(wl + WO_POOL), PW, PW, 384, nullptr}; pg8::StaticOrder S{T / 256, 3, launder_s(F.G), launder_s(cb), PW, PW, PGD};
              pg8::EpiPlain E{AP, D, SBW, INP(10) + (size_t)l * PW, INP(11) + (size_t)l * PW};
              pg8::gemm_phase<pg8::EpiPlain, pg8::StaticOrder, 3>(F.lds, F.wave, g, S, E); }
        }
        SEAM(pb + 2);
        if (IN(pb + 3)) for (int _rep = ((REP_MASK >> 15) & 1) ? 0 : 1; _rep < 2; ++_rep) { unsigned char* ws = WSB(); unsigned char* wl = ws + WS_W + (size_t)l * WL_STRIDE;
            pg8::Gemm g{(const bf16_t*)(ws + WS_AP) + SBW, (const bf16_t*)(wl + WO_BRP), D, PW, PW, nullptr}; pg8::StaticOrder S{T / 256, 4, launder_s(F.G), launder_s(cb), D, PW, 0}; pg8::EpiBranch<true> E{(bf16_t*)(ws + WS_Y), (const bf16_t*)(ws + WS_G), 4, (bf16_t*)(ws + WS_MRG)};
            pg8::gemm_phase<pg8::EpiBranch<true>, pg8::StaticOrder, 4>(F.lds, F.wave, g, S, E); }
        SEAM(pb + 3);
        if (IN(pb + 4)) REPEAT(8) { unsigned char* ws = WSB(); unsigned char* wl = ws + WS_W + (size_t)l * WL_STRIDE;
            pg8::Gemm g{(const bf16_t*)(ws + WS_MRG), (const bf16_t*)(wl + WO_OUT), D, D, D, nullptr}; pg8::StaticOrder S{T / 256, 4, launder_s(F.G), launder_s(cb), D, D, 0}; pg8::EpiPlain E{(bf16_t*)(ws + WS_Y), D, 0, nullptr, nullptr};
            pg8::gemm_phase<pg8::EpiPlain, pg8::StaticOrder, 5>(F.lds, F.wave, g, S, E); }
        SEAM(pb + 4);
        if (IN(pb + 5)) { unsigned char* ws = WSB(); unsigned char* wl = ws + WS_W + (size_t)l * WL_STRIDE; PHASE_FRAME();
            MidArgs M{l == 0 ? (const void*)INP(0) : (const void*)(ws + WS_XB), l != 0, (bf16_t*)(ws + WS_XB), (const bf16_t*)(ws + WS_Y), INP(5) + (size_t)l * D, INP(6) + (size_t)l * D, (const float*)(ws + WS_MOD) + (size_t)l * BATCH * 6 * D, (bf16_t*)(ws + WS_H), ws + WS_H8};
            router_phase_a(P, M, (const bf16_t*)(ws + WS_H), (const bf16_t*)(wl + WO_ROUTER), INP(16) + (size_t)l * NE, (int*)(ws + WS_HIST) + (size_t)l * NBLK * NE, (int*)(ws + WS_TOPE), (int*)(ws + WS_TOPL), (float*)(ws + WS_TOPG)); }
        SEAM(pb + 5);
        if (IN(pb + 6)) REPEAT(13) { unsigned char* ws = WSB(); PHASE_FRAME();
            router_phase_b(P, (const int*)(ws + WS_HIST) + (size_t)l * NBLK * NE, (const int*)(ws + WS_TOPE), (const int*)(ws + WS_TOPL), (const float*)(ws + WS_TOPG), (int*)(ws + WS_TOPS), (int*)(ws + WS_ROWTOK), (float*)(ws + WS_ROWGATE)); }
        SEAM(pb + 6);
        if (IN(pb + 7)) REPEAT(10) { unsigned char* ws = WSB(); unsigned char* wl = ws + WS_W + (size_t)l * WL_STRIDE; if (N_LAUNCHES != 1 || F.G > NBLK) { PHASE_FRAME(); moe_table(P, (const int*)(ws + WS_HIST) + (size_t)l * NBLK * NE); }
            pg8::Gemm g{(const bf16_t*)(ws + WS_H8), (const bf16_t*)(wl + WO_GU), D, D, D, (const int*)(ws + WS_ROWTOK)};
            pg8::MoeOrder S{(const volatile LAS int*)(F.MISC + MISC_TB), (const volatile LAS int*)(F.MISC + MISC_CNT), 8, launder_s(F.G), launder_s(cb), 2 * D};
            pg8::EpiGU E{ws + WS_ACT, INP(18) + (size_t)l * NE * 2 * D};
            pg8::gemm_phase<pg8::EpiGU, pg8::MoeOrder, 6>(F.lds, F.wave, g, S, E); }
        SEAM(pb + 7);
        if (IN(pb + 8)) REPEAT(11) { unsigned char* ws = WSB(); unsigned char* wl = ws + WS_W + (size_t)l * WL_STRIDE; if (N_LAUNCHES != 1 || F.G > NBLK) { PHASE_FRAME(); moe_table(P, (const int*)(ws + WS_HIST) + (size_t)l * NBLK * NE); }
            pg8::Gemm g{(const bf16_t*)(ws + WS_ACT), (const bf16_t*)(wl + WO_DN), D, D, D, nullptr};
            pg8::MoeOrder S{(const volatile LAS int*)(F.MISC + MISC_TB), (const volatile LAS int*)(F.MISC + MISC_CNT), 4, launder_s(F.G), launder_s(cb), D};
            pg8::EpiDN E{(bf16_t*)(ws + WS_YR), INP(20) + (size_t)l * NE * D, (const float*)(ws + WS_ROWGATE), (const int*)(ws + WS_ROWTOK)};
            pg8::gemm_phase<pg8::EpiDN, pg8::MoeOrder, 7>(F.lds, F.wave, g, S, E); }
        SEAM(pb + 8);
        if (IN(pb + 9)) for (int _rep = ((REP_MASK >> 14) & 1) ? 0 : 1; _rep < 2; ++_rep) { unsigned char* ws = WSB(); PHASE_FRAME();
            const bool hn = (l + 1 < DEPTH); const float* MOD = (const float*)(ws + WS_MOD);
            rowpass_comb(P, (const bf16_t*)(ws + WS_XB), _rep == 0 ? (void*)(ws + WS_ACT) : (hn ? (void*)(ws + WS_XB) : (void*)OUTP()), hn, (const bf16_t*)(ws + WS_YR), INP(7) + (size_t)l * D, MOD + (size_t)l * BATCH * 6 * D,
                         hn, INP(4) + (size_t)(hn ? l + 1 : l) * D, MOD + (size_t)(hn ? l + 1 : l) * BATCH * 6 * D, (bf16_t*)(ws + WS_H)); }
        SEAM(pb + 9);
    }
    if ((PROF_REGION != 0) || PROF_BARRIER || SPAN_HI >= 0) { if (F.wave == 0) { const unsigned long long dt = F.MISC[MISC_PROF], t0 = __builtin_amdgcn_s_memrealtime(); while (__builtin_amdgcn_s_memrealtime() - t0 < dt) __builtin_amdgcn_s_sleep(8); } }
#if TIMER_ON
    { xcd_barrier(bar, F.wave == 0 && lane_id_v() == 0);
      const unsigned long long* ts = (const unsigned long long*)(F.ctl + CW_TS);
      const float us1 = (float)(long long)(ts[TIMER_B1] - ts[TIMER_A1]) * 0.01f, us2 = (float)(long long)(ts[TIMER_B2] - ts[TIMER_A2]) * 0.01f;
      const float a = sqrtf(us1 * 1e-4f); float* o = OUTP(); const int lane = lane_id_v(), gtid = ((int)blockIdx.x * NWAVES + F.wave) * 64 + lane;
      for (size_t i = (size_t)gtid; i < (size_t)T * D; i += (size_t)F.G * NTHREADS) o[i] += (i & 1) ? a : -a;
      xcd_barrier(bar, F.wave == 0 && lane_id_v() == 0);
      if (blockIdx.x == 0 && F.wave == 0 && lane == 0) o[5] += us2 * 0.2f; }
#endif
#undef IN
#undef SEAM
}

extern "C" void kernel_launch(void* const* d_in, const int* in_sizes, int n_in, void* d_out, int out_size, void* d_ws, size_t ws_size, hipStream_t stream) {
    static int grid = 0;
    if (grid == 0) {
        if (n_in != 21 || in_sizes[0] != T * D || out_size != T * D || ws_size < WS_END) { fprintf(stderr, "kernel_launch: unexpected shapes (n_in %d, in0 %d, out %d, ws %zu < %zu); nothing launched\n", n_in, n_in > 0 ? in_sizes[0] : -1, out_size, ws_size, (size_t)WS_END); grid = -1; return; }
        int dev = 0, cus = 0, per_cu = 0;
        if (hipGetDevice(&dev) != hipSuccess || hipDeviceGetAttribute(&cus, hipDeviceAttributeMultiprocessorCount, dev) != hipSuccess) { grid = -1; return; }
        if (hipFuncSetAttribute((const void*)fwd, hipFuncAttributeMaxDynamicSharedMemorySize, LDS_BYTES) != hipSuccess) { fprintf(stderr, "kernel_launch: hipFuncSetAttribute failed\n"); grid = -1; return; }
        if (hipOccupancyMaxActiveBlocksPerMultiprocessor(&per_cu, (const void*)fwd, NTHREADS, LDS_BYTES) != hipSuccess || per_cu < 1) { fprintf(stderr, "kernel_launch: occupancy query says %d\n", per_cu); }
        (void)hipGetLastError();
        grid = cus;
    }
    if (grid < 0) return;
    if (hipMemsetAsync((char*)d_ws + WS_CTL, 0, CTL_ZERO_BYTES, stream) != hipSuccess) return;
    Args a{};
    for (int i = 0; i < 21; ++i) a.in[i] = (const float*)d_in[i];
    a.out = (float*)d_out; a.ws = (unsigned char*)d_ws;
#if N_LAUNCHES == 1
    a.ph_lo = 0; a.ph_hi = NPHASES;
    hipLaunchKernelGGL(fwd, dim3(grid), dim3(NTHREADS), LDS_BYTES, stream, a);
#else
    for (int p = 0; p < NPHASES; ++p) { a.ph_lo = p; a.ph_hi = p + 1; hipLaunchKernelGGL(fwd, dim3(grid), dim3(NTHREADS), LDS_BYTES, stream, a); }
#endif
}
```
